# Optimizing an MI355X kernel written in HIP

```python
import jax, jax.numpy as jnp
from jax import lax
import numpy as np

D_MODEL = 1024
BATCH = 8
SEQ = 2048
DEPTH = 2

CONV_GROUPS = 4
CONV_GROUP_DIM = 128
CONV_DIM = CONV_GROUPS * CONV_GROUP_DIM
CONV_WIDTH = 31
SGU_HEADS = 4
SGU_HEAD_DIM = 128
SGU_DIM = SGU_HEADS * SGU_HEAD_DIM
CHUNK = 128
EVEN_IN = 2 * CONV_DIM + 2 * SGU_DIM
EVEN_MIX = CONV_DIM + SGU_DIM

MLA_HEADS = 8
MLA_Q_RANK = 256
MLA_KV_RANK = 128
MLA_NOPE = 64
MLA_ROPE = 32
MLA_V = 64
ROPE_THETA = 10000.0
SWA_HEADS = 8
SWA_KV_HEADS = 2
SWA_HEAD_DIM = 64
WINDOW = 128
BLOCK = 128
ODD_SPLITS = (MLA_Q_RANK, MLA_KV_RANK, MLA_ROPE, SWA_HEADS * SWA_HEAD_DIM,
              SWA_KV_HEADS * SWA_HEAD_DIM, SWA_KV_HEADS * SWA_HEAD_DIM)
ODD_IN = sum(ODD_SPLITS)
ODD_MIX = MLA_HEADS * MLA_V + SWA_HEADS * SWA_HEAD_DIM

N_GROUPS = 4
EXPERTS_PER_GROUP = 8
TOP_K = 2
D_EXPERT = 256

EPS = 1e-6
NEG_INF = -1e30

kernel_name = "hybrid_conv_sgu_mla_swa_hmoe_encoder"


def _rmsnorm(x, g):
    xf = x.astype(jnp.float32)
    y = xf * lax.rsqrt(jnp.mean(xf * xf, axis=-1, keepdims=True) + EPS)
    return (y * g.astype(jnp.float32)).astype(x.dtype)


def _layernorm(x, g, b):
    xf = x.astype(jnp.float32)
    mu = jnp.mean(xf, axis=-1, keepdims=True)
    var = jnp.mean(jnp.square(xf - mu), axis=-1, keepdims=True)
    y = (xf - mu) * lax.rsqrt(var + EPS)
    return (y * g.astype(jnp.float32) + b.astype(jnp.float32)).astype(x.dtype)


def _split_at(p, sizes):
    offs = np.cumsum(sizes)[:-1].tolist()
    return jnp.split(p, offs, axis=-1)


def _conv_sgu_mixer(h, w_in, conv_w, conv_b, cnorm_g, cnorm_b, vnorm_g, vnorm_b, w_sp, b_sp, w_out):
    B, S, _ = h.shape
    p = h @ w_in
    a_val, a_gate, u, v = _split_at(p, (CONV_DIM, CONV_DIM, SGU_DIM, SGU_DIM))
    a = a_val * jax.nn.sigmoid(a_gate)
    a = lax.conv_general_dilated(a, conv_w[:, None, :], window_strides=(1,),
                                 padding=[(CONV_WIDTH // 2, CONV_WIDTH // 2)],
                                 dimension_numbers=('NWC', 'WIO', 'NWC'),
                                 feature_group_count=CONV_DIM) + conv_b
    a = _layernorm(a.reshape(B, S, CONV_GROUPS, CONV_GROUP_DIM),
                   cnorm_g.reshape(CONV_GROUPS, CONV_GROUP_DIM),
                   cnorm_b.reshape(CONV_GROUPS, CONV_GROUP_DIM)).reshape(B, S, CONV_DIM)
    a = jax.nn.silu(a)
    nc = S // CHUNK
    u = jax.nn.gelu(u).reshape(B, nc, CHUNK, SGU_HEADS, SGU_HEAD_DIM)
    v = jax.nn.gelu(v).reshape(B, nc, CHUNK, SGU_HEADS, SGU_HEAD_DIM)
    v = _layernorm(v, vnorm_g.reshape(SGU_HEADS, SGU_HEAD_DIM), vnorm_b.reshape(SGU_HEADS, SGU_HEAD_DIM))
    sv = jnp.einsum('hts,bnshc->bnthc', w_sp, v) + jnp.swapaxes(b_sp, 0, 1)[:, :, None]
    s_out = (u * sv).reshape(B, S, SGU_DIM)
    return jnp.concatenate([a, s_out], axis=-1) @ w_out


def _rope_tables(S, dim):
    pos = jnp.arange(S, dtype=jnp.float32)
    inv = 1.0 / (ROPE_THETA ** (jnp.arange(0, dim, 2, dtype=jnp.float32) / dim))
    ang = pos[:, None] * inv[None, :]
    ang = jnp.concatenate([ang, ang], axis=-1)
    return jnp.cos(ang), jnp.sin(ang)


def _apply_rope(x, cos, sin):
    xf = x.astype(jnp.float32)
    x1, x2 = jnp.split(xf, 2, axis=-1)
    rot = jnp.concatenate([-x2, x1], axis=-1)
    return (xf * cos + rot * sin).astype(x.dtype)


def _alibi_slopes(n_heads):
    return jnp.exp2(-8.0 * jnp.arange(1, n_heads + 1, dtype=jnp.float32) / n_heads)


def _dense_attention(q, k, v):
    B, S, H, dqk = q.shape
    scale = dqk ** -0.5
    nb = S // BLOCK
    qb = q.reshape(B, nb, BLOCK, H, dqk).transpose(1, 0, 2, 3, 4)

    def one_block(qblk):
        s = jnp.einsum('bqhd,bkhd->bhqk', qblk, k).astype(jnp.float32) * scale
        p = jax.nn.softmax(s, axis=-1).astype(v.dtype)
        return jnp.einsum('bhqk,bkhd->bqhd', p, v)

    out = lax.map(one_block, qb)
    return out.transpose(1, 0, 2, 3, 4).reshape(B, S, H, v.shape[-1])


def _window_gqa_attention(q, k, v, sink):
    B, S, Hq, dh = q.shape
    G = k.shape[2]
    R = Hq // G
    nb = S // BLOCK
    span = BLOCK + 2 * WINDOW
    qb = q.reshape(B, nb, BLOCK, G, R, dh)
    idx = jnp.arange(nb)[:, None] * BLOCK + jnp.arange(span)[None, :]
    kp = jnp.pad(k, ((0, 0), (WINDOW, WINDOW), (0, 0), (0, 0)))
    vp = jnp.pad(v, ((0, 0), (WINDOW, WINDOW), (0, 0), (0, 0)))
    kb = kp[:, idx]
    vb = vp[:, idx]
    s = jnp.einsum('bnqgrd,bnkgd->bngrqk', qb, kb).astype(jnp.float32) * (dh ** -0.5)
    qi = jnp.arange(BLOCK)
    kj = jnp.arange(span)
    dist = qi[:, None] + WINDOW - kj[None, :]
    in_win = jnp.abs(dist) <= WINDOW
    kpos = jnp.arange(nb)[:, None] * BLOCK - WINDOW + kj[None, :]
    in_seq = (kpos >= 0) & (kpos < S)
    mask = in_win[None] & in_seq[:, None, :]
    slopes = _alibi_slopes(Hq).reshape(G, R)
    bias = -slopes[:, :, None, None] * jnp.abs(dist).astype(jnp.float32)
    s = jnp.where(mask[None, :, None, None], s + bias, NEG_INF)
    sk = sink.astype(jnp.float32).reshape(G, R)[:, :, None]
    m = jnp.maximum(jnp.max(s, axis=-1), sk)
    e = jnp.exp(s - m[..., None])
    denom = jnp.sum(e, axis=-1) + jnp.exp(sk - m)
    pr = (e / denom[..., None]).astype(v.dtype)
    o = jnp.einsum('bngrqk,bnkgd->bnqgrd', pr, vb)
    return o.reshape(B, S, Hq, dh)


def _mla_swa_mixer(h, w_in, g_cq, w_uq, g_ckv, w_ukv, sink, w_out):
    B, S, _ = h.shape
    p = h @ w_in
    c_q, c_kv, k_pe, q_s, k_s, v_s = _split_at(p, ODD_SPLITS)
    cos, sin = _rope_tables(S, MLA_ROPE)
    q = (_rmsnorm(c_q, g_cq) @ w_uq).reshape(B, S, MLA_HEADS, MLA_NOPE + MLA_ROPE)
    q_nope, q_pe = jnp.split(q, [MLA_NOPE], axis=-1)
    q_pe = _apply_rope(q_pe, cos[:, None, :], sin[:, None, :])
    kv = (_rmsnorm(c_kv, g_ckv) @ w_ukv).reshape(B, S, MLA_HEADS, MLA_NOPE + MLA_V)
    k_nope, v_mla = jnp.split(kv, [MLA_NOPE], axis=-1)
    k_pe = _apply_rope(k_pe, cos, sin)
    q_full = jnp.concatenate([q_nope, q_pe], axis=-1)
    k_full = jnp.concatenate([k_nope, jnp.broadcast_to(k_pe[:, :, None, :], (B, S, MLA_HEADS, MLA_ROPE))], axis=-1)
    mla = _dense_attention(q_full, k_full, v_mla).reshape(B, S, MLA_HEADS * MLA_V)
    swa = _window_gqa_attention(q_s.reshape(B, S, SWA_HEADS, SWA_HEAD_DIM),
                                k_s.reshape(B, S, SWA_KV_HEADS, SWA_HEAD_DIM),
                                v_s.reshape(B, S, SWA_KV_HEADS, SWA_HEAD_DIM),
                                sink).reshape(B, S, SWA_HEADS * SWA_HEAD_DIM)
    return jnp.concatenate([mla, swa], axis=-1) @ w_out


def _hier_moe(h, w_group, b_group, w_router, b_router, w_gate, w_up, w_down):
    B, S, D = h.shape
    f32 = jnp.float32
    t = h.reshape(B * S, D)
    group_prob = jax.nn.softmax((t @ w_group).astype(f32) + b_group.astype(f32), axis=-1)
    g_p, g_idx = lax.top_k(group_prob, 1)
    exp_logits = jnp.einsum('td,gde->tge', t, w_router).astype(f32) + b_router.astype(f32)
    sel = jnp.take_along_axis(exp_logits, g_idx[:, :, None], axis=1)[:, 0]
    top_v, top_i = lax.top_k(sel, TOP_K)
    top_w = jax.nn.softmax(top_v, axis=-1) * g_p
    within = jnp.einsum('tk,tke->te', top_w, jax.nn.one_hot(top_i, EXPERTS_PER_GROUP, dtype=f32))
    gate = jax.nn.one_hot(g_idx[:, 0], N_GROUPS, dtype=f32)[:, :, None] * within[:, None, :]
    y = jnp.zeros((B * S, D), f32)
    for g in range(N_GROUPS):
        hid = jax.nn.silu(jnp.einsum('td,edf->tef', t, w_gate[g])) * jnp.einsum('td,edf->tef', t, w_up[g])
        hid = hid * gate[:, g, :, None].astype(hid.dtype)
        y = y + jnp.einsum('tef,efd->td', hid, w_down[g]).astype(f32)
    return y.astype(h.dtype).reshape(B, S, D)


def setup_inputs(seed: int = 0) -> dict:
    key = jax.random.key(seed)
    ks = list(jax.random.split(key, 32))
    f32 = jnp.float32
    ne = (DEPTH + 1) // 2
    no = DEPTH // 2

    def nrm(shape, scale):
        return jax.random.normal(ks.pop(), shape, f32) * scale

    def gain(shape):
        return 1.0 + nrm(shape, 0.1)

    D = D_MODEL
    ng, ne_g, F = N_GROUPS, EXPERTS_PER_GROUP, D_EXPERT
    return {
        "x": nrm((BATCH, SEQ, D), 1.0),
        "norm_mix": gain((DEPTH, D)),
        "norm_ffn": gain((DEPTH, D)),
        "norm_final": gain((D,)),
        "ev_w_in": nrm((ne, D, EVEN_IN), D ** -0.5),
        "ev_conv_w": nrm((ne, CONV_WIDTH, CONV_DIM), CONV_WIDTH ** -0.5),
        "ev_conv_b": nrm((ne, CONV_DIM), 0.02),
        "ev_cnorm_g": gain((ne, CONV_DIM)),
        "ev_cnorm_b": nrm((ne, CONV_DIM), 0.02),
        "ev_vnorm_g": gain((ne, SGU_DIM)),
        "ev_vnorm_b": nrm((ne, SGU_DIM), 0.02),
        "ev_w_sp": nrm((ne, SGU_HEADS, CHUNK, CHUNK), CHUNK ** -0.5),
        "ev_b_sp": gain((ne, SGU_HEADS, CHUNK)),
        "ev_w_out": nrm((ne, EVEN_MIX, D), EVEN_MIX ** -0.5),
        "od_w_in": nrm((no, D, ODD_IN), D ** -0.5),
        "od_g_cq": gain((no, MLA_Q_RANK)),
        "od_w_uq": nrm((no, MLA_Q_RANK, MLA_HEADS * (MLA_NOPE + MLA_ROPE)), MLA_Q_RANK ** -0.5),
        "od_g_ckv": gain((no, MLA_KV_RANK)),
        "od_w_ukv": nrm((no, MLA_KV_RANK, MLA_HEADS * (MLA_NOPE + MLA_V)), MLA_KV_RANK ** -0.5),
        "od_sink": nrm((no, SWA_HEADS), 1.0),
        "od_w_out": nrm((no, ODD_MIX, D), ODD_MIX ** -0.5),
        "moe_w_group": nrm((DEPTH, D, ng), D ** -0.5),
        "moe_b_group": nrm((DEPTH, ng), 0.01),
        "moe_w_router": nrm((DEPTH, ng, D, ne_g), D ** -0.5),
        "moe_b_router": nrm((DEPTH, ng, ne_g), 0.01),
        "moe_w_gate": nrm((DEPTH, ng, ne_g, D, F), D ** -0.5),
        "moe_w_up": nrm((DEPTH, ng, ne_g, D, F), D ** -0.5),
        "moe_w_down": nrm((DEPTH, ng, ne_g, F, D), F ** -0.5),
    }


def reference(x, norm_mix, norm_ffn, norm_final,
              ev_w_in, ev_conv_w, ev_conv_b, ev_cnorm_g, ev_cnorm_b, ev_vnorm_g, ev_vnorm_b,
              ev_w_sp, ev_b_sp, ev_w_out,
              od_w_in, od_g_cq, od_w_uq, od_g_ckv, od_w_ukv, od_sink, od_w_out,
              moe_w_group, moe_b_group, moe_w_router, moe_b_router, moe_w_gate, moe_w_up, moe_w_down):
    for layer in range(DEPTH):
        i = layer // 2
        h = _rmsnorm(x, norm_mix[layer])
        if layer % 2 == 0:
            x = x + _conv_sgu_mixer(h, ev_w_in[i], ev_conv_w[i], ev_conv_b[i], ev_cnorm_g[i], ev_cnorm_b[i],
                                    ev_vnorm_g[i], ev_vnorm_b[i], ev_w_sp[i], ev_b_sp[i], ev_w_out[i])
        else:
            x = x + _mla_swa_mixer(h, od_w_in[i], od_g_cq[i], od_w_uq[i], od_g_ckv[i], od_w_ukv[i],
                                   od_sink[i], od_w_out[i])
        h = _rmsnorm(x, norm_ffn[layer])
        x = x + _hier_moe(h, moe_w_group[layer], moe_b_group[layer], moe_w_router[layer], moe_b_router[layer],
                          moe_w_gate[layer], moe_w_up[layer], moe_w_down[layer])
    return _rmsnorm(x, norm_final)
```

```cpp
#define MK_PF1 2
#define MK_PF2 2
#include <hip/hip_runtime.h>
#include <hip/hip_bf16.h>
#include <cstdio>
#include <cstdint>
namespace pg8 {
#define PG8_LAS __attribute__((address_space(3)))
typedef unsigned short bf16_t;
typedef short bf16x8 __attribute__((ext_vector_type(8)));
typedef float f32x4 __attribute__((ext_vector_type(4)));
typedef unsigned u32x4 __attribute__((ext_vector_type(4)));
constexpr int BM = 256, BK = 64, HALF = 128, HTB = HALF * BK * 2  , STAGE_BYTES = 8 * HTB, NXCD = 8, WGM = 8;

__host__ __device__ __forceinline__ int lds_byte(int r, int c) { const int st = (r >> 4) * 2 + (c >> 5), rr = r & 15, cc = c & 31, ob = rr * 64 + cc * 2; return st * 1024 + (ob ^ (((ob >> 9) & 1) << 5)); }
__host__ __device__ __forceinline__ void stage_rc(int b, int& R, int& C) { const int st = b / 1024, sb = b % 1024, swz = sb ^ (((sb >> 9) & 1) << 5); R = (st >> 1) * 16 + swz / 64; C = (st & 1) * 32 + (swz % 64) / 2; }
__host__ __device__ __forceinline__ int perm32(int rho) { const int n = rho >> 4, i = rho & 15; return 8 * (i >> 2) + 4 * n + (i & 3); }

struct Unit { int pm, pn, aoff; };
struct Gemm { const bf16_t* A; const bf16_t* Bt; int M, N, K, lda, ldb; };

struct StaticOrder {
    int nM, nN, nwg, G, c;
    __host__ __device__ void init(int M, int N, int G_, int c_) { nM = M / BM; nN = N / BM; nwg = nM * nN; G = G_; c = c_; }
    __host__ __device__ bool next(int i, Unit& u) const {
        const long L = (long)i * G + c; if (L >= nwg) return false;
        int wgid = (int)L; { const int q = nwg / NXCD, r = nwg % NXCD, xcd = wgid % NXCD, off = wgid / NXCD; wgid = (xcd < r ? xcd * (q + 1) : r * (q + 1) + (xcd - r) * q) + off; }
        const int nig = WGM * nN, gid = wgid / nig, fm = gid * WGM, gsz = (nM - fm) < WGM ? (nM - fm) : WGM;
        u.pm = fm + ((wgid % nig) % gsz); u.pn = (wgid % nig) / gsz; u.aoff = 0; return true;
    }
    __device__ __forceinline__ void a_ready(const Unit&) const {}
    __device__ __forceinline__ void done(const Unit&) const {}
};

__device__ __forceinline__ unsigned cvt_pk_bf16(float lo, float hi) { unsigned r; asm volatile("v_cvt_pk_bf16_f32 %0, %1, %2" : "=v"(r) : "v"(lo), "v"(hi)); return r; }
typedef float f32x2 __attribute__((ext_vector_type(2)));
template <class Epi, class Sched, bool ALIGN_EPI = false, bool SP2 = false>
__device__ __forceinline__ void gemm_phase(PG8_LAS unsigned char* lds, const Gemm g, const Sched& S, const Epi& E) {
    int tid_ = threadIdx.x; asm volatile("" : "+v"(tid_));
    const int tid = tid_, wid = __builtin_amdgcn_readfirstlane(tid >> 6), lane = tid & 63, wr = wid >> 2, wc = wid & 3, fr = lane & 15, fq = lane >> 4;
    const int K = g.K, nt = K / BK;
    unsigned voffA[2], voffB[2];
#pragma unroll
    for (int i = 0; i < 2; ++i) { int R, C; stage_rc(tid * 16 + i * 8192, R, C); const int Rb = Epi::PERM ? ((R & ~31) + perm32(R & 31)) : R;
        voffA[i] = (unsigned)(R * g.lda + C) * 2u; voffB[i] = (unsigned)(Rb * g.ldb + C) * 2u; }
    const size_t kstep = (size_t)(BK * 2);
    const size_t hstepA = (size_t)HALF * g.lda * 2, hstepB = (size_t)HALF * g.ldb * 2;
    const size_t tstepA = 2 * hstepA, tstepB = 2 * hstepB;
    const unsigned ldsw = (unsigned)wid * 1024u;
    const int aoff = lds_byte(wr * 64 + fr, fq * 8), boff = lds_byte(wc * 32 + fr, fq * 8);
#define PG8_SA(b, h) (((b) * 2 + (h)) * HTB)
#define PG8_SB(b, h) ((4 + (b) * 2 + (h)) * HTB)
#define PG8_STAGE(bufoff, gbase, voff) do { _Pragma("unroll") for (int _i = 0; _i < 2; ++_i) \
        __builtin_amdgcn_global_load_lds((const unsigned*)((const char*)(gbase) + (voff)[_i]), (PG8_LAS unsigned*)(lds + (bufoff) + ldsw + _i * 8192), 16, 0, 0); } while (0)
#define PG8_LDA(dst, b, h) do { _Pragma("unroll") for (int m = 0; m < 4; ++m) _Pragma("unroll") for (int k = 0; k < 2; ++k) dst[m][k] = *(const PG8_LAS bf16x8*)(lds + PG8_SA(b, h) + aoff + m * 2048 + k * 1024); } while (0)
#define PG8_LDB(dst, b, h) do { _Pragma("unroll") for (int n = 0; n < 2; ++n) _Pragma("unroll") for (int k = 0; k < 2; ++k) dst[n][k] = *(const PG8_LAS bf16x8*)(lds + PG8_SB(b, h) + boff + n * 2048 + k * 1024); } while (0)
#define PG8_MMA(ai, bj, At, Bt) do { __builtin_amdgcn_s_setprio(1); _Pragma("unroll") for (int m = 0; m < 4; ++m) _Pragma("unroll") for (int n = 0; n < 2; ++n) _Pragma("unroll") for (int k = 0; k < 2; ++k) \
        acc[ai][bj][m][n] = __builtin_amdgcn_mfma_f32_16x16x32_bf16(Bt[n][k], At[m][k], acc[ai][bj][m][n], 0, 0, 0); __builtin_amdgcn_s_setprio(0); } while (0)
#define PG8_WAIT_V(n) asm volatile("s_waitcnt vmcnt(" #n ")" ::: "memory")
#define PG8_WAIT_L(n) asm volatile("s_waitcnt lgkmcnt(" #n ")" ::: "memory")
#define PG8_BAR __builtin_amdgcn_s_barrier()
#define PG8_SCHED __builtin_amdgcn_sched_barrier(0)
    Unit cur, nxt; int ui = 0;
    if (!S.next(0, cur)) return;
    f32x4 acc[2][2][4][2];
#pragma unroll
    for (int a = 0; a < 2; ++a)
#pragma unroll
        for (int b = 0; b < 2; ++b)
#pragma unroll
            for (int m = 0; m < 4; ++m)
#pragma unroll
                for (int n = 0; n < 2; ++n) acc[a][b][m][n] = (f32x4){0.f, 0.f, 0.f, 0.f};
    bf16x8 At[4][2], B0[2][2], B1[2][2];
    const char* cA = (const char*)g.A + (size_t)cur.pm * tstepA + cur.aoff; const char* cB = (const char*)g.Bt + (size_t)cur.pn * tstepB;
    S.a_ready(cur);
    if constexpr (SP2) {
        PG8_STAGE(PG8_SB(0, 0), cB, voffB); PG8_STAGE(PG8_SB(0, 1), cB + hstepB, voffB); PG8_STAGE(PG8_SA(0, 0), cA, voffA); PG8_STAGE(PG8_SA(0, 1), cA + hstepA, voffA);
        if (wr == 1) PG8_BAR;
        PG8_WAIT_V(2); PG8_BAR;
        PG8_STAGE(PG8_SB(1, 0), cB + kstep, voffB); PG8_STAGE(PG8_SA(1, 0), cA + kstep, voffA); PG8_STAGE(PG8_SB(1, 1), cB + hstepB + kstep, voffB);
        PG8_WAIT_V(6); PG8_BAR;
    } else {
        PG8_STAGE(PG8_SB(0, 0), cB, voffB); PG8_STAGE(PG8_SA(0, 0), cA, voffA); PG8_STAGE(PG8_SB(0, 1), cB + hstepB, voffB); PG8_STAGE(PG8_SA(0, 1), cA + hstepA, voffA);
        if (wr == 1) PG8_BAR;
        PG8_WAIT_V(4); PG8_BAR;
        PG8_STAGE(PG8_SB(1, 0), cB + kstep, voffB); PG8_STAGE(PG8_SA(1, 0), cA + kstep, voffA); PG8_STAGE(PG8_SB(1, 1), cB + hstepB + kstep, voffB);
        PG8_WAIT_V(6); PG8_BAR;
    }
    for (;;) {
        const bool has_next = S.next(ui + 1, nxt);
        const char* nA = has_next ? (const char*)g.A + (size_t)nxt.pm * tstepA + nxt.aoff : cA; const char* nB = has_next ? (const char*)g.Bt + (size_t)nxt.pn * tstepB : cB;
        for (int t = 0; t < nt; t += 2) {
            const bool last = (t == nt - 2);
            const char* a1 = cA + (size_t)(t + 1) * kstep;
            const char* a2 = last ? nA : cA + (size_t)(t + 2) * kstep; const char* b2 = last ? nB : cB + (size_t)(t + 2) * kstep;
            const char* a3 = a2 + kstep; const char* b3 = b2 + kstep;
            if (last && has_next) S.a_ready(nxt);
            if constexpr (SP2) {
            PG8_LDB(B0, 0, 0); PG8_LDB(B1, 0, 1); PG8_SCHED; PG8_LDA(At, 0, 0); PG8_STAGE(PG8_SA(1, 1), a1 + hstepA, voffA);
            PG8_WAIT_V(8); PG8_WAIT_L(0); PG8_BAR; PG8_MMA(0, 0, At, B0); PG8_MMA(0, 1, At, B1); PG8_BAR; PG8_SCHED;
            PG8_LDA(At, 0, 1); PG8_STAGE(PG8_SB(0, 0), b2, voffB); PG8_STAGE(PG8_SB(0, 1), b2 + hstepB, voffB); PG8_STAGE(PG8_SA(0, 0), a2, voffA);
            PG8_WAIT_V(8); PG8_WAIT_L(0); PG8_BAR; PG8_MMA(1, 0, At, B0); PG8_MMA(1, 1, At, B1); PG8_BAR; PG8_SCHED;
            PG8_LDB(B0, 1, 0); PG8_LDB(B1, 1, 1); PG8_SCHED; PG8_LDA(At, 1, 0); PG8_STAGE(PG8_SA(0, 1), a2 + hstepA, voffA);
            PG8_WAIT_V(8); PG8_WAIT_L(0); PG8_BAR; PG8_MMA(0, 0, At, B0); PG8_MMA(0, 1, At, B1); PG8_BAR; PG8_SCHED;
            PG8_LDA(At, 1, 1); PG8_STAGE(PG8_SB(1, 0), b3, voffB); PG8_STAGE(PG8_SB(1, 1), b3 + hstepB, voffB); PG8_STAGE(PG8_SA(1, 0), a3, voffA);
            PG8_WAIT_V(8); PG8_WAIT_L(0); PG8_BAR; PG8_MMA(1, 0, At, B0); PG8_MMA(1, 1, At, B1); PG8_BAR; PG8_SCHED;
            } else {
            PG8_LDB(B0, 0, 0); PG8_SCHED; PG8_LDA(At, 0, 0); PG8_STAGE(PG8_SA(1, 1), a1 + hstepA, voffA);
            PG8_WAIT_L(8); PG8_BAR; PG8_WAIT_L(0); PG8_MMA(0, 0, At, B0); PG8_BAR; PG8_SCHED;
            PG8_LDB(B1, 0, 1); PG8_STAGE(PG8_SB(0, 0), b2, voffB);
            PG8_BAR; PG8_WAIT_L(0); PG8_MMA(0, 1, At, B1); PG8_BAR;
            PG8_LDA(At, 0, 1); PG8_STAGE(PG8_SA(0, 0), a2, voffA);
            PG8_BAR; PG8_WAIT_L(0); PG8_MMA(1, 0, At, B0); PG8_BAR; PG8_SCHED;
            PG8_STAGE(PG8_SB(0, 1), b2 + hstepB, voffB);
            PG8_WAIT_V(6); PG8_BAR; PG8_MMA(1, 1, At, B1); PG8_BAR;
            PG8_LDB(B0, 1, 0); PG8_SCHED; PG8_LDA(At, 1, 0); PG8_STAGE(PG8_SA(0, 1), a2 + hstepA, voffA);
            PG8_WAIT_L(8); PG8_BAR; PG8_WAIT_L(0); PG8_MMA(0, 0, At, B0); PG8_BAR; PG8_SCHED;
            PG8_LDB(B1, 1, 1); PG8_STAGE(PG8_SB(1, 0), b3, voffB);
            PG8_BAR; PG8_WAIT_L(0); PG8_MMA(0, 1, At, B1); PG8_BAR;
            PG8_LDA(At, 1, 1); PG8_STAGE(PG8_SA(1, 0), a3, voffA);
            PG8_BAR; PG8_WAIT_L(0); PG8_MMA(1, 0, At, B0); PG8_BAR; PG8_SCHED;
            PG8_STAGE(PG8_SB(1, 1), b3 + hstepB, voffB);
            PG8_WAIT_V(6); PG8_BAR; PG8_MMA(1, 1, At, B1); PG8_BAR;
            }
        }
        if constexpr (ALIGN_EPI) { if (wr == 0) PG8_BAR; }
        if constexpr (!Epi::AFTER_DRAIN) { E(acc, cur, wr, wc, fr, fq); S.done(cur); }
        if (!has_next) break;
#pragma unroll
        for (int a = 0; a < 2; ++a)
#pragma unroll
            for (int b = 0; b < 2; ++b)
#pragma unroll
                for (int m = 0; m < 4; ++m)
#pragma unroll
                    for (int n = 0; n < 2; ++n) acc[a][b][m][n] = (f32x4){0.f, 0.f, 0.f, 0.f};
        cur = nxt; cA = nA; cB = nB; ++ui;
        if constexpr (ALIGN_EPI) { if (wr == 1) PG8_BAR; }
    }
    PG8_WAIT_V(0);
    if constexpr (!ALIGN_EPI) { if (wr == 0) PG8_BAR; }
    PG8_BAR;
    if constexpr (Epi::AFTER_DRAIN) { E.fused(acc, cur, wr, wc, fr, fq, lds, wid, lane); S.done(cur); }
#undef PG8_SA
#undef PG8_SB
#undef PG8_STAGE
#undef PG8_LDA
#undef PG8_LDB
#undef PG8_MMA
#undef PG8_WAIT_V
#undef PG8_WAIT_L
#undef PG8_BAR
#undef PG8_SCHED
}
}
namespace mk {
using pg8::bf16_t; using pg8::bf16x8; using pg8::f32x4; using pg8::u32x4; using pg8::f32x2;
typedef float f32x16 __attribute__((ext_vector_type(16)));
typedef unsigned u32x2 __attribute__((ext_vector_type(2)));
typedef short s16x4 __attribute__((ext_vector_type(4)));
#define GAS __attribute__((address_space(1)))
#define LAS __attribute__((address_space(3)))
typedef GAS unsigned gu32;
#define RLX_AGENT __ATOMIC_RELAXED, __HIP_MEMORY_SCOPE_AGENT
#define LDS_WAIT() asm volatile("s_waitcnt lgkmcnt(0)" ::: "memory")
#define VM_WAIT() asm volatile("s_waitcnt vmcnt(0)" ::: "memory")

constexpr int T = 16384, D = 1024, S = 2048, NB = 8;
constexpr int NWAVES = 8, NTHR = 512;
constexpr float EPS = 1e-6f;
constexpr float LOG2E = 1.4426950408889634f;
constexpr float C2M = 0.10206207261596575f * LOG2E;
constexpr float C2S = 0.125f * LOG2E;

constexpr size_t MiB = (size_t)1 << 20;
constexpr size_t WS_CTL = 0, CTL_ZERO_BYTES = 1 * MiB;
constexpr size_t WS_WINE = 1 * MiB;
constexpr size_t WS_WOUTE = 5 * MiB;
constexpr size_t WS_WINO = 7 * MiB;
constexpr size_t WS_WUQ = 10 * MiB;
constexpr size_t WS_WUKV = 10 * MiB + 393216;
constexpr size_t WS_WOUTO = 11 * MiB;
constexpr size_t WS_ROUTER = 13 * MiB;
constexpr size_t WS_ROPE = 14 * MiB;
constexpr size_t WS_RS0 = 14 * MiB + 512 * 1024;
constexpr size_t WS_RSM = WS_RS0 + 64 * 1024;
constexpr size_t WS_SSQQ = 15 * MiB;
constexpr size_t WS_SSQKV = 15 * MiB + 256 * 1024;
constexpr size_t WS_WMOE = 16 * MiB;
constexpr size_t WS_XB = 64 * MiB;
constexpr size_t WS_MB = 96 * MiB;
constexpr size_t WS_Y = 128 * MiB;
constexpr size_t WS_Q = 128 * MiB;
constexpr size_t WS_KV = 152 * MiB;
constexpr size_t WS_P = 192 * MiB;
constexpr size_t WS_LSLOT = 232 * MiB;
constexpr size_t WS_LGW = 234 * MiB;
constexpr size_t WS_KPE = 236 * MiB;
constexpr size_t WS_END = 240 * MiB;
constexpr size_t W1_EXP = 524288, W2_EXP = 262144;

constexpr int CW_TMO = 0;
constexpr int CW_BAR = 4096;
constexpr int CW_CVT = 8192;
constexpr int CW_ECNT = 16384;

constexpr int LDS_BYTES = 160 * 1024;
constexpr int RING_BYTES = 131072;
constexpr int MISC_OFF = 159 * 1024;

__device__ __forceinline__ unsigned f2bf(float f) { unsigned u = __builtin_bit_cast(unsigned, f); return (u + 0x7fffu + ((u >> 16) & 1u)) >> 16; }
__device__ __forceinline__ float bf2f(unsigned h) { return __builtin_bit_cast(float, h << 16); }
__device__ __forceinline__ unsigned pk2(float lo, float hi) { return pg8::cvt_pk_bf16(lo, hi); }
__device__ __forceinline__ float wave_sum(float v) {
#pragma unroll
    for (int o = 1; o < 64; o <<= 1) v += __shfl_xor(v, o);
    return v;
}
__device__ __forceinline__ float fast_exp2(float x) { return __builtin_amdgcn_exp2f(x); }
__device__ __forceinline__ float fast_rcp(float x) { return __builtin_amdgcn_rcpf(x); }
__device__ __forceinline__ float sigmoid_f(float x) { return fast_rcp(1.f + fast_exp2(-x * LOG2E)); }
__device__ __forceinline__ float silu_f(float x) { return x * sigmoid_f(x); }
__device__ __forceinline__ float gelu_f(float x) { const float u = 0.7978845608028654f * (x + 0.044715f * x * x * x); return x * sigmoid_f(2.f * u); }

#define XB_TMO      128
#define XB_XCNT(j)  (256  + 64 * (j))
#define XB_XSUB(j)  (1280 + 64 * (j))
#define XB_XGEN(j)  (2304 + 64 * (j))
#define XB_TOP      3328
#define XB_TOPGEN   3392
#define XCD_BAR_WORDS 3456
#define XB_SPIN_CAP (1u << 18)
__device__ __forceinline__ unsigned xb_ld(unsigned* p)              { return __hip_atomic_load(p, __ATOMIC_RELAXED, __HIP_MEMORY_SCOPE_AGENT); }
__device__ __forceinline__ unsigned xb_add(unsigned* p, unsigned v) { return __hip_atomic_fetch_add(p, v, __ATOMIC_RELAXED, __HIP_MEMORY_SCOPE_AGENT); }
__device__ __forceinline__ unsigned xb_xcc_id() { return (unsigned)__builtin_amdgcn_s_getreg((3 << 11) | 20) & 0xFu; }
#define XB_SPIN(cond, bar) do { unsigned _sp = 0; while (cond) { __builtin_amdgcn_s_sleep(1); \
    if ((++_sp & 255u) == 0u) { if (xb_ld(&(bar)[XB_TMO])) break; if (_sp > XB_SPIN_CAP) { atomicAdd(&(bar)[XB_TMO], 1u); break; } } } } while (0)
struct XcdBarrier { unsigned* bar; unsigned x; volatile LAS unsigned* st; };
__device__ __forceinline__ XcdBarrier xcd_barrier_post(unsigned* bar, volatile LAS unsigned* st) {
    XcdBarrier b; b.bar = bar; b.x = xb_xcc_id(); b.st = st;
    if (threadIdx.x == 0) (void)xb_add(&bar[XB_XCNT(b.x)], 1u);
    return b;
}
__device__ __forceinline__ void xcd_barrier_complete(unsigned* bar, unsigned x, unsigned& nloc, unsigned& nx) {
    const unsigned G = gridDim.x * gridDim.y * gridDim.z;
    unsigned sum, cnt, mine, sp = 0u;
    for (;;) {
        sum = 0u; cnt = 0u; mine = 0u;
#pragma unroll
        for (unsigned j = 0; j < 16; ++j) { const unsigned c = xb_ld(&bar[XB_XCNT(j)]); sum += c; cnt += (c > 0u) ? 1u : 0u; mine = (j == x) ? c : mine; }
        if (sum == G) break;
        __builtin_amdgcn_s_sleep(1);
        if ((++sp & 255u) == 0u) { if (xb_ld(&bar[XB_TMO])) break; if (sp > XB_SPIN_CAP) { atomicAdd(&bar[XB_TMO], 1u); break; } }
    }
    nloc = mine > 0u ? mine : 1u; nx = cnt > 0u ? cnt : 1u;
}
__device__ __forceinline__ void xcd_barrier(const XcdBarrier& b) {
    asm volatile("s_waitcnt vmcnt(0)" ::: "memory");
    __syncthreads();
    if (threadIdx.x == 0) {
        unsigned* bar = b.bar;
        __builtin_amdgcn_s_waitcnt(0);
        unsigned nloc = b.st[0], nx = b.st[1];
        if (nloc == 0u) { xcd_barrier_complete(bar, b.x, nloc, nx); b.st[0] = nloc; b.st[1] = nx; }
        const unsigned old = xb_add(&bar[XB_XSUB(b.x)], 1u);
        const unsigned gen = old / nloc;
        if (old + 1u == (gen + 1u) * nloc) {
            __builtin_amdgcn_fence(__ATOMIC_RELEASE, "agent");
            asm volatile("s_waitcnt vmcnt(0)" ::: "memory");
            const unsigned og = xb_add(&bar[XB_TOP], 1u);
            const unsigned tg = og / nx;
            if (og + 1u == (tg + 1u) * nx) xb_add(&bar[XB_TOPGEN], 1u);
            else XB_SPIN(xb_ld(&bar[XB_TOPGEN]) == tg, bar);
            __builtin_amdgcn_fence(__ATOMIC_ACQUIRE, "agent");
            xb_add(&bar[XB_XGEN(b.x)], 1u);
            asm volatile("s_waitcnt vmcnt(0)" ::: "memory");
        } else {
            XB_SPIN(xb_ld(&bar[XB_XGEN(b.x)]) == gen, bar);
            __builtin_amdgcn_fence(__ATOMIC_ACQUIRE, "agent");
            asm volatile("s_waitcnt vmcnt(0)" ::: "memory");
        }
    }
    __syncthreads();
}

struct Args { const float* in[28]; float* out; unsigned char* ws; int ph_lo, ph_hi; };

struct Frame {
    LAS unsigned char* lds;
    int tid, lane, wave, vcu, G;
    const float* const* in;
    float* out; unsigned char* ws;
};
}
namespace mk {
__device__ __forceinline__ void p0_transpose_item(const float* W, int ldn, int k0, int src_n0, bf16_t* WT, int ldk, int dst_n0,
                                                  const float* gain, float scale, LAS float* scr, int lane) {
    if (src_n0 >= 0) {
#pragma unroll 8
        for (int i = 0; i < 32; ++i) { const int kk = 2 * i + (lane >> 5);
            float v = W[(size_t)(k0 + kk) * ldn + src_n0 + (lane & 31)] * scale; if (gain) v *= gain[k0 + kk];
            scr[kk * 33 + (lane & 31)] = v; }
    } else {
#pragma unroll 8
        for (int i = 0; i < 32; ++i) { const int kk = 2 * i + (lane >> 5); scr[kk * 33 + (lane & 31)] = 0.f; }
    }
    LDS_WAIT(); asm volatile("" ::: "memory");
    const int c = lane & 7;
#pragma unroll
    for (int j = 0; j < 4; ++j) { const int n = (lane >> 3) + 8 * j; const LAS float* s = scr + (8 * c) * 33 + n;
        u32x4 o; o.x = pk2(s[0 * 33], s[1 * 33]); o.y = pk2(s[2 * 33], s[3 * 33]); o.z = pk2(s[4 * 33], s[5 * 33]); o.w = pk2(s[6 * 33], s[7 * 33]);
        *(GAS u32x4*)(WT + (size_t)(dst_n0 + n) * ldk + k0 + 8 * c) = o; }
    LDS_WAIT(); asm volatile("" ::: "memory");
}
template <bool STAGE2>
__device__ __forceinline__ void moe_cvt_tile(const float* src, int ld, const float* gain16, bf16_t* dst0, size_t piece_stride  , LAS float* scr, int lane) {
#pragma unroll 4
    for (int i = 0; i < 16; ++i) { f32x4 v = *(const GAS f32x4*)(src + (size_t)i * ld + 4 * lane); if (gain16) v = v * gain16[i]; *(LAS f32x4*)(scr + i * 256 + 4 * lane) = v; }
    LDS_WAIT(); asm volatile("" ::: "memory");
    const int r = lane & 31, h = lane >> 5;
#pragma unroll
    for (int c = 0; c < 8; ++c) {
        float v[8];
#pragma unroll
        for (int j = 0; j < 8; ++j) { const int row = STAGE2 ? (8 * (j >> 2) + 4 * h + (j & 3)) : (8 * h + j); v[j] = scr[row * 256 + 32 * c + r]; }
        u32x4 o; o.x = pk2(v[0], v[1]); o.y = pk2(v[2], v[3]); o.z = pk2(v[4], v[5]); o.w = pk2(v[6], v[7]);
        *(GAS u32x4*)(dst0 + (size_t)c * piece_stride + (size_t)lane * 8) = o;
    }
    LDS_WAIT(); asm volatile("" ::: "memory");
}
constexpr int MOE_CVT_ITEMS = 6144;
struct CvtRegs { f32x4 v[16]; };
__device__ __forceinline__ void moe_cvt_load(const Frame& F, int layer, int it, CvtRegs& R) {
    const float* src; int ld;
    if (it < 4096) { const int gu = it >> 11, r = it & 2047, e = r >> 6, ks = r & 63; src = (gu ? F.in[26] : F.in[25]) + ((size_t)(layer * 32 + e) * 1024 + 16 * ks) * 256; ld = 256; }
    else { const int r = it - 4096, e = r >> 6, kk = (r >> 2) & 15, dq = r & 3; src = F.in[27] + ((size_t)(layer * 32 + e) * 256 + 16 * kk) * 1024 + 256 * dq; ld = 1024; }
#pragma unroll
    for (int i = 0; i < 16; ++i) R.v[i] = *(const GAS f32x4*)(src + (size_t)i * ld + 4 * F.lane);
}
__device__ __forceinline__ void moe_cvt_stage(const Frame& F, int layer, int it, const CvtRegs& R, LAS float* scr) {
    if (it < 4096) { const int ks = it & 63; const float* gain = F.in[2] + layer * 1024 + 16 * ks;
#pragma unroll
        for (int i = 0; i < 16; ++i) *(LAS f32x4*)(scr + i * 256 + 4 * F.lane) = R.v[i] * gain[i];
    } else {
#pragma unroll
        for (int i = 0; i < 16; ++i) *(LAS f32x4*)(scr + i * 256 + 4 * F.lane) = R.v[i];
    }
    LDS_WAIT(); asm volatile("" ::: "memory");
}
__device__ __forceinline__ void moe_cvt_emit(const Frame& F, int it, LAS float* scr) {
    bf16_t* W1 = (bf16_t*)(F.ws + WS_WMOE); bf16_t* W2 = W1 + 32 * W1_EXP;
    const int rr = F.lane & 31, h = F.lane >> 5;
    const bool s2 = it >= 4096;
    bf16_t* base; size_t st_c2, st_dt;
    if (!s2) { const int gu = it >> 11, r = it & 2047, e = r >> 6, ks = r & 63; base = W1 + (size_t)e * W1_EXP + ((size_t)ks * 2 + gu) * 512; st_c2 = 2 * 65536; st_dt = 65536; }
    else { const int r = it - 4096, e = r >> 6, kk = (r >> 2) & 15, dq = r & 3; const int p = dq >> 1, w0 = (dq & 1) * 4;
        base = W2 + (size_t)e * W2_EXP + ((size_t)(p * 8 + w0) * 16 + kk) * 1024; st_c2 = 16 * 1024; st_dt = 512; }
#pragma unroll
    for (int c = 0; c < 8; ++c) {
        float v[8];
#pragma unroll
        for (int j = 0; j < 8; ++j) { const int row = s2 ? (8 * (j >> 2) + 4 * h + (j & 3)) : (8 * h + j); v[j] = scr[row * 256 + 32 * c + rr]; }
        u32x4 o; o.x = pk2(v[0], v[1]); o.y = pk2(v[2], v[3]); o.z = pk2(v[4], v[5]); o.w = pk2(v[6], v[7]);
        *(GAS u32x4*)(base + (size_t)(c >> 1) * st_c2 + (size_t)(c & 1) * st_dt + (size_t)F.lane * 8) = o;
    }
    LDS_WAIT(); asm volatile("" ::: "memory");
}
__device__ __forceinline__ void row_to_bf16_rs(const float* xrow, bf16_t* orow, float* rs, int lane) {
    const GAS f32x4* xr = (const GAS f32x4*)xrow + lane;
    f32x4 v[4]; float s = 0.f;
#pragma unroll
    for (int j = 0; j < 4; ++j) { v[j] = xr[64 * j]; s += (v[j].x * v[j].x + v[j].y * v[j].y) + (v[j].z * v[j].z + v[j].w * v[j].w); }
    s = wave_sum(s);
    GAS u32x2* o8 = (GAS u32x2*)orow + lane;
#pragma unroll
    for (int j = 0; j < 4; ++j) { u32x2 w; w.x = pk2(v[j].x, v[j].y); w.y = pk2(v[j].z, v[j].w); o8[64 * j] = w; }
    if (lane == 0) *rs = 1.0f / sqrtf(s * (1.f / 1024.f) + EPS);
}

struct DenseDesc { int src_idx, K, ldn, nblk, ldk; size_t dst; int kind; };
__device__ __forceinline__ void p0_dense_item(const Frame& F, int it, LAS float* scr) {
    int r = it;
    if (r < 1024) { const int kb = r >> 6, nb = r & 63; const int n = 32 * nb; int src;
        if (n < 1024) { const int j = n >> 8, c = n & 255; src = (c < 128) ? (128 * j + c) : (512 + 128 * j + (c - 128)); } else src = n;
        p0_transpose_item(F.in[4], 2048, 64 * kb, src, (bf16_t*)(F.ws + WS_WINE), 1024, n, F.in[1], 1.f, scr, F.lane); return; } r -= 1024;
    if (r < 512) { const int kb = r >> 5, nb = r & 31;
        p0_transpose_item(F.in[13], 1024, 64 * kb, 32 * nb, (bf16_t*)(F.ws + WS_WOUTE), 1024, 32 * nb, nullptr, 1.f, scr, F.lane); return; } r -= 512;
    if (r < 640) { const int kb = r / 40, nb = r % 40; const int n = 32 * nb; int src; float sc = 1.f;
        if (n < 416) src = n; else if (n < 512) src = -1; else if (n < 1024) { src = 416 + (n - 512); sc = C2S; } else if (n < 1152) src = 928 + (n - 1024); else src = 1056 + (n - 1152);
        p0_transpose_item(F.in[14], 1184, 64 * kb, src, (bf16_t*)(F.ws + WS_WINO), 1024, n, F.in[1] + 1024, sc, scr, F.lane); return; } r -= 640;
    if (r < 96) { const int kb = r / 24, nb = r % 24; const int n = 32 * nb; int src;
        if (n < 512) src = 96 * (n >> 6) + (n & 63); else src = 96 * ((n - 512) >> 5) + 64;
        p0_transpose_item(F.in[16], 768, 64 * kb, src, (bf16_t*)(F.ws + WS_WUQ), 256, n, F.in[15], C2M, scr, F.lane); return; } r -= 96;
    if (r < 128) { const int kb = r >> 5, nb = r & 31; const int n = 32 * nb; int src;
        if (n < 512) src = 128 * (n >> 6) + (n & 63); else src = 128 * ((n - 512) >> 6) + 64 + ((n - 512) & 63);
        if (kb >= 2) src = -1;
        p0_transpose_item(F.in[18], 1024, kb >= 2 ? 0 : 64 * kb, src, (bf16_t*)(F.ws + WS_WUKV) + (kb >= 2 ? 64 * kb : 0), 256, n, F.in[17], 1.f, scr, F.lane); return; } r -= 128;
    { const int kb = r >> 5, nb = r & 31;
        p0_transpose_item(F.in[20], 1024, 64 * kb, 32 * nb, (bf16_t*)(F.ws + WS_WOUTO), 1024, 32 * nb, nullptr, 1.f, scr, F.lane); }
}
constexpr int DENSE_ITEMS = 2912;

__device__ __forceinline__ void phase_p0(const Frame& F) {
    LAS float* scr = (LAS float*)(F.lds + F.wave * 16384);
    const int gw = F.vcu * NWAVES + F.wave, NGW = F.G * NWAVES;
    { CvtRegs R; int it = gw; if (it < MOE_CVT_ITEMS) moe_cvt_load(F, 0, it, R);
      for (; it < MOE_CVT_ITEMS; it += NGW) { moe_cvt_stage(F, 0, it, R, scr); if (it + NGW < MOE_CVT_ITEMS) moe_cvt_load(F, 0, it + NGW, R); moe_cvt_emit(F, it, scr); } }
    for (int it = gw; it < DENSE_ITEMS; it += NGW) p0_dense_item(F, it, scr);
    for (int m = gw; m < T; m += NGW) row_to_bf16_rs(F.in[0] + (size_t)m * D, (bf16_t*)(F.ws + WS_XB) + (size_t)m * D, (float*)(F.ws + WS_RS0) + m, F.lane);
    const int gt = gw * 64 + F.lane, NGT = NGW * 64;
    for (int idx = gt; idx < 2 * 49152; idx += NGT) {
        const int layer = idx / 49152, li = idx % 49152;
        const int j = li & 7, ln = (li >> 3) & 63, blk = li >> 9, ct = blk % 3, ks = (blk / 3) & 3, w = blk / 12;
        const int k = 128 * w + 32 * ks + 8 * (ln >> 4) + j, col = 16 * ct + (ln & 15);
        float v = 0.f;
        if (col < 4) v = F.in[21][((size_t)layer * 1024 + k) * 4 + col];
        else if (col < 36) v = F.in[23][(((size_t)layer * 4 + ((col - 4) >> 3)) * 1024 + k) * 8 + ((col - 4) & 7)];
        v *= F.in[2][layer * 1024 + k];
        const unsigned hi = f2bf(v); const unsigned lo = f2bf(v - bf2f(hi));
        bf16_t* R = (bf16_t*)(F.ws + WS_ROUTER);
        R[(size_t)(layer * 2 + 0) * 49152 + li] = (bf16_t)hi;
        R[(size_t)(layer * 2 + 1) * 49152 + li] = (bf16_t)lo;
    }
    for (int idx = gt; idx < S * 16; idx += NGT) {
        const int pos = idx >> 4, j = idx & 15;
        const double inv = pow(10000.0, -(double)(2 * j) / 32.0), ang = (double)pos * inv;
        f32x2 cs; cs.x = (float)cos(ang); cs.y = (float)sin(ang);
        ((f32x2*)(F.ws + WS_ROPE))[idx] = cs;
    }
}
}
namespace mk {
using pg8::Unit;
__device__ __forceinline__ u32x4 pack8(const f32x4& a, const f32x4& b) { u32x4 w; w.x = pk2(a[0], a[1]); w.y = pk2(a[2], a[3]); w.z = pk2(b[0], b[1]); w.w = pk2(b[2], b[3]); return w; }

struct EpiE1 {
    static constexpr bool PERM = true, AFTER_DRAIN = false;
    bf16_t* ACT; const float* rs;
    __device__ __forceinline__ void operator()(const f32x4 (&acc)[2][2][4][2], const Unit& u, int wr, int wc, int fr, int fq) const {
        const int row0 = u.pm * 256 + wr * 64 + fr, cl = wc * 32 + 8 * fq;
#pragma unroll
        for (int ai = 0; ai < 2; ++ai)
#pragma unroll
            for (int m = 0; m < 4; ++m) {
                const int row = row0 + ai * 128 + m * 16; const float r = rs[row]; bf16_t* rowp = ACT + (size_t)row * 1536;
                if (u.pn < 4) {
                    f32x4 o0, o1;
#pragma unroll
                    for (int i = 0; i < 4; ++i) { o0[i] = acc[ai][0][m][0][i] * r * sigmoid_f(acc[ai][1][m][0][i] * r); o1[i] = acc[ai][0][m][1][i] * r * sigmoid_f(acc[ai][1][m][1][i] * r); }
                    *(u32x4*)(rowp + 128 * u.pn + cl) = pack8(o0, o1);
                } else {
                    const int base = (u.pn < 6) ? (512 + (u.pn - 4) * 256) : (1024 + (u.pn - 6) * 256);
#pragma unroll
                    for (int bj = 0; bj < 2; ++bj) { f32x4 o0, o1;
#pragma unroll
                        for (int i = 0; i < 4; ++i) { o0[i] = gelu_f(acc[ai][bj][m][0][i] * r); o1[i] = gelu_f(acc[ai][bj][m][1][i] * r); }
                        *(u32x4*)(rowp + base + bj * 128 + cl) = pack8(o0, o1); }
                }
            }
    }
};
struct EpiRes {
    static constexpr bool PERM = true, AFTER_DRAIN = false;
    const float* resid; float* out; bf16_t* xb;
    __device__ __forceinline__ void operator()(const f32x4 (&acc)[2][2][4][2], const Unit& u, int wr, int wc, int fr, int fq) const {
        const int row0 = u.pm * 256 + wr * 64 + fr, col0 = u.pn * 256 + wc * 32 + 8 * fq;
#pragma unroll
        for (int ai = 0; ai < 2; ++ai)
#pragma unroll
            for (int m = 0; m < 4; ++m) {
                const size_t off = (size_t)(row0 + ai * 128 + m * 16) * 1024 + col0;
#pragma unroll
                for (int bj = 0; bj < 2; ++bj) {
                    const f32x4 r0 = *(const f32x4*)(resid + off + bj * 128), r1 = *(const f32x4*)(resid + off + bj * 128 + 4);
                    const f32x4 v0 = acc[ai][bj][m][0] + r0, v1 = acc[ai][bj][m][1] + r1;
                    *(f32x4*)(out + off + bj * 128) = v0; *(f32x4*)(out + off + bj * 128 + 4) = v1;
                    *(u32x4*)(xb + off + bj * 128) = pack8(v0, v1);
                }
            }
    }
};
struct EpiO1 {
    static constexpr bool PERM = true, AFTER_DRAIN = false;
    bf16_t* P; const float* rs; float* ssqq; float* ssqkv; bf16_t* kpe; const f32x2* rope;
    __device__ __forceinline__ void operator()(const f32x4 (&acc)[2][2][4][2], const Unit& u, int wr, int wc, int fr, int fq) const {
        const int row0 = u.pm * 256 + wr * 64 + fr, cl = wc * 32 + 8 * fq;
#pragma unroll
        for (int ai = 0; ai < 2; ++ai)
#pragma unroll
            for (int m = 0; m < 4; ++m) {
                const int row = row0 + ai * 128 + m * 16; const float r = rs[row]; bf16_t* rowp = P + (size_t)row * 1280 + u.pn * 256 + cl;
                f32x4 v[2][2];
#pragma unroll
                for (int bj = 0; bj < 2; ++bj) { v[bj][0] = acc[ai][bj][m][0] * r; v[bj][1] = acc[ai][bj][m][1] * r; *(u32x4*)(rowp + bj * 128) = pack8(v[bj][0], v[bj][1]); }
                if (u.pn <= 1) {
                    float s = 0.f;
#pragma unroll
                    for (int i = 0; i < 4; ++i) { s += v[0][0][i] * v[0][0][i] + v[0][1][i] * v[0][1][i]; if (u.pn == 0) s += v[1][0][i] * v[1][0][i] + v[1][1][i] * v[1][1][i]; }
                    s += __shfl_xor(s, 16); s += __shfl_xor(s, 32);
                    if (fq == 0) (u.pn == 0 ? ssqq : ssqkv)[(size_t)row * 4 + wc] = s;
                }
                if (u.pn == 1 && wc == 0) {
                    const int pos = row & (S - 1); f32x4 o[2];
#pragma unroll
                    for (int n = 0; n < 2; ++n)
#pragma unroll
                        for (int i = 0; i < 4; ++i) { const float x = v[1][n][i], y = __shfl_xor(x, 32); const f32x2 cs = rope[pos * 16 + ((8 * fq + 4 * n + i) & 15)];
                            o[n][i] = (fq < 2) ? (x * cs.x - y * cs.y) : (x * cs.x + y * cs.y); }
                    *(u32x4*)(kpe + (size_t)row * 32 + 8 * fq) = pack8(o[0], o[1]);
                }
                asm volatile("" ::: "memory");
            }
    }
};
struct O2Order : pg8::StaticOrder {
    __device__ bool next(int i, Unit& u) const { const bool ok = pg8::StaticOrder::next(i, u); if (ok) u.aoff = (u.pn >= 3) ? 512 : 0; return ok; }
};
struct EpiO2 {
    static constexpr bool PERM = true, AFTER_DRAIN = false;
    bf16_t* Q; bf16_t* KV; const float* ssqq; const float* ssqkv;
    __device__ __forceinline__ void operator()(const f32x4 (&acc)[2][2][4][2], const Unit& u, int wr, int wc, int fr, int fq) const {
        const int row0 = u.pm * 256 + wr * 64 + fr, cl = wc * 32 + 8 * fq;
        const bool isq = u.pn < 3; const float* ssq = isq ? ssqq : ssqkv; const float inv_n = isq ? (1.f / 256.f) : (1.f / 128.f);
        bf16_t* O = isq ? (Q + u.pn * 256 + cl) : (KV + (u.pn - 3) * 256 + cl); const int ldo = isq ? 768 : 1024;
#pragma unroll
        for (int ai = 0; ai < 2; ++ai)
#pragma unroll
            for (int m = 0; m < 4; ++m) {
                const int row = row0 + ai * 128 + m * 16; const f32x4 sq = *(const f32x4*)(ssq + (size_t)row * 4);
                const float r = __builtin_amdgcn_rsqf(((sq[0] + sq[1]) + (sq[2] + sq[3])) * inv_n + EPS);
                bf16_t* rowp = O + (size_t)row * ldo;
#pragma unroll
                for (int bj = 0; bj < 2; ++bj) *(u32x4*)(rowp + bj * 128) = pack8(acc[ai][bj][m][0] * r, acc[ai][bj][m][1] * r);
                asm volatile("" ::: "memory");
            }
    }
};
}
namespace mk {
__device__ __forceinline__ void e2_conv_unit(const Frame& F, int tt, int grp, const bf16_t* ACT, bf16_t* MBo) {
    LAS bf16_t* tile = (LAS bf16_t*)F.lds;
    const int t0 = tt * 128, s0 = t0 & (S - 1);
    for (int idx = F.tid; idx < 158 * 16; idx += NTHR) { const int r = idx >> 4, c = idx & 15; const int sp = s0 + r - 15;
        u32x4 v = {0u, 0u, 0u, 0u};
        if (sp >= 0 && sp < S) v = *(const GAS u32x4*)(ACT + (size_t)(t0 + r - 15) * 1536 + grp * 128 + c * 8);
        *(LAS u32x4*)(tile + r * 128 + c * 8) = v; }
    __syncthreads();
    const int ch = grp * 128 + 2 * F.lane;
    const float* cw = F.in[5]; float w0[31], w1[31];
#pragma unroll
    for (int q = 0; q < 31; ++q) { const f32x2 wv = *(const f32x2*)(cw + q * 512 + ch); w0[q] = wv.x; w1[q] = wv.y; }
    const f32x2 bias = *(const f32x2*)(F.in[6] + ch);
    float a0[16], a1[16];
#pragma unroll
    for (int k = 0; k < 16; ++k) { a0[k] = bias.x; a1[k] = bias.y; }
    const LAS unsigned* src = (const LAS unsigned*)(tile + (16 * F.wave) * 128 + 2 * F.lane);
#pragma unroll
    for (int i = 0; i < 46; ++i) { const unsigned x = src[i * 64]; const float x0 = bf2f(x & 0xffffu), x1 = bf2f(x >> 16);
#pragma unroll
        for (int k = 0; k < 16; ++k) { const int q = i - k; if (q >= 0 && q <= 30) { a0[k] = fmaf(x0, w0[q], a0[k]); a1[k] = fmaf(x1, w1[q], a1[k]); } } }
    const f32x2 g = *(const f32x2*)(F.in[7] + ch), bt = *(const f32x2*)(F.in[8] + ch);
    LAS float* scr = (LAS float*)(F.lds + 49152) + F.wave * 32;
    const bool b5 = (F.lane & 32) != 0, b4 = (F.lane & 16) != 0, b3 = (F.lane & 8) != 0, b2 = (F.lane & 4) != 0;
    const int tk = (b5 ? 8 : 0) + (b4 ? 4 : 0) + (b3 ? 2 : 0) + (b2 ? 1 : 0);
#define E2_BFLY(S, OUT) do { float v8_[8], v4_[4], v2_[2]; \
        _Pragma("unroll") for (int k = 0; k < 8; ++k) { const float kp = b5 ? S[k + 8] : S[k], sd = b5 ? S[k] : S[k + 8]; v8_[k] = kp + __shfl_xor(sd, 32); } \
        _Pragma("unroll") for (int k = 0; k < 4; ++k) { const float kp = b4 ? v8_[k + 4] : v8_[k], sd = b4 ? v8_[k] : v8_[k + 4]; v4_[k] = kp + __shfl_xor(sd, 16); } \
        _Pragma("unroll") for (int k = 0; k < 2; ++k) { const float kp = b3 ? v4_[k + 2] : v4_[k], sd = b3 ? v4_[k] : v4_[k + 2]; v2_[k] = kp + __shfl_xor(sd, 8); } \
        { const float kp = b2 ? v2_[1] : v2_[0], sd = b2 ? v2_[0] : v2_[1]; OUT = kp + __shfl_xor(sd, 4); } \
        OUT += __shfl_xor(OUT, 2); OUT += __shfl_xor(OUT, 1); } while (0)
    float st[16], tot;
#pragma unroll
    for (int k = 0; k < 16; ++k) st[k] = a0[k] + a1[k];
    E2_BFLY(st, tot);
    if ((F.lane & 3) == 0) scr[tk] = tot * (1.f / 128.f);
    LDS_WAIT(); asm volatile("" ::: "memory");
    float mu[16];
#pragma unroll
    for (int k4 = 0; k4 < 4; ++k4) { const f32x4 m4 = *(const LAS f32x4*)(scr + 4 * k4); mu[4 * k4] = m4.x; mu[4 * k4 + 1] = m4.y; mu[4 * k4 + 2] = m4.z; mu[4 * k4 + 3] = m4.w; }
#pragma unroll
    for (int k = 0; k < 16; ++k) { a0[k] -= mu[k]; a1[k] -= mu[k]; st[k] = a0[k] * a0[k] + a1[k] * a1[k]; }
    E2_BFLY(st, tot);
    if ((F.lane & 3) == 0) scr[16 + tk] = 1.0f / sqrtf(tot * (1.f / 128.f) + EPS);
    LDS_WAIT(); asm volatile("" ::: "memory");
#undef E2_BFLY
#pragma unroll
    for (int k4 = 0; k4 < 4; ++k4) { const f32x4 r4 = *(const LAS f32x4*)(scr + 16 + 4 * k4);
#pragma unroll
        for (int i = 0; i < 4; ++i) { const int k = 4 * k4 + i; const float rs = r4[i];
            const float y0 = silu_f(a0[k] * rs * g.x + bt.x), y1 = silu_f(a1[k] * rs * g.y + bt.y);
            *(GAS unsigned*)(MBo + (size_t)(t0 + 16 * F.wave + k) * 1024 + ch) = pk2(y0, y1); } }
    __syncthreads();
}
__device__ __forceinline__ void e2_sgu_unit(const Frame& F, int chunk, int h, const bf16_t* ACT, bf16_t* MBo) {
    constexpr int LD = 136, LDO = 132;
    LAS bf16_t* WSl = (LAS bf16_t*)F.lds;
    LAS bf16_t* VTl = (LAS bf16_t*)(F.lds + 34816);
    LAS float* OUTl = (LAS float*)(F.lds + 69632);
    const int t0 = chunk * 128;
    const float* wsp = F.in[11] + (size_t)h * 128 * 128;
    for (int idx = F.tid; idx < 4096; idx += NTHR) { const int r = idx >> 5, c4 = idx & 31; const f32x4 v = *(const GAS f32x4*)(wsp + r * 128 + 4 * c4);
        u32x2 w; w.x = pk2(v.x, v.y); w.y = pk2(v.z, v.w); *(LAS u32x2*)(WSl + r * LD + 4 * c4) = w; }
#pragma unroll
    for (int it = 0; it < 4; ++it) { const int idx = F.tid + NTHR * it, s = idx >> 4, c = idx & 15;
        const u32x4 raw = *(const GAS u32x4*)(ACT + (size_t)(t0 + s) * 1536 + 1024 + h * 128 + 8 * c);
        float x[8]; x[0] = bf2f(raw.x & 0xffffu); x[1] = bf2f(raw.x >> 16); x[2] = bf2f(raw.y & 0xffffu); x[3] = bf2f(raw.y >> 16);
        x[4] = bf2f(raw.z & 0xffffu); x[5] = bf2f(raw.z >> 16); x[6] = bf2f(raw.w & 0xffffu); x[7] = bf2f(raw.w >> 16);
        float sm = 0.f;
#pragma unroll
        for (int i = 0; i < 8; ++i) sm += x[i];
        sm += __shfl_xor(sm, 1); sm += __shfl_xor(sm, 2); sm += __shfl_xor(sm, 4); sm += __shfl_xor(sm, 8);
        const float mu = sm * (1.f / 128.f); float q = 0.f;
#pragma unroll
        for (int i = 0; i < 8; ++i) { x[i] -= mu; q += x[i] * x[i]; }
        q += __shfl_xor(q, 1); q += __shfl_xor(q, 2); q += __shfl_xor(q, 4); q += __shfl_xor(q, 8);
        const float rs = 1.0f / sqrtf(q * (1.f / 128.f) + EPS);
        const float* vg = F.in[9] + h * 128 + 8 * c; const float* vb = F.in[10] + h * 128 + 8 * c;
#pragma unroll
        for (int i = 0; i < 8; ++i) { const float y = x[i] * rs * vg[i] + vb[i]; VTl[(8 * c + i) * LD + s] = (bf16_t)f2bf(y); }
    }
    __syncthreads();
    const int wt = F.wave >> 1, wc = F.wave & 1, r32 = F.lane & 31, hi = F.lane >> 5;
    f32x16 acc[2]; acc[0] = f32x16{}; acc[1] = f32x16{};
#pragma unroll
    for (int ks = 0; ks < 8; ++ks) {
        const bf16x8 a = *(const LAS bf16x8*)(WSl + (32 * wt + r32) * LD + 16 * ks + 8 * hi);
#pragma unroll
        for (int ct = 0; ct < 2; ++ct) { const bf16x8 b = *(const LAS bf16x8*)(VTl + (64 * wc + 32 * ct + r32) * LD + 16 * ks + 8 * hi);
            acc[ct] = __builtin_amdgcn_mfma_f32_32x32x16_bf16(a, b, acc[ct], 0, 0, 0); }
    }
    const float* bsp = F.in[12] + h * 128;
#pragma unroll
    for (int ct = 0; ct < 2; ++ct)
#pragma unroll
        for (int r = 0; r < 16; ++r) { const int trow = 32 * wt + (r & 3) + 8 * (r >> 2) + 4 * hi; OUTl[trow * LDO + 64 * wc + 32 * ct + r32] = acc[ct][r] + bsp[trow]; }
    __syncthreads();
#pragma unroll
    for (int it = 0; it < 4; ++it) { const int idx = F.tid + NTHR * it, t = idx >> 4, c = idx & 15;
        const u32x4 raw = *(const GAS u32x4*)(ACT + (size_t)(t0 + t) * 1536 + 512 + h * 128 + 8 * c);
        const f32x4 s0 = *(const LAS f32x4*)(OUTl + t * LDO + 8 * c), s1 = *(const LAS f32x4*)(OUTl + t * LDO + 8 * c + 4);
        u32x4 o; o.x = pk2(bf2f(raw.x & 0xffffu) * s0.x, bf2f(raw.x >> 16) * s0.y); o.y = pk2(bf2f(raw.y & 0xffffu) * s0.z, bf2f(raw.y >> 16) * s0.w);
        o.z = pk2(bf2f(raw.z & 0xffffu) * s1.x, bf2f(raw.z >> 16) * s1.y); o.w = pk2(bf2f(raw.w & 0xffffu) * s1.z, bf2f(raw.w >> 16) * s1.w);
        *(GAS u32x4*)(MBo + (size_t)(t0 + t) * 1024 + 512 + h * 128 + 8 * c) = o; }
    __syncthreads();
}
__device__ __forceinline__ void phase_e2(const Frame& F) {
    const bf16_t* ACT = (const bf16_t*)F.out; bf16_t* MBo = (bf16_t*)(F.ws + WS_MB);
    for (int u = F.vcu; u < 1024; u += F.G) {
        if (u < 512) e2_conv_unit(F, u >> 2, u & 3, ACT, MBo);
        else e2_sgu_unit(F, (u - 512) >> 2, (u - 512) & 3, ACT, MBo);
    }
}
template <bool FINAL> __device__ __forceinline__ void combine_rows(const Frame& F) {
    const int gw = F.vcu * NWAVES + F.wave, NGW = F.G * NWAVES;
    const bf16_t* Y = (const bf16_t*)(F.ws + WS_Y);
    for (int m = gw; m < T; m += NGW) {
        GAS f32x4* xr = (GAS f32x4*)(F.out + (size_t)m * D) + F.lane;
        const GAS u32x2* y0 = (const GAS u32x2*)(Y + (size_t)(2 * m) * D) + F.lane; const GAS u32x2* y1 = (const GAS u32x2*)(Y + (size_t)(2 * m + 1) * D) + F.lane;
        f32x4 v[4]; float s = 0.f;
#pragma unroll
        for (int j = 0; j < 4; ++j) { v[j] = xr[64 * j]; const u32x2 a = y0[64 * j], b = y1[64 * j];
            v[j].x += bf2f(a.x & 0xffffu) + bf2f(b.x & 0xffffu); v[j].y += bf2f(a.x >> 16) + bf2f(b.x >> 16);
            v[j].z += bf2f(a.y & 0xffffu) + bf2f(b.y & 0xffffu); v[j].w += bf2f(a.y >> 16) + bf2f(b.y >> 16);
            s += (v[j].x * v[j].x + v[j].y * v[j].y) + (v[j].z * v[j].z + v[j].w * v[j].w); }
        s = wave_sum(s);
        const float rs = 1.0f / sqrtf(s * (1.f / 1024.f) + EPS);
        if (FINAL) {
            const GAS f32x4* g = (const GAS f32x4*)F.in[3] + F.lane;
#pragma unroll
            for (int j = 0; j < 4; ++j) { const f32x4 gg = g[64 * j]; xr[64 * j] = v[j] * rs * gg; }
        } else {
            GAS u32x2* o8 = (GAS u32x2*)((bf16_t*)(F.ws + WS_XB) + (size_t)m * D) + F.lane;
#pragma unroll
            for (int j = 0; j < 4; ++j) { xr[64 * j] = v[j]; u32x2 w; w.x = pk2(v[j].x, v[j].y); w.y = pk2(v[j].z, v[j].w); o8[64 * j] = w; }
            if (F.lane == 0) ((float*)(F.ws + WS_RS0))[m] = rs;
        }
    }
}
}
namespace mk {
typedef float f32x4v __attribute__((ext_vector_type(4)));
__device__ __forceinline__ void phase_router(const Frame& F, int layer) {
    LAS float* red = (LAS float*)F.lds;
    LAS float* ssqr = (LAS float*)(F.lds + 98304);
    LAS float* lg = (LAS float*)(F.lds + 100352);
    LAS float* rsl = (LAS float*)(F.lds + 112640);
    LAS int* sel = (LAS int*)(F.lds + 112896);
    LAS float* gwl = (LAS float*)(F.lds + 113408);
    LAS int* basel = (LAS int*)(F.lds + 113920);
    const bf16_t* RH = (const bf16_t*)(F.ws + WS_ROUTER) + (size_t)(layer * 2) * 49152 + (size_t)F.wave * 6144;
    const bf16_t* RL = RH + 49152;
    unsigned* gcnt = (unsigned*)(F.ws + WS_CTL) + CW_ECNT + layer * 32 * 64;
    const int r = F.lane & 15, q = F.lane >> 4;
    for (int unit = F.vcu; unit < T / 64; unit += F.G) {
        const int tok0 = unit * 64;
        const float* X = F.out + (size_t)tok0 * D + 128 * F.wave + 8 * q;
        f32x4 acc[4][3]; float ssq[4];
#pragma unroll
        for (int tt = 0; tt < 4; ++tt) { ssq[tt] = 0.f;
#pragma unroll
            for (int ct = 0; ct < 3; ++ct) acc[tt][ct] = (f32x4){0.f, 0.f, 0.f, 0.f}; }
#pragma unroll 1
        for (int ks = 0; ks < 4; ++ks) {
            bf16x8 bh[3], bl[3];
#pragma unroll
            for (int ct = 0; ct < 3; ++ct) { bh[ct] = *(const GAS bf16x8*)(RH + ((ks * 3 + ct) * 64 + F.lane) * 8); bl[ct] = *(const GAS bf16x8*)(RL + ((ks * 3 + ct) * 64 + F.lane) * 8); }
#pragma unroll
            for (int tt = 0; tt < 4; ++tt) {
                const float* xp = X + (size_t)(16 * tt + r) * D + 32 * ks;
                const f32x4 x0 = *(const GAS f32x4*)xp, x1 = *(const GAS f32x4*)(xp + 4);
                float xv[8] = {x0.x, x0.y, x0.z, x0.w, x1.x, x1.y, x1.z, x1.w};
                unsigned hh[8], ll[8];
#pragma unroll
                for (int j = 0; j < 8; ++j) { ssq[tt] = fmaf(xv[j], xv[j], ssq[tt]); hh[j] = f2bf(xv[j]); ll[j] = f2bf(xv[j] - bf2f(hh[j])); }
                u32x4 ahw, alw;
                ahw.x = hh[0] | (hh[1] << 16); ahw.y = hh[2] | (hh[3] << 16); ahw.z = hh[4] | (hh[5] << 16); ahw.w = hh[6] | (hh[7] << 16);
                alw.x = ll[0] | (ll[1] << 16); alw.y = ll[2] | (ll[3] << 16); alw.z = ll[4] | (ll[5] << 16); alw.w = ll[6] | (ll[7] << 16);
                const bf16x8 ah = __builtin_bit_cast(bf16x8, ahw), al = __builtin_bit_cast(bf16x8, alw);
#pragma unroll
                for (int ct = 0; ct < 3; ++ct) {
                    acc[tt][ct] = __builtin_amdgcn_mfma_f32_16x16x32_bf16(ah, bh[ct], acc[tt][ct], 0, 0, 0);
                    acc[tt][ct] = __builtin_amdgcn_mfma_f32_16x16x32_bf16(al, bh[ct], acc[tt][ct], 0, 0, 0);
                    acc[tt][ct] = __builtin_amdgcn_mfma_f32_16x16x32_bf16(ah, bl[ct], acc[tt][ct], 0, 0, 0);
                }
            }
        }
#pragma unroll
        for (int tt = 0; tt < 4; ++tt) {
#pragma unroll
            for (int ct = 0; ct < 3; ++ct)
#pragma unroll
                for (int i = 0; i < 4; ++i) red[(F.wave * 64 + 16 * tt + 4 * q + i) * 48 + 16 * ct + r] = acc[tt][ct][i];
            float s = ssq[tt]; s += __shfl_xor(s, 16); s += __shfl_xor(s, 32);
            if (q == 0) ssqr[F.wave * 64 + 16 * tt + r] = s;
        }
        __syncthreads();
        for (int idx = F.tid; idx < 3072; idx += NTHR) { float s = 0.f;
#pragma unroll
            for (int w = 0; w < 8; ++w) s += red[w * 3072 + idx];
            lg[idx] = s; }
        if (F.tid < 64) { float s = 0.f;
#pragma unroll
            for (int w = 0; w < 8; ++w) s += ssqr[w * 64 + F.tid];
            rsl[F.tid] = 1.0f / sqrtf(s * (1.f / 1024.f) + EPS); }
        __syncthreads();
        if (F.tid < 64) {
            const int t = tok0 + F.tid; const float rs = rsl[F.tid]; const LAS float* L = lg + F.tid * 48;
            const float* bg = F.in[22] + layer * 4; const float* br = F.in[24] + layer * 32;
            float gl[4];
#pragma unroll
            for (int j = 0; j < 4; ++j) gl[j] = L[j] * rs + bg[j];
            int gi = 0; float gm = gl[0];
#pragma unroll
            for (int j = 1; j < 4; ++j) if (gl[j] > gm) { gm = gl[j]; gi = j; }
            float den = 0.f;
#pragma unroll
            for (int j = 0; j < 4; ++j) den += __expf(gl[j] - gm);
            const float gp = 1.f / den;
            float el[8];
#pragma unroll
            for (int e = 0; e < 8; ++e) el[e] = L[4 + 8 * gi + e] * rs + br[gi * 8 + e];
            int i1 = 0; float v1 = el[0];
#pragma unroll
            for (int e = 1; e < 8; ++e) if (el[e] > v1) { v1 = el[e]; i1 = e; }
            int i2 = 0; float v2 = -3.0e38f;
#pragma unroll
            for (int e = 0; e < 8; ++e) if (e != i1 && el[e] > v2) { v2 = el[e]; i2 = e; }
            const float e2 = __expf(v2 - v1);
            sel[2 * F.tid] = gi * 8 + i1; sel[2 * F.tid + 1] = gi * 8 + i2;
            gwl[2 * F.tid] = gp / (1.f + e2); gwl[2 * F.tid + 1] = gp * e2 / (1.f + e2);
            ((float*)(F.ws + WS_RSM))[t] = rs;
        }
        __syncthreads();
        int pos = 0, myexp = 0;
        if (F.tid < 128) { myexp = sel[F.tid]; for (int j = 0; j < F.tid; ++j) pos += (sel[j] == myexp) ? 1 : 0; }
        if (F.tid >= 128 && F.tid < 160) { const int e = F.tid - 128; int c = 0; for (int j = 0; j < 128; ++j) c += (sel[j] == e) ? 1 : 0;
            basel[e] = c ? (int)__hip_atomic_fetch_add(gcnt + e * 64, (unsigned)c, __ATOMIC_RELAXED, __HIP_MEMORY_SCOPE_AGENT) : 0; }
        __syncthreads();
        if (F.tid < 128) { const size_t dst = (size_t)myexp * T + basel[myexp] + pos;
            ((int*)(F.ws + WS_LSLOT))[dst] = 2 * (tok0 + (F.tid >> 1)) + (F.tid & 1);
            ((float*)(F.ws + WS_LGW))[dst] = gwl[F.tid]; }
        __syncthreads();
    }
}

template <int NT> __device__ __forceinline__ void moe_segment_t(const Frame& F, int e, int l0, int n) {
    constexpr int PF = MK_PF1, PF2 = MK_PF2;
    LAS unsigned char* XR = F.lds;
    LAS unsigned char* HID = F.lds + 65536;
    LAS int* s_tok = (LAS int*)(F.lds + 131072);
    LAS int* s_slot = s_tok + 128;
    LAS float* s_gw = (LAS float*)(s_slot + 128);
    LAS float* s_rs = s_gw + 128;
    const int r32 = F.lane & 31, hi = F.lane >> 5, w = F.wave;
    const bf16_t* W1e = (const bf16_t*)(F.ws + WS_WMOE) + (size_t)e * W1_EXP + (size_t)w * 65536 + F.lane * 8;
    const bf16_t* W2e = (const bf16_t*)(F.ws + WS_WMOE) + 32 * W1_EXP + (size_t)e * W2_EXP + (size_t)w * 16384 + F.lane * 8;
    bf16x8 wb[PF > PF2 ? PF : PF2][2];
#pragma unroll
    for (int s = 0; s < PF; ++s) { wb[s][0] = *(const GAS bf16x8*)(W1e + (size_t)(s * 2) * 512); wb[s][1] = *(const GAS bf16x8*)(W1e + (size_t)(s * 2 + 1) * 512); }
    if (F.tid < 128) { const int idx = F.tid < n ? F.tid : 0; const size_t li = (size_t)e * T + l0 + idx;
        const int slot = ((const int*)(F.ws + WS_LSLOT))[li]; const int tok = slot >> 1;
        s_tok[F.tid] = tok; s_slot[F.tid] = F.tid < n ? slot : -1; s_gw[F.tid] = F.tid < n ? ((const float*)(F.ws + WS_LGW))[li] : 0.f;
        s_rs[F.tid] = ((const float*)(F.ws + WS_RSM))[tok]; }
    __syncthreads();
    const bf16_t* xrow = (const bf16_t*)(F.ws + WS_XB) + (size_t)s_tok[F.tid & 127] * D + (F.tid >> 7) * 8;
    const int xoff = ((F.tid >> 7) * 128 + (F.tid & 127)) * 16;
    u32x4 xs[2];
#pragma unroll
    for (int i = 0; i < 4; ++i) { xs[0] = *(const GAS u32x4*)(xrow + 32 * i); *(LAS u32x4*)(XR + xoff + i * 8192) = xs[0]; }
    __syncthreads();
    f32x16 accg[NT], accu[NT];
#pragma unroll
    for (int i = 0; i < NT; ++i) { accg[i] = f32x16{}; accu[i] = f32x16{}; }
    for (int kc = 0; kc < 8; ++kc) {
        const LAS unsigned char* buf = XR + (kc & 1) * 32768 + (hi * 128 + r32) * 16;
        LAS unsigned char* nb = XR + ((kc + 1) & 1) * 32768 + xoff;
#pragma unroll
        for (int ks = 0; ks < 8; ++ks) {
            if (kc < 7) {
                if (ks == 0) { xs[0] = *(const GAS u32x4*)(xrow + (kc + 1) * 128); xs[1] = *(const GAS u32x4*)(xrow + (kc + 1) * 128 + 32); }
                if (ks == 3) { *(LAS u32x4*)(nb) = xs[0]; *(LAS u32x4*)(nb + 8192) = xs[1]; }
                if (ks == 4) { xs[0] = *(const GAS u32x4*)(xrow + (kc + 1) * 128 + 64); xs[1] = *(const GAS u32x4*)(xrow + (kc + 1) * 128 + 96); }
                if (ks == 7) { *(LAS u32x4*)(nb + 16384) = xs[0]; *(LAS u32x4*)(nb + 24576) = xs[1]; }
            }
            const bf16x8 wg = wb[ks % PF][0], wu = wb[ks % PF][1];
            if (ks < 8 - PF || kc < 7) { const size_t o = (size_t)((kc * 8 + ks + PF) * 2) * 512;
                wb[ks % PF][0] = *(const GAS bf16x8*)(W1e + o); wb[ks % PF][1] = *(const GAS bf16x8*)(W1e + o + 512); }
#pragma unroll
            for (int i = 0; i < NT; ++i) {
                const bf16x8 xf = *(const LAS bf16x8*)(buf + (2 * ks * 128 + 32 * i) * 16);
                accg[i] = __builtin_amdgcn_mfma_f32_32x32x16_bf16(wg, xf, accg[i], 0, 0, 0);
                accu[i] = __builtin_amdgcn_mfma_f32_32x32x16_bf16(wu, xf, accu[i], 0, 0, 0);
            }
        }
        __syncthreads();
    }
#pragma unroll
    for (int i = 0; i < NT; ++i) {
        const float rs = s_rs[32 * i + r32], gw = s_gw[32 * i + r32];
#pragma unroll
        for (int s = 0; s < 2; ++s) { float hv[8];
#pragma unroll
            for (int j = 0; j < 8; ++j) { const float g = accg[i][8 * s + j] * rs, u = accu[i][8 * s + j] * rs; hv[j] = silu_f(g) * u * gw; }
            u32x4 o; o.x = pk2(hv[0], hv[1]); o.y = pk2(hv[2], hv[3]); o.z = pk2(hv[4], hv[5]); o.w = pk2(hv[6], hv[7]);
            *(LAS u32x4*)(HID + (((2 * w + s) * 2 + hi) * 128 + 32 * i + r32) * 16) = o; }
    }
    __syncthreads();
#pragma unroll
    for (int s = 0; s < PF2; ++s) { wb[s][0] = *(const GAS bf16x8*)(W2e + (size_t)s * 1024); wb[s][1] = *(const GAS bf16x8*)(W2e + (size_t)s * 1024 + 512); }
    bf16_t* Y = (bf16_t*)(F.ws + WS_Y);
    const LAS unsigned char* hb = HID + (hi * 128 + r32) * 16;
#pragma unroll 1
    for (int p = 0; p < 2; ++p) {
        f32x16 acc2[NT][2];
#pragma unroll
        for (int i = 0; i < NT; ++i) { acc2[i][0] = f32x16{}; acc2[i][1] = f32x16{}; }
#pragma unroll
        for (int kk = 0; kk < 16; ++kk) {
            const bf16x8 a0 = wb[kk % PF2][0], a1 = wb[kk % PF2][1];
            if (kk < 16 - PF2 || p < 1) { const size_t o = (kk < 16 - PF2) ? ((size_t)p * 131072 + (size_t)(kk + PF2) * 1024) : ((size_t)(p + 1) * 131072 + (size_t)(kk + PF2 - 16) * 1024);
                wb[kk % PF2][0] = *(const GAS bf16x8*)(W2e + o); wb[kk % PF2][1] = *(const GAS bf16x8*)(W2e + o + 512); }
#pragma unroll
            for (int i = 0; i < NT; ++i) {
                const bf16x8 hf = *(const LAS bf16x8*)(hb + (kk * 2 * 128 + 32 * i) * 16);
                acc2[i][0] = __builtin_amdgcn_mfma_f32_32x32x16_bf16(a0, hf, acc2[i][0], 0, 0, 0);
                acc2[i][1] = __builtin_amdgcn_mfma_f32_32x32x16_bf16(a1, hf, acc2[i][1], 0, 0, 0);
            }
        }
#pragma unroll
        for (int i = 0; i < NT; ++i) {
            const int slot = s_slot[32 * i + r32];
            if (slot >= 0) {
                bf16_t* yr = Y + (size_t)slot * D + 512 * p + 64 * w + 4 * hi;
#pragma unroll
                for (int dt = 0; dt < 2; ++dt)
#pragma unroll
                    for (int qd = 0; qd < 4; ++qd) { u32x2 o; o.x = pk2(acc2[i][dt][4 * qd], acc2[i][dt][4 * qd + 1]); o.y = pk2(acc2[i][dt][4 * qd + 2], acc2[i][dt][4 * qd + 3]);
                        *(GAS u32x2*)(yr + 32 * dt + 8 * qd) = o; }
            }
        }
    }
    __syncthreads();
}
__device__ __forceinline__ void moe_segment(const Frame& F, int e, int l0, int n) {
    const int nt = (n + 31) >> 5;
    if (nt == 4) moe_segment_t<4>(F, e, l0, n); else if (nt == 3) moe_segment_t<3>(F, e, l0, n); else if (nt == 2) moe_segment_t<2>(F, e, l0, n); else moe_segment_t<1>(F, e, l0, n);
}
__device__ __forceinline__ void phase_moe(const Frame& F, int layer) {
    unsigned* gcnt = (unsigned*)(F.ws + WS_CTL) + CW_ECNT + layer * 32 * 64;
    for (int unit = F.vcu; unit < 256; unit += F.G) {
        const int v0 = 128 * unit, v1 = v0 + 128; int vb = 0;
        for (int e = 0; e < 32; ++e) {
            const int ne = (int)__builtin_amdgcn_readfirstlane(__hip_atomic_load(gcnt + e * 64, __ATOMIC_RELAXED, __HIP_MEMORY_SCOPE_AGENT));
            const int lo = v0 > vb ? v0 : vb, hi_ = v1 < vb + ne ? v1 : vb + ne;
            if (lo < hi_) moe_segment(F, e, lo - vb, hi_ - lo);
            vb += ne;
        }
    }
}
}
namespace mk {
__device__ __forceinline__ int crow(int r, int hi) { return (r & 3) + 8 * (r >> 2) + 4 * hi; }
__device__ __forceinline__ s16x4 vtr(const LAS unsigned char* p) {
    typedef short v4i16_t __attribute__((ext_vector_type(4)));
    return __builtin_bit_cast(s16x4, __builtin_amdgcn_ds_read_tr16_b64_v4i16((LAS v4i16_t*)p));
}
constexpr float ATT_THR = 8.f;

template <int MODE> __device__ __forceinline__ void attn_unit(const Frame& F, int unit) {
    constexpr int NKC = MODE == 0 ? 12 : 8, ND0 = NKC / 2, KBYTES = NKC * 1024, BUF = KBYTES + 8192;
    const int lane = F.lane, w = F.wave, r32 = lane & 31, hi = lane >> 5;
    LAS unsigned char* lds = F.lds;
    LAS float* wsf = (LAS float*)(lds + 2 * BUF) + w * 64;
    LAS bf16_t* stg = (LAS bf16_t*)(lds + 2 * BUF + 2048) + w * 2048;
    const bf16_t* Qb = (const bf16_t*)(F.ws + WS_Q); const bf16_t* KVb = (const bf16_t*)(F.ws + WS_KV); const bf16_t* KPE = (const bf16_t*)(F.ws + WS_KPE);
    const bf16_t* Pb = (const bf16_t*)(F.ws + WS_P); bf16_t* Ob = (bf16_t*)(F.ws + WS_MB);
    int b, h = 0, g = 0, hq = 0, tq0, j_lo, j_hi, kbase0, ocol, qpos0 = 0;
    if (MODE == 0) { b = unit >> 6; h = (unit >> 3) & 7; const int qb = unit & 7; tq0 = b * S + 256 * qb + 32 * w; j_lo = 0; j_hi = 32; kbase0 = b * S; ocol = h * 64; }
    else { b = unit >> 6; const int rem = unit & 63; g = rem >> 5; const int qblk = (rem >> 1) & 15, hp = rem & 1; hq = 4 * g + 2 * hp + (w >> 2);
        qpos0 = 128 * qblk + 32 * (w & 3); tq0 = b * S + qpos0; j_lo = (qblk == 0) ? 2 : 0; j_hi = (qblk == 15) ? 4 : 6; kbase0 = b * S + 128 * qblk - 128; ocol = 512 + hq * 64; }
    bf16x8 qr[ND0];
    if (MODE == 0) { const bf16_t* qrow = Qb + (size_t)(tq0 + r32) * 768;
#pragma unroll
        for (int d0 = 0; d0 < 4; ++d0) qr[d0] = *(const GAS bf16x8*)(qrow + h * 64 + 16 * d0 + 8 * hi);
#pragma unroll
        for (int d0 = 4; d0 < 6; ++d0) qr[d0] = *(const GAS bf16x8*)(qrow + 512 + h * 32 + 16 * (d0 - 4) + 8 * hi);
        {
            const f32x2* rp = (const f32x2*)(F.ws + WS_ROPE) + ((tq0 + r32) & (S - 1)) * 16 + 8 * hi;
            bf16x8 a4 = qr[4], a5 = qr[5];
#pragma unroll
            for (int j = 0; j < 8; ++j) { const f32x2 cs = rp[j]; const float x = bf2f((unsigned short)a4[j]), y = bf2f((unsigned short)a5[j]);
                a4[j] = (short)f2bf(x * cs.x - y * cs.y); a5[j] = (short)f2bf(y * cs.x + x * cs.y); }
            qr[4] = a4; qr[5] = a5; }
    } else { const bf16_t* qrow = Pb + (size_t)(tq0 + r32) * 1280 + 512 + hq * 64;
#pragma unroll
        for (int d0 = 0; d0 < ND0; ++d0) qr[d0] = *(const GAS bf16x8*)(qrow + 16 * d0 + 8 * hi);
    }
    const bf16_t *ksrc0, *ksrc1 = nullptr, *vsrc; size_t kstride, kstride1 = 0, vstride;
    const int vrow = 16 * (w & 3) + (lane >> 2), vcol = (w >> 2) * 32 + (lane & 3) * 8;
    if (MODE == 0) { ksrc0 = KVb + (size_t)(kbase0 + lane) * 1024 + h * 64 + w * 8; kstride = 64 * 1024;
        ksrc1 = KPE + (size_t)(kbase0 + lane) * 32 + (w & 3) * 8; kstride1 = 64 * 32;
        vsrc = KVb + (size_t)(kbase0 + vrow) * 1024 + 512 + h * 64 + vcol; vstride = 64 * 1024; }
    else { ksrc0 = Pb + (size_t)((long)kbase0 + lane) * 1280 + 1024 + g * 64 + w * 8; kstride = 64 * 1280;
        vsrc = Pb + (size_t)((long)kbase0 + vrow) * 1280 + 1152 + g * 64 + vcol; vstride = 64 * 1280; }
    const bool two_k = (MODE == 0) && (w < 4);
    u32x4 ks0, ks1 = {0u, 0u, 0u, 0u}, vs;
#define ATT_LOAD(j) do { ks0 = *(const GAS u32x4*)(ksrc0 + (size_t)(j) * kstride); if (two_k) ks1 = *(const GAS u32x4*)(ksrc1 + (size_t)(j) * kstride1); vs = *(const GAS u32x4*)(vsrc + (size_t)(j) * vstride); } while (0)
#define ATT_WRITE(bufo) do { *(LAS u32x4*)(lds + (bufo) + w * 1024 + lane * 16) = ks0; if (two_k) *(LAS u32x4*)(lds + (bufo) + (8 + w) * 1024 + lane * 16) = ks1; \
        *(LAS u32x4*)(lds + (bufo) + KBYTES + w * 1024 + lane * 16) = vs; } while (0)
    float m_run, l_run; f32x16 o[2]; o[0] = f32x16{}; o[1] = f32x16{};
    float slope2 = 0.f;
    if (MODE == 1) { m_run = F.in[19][hq] * LOG2E; l_run = (hi == 0) ? 1.f : 0.f; slope2 = exp2f(-(float)(hq + 1)) * LOG2E; }
    else { m_run = -1e30f; l_run = 0.f; }
    ATT_LOAD(j_lo); ATT_WRITE(0); __syncthreads();
    const int voff = KBYTES + ((lane >> 4) & 1) * 32 + (lane & 3) * 8 + (4 * hi + ((lane & 15) >> 2)) * 64;
    for (int j = j_lo; j < j_hi; ++j) {
        const int bo = ((j - j_lo) & 1) * BUF;
        if (j + 1 < j_hi) ATT_LOAD(j + 1);
        f32x16 p0 = f32x16{}, p1 = f32x16{};
        const LAS unsigned char* kb = lds + bo + hi * 1024 + r32 * 16;
#pragma unroll
        for (int d0 = 0; d0 < ND0; ++d0) {
            const bf16x8 b0 = *(const LAS bf16x8*)(kb + d0 * 2048), b1 = *(const LAS bf16x8*)(kb + d0 * 2048 + 512);
            p0 = __builtin_amdgcn_mfma_f32_32x32x16_bf16(b0, qr[d0], p0, 0, 0, 0);
            p1 = __builtin_amdgcn_mfma_f32_32x32x16_bf16(b1, qr[d0], p1, 0, 0, 0);
        }
        if (MODE == 1) {
            const int qp = qpos0 + r32, kp = 128 * ((unit >> 1) & 15) - 128 + 64 * j;
#pragma unroll
            for (int r = 0; r < 16; ++r) { const int k0 = kp + crow(r, hi); int d0_ = qp - k0; d0_ = d0_ < 0 ? -d0_ : d0_; int d1_ = qp - (k0 + 32); d1_ = d1_ < 0 ? -d1_ : d1_;
                p0[r] = (d0_ <= 128) ? p0[r] - slope2 * (float)d0_ : -1e30f; p1[r] = (d1_ <= 128) ? p1[r] - slope2 * (float)d1_ : -1e30f; }
        }
        float pmax = p0[0];
#pragma unroll
        for (int r = 1; r < 16; ++r) pmax = fmaxf(pmax, p0[r]);
#pragma unroll
        for (int r = 0; r < 16; ++r) pmax = fmaxf(pmax, p1[r]);
        pmax = fmaxf(pmax, __shfl_xor(pmax, 32));
        if (!__all(pmax - m_run <= ATT_THR)) {
            const float mn = fmaxf(m_run, pmax), alpha = fast_exp2(m_run - mn); m_run = mn; l_run *= alpha;
            if (hi == 0) wsf[r32] = alpha;
            LDS_WAIT(); asm volatile("" ::: "memory");
#pragma unroll
            for (int r = 0; r < 16; ++r) { const float a = wsf[crow(r, hi)]; o[0][r] *= a; o[1][r] *= a; }
        }
        float ps = 0.f;
#pragma unroll
        for (int r = 0; r < 16; ++r) { p0[r] = fast_exp2(p0[r] - m_run); p1[r] = fast_exp2(p1[r] - m_run); ps += p0[r] + p1[r]; }
        l_run += ps;
        u32x4 pw[4];
        pw[0] = (u32x4){pk2(p0[0], p0[1]), pk2(p0[2], p0[3]), pk2(p0[4], p0[5]), pk2(p0[6], p0[7])};
        pw[1] = (u32x4){pk2(p0[8], p0[9]), pk2(p0[10], p0[11]), pk2(p0[12], p0[13]), pk2(p0[14], p0[15])};
        pw[2] = (u32x4){pk2(p1[0], p1[1]), pk2(p1[2], p1[3]), pk2(p1[4], p1[5]), pk2(p1[6], p1[7])};
        pw[3] = (u32x4){pk2(p1[8], p1[9]), pk2(p1[10], p1[11]), pk2(p1[12], p1[13]), pk2(p1[14], p1[15])};
        const LAS unsigned char* vp = lds + bo + voff;
#pragma unroll
        for (int d0 = 0; d0 < 2; ++d0)
#pragma unroll
            for (int ks = 0; ks < 4; ++ks) {
                const s16x4 vlo = vtr(vp + d0 * 4096 + ks * 1024), vhi = vtr(vp + d0 * 4096 + ks * 1024 + 512);
                const bf16x8 vf = (bf16x8){vlo[0], vlo[1], vlo[2], vlo[3], vhi[0], vhi[1], vhi[2], vhi[3]};
                o[d0] = __builtin_amdgcn_mfma_f32_32x32x16_bf16(__builtin_bit_cast(bf16x8, pw[ks]), vf, o[d0], 0, 0, 0);
            }
        if (j + 1 < j_hi) ATT_WRITE(BUF - bo);
        __syncthreads();
    }
#undef ATT_LOAD
#undef ATT_WRITE
    const float lt = l_run + __shfl_xor(l_run, 32);
    if (hi == 0) wsf[32 + r32] = lt;
    LDS_WAIT(); asm volatile("" ::: "memory");
#pragma unroll
    for (int r = 0; r < 16; ++r) { const int orow = crow(r, hi); const float rl = fast_rcp(wsf[32 + orow]);
        stg[orow * 64 + r32] = (bf16_t)f2bf(o[0][r] * rl); stg[orow * 64 + 32 + r32] = (bf16_t)f2bf(o[1][r] * rl); }
    LDS_WAIT(); asm volatile("" ::: "memory");
    bf16_t* Ow = Ob + (size_t)tq0 * 1024 + ocol;
#pragma unroll
    for (int i = 0; i < 4; ++i) { const int row = i * 8 + (lane >> 3), ch = lane & 7; const u32x4 v = *(const LAS u32x4*)(stg + row * 64 + ch * 8); *(GAS u32x4*)(Ow + (size_t)row * 1024 + ch * 8) = v; }
    __syncthreads();
}
__device__ __forceinline__ void phase_attn(const Frame& F) {
    for (int u = F.vcu; u < 1024; u += F.G) { if (u < 512) attn_unit<0>(F, u); else attn_unit<1>(F, u - 512); }
}
}
namespace mk {
constexpr int N_PHASES = 14;
__global__ void __launch_bounds__(NTHR, 2) fwd_mega(Args args) {
    extern __shared__ __attribute__((aligned(16))) unsigned char lds_raw[];
    Frame F;
    F.lds = (LAS unsigned char*)lds_raw;
    F.tid = threadIdx.x; F.lane = F.tid & 63; F.wave = __builtin_amdgcn_readfirstlane(F.tid >> 6);
    F.G = gridDim.x; { const int bx = blockIdx.x; F.vcu = (F.G % 8 == 0) ? (bx % 8) * (F.G / 8) + bx / 8 : bx; }
    F.in = args.in; F.out = args.out; F.ws = args.ws;
    volatile LAS unsigned* MISC = (volatile LAS unsigned*)(F.lds + MISC_OFF);
    if (F.tid < 64) MISC[F.tid] = 0u;
    __syncthreads();
    unsigned* ctl = (unsigned*)(F.ws + WS_CTL);
    const int lo = args.ph_lo, hi = args.ph_hi;
    XcdBarrier bar; bar.bar = ctl + CW_BAR; bar.x = 0; bar.st = nullptr;
    if (hi - lo > 1) bar = xcd_barrier_post(ctl + CW_BAR, MISC + 8);
#ifndef MK_PHASE_MASK
#define MK_PHASE_MASK 0x3fff
#endif
#define IN(k) (((MK_PHASE_MASK >> (k)) & 1) && lo <= (k) && (k) < hi)
#ifndef MK_DUP_MASK
#define MK_DUP_MASK 0
#endif
#define REP(k) for (int rep_ = 0; rep_ <= ((MK_DUP_MASK >> (k)) & 1); ++rep_)
#define FRESH() do { int t_ = threadIdx.x; asm volatile("" : "+v"(t_)); F.tid = t_; F.lane = t_ & 63; F.wave = __builtin_amdgcn_readfirstlane(t_ >> 6); } while (0)
#define SEAM(k) do { if (IN(k) && IN((k) + 1)) xcd_barrier(bar); } while (0)
    bf16_t* XB = (bf16_t*)(F.ws + WS_XB); bf16_t* MBp = (bf16_t*)(F.ws + WS_MB); bf16_t* Pp = (bf16_t*)(F.ws + WS_P);
    float* RS0 = (float*)(F.ws + WS_RS0);
    const f32x2* rope = (const f32x2*)(F.ws + WS_ROPE);
    const int bid = (int)blockIdx.x;

    if (IN(0)) REP(0) { FRESH(); phase_p0(F); } SEAM(0);
    if (IN(1)) REP(1) { FRESH(); pg8::Gemm g{XB, (const bf16_t*)(F.ws + WS_WINE), T, 2048, 1024, 1024, 1024}; pg8::StaticOrder So; So.init(T, 2048, F.G, bid);
        EpiE1 E{(bf16_t*)F.out, RS0}; pg8::gemm_phase<EpiE1, pg8::StaticOrder, true, true>(F.lds, g, So, E); } SEAM(1);
    if (IN(2)) REP(2) { FRESH(); phase_e2(F); } SEAM(2);
    if (IN(3)) REP(3) { FRESH(); pg8::Gemm g{MBp, (const bf16_t*)(F.ws + WS_WOUTE), T, 1024, 1024, 1024, 1024}; pg8::StaticOrder So; So.init(T, 1024, F.G, bid);
        EpiRes E{F.in[0], F.out, XB}; pg8::gemm_phase<EpiRes, pg8::StaticOrder, true, true>(F.lds, g, So, E); } SEAM(3);
    if (IN(4)) REP(4) { FRESH(); phase_router(F, 0); } SEAM(4);
    if (IN(5)) REP(5) { FRESH(); phase_moe(F, 0); } SEAM(5);
    if (IN(6)) REP(6) { FRESH(); combine_rows<false>(F);
 } SEAM(6);
    if (IN(7)) REP(7) { FRESH(); pg8::Gemm g{XB, (const bf16_t*)(F.ws + WS_WINO), T, 1280, 1024, 1024, 1024}; pg8::StaticOrder So; So.init(T, 1280, F.G, bid);
        EpiO1 E{Pp, RS0, (float*)(F.ws + WS_SSQQ), (float*)(F.ws + WS_SSQKV), (bf16_t*)(F.ws + WS_KPE), rope};
        pg8::gemm_phase<EpiO1, pg8::StaticOrder, true, true>(F.lds, g, So, E);
        if (rep_ == 0) { LAS float* scr = (LAS float*)(F.lds + F.wave * 16384); unsigned* ctr = ctl + CW_CVT; CvtRegs R;
            int it = (int)__builtin_amdgcn_readfirstlane((F.lane == 0) ? (int)__hip_atomic_fetch_add(ctr, 1u, __ATOMIC_RELAXED, __HIP_MEMORY_SCOPE_AGENT) : 0);
            if (it < MOE_CVT_ITEMS) moe_cvt_load(F, 1, it, R);
            while (it < MOE_CVT_ITEMS) {
                moe_cvt_stage(F, 1, it, R, scr);
                const int nx = (int)__builtin_amdgcn_readfirstlane((F.lane == 0) ? (int)__hip_atomic_fetch_add(ctr, 1u, __ATOMIC_RELAXED, __HIP_MEMORY_SCOPE_AGENT) : 0);
                if (nx < MOE_CVT_ITEMS) moe_cvt_load(F, 1, nx, R);
                moe_cvt_emit(F, it, scr); it = nx; } } } SEAM(7);
    if (IN(8)) REP(8) { FRESH(); pg8::Gemm g{Pp, (const bf16_t*)(F.ws + WS_WUQ), T, 1792, 256, 1280, 256}; O2Order So; So.init(T, 1792, F.G, bid);
        EpiO2 E{(bf16_t*)(F.ws + WS_Q), (bf16_t*)(F.ws + WS_KV), (const float*)(F.ws + WS_SSQQ), (const float*)(F.ws + WS_SSQKV)};
        pg8::gemm_phase<EpiO2, O2Order, true, true>(F.lds, g, So, E);
    } SEAM(8);
    if (IN(9)) REP(9) { FRESH(); phase_attn(F); } SEAM(9);
    if (IN(10)) REP(10) { FRESH(); pg8::Gemm g{MBp, (const bf16_t*)(F.ws + WS_WOUTO), T, 1024, 1024, 1024, 1024}; pg8::StaticOrder So; So.init(T, 1024, F.G, bid);
        EpiRes E{F.out, F.out, XB}; pg8::gemm_phase<EpiRes, pg8::StaticOrder, true, true>(F.lds, g, So, E); } SEAM(10);
    if (IN(11)) REP(11) { FRESH(); phase_router(F, 1); } SEAM(11);
    if (IN(12)) REP(12) { FRESH(); phase_moe(F, 1); } SEAM(12);
    if (IN(13)) REP(13) { FRESH(); combine_rows<true>(F); }
#undef IN
#undef SEAM
}

static int g_grid = 0;
static bool setup() {
    if (g_grid) return g_grid > 0;
    int dev = 0, cus = 0;
    if (hipGetDevice(&dev) != hipSuccess || hipDeviceGetAttribute(&cus, hipDeviceAttributeMultiprocessorCount, dev) != hipSuccess) { g_grid = -1; return false; }
    if (hipFuncSetAttribute((const void*)fwd_mega, hipFuncAttributeMaxDynamicSharedMemorySize, LDS_BYTES) != hipSuccess) { fprintf(stderr, "hipFuncSetAttribute failed\n"); g_grid = -1; return false; }
    int per_cu = 0;
    if (hipOccupancyMaxActiveBlocksPerMultiprocessor(&per_cu, (const void*)fwd_mega, NTHR, LDS_BYTES) != hipSuccess || per_cu < 1) { fprintf(stderr, "occupancy query: %d\n", per_cu); }
    (void)hipGetLastError();
    g_grid = cus;
    return true;
}
static void launch_range(void* const* d_in, float* out, unsigned char* ws, int lo, int hi, hipStream_t st) {
    Args a{};
    for (int i = 0; i < 28; ++i) a.in[i] = (const float*)d_in[i];
    a.out = out; a.ws = ws; a.ph_lo = lo; a.ph_hi = hi;
    hipLaunchKernelGGL(fwd_mega, dim3(g_grid), dim3(NTHR), LDS_BYTES, st, a);
}
}
extern "C" void kernel_launch(void* const* d_in, const int* in_sizes, int n_in, void* d_out, int out_size, void* d_ws, size_t ws_size, hipStream_t stream) {
    if (n_in != 28 || out_size != mk::T * mk::D || ws_size < mk::WS_END) { fprintf(stderr, "kernel_launch: unexpected shapes n_in %d out %d ws %zu\n", n_in, out_size, ws_size); return; }
    if (!mk::setup()) return;
    if (hipMemsetAsync((unsigned char*)d_ws + mk::WS_CTL, 0, mk::CTL_ZERO_BYTES, stream) != hipSuccess) { fprintf(stderr, "kernel_launch: memset failed\n"); return; }
    mk::launch_range(d_in, (float*)d_out, (unsigned char*)d_ws, 0, mk::N_PHASES, stream);
}
```

```cpp
#define MK_PF1 2
#define MK_PF2 2
#include <hip/hip_runtime.h>
#include <hip/hip_bf16.h>
#include <cstdio>
#include <cstdint>
namespace pg8 {
#define PG8_LAS __attribute__((address_space(3)))
typedef unsigned short bf16_t;
typedef short bf16x8 __attribute__((ext_vector_type(8)));
typedef float f32x4 __attribute__((ext_vector_type(4)));
typedef unsigned u32x4 __attribute__((ext_vector_type(4)));
constexpr int BM = 256, BK = 64, HALF = 128, HTB = HALF * BK * 2  , STAGE_BYTES = 8 * HTB, NXCD = 8, WGM = 8;

__host__ __device__ __forceinline__ int lds_byte(int r, int c) { const int st = (r >> 4) * 2 + (c >> 5), rr = r & 15, cc = c & 31, ob = rr * 64 + cc * 2; return st * 1024 + (ob ^ (((ob >> 9) & 1) << 5)); }
__host__ __device__ __forceinline__ void stage_rc(int b, int& R, int& C) { const int st = b / 1024, sb = b % 1024, swz = sb ^ (((sb >> 9) & 1) << 5); R = (st >> 1) * 16 + swz / 64; C = (st & 1) * 32 + (swz % 64) / 2; }
__host__ __device__ __forceinline__ int perm32(int rho) { const int n = rho >> 4, i = rho & 15; return 8 * (i >> 2) + 4 * n + (i & 3); }

struct Unit { int pm, pn, aoff; };
struct Gemm { const bf16_t* A; const bf16_t* Bt; int M, N, K, lda, ldb; };

struct StaticOrder {
    int nM, nN, nwg, G, c;
    __host__ __device__ void init(int M, int N, int G_, int c_) { nM = M / BM; nN = N / BM; nwg = nM * nN; G = G_; c = c_; }
    __host__ __device__ bool next(int i, Unit& u) const {
        const long L = (long)i * G + c; if (L >= nwg) return false;
        int wgid = (int)L; { const int q = nwg / NXCD, r = nwg % NXCD, xcd = wgid % NXCD, off = wgid / NXCD; wgid = (xcd < r ? xcd * (q + 1) : r * (q + 1) + (xcd - r) * q) + off; }
        const int nig = WGM * nN, gid = wgid / nig, fm = gid * WGM, gsz = (nM - fm) < WGM ? (nM - fm) : WGM;
        u.pm = fm + ((wgid % nig) % gsz); u.pn = (wgid % nig) / gsz; u.aoff = 0; return true;
    }
    __device__ __forceinline__ void a_ready(const Unit&) const {}
    __device__ __forceinline__ void done(const Unit&) const {}
};

__device__ __forceinline__ unsigned cvt_pk_bf16(float lo, float hi) { unsigned r; asm volatile("v_cvt_pk_bf16_f32 %0, %1, %2" : "=v"(r) : "v"(lo), "v"(hi)); return r; }
typedef float f32x2 __attribute__((ext_vector_type(2)));
template <class Epi, class Sched, bool ALIGN_EPI = false, bool SP2 = false>
__device__ __forceinline__ void gemm_phase(PG8_LAS unsigned char* lds, const Gemm g, const Sched& S, const Epi& E) {
    int tid_ = threadIdx.x; asm volatile("" : "+v"(tid_));
    const int tid = tid_, wid = __builtin_amdgcn_readfirstlane(tid >> 6), lane = tid & 63, wr = wid >> 2, wc = wid & 3, fr = lane & 15, fq = lane >> 4;
    const int K = g.K, nt = K / BK;
    unsigned voffA[2], voffB[2];
#pragma unroll
    for (int i = 0; i < 2; ++i) { int R, C; stage_rc(tid * 16 + i * 8192, R, C); const int Rb = Epi::PERM ? ((R & ~31) + perm32(R & 31)) : R;
        voffA[i] = (unsigned)(R * g.lda + C) * 2u; voffB[i] = (unsigned)(Rb * g.ldb + C) * 2u; }
    const size_t kstep = (size_t)(BK * 2);
    const size_t hstepA = (size_t)HALF * g.lda * 2, hstepB = (size_t)HALF * g.ldb * 2;
    const size_t tstepA = 2 * hstepA, tstepB = 2 * hstepB;
    const unsigned ldsw = (unsigned)wid * 1024u;
    const int aoff = lds_byte(wr * 64 + fr, fq * 8), boff = lds_byte(wc * 32 + fr, fq * 8);
#define PG8_SA(b, h) (((b) * 2 + (h)) * HTB)
#define PG8_SB(b, h) ((4 + (b) * 2 + (h)) * HTB)
#define PG8_STAGE(bufoff, gbase, voff) do { _Pragma("unroll") for (int _i = 0; _i < 2; ++_i) \
        __builtin_amdgcn_global_load_lds((const unsigned*)((const char*)(gbase) + (voff)[_i]), (PG8_LAS unsigned*)(lds + (bufoff) + ldsw + _i * 8192), 16, 0, 0); } while (0)
#define PG8_LDA(dst, b, h) do { _Pragma("unroll") for (int m = 0; m < 4; ++m) _Pragma("unroll") for (int k = 0; k < 2; ++k) dst[m][k] = *(const PG8_LAS bf16x8*)(lds + PG8_SA(b, h) + aoff + m * 2048 + k * 1024); } while (0)
#define PG8_LDB(dst, b, h) do { _Pragma("unroll") for (int n = 0; n < 2; ++n) _Pragma("unroll") for (int k = 0; k < 2; ++k) dst[n][k] = *(const PG8_LAS bf16x8*)(lds + PG8_SB(b, h) + boff + n * 2048 + k * 1024); } while (0)
#define PG8_MMA(ai, bj, At, Bt) do { __builtin_amdgcn_s_setprio(1); _Pragma("unroll") for (int m = 0; m < 4; ++m) _Pragma("unroll") for (int n = 0; n < 2; ++n) _Pragma("unroll") for (int k = 0; k < 2; ++k) \
        acc[ai][bj][m][n] = __builtin_amdgcn_mfma_f32_16x16x32_bf16(Bt[n][k], At[m][k], acc[ai][bj][m][n], 0, 0, 0); __builtin_amdgcn_s_setprio(0); } while (0)
#define PG8_WAIT_V(n) asm volatile("s_waitcnt vmcnt(" #n ")" ::: "memory")
#define PG8_WAIT_L(n) asm volatile("s_waitcnt lgkmcnt(" #n ")" ::: "memory")
#define PG8_BAR __builtin_amdgcn_s_barrier()
#define PG8_SCHED __builtin_amdgcn_sched_barrier(0)
    Unit cur, nxt; int ui = 0;
    if (!S.next(0, cur)) return;
    f32x4 acc[2][2][4][2];
#pragma unroll
    for (int a = 0; a < 2; ++a)
#pragma unroll
        for (int b = 0; b < 2; ++b)
#pragma unroll
            for (int m = 0; m < 4; ++m)
#pragma unroll
                for (int n = 0; n < 2; ++n) acc[a][b][m][n] = (f32x4){0.f, 0.f, 0.f, 0.f};
    bf16x8 At[4][2], B0[2][2], B1[2][2];
    const char* cA = (const char*)g.A + (size_t)cur.pm * tstepA + cur.aoff; const char* cB = (const char*)g.Bt + (size_t)cur.pn * tstepB;
    S.a_ready(cur);
    if constexpr (SP2) {
        PG8_STAGE(PG8_SB(0, 0), cB, voffB); PG8_STAGE(PG8_SB(0, 1), cB + hstepB, voffB); PG8_STAGE(PG8_SA(0, 0), cA, voffA); PG8_STAGE(PG8_SA(0, 1), cA + hstepA, voffA);
        if (wr == 1) PG8_BAR;
        PG8_WAIT_V(2); PG8_BAR;
        PG8_STAGE(PG8_SB(1, 0), cB + kstep, voffB); PG8_STAGE(PG8_SA(1, 0), cA + kstep, voffA); PG8_STAGE(PG8_SB(1, 1), cB + hstepB + kstep, voffB);
        PG8_WAIT_V(6); PG8_BAR;
    } else {
        PG8_STAGE(PG8_SB(0, 0), cB, voffB); PG8_STAGE(PG8_SA(0, 0), cA, voffA); PG8_STAGE(PG8_SB(0, 1), cB + hstepB, voffB); PG8_STAGE(PG8_SA(0, 1), cA + hstepA, voffA);
        if (wr == 1) PG8_BAR;
        PG8_WAIT_V(4); PG8_BAR;
        PG8_STAGE(PG8_SB(1, 0), cB + kstep, voffB); PG8_STAGE(PG8_SA(1, 0), cA + kstep, voffA); PG8_STAGE(PG8_SB(1, 1), cB + hstepB + kstep, voffB);
        PG8_WAIT_V(6); PG8_BAR;
    }
    for (;;) {
        const bool has_next = S.next(ui + 1, nxt);
        const char* nA = has_next ? (const char*)g.A + (size_t)nxt.pm * tstepA + nxt.aoff : cA; const char* nB = has_next ? (const char*)g.Bt + (size_t)nxt.pn * tstepB : cB;
        for (int t = 0; t < nt; t += 2) {
            const bool last = (t == nt - 2);
            const char* a1 = cA + (size_t)(t + 1) * kstep;
            const char* a2 = last ? nA : cA + (size_t)(t + 2) * kstep; const char* b2 = last ? nB : cB + (size_t)(t + 2) * kstep;
            const char* a3 = a2 + kstep; const char* b3 = b2 + kstep;
            if (last && has_next) S.a_ready(nxt);
            if constexpr (SP2) {
            PG8_LDB(B0, 0, 0); PG8_LDB(B1, 0, 1); PG8_SCHED; PG8_LDA(At, 0, 0); PG8_STAGE(PG8_SA(1, 1), a1 + hstepA, voffA);
            PG8_WAIT_V(8); PG8_WAIT_L(0); PG8_BAR; PG8_MMA(0, 0, At, B0); PG8_MMA(0, 1, At, B1); PG8_BAR; PG8_SCHED;
            PG8_LDA(At, 0, 1); PG8_STAGE(PG8_SB(0, 0), b2, voffB); PG8_STAGE(PG8_SB(0, 1), b2 + hstepB, voffB); PG8_STAGE(PG8_SA(0, 0), a2, voffA);
            PG8_WAIT_V(8); PG8_WAIT_L(0); PG8_BAR; PG8_MMA(1, 0, At, B0); PG8_MMA(1, 1, At, B1); PG8_BAR; PG8_SCHED;
            PG8_LDB(B0, 1, 0); PG8_LDB(B1, 1, 1); PG8_SCHED; PG8_LDA(At, 1, 0); PG8_STAGE(PG8_SA(0, 1), a2 + hstepA, voffA);
            PG8_WAIT_V(8); PG8_WAIT_L(0); PG8_BAR; PG8_MMA(0, 0, At, B0); PG8_MMA(0, 1, At, B1); PG8_BAR; PG8_SCHED;
            PG8_LDA(At, 1, 1); PG8_STAGE(PG8_SB(1, 0), b3, voffB); PG8_STAGE(PG8_SB(1, 1), b3 + hstepB, voffB); PG8_STAGE(PG8_SA(1, 0), a3, voffA);
            PG8_WAIT_V(8); PG8_WAIT_L(0); PG8_BAR; PG8_MMA(1, 0, At, B0); PG8_MMA(1, 1, At, B1); PG8_BAR; PG8_SCHED;
            } else {
            PG8_LDB(B0, 0, 0); PG8_SCHED; PG8_LDA(At, 0, 0); PG8_STAGE(PG8_SA(1, 1), a1 + hstepA, voffA);
            PG8_WAIT_L(8); PG8_BAR; PG8_WAIT_L(0); PG8_MMA(0, 0, At, B0); PG8_BAR; PG8_SCHED;
            PG8_LDB(B1, 0, 1); PG8_STAGE(PG8_SB(0, 0), b2, voffB);
            PG8_BAR; PG8_WAIT_L(0); PG8_MMA(0, 1, At, B1); PG8_BAR;
            PG8_LDA(At, 0, 1); PG8_STAGE(PG8_SA(0, 0), a2, voffA);
            PG8_BAR; PG8_WAIT_L(0); PG8_MMA(1, 0, At, B0); PG8_BAR; PG8_SCHED;
            PG8_STAGE(PG8_SB(0, 1), b2 + hstepB, voffB);
            PG8_WAIT_V(6); PG8_BAR; PG8_MMA(1, 1, At, B1); PG8_BAR;
            PG8_LDB(B0, 1, 0); PG8_SCHED; PG8_LDA(At, 1, 0); PG8_STAGE(PG8_SA(0, 1), a2 + hstepA, voffA);
            PG8_WAIT_L(8); PG8_BAR; PG8_WAIT_L(0); PG8_MMA(0, 0, At, B0); PG8_BAR; PG8_SCHED;
            PG8_LDB(B1, 1, 1); PG8_STAGE(PG8_SB(1, 0), b3, voffB);
            PG8_BAR; PG8_WAIT_L(0); PG8_MMA(0, 1, At, B1); PG8_BAR;
            PG8_LDA(At, 1, 1); PG8_STAGE(PG8_SA(1, 0), a3, voffA);
            PG8_BAR; PG8_WAIT_L(0); PG8_MMA(1, 0, At, B0); PG8_BAR; PG8_SCHED;
            PG8_STAGE(PG8_SB(1, 1), b3 + hstepB, voffB);
            PG8_WAIT_V(6); PG8_BAR; PG8_MMA(1, 1, At, B1); PG8_BAR;
            }
        }
        if constexpr (ALIGN_EPI) { if (wr == 0) PG8_BAR; }
        if constexpr (!Epi::AFTER_DRAIN) { E(acc, cur, wr, wc, fr, fq); S.done(cur); }
        if (!has_next) break;
#pragma unroll
        for (int a = 0; a < 2; ++a)
#pragma unroll
            for (int b = 0; b < 2; ++b)
#pragma unroll
                for (int m = 0; m < 4; ++m)
#pragma unroll
                    for (int n = 0; n < 2; ++n) acc[a][b][m][n] = (f32x4){0.f, 0.f, 0.f, 0.f};
        cur = nxt; cA = nA; cB = nB; ++ui;
        if constexpr (ALIGN_EPI) { if (wr == 1) PG8_BAR; }
    }
    PG8_WAIT_V(0);
    if constexpr (!ALIGN_EPI) { if (wr == 0) PG8_BAR; }
    PG8_BAR;
    if constexpr (Epi::AFTER_DRAIN) { E.fused(acc, cur, wr, wc, fr, fq, lds, wid, lane); S.done(cur); }
#undef PG8_SA
#undef PG8_SB
#undef PG8_STAGE
#undef PG8_LDA
#undef PG8_LDB
#undef PG8_MMA
#undef PG8_WAIT_V
#undef PG8_WAIT_L
#undef PG8_BAR
#undef PG8_SCHED
}
}
namespace mk {
using pg8::bf16_t; using pg8::bf16x8; using pg8::f32x4; using pg8::u32x4; using pg8::f32x2;
typedef float f32x16 __attribute__((ext_vector_type(16)));
typedef unsigned u32x2 __attribute__((ext_vector_type(2)));
typedef short s16x4 __attribute__((ext_vector_type(4)));
#define GAS __attribute__((address_space(1)))
#define LAS __attribute__((address_space(3)))
typedef GAS unsigned gu32;
#define RLX_AGENT __ATOMIC_RELAXED, __HIP_MEMORY_SCOPE_AGENT
#define LDS_WAIT() asm volatile("s_waitcnt lgkmcnt(0)" ::: "memory")
#define VM_WAIT() asm volatile("s_waitcnt vmcnt(0)" ::: "memory")

constexpr int T = 16384, D = 1024, S = 2048, NB = 8;
constexpr int NWAVES = 8, NTHR = 512;
constexpr float EPS = 1e-6f;
constexpr float LOG2E = 1.4426950408889634f;
constexpr float C2M = 0.10206207261596575f * LOG2E;
constexpr float C2S = 0.125f * LOG2E;

constexpr size_t MiB = (size_t)1 << 20;
constexpr size_t WS_CTL = 0, CTL_ZERO_BYTES = 1 * MiB;
constexpr size_t WS_WINE = 1 * MiB;
constexpr size_t WS_WOUTE = 5 * MiB;
constexpr size_t WS_WINO = 7 * MiB;
constexpr size_t WS_WUQ = 10 * MiB;
constexpr size_t WS_WUKV = 10 * MiB + 393216;
constexpr size_t WS_WOUTO = 11 * MiB;
constexpr size_t WS_ROUTER = 13 * MiB;
constexpr size_t WS_ROPE = 14 * MiB;
constexpr size_t WS_RS0 = 14 * MiB + 512 * 1024;
constexpr size_t WS_RSM = WS_RS0 + 64 * 1024;
constexpr size_t WS_SSQQ = 15 * MiB;
constexpr size_t WS_SSQKV = 15 * MiB + 256 * 1024;
constexpr size_t WS_WMOE = 16 * MiB;
constexpr size_t WS_XB = 64 * MiB;
constexpr size_t WS_MB = 96 * MiB;
constexpr size_t WS_Y = 128 * MiB;
constexpr size_t WS_Q = 128 * MiB;
constexpr size_t WS_KV = 152 * MiB;
constexpr size_t WS_P = 192 * MiB;
constexpr size_t WS_LSLOT = 232 * MiB;
constexpr size_t WS_LGW = 234 * MiB;
constexpr size_t WS_KPE = 236 * MiB;
constexpr size_t WS_END = 240 * MiB;
constexpr size_t W1_EXP = 524288, W2_EXP = 262144;

constexpr int CW_TMO = 0;
constexpr int CW_BAR = 4096;
constexpr int CW_CVT = 8192;
constexpr int CW_ECNT = 16384;

constexpr int LDS_BYTES = 160 * 1024;
constexpr int RING_BYTES = 131072;
constexpr int MISC_OFF = 159 * 1024;

__device__ __forceinline__ unsigned f2bf(float f) { unsigned u = __builtin_bit_cast(unsigned, f); return (u + 0x7fffu + ((u >> 16) & 1u)) >> 16; }
__device__ __forceinline__ float bf2f(unsigned h) { return __builtin_bit_cast(float, h << 16); }
__device__ __forceinline__ unsigned pk2(float lo, float hi) { return pg8::cvt_pk_bf16(lo, hi); }
__device__ __forceinline__ float wave_sum(float v) {
#pragma unroll
    for (int o = 1; o < 64; o <<= 1) v += __shfl_xor(v, o);
    return v;
}
__device__ __forceinline__ float fast_exp2(float x) { return __builtin_amdgcn_exp2f(x); }
__device__ __forceinline__ float fast_rcp(float x) { return __builtin_amdgcn_rcpf(x); }
__device__ __forceinline__ float sigmoid_f(float x) { return fast_rcp(1.f + fast_exp2(-x * LOG2E)); }
__device__ __forceinline__ float silu_f(float x) { return x * sigmoid_f(x); }
__device__ __forceinline__ float gelu_f(float x) { const float u = 0.7978845608028654f * (x + 0.044715f * x * x * x); return x * sigmoid_f(2.f * u); }

#define XB_TMO      128
#define XB_XCNT(j)  (256  + 64 * (j))
#define XB_XSUB(j)  (1280 + 64 * (j))
#define XB_XGEN(j)  (2304 + 64 * (j))
#define XB_TOP      3328
#define XB_TOPGEN   3392
#define XCD_BAR_WORDS 3456
#define XB_SPIN_CAP (1u << 18)
__device__ __forceinline__ unsigned xb_ld(unsigned* p)              { return __hip_atomic_load(p, __ATOMIC_RELAXED, __HIP_MEMORY_SCOPE_AGENT); }
__device__ __forceinline__ unsigned xb_add(unsigned* p, unsigned v) { return __hip_atomic_fetch_add(p, v, __ATOMIC_RELAXED, __HIP_MEMORY_SCOPE_AGENT); }
__device__ __forceinline__ unsigned xb_xcc_id() { return (unsigned)__builtin_amdgcn_s_getreg((3 << 11) | 20) & 0xFu; }
#define XB_SPIN(cond, bar) do { unsigned _sp = 0; while (cond) { __builtin_amdgcn_s_sleep(1); \
    if ((++_sp & 255u) == 0u) { if (xb_ld(&(bar)[XB_TMO])) break; if (_sp > XB_SPIN_CAP) { atomicAdd(&(bar)[XB_TMO], 1u); break; } } } } while (0)
struct XcdBarrier { unsigned* bar; unsigned x; volatile LAS unsigned* st; };
__device__ __forceinline__ XcdBarrier xcd_barrier_post(unsigned* bar, volatile LAS unsigned* st) {
    XcdBarrier b; b.bar = bar; b.x = xb_xcc_id(); b.st = st;
    if (threadIdx.x == 0) (void)xb_add(&bar[XB_XCNT(b.x)], 1u);
    return b;
}
__device__ __forceinline__ void xcd_barrier_complete(unsigned* bar, unsigned x, unsigned& nloc, unsigned& nx) {
    const unsigned G = gridDim.x * gridDim.y * gridDim.z;
    unsigned sum, cnt, mine, sp = 0u;
    for (;;) {
        sum = 0u; cnt = 0u; mine = 0u;
#pragma unroll
        for (unsigned j = 0; j < 16; ++j) { const unsigned c = xb_ld(&bar[XB_XCNT(j)]); sum += c; cnt += (c > 0u) ? 1u : 0u; mine = (j == x) ? c : mine; }
        if (sum == G) break;
        __builtin_amdgcn_s_sleep(1);
        if ((++sp & 255u) == 0u) { if (xb_ld(&bar[XB_TMO])) break; if (sp > XB_SPIN_CAP) { atomicAdd(&bar[XB_TMO], 1u); break; } }
    }
    nloc = mine > 0u ? mine : 1u; nx = cnt > 0u ? cnt : 1u;
}
__device__ __forceinline__ void xcd_barrier(const XcdBarrier& b) {
    asm volatile("s_waitcnt vmcnt(0)" ::: "memory");
    __syncthreads();
    if (threadIdx.x == 0) {
        unsigned* bar = b.bar;
        __builtin_amdgcn_s_waitcnt(0);
        unsigned nloc = b.st[0], nx = b.st[1];
        if (nloc == 0u) { xcd_barrier_complete(bar, b.x, nloc, nx); b.st[0] = nloc; b.st[1] = nx; }
        const unsigned old = xb_add(&bar[XB_XSUB(b.x)], 1u);
        const unsigned gen = old / nloc;
        if (old + 1u == (gen + 1u) * nloc) {
            __builtin_amdgcn_fence(__ATOMIC_RELEASE, "agent");
            asm volatile("s_waitcnt vmcnt(0)" ::: "memory");
            const unsigned og = xb_add(&bar[XB_TOP], 1u);
            const unsigned tg = og / nx;
            if (og + 1u == (tg + 1u) * nx) xb_add(&bar[XB_TOPGEN], 1u);
            else XB_SPIN(xb_ld(&bar[XB_TOPGEN]) == tg, bar);
            __builtin_amdgcn_fence(__ATOMIC_ACQUIRE, "agent");
            xb_add(&bar[XB_XGEN(b.x)], 1u);
            asm volatile("s_waitcnt vmcnt(0)" ::: "memory");
        } else {
            XB_SPIN(xb_ld(&bar[XB_XGEN(b.x)]) == gen, bar);
            __builtin_amdgcn_fence(__ATOMIC_ACQUIRE, "agent");
            asm volatile("s_waitcnt vmcnt(0)" ::: "memory");
        }
    }
    __syncthreads();
}

struct Args { const float* in[28]; float* out; unsigned char* ws; int ph_lo, ph_hi; };

struct Frame {
    LAS unsigned char* lds;
    int tid, lane, wave, vcu, G;
    const float* const* in;
    float* out; unsigned char* ws;
};
}
namespace mk {
__device__ __forceinline__ void p0_transpose_item(const float* W, int ldn, int k0, int src_n0, bf16_t* WT, int ldk, int dst_n0,
                                                  const float* gain, float scale, LAS float* scr, int lane) {
    if (src_n0 >= 0) {
#pragma unroll 8
        for (int i = 0; i < 32; ++i) { const int kk = 2 * i + (lane >> 5);
            float v = W[(size_t)(k0 + kk) * ldn + src_n0 + (lane & 31)] * scale; if (gain) v *= gain[k0 + kk];
            scr[kk * 33 + (lane & 31)] = v; }
    } else {
#pragma unroll 8
        for (int i = 0; i < 32; ++i) { const int kk = 2 * i + (lane >> 5); scr[kk * 33 + (lane & 31)] = 0.f; }
    }
    LDS_WAIT(); asm volatile("" ::: "memory");
    const int c = lane & 7;
#pragma unroll
    for (int j = 0; j < 4; ++j) { const int n = (lane >> 3) + 8 * j; const LAS float* s = scr + (8 * c) * 33 + n;
        u32x4 o; o.x = pk2(s[0 * 33], s[1 * 33]); o.y = pk2(s[2 * 33], s[3 * 33]); o.z = pk2(s[4 * 33], s[5 * 33]); o.w = pk2(s[6 * 33], s[7 * 33]);
        *(GAS u32x4*)(WT + (size_t)(dst_n0 + n) * ldk + k0 + 8 * c) = o; }
    LDS_WAIT(); asm volatile("" ::: "memory");
}
template <bool STAGE2>
__device__ __forceinline__ void moe_cvt_tile(const float* src, int ld, const float* gain16, bf16_t* dst0, size_t piece_stride  , LAS float* scr, int lane) {
#pragma unroll 4
    for (int i = 0; i < 16; ++i) { f32x4 v = *(const GAS f32x4*)(src + (size_t)i * ld + 4 * lane); if (gain16) v = v * gain16[i]; *(LAS f32x4*)(scr + i * 256 + 4 * lane) = v; }
    LDS_WAIT(); asm volatile("" ::: "memory");
    const int r = lane & 31, h = lane >> 5;
#pragma unroll
    for (int c = 0; c < 8; ++c) {
        float v[8];
#pragma unroll
        for (int j = 0; j < 8; ++j) { const int row = STAGE2 ? (8 * (j >> 2) + 4 * h + (j & 3)) : (8 * h + j); v[j] = scr[row * 256 + 32 * c + r]; }
        u32x4 o; o.x = pk2(v[0], v[1]); o.y = pk2(v[2], v[3]); o.z = pk2(v[4], v[5]); o.w = pk2(v[6], v[7]);
        *(GAS u32x4*)(dst0 + (size_t)c * piece_stride + (size_t)lane * 8) = o;
    }
    LDS_WAIT(); asm volatile("" ::: "memory");
}
constexpr int MOE_CVT_ITEMS = 6144;
struct CvtRegs { f32x4 v[16]; };
__device__ __forceinline__ void moe_cvt_load(const Frame& F, int layer, int it, CvtRegs& R) {
    const float* src; int ld;
    if (it < 4096) { const int gu = it >> 11, r = it & 2047, e = r >> 6, ks = r & 63; src = (gu ? F.in[26] : F.in[25]) + ((size_t)(layer * 32 + e) * 1024 + 16 * ks) * 256; ld = 256; }
    else { const int r = it - 4096, e = r >> 6, kk = (r >> 2) & 15, dq = r & 3; src = F.in[27] + ((size_t)(layer * 32 + e) * 256 + 16 * kk) * 1024 + 256 * dq; ld = 1024; }
#pragma unroll
    for (int i = 0; i < 16; ++i) R.v[i] = *(const GAS f32x4*)(src + (size_t)i * ld + 4 * F.lane);
}
__device__ __forceinline__ void moe_cvt_stage(const Frame& F, int layer, int it, const CvtRegs& R, LAS float* scr) {
    if (it < 4096) { const int ks = it & 63; const float* gain = F.in[2] + layer * 1024 + 16 * ks;
#pragma unroll
        for (int i = 0; i < 16; ++i) *(LAS f32x4*)(scr + i * 256 + 4 * F.lane) = R.v[i] * gain[i];
    } else {
#pragma unroll
        for (int i = 0; i < 16; ++i) *(LAS f32x4*)(scr + i * 256 + 4 * F.lane) = R.v[i];
    }
    LDS_WAIT(); asm volatile("" ::: "memory");
}
__device__ __forceinline__ void moe_cvt_emit(const Frame& F, int it, LAS float* scr) {
    bf16_t* W1 = (bf16_t*)(F.ws + WS_WMOE); bf16_t* W2 = W1 + 32 * W1_EXP;
    const int rr = F.lane & 31, h = F.lane >> 5;
    const bool s2 = it >= 4096;
    bf16_t* base; size_t st_c2, st_dt;
    if (!s2) { const int gu = it >> 11, r = it & 2047, e = r >> 6, ks = r & 63; base = W1 + (size_t)e * W1_EXP + ((size_t)ks * 2 + gu) * 512; st_c2 = 2 * 65536; st_dt = 65536; }
    else { const int r = it - 4096, e = r >> 6, kk = (r >> 2) & 15, dq = r & 3; const int p = dq >> 1, w0 = (dq & 1) * 4;
        base = W2 + (size_t)e * W2_EXP + ((size_t)(p * 8 + w0) * 16 + kk) * 1024; st_c2 = 16 * 1024; st_dt = 512; }
#pragma unroll
    for (int c = 0; c < 8; ++c) {
        float v[8];
#pragma unroll
        for (int j = 0; j < 8; ++j) { const int row = s2 ? (8 * (j >> 2) + 4 * h + (j & 3)) : (8 * h + j); v[j] = scr[row * 256 + 32 * c + rr]; }
        u32x4 o; o.x = pk2(v[0], v[1]); o.y = pk2(v[2], v[3]); o.z = pk2(v[4], v[5]); o.w = pk2(v[6], v[7]);
        *(GAS u32x4*)(base + (size_t)(c >> 1) * st_c2 + (size_t)(c & 1) * st_dt + (size_t)F.lane * 8) = o;
    }
    LDS_WAIT(); asm volatile("" ::: "memory");
}
__device__ __forceinline__ void row_to_bf16_rs(const float* xrow, bf16_t* orow, float* rs, int lane) {
    const GAS f32x4* xr = (const GAS f32x4*)xrow + lane;
    f32x4 v[4]; float s = 0.f;
#pragma unroll
    for (int j = 0; j < 4; ++j) { v[j] = xr[64 * j]; s += (v[j].x * v[j].x + v[j].y * v[j].y) + (v[j].z * v[j].z + v[j].w * v[j].w); }
    s = wave_sum(s);
    GAS u32x2* o8 = (GAS u32x2*)orow + lane;
#pragma unroll
    for (int j = 0; j < 4; ++j) { u32x2 w; w.x = pk2(v[j].x, v[j].y); w.y = pk2(v[j].z, v[j].w); o8[64 * j] = w; }
    if (lane == 0) *rs = 1.0f / sqrtf(s * (1.f / 1024.f) + EPS);
}

struct DenseDesc { int src_idx, K, ldn, nblk, ldk; size_t dst; int kind; };
__device__ __forceinline__ void p0_dense_item(const Frame& F, int it, LAS float* scr) {
    int r = it;
    if (r < 1024) { const int kb = r >> 6, nb = r & 63; const int n = 32 * nb; int src;
        if (n < 1024) { const int j = n >> 8, c = n & 255; src = (c < 128) ? (128 * j + c) : (512 + 128 * j + (c - 128)); } else src = n;
        p0_transpose_item(F.in[4], 2048, 64 * kb, src, (bf16_t*)(F.ws + WS_WINE), 1024, n, F.in[1], 1.f, scr, F.lane); return; } r -= 1024;
    if (r < 512) { const int kb = r >> 5, nb = r & 31;
        p0_transpose_item(F.in[13], 1024, 64 * kb, 32 * nb, (bf16_t*)(F.ws + WS_WOUTE), 1024, 32 * nb, nullptr, 1.f, scr, F.lane); return; } r -= 512;
    if (r < 640) { const int kb = r / 40, nb = r % 40; const int n = 32 * nb; int src; float sc = 1.f;
        if (n < 416) src = n; else if (n < 512) src = -1; else if (n < 1024) { src = 416 + (n - 512); sc = C2S; } else if (n < 1152) src = 928 + (n - 1024); else src = 1056 + (n - 1152);
        p0_transpose_item(F.in[14], 1184, 64 * kb, src, (bf16_t*)(F.ws + WS_WINO), 1024, n, F.in[1] + 1024, sc, scr, F.lane); return; } r -= 640;
    if (r < 96) { const int kb = r / 24, nb = r % 24; const int n = 32 * nb; int src;
        if (n < 512) src = 96 * (n >> 6) + (n & 63); else src = 96 * ((n - 512) >> 5) + 64;
        p0_transpose_item(F.in[16], 768, 64 * kb, src, (bf16_t*)(F.ws + WS_WUQ), 256, n, F.in[15], C2M, scr, F.lane); return; } r -= 96;
    if (r < 128) { const int kb = r >> 5, nb = r & 31; const int n = 32 * nb; int src;
        if (n < 512) src = 128 * (n >> 6) + (n & 63); else src = 128 * ((n - 512) >> 6) + 64 + ((n - 512) & 63);
        if (kb >= 2) src = -1;
        p0_transpose_item(F.in[18], 1024, kb >= 2 ? 0 : 64 * kb, src, (bf16_t*)(F.ws + WS_WUKV) + (kb >= 2 ? 64 * kb : 0), 256, n, F.in[17], 1.f, scr, F.lane); return; } r -= 128;
    { const int kb = r >> 5, nb = r & 31;
        p0_transpose_item(F.in[20], 1024, 64 * kb, 32 * nb, (bf16_t*)(F.ws + WS_WOUTO), 1024, 32 * nb, nullptr, 1.f, scr, F.lane); }
}
constexpr int DENSE_ITEMS = 2912;

__device__ __forceinline__ void phase_p0(const Frame& F) {
    LAS float* scr = (LAS float*)(F.lds + F.wave * 16384);
    const int gw = F.vcu * NWAVES + F.wave, NGW = F.G * NWAVES;
    { CvtRegs R; int it = gw; if (it < MOE_CVT_ITEMS) moe_cvt_load(F, 0, it, R);
      for (; it < MOE_CVT_ITEMS; it += NGW) { moe_cvt_stage(F, 0, it, R, scr); if (it + NGW < MOE_CVT_ITEMS) moe_cvt_load(F, 0, it + NGW, R); moe_cvt_emit(F, it, scr); } }
    for (int it = gw; it < DENSE_ITEMS; it += NGW) p0_dense_item(F, it, scr);
    for (int m = gw; m < T; m += NGW) row_to_bf16_rs(F.in[0] + (size_t)m * D, (bf16_t*)(F.ws + WS_XB) + (size_t)m * D, (float*)(F.ws + WS_RS0) + m, F.lane);
    const int gt = gw * 64 + F.lane, NGT = NGW * 64;
    for (int idx = gt; idx < 2 * 49152; idx += NGT) {
        const int layer = idx / 49152, li = idx % 49152;
        const int j = li & 7, ln = (li >> 3) & 63, blk = li >> 9, ct = blk % 3, ks = (blk / 3) & 3, w = blk / 12;
        const int k = 128 * w + 32 * ks + 8 * (ln >> 4) + j, col = 16 * ct + (ln & 15);
        float v = 0.f;
        if (col < 4) v = F.in[21][((size_t)layer * 1024 + k) * 4 + col];
        else if (col < 36) v = F.in[23][(((size_t)layer * 4 + ((col - 4) >> 3)) * 1024 + k) * 8 + ((col - 4) & 7)];
        v *= F.in[2][layer * 1024 + k];
        const unsigned hi = f2bf(v); const unsigned lo = f2bf(v - bf2f(hi));
        bf16_t* R = (bf16_t*)(F.ws + WS_ROUTER);
        R[(size_t)(layer * 2 + 0) * 49152 + li] = (bf16_t)hi;
        R[(size_t)(layer * 2 + 1) * 49152 + li] = (bf16_t)lo;
    }
    for (int idx = gt; idx < S * 16; idx += NGT) {
        const int pos = idx >> 4, j = idx & 15;
        const double inv = pow(10000.0, -(double)(2 * j) / 32.0), ang = (double)pos * inv;
        f32x2 cs; cs.x = (float)cos(ang); cs.y = (float)sin(ang);
        ((f32x2*)(F.ws + WS_ROPE))[idx] = cs;
    }
}
}
namespace mk {
using pg8::Unit;
__device__ __forceinline__ u32x4 pack8(const f32x4& a, const f32x4& b) { u32x4 w; w.x = pk2(a[0], a[1]); w.y = pk2(a[2], a[3]); w.z = pk2(b[0], b[1]); w.w = pk2(b[2], b[3]); return w; }

struct EpiE1 {
    static constexpr bool PERM = true, AFTER_DRAIN = false;
    bf16_t* ACT; const float* rs;
    __device__ __forceinline__ void operator()(const f32x4 (&acc)[2][2][4][2], const Unit& u, int wr, int wc, int fr, int fq) const {
        const int row0 = u.pm * 256 + wr * 64 + fr, cl = wc * 32 + 8 * fq;
#pragma unroll
        for (int ai = 0; ai < 2; ++ai)
#pragma unroll
            for (int m = 0; m < 4; ++m) {
                const int row = row0 + ai * 128 + m * 16; const float r = rs[row]; bf16_t* rowp = ACT + (size_t)row * 1536;
                if (u.pn < 4) {
                    f32x4 o0, o1;
#pragma unroll
                    for (int i = 0; i < 4; ++i) { o0[i] = acc[ai][0][m][0][i] * r * sigmoid_f(acc[ai][1][m][0][i] * r); o1[i] = acc[ai][0][m][1][i] * r * sigmoid_f(acc[ai][1][m][1][i] * r); }
                    *(u32x4*)(rowp + 128 * u.pn + cl) = pack8(o0, o1);
                } else {
                    const int base = (u.pn < 6) ? (512 + (u.pn - 4) * 256) : (1024 + (u.pn - 6) * 256);
#pragma unroll
                    for (int bj = 0; bj < 2; ++bj) { f32x4 o0, o1;
#pragma unroll
                        for (int i = 0; i < 4; ++i) { o0[i] = gelu_f(acc[ai][bj][m][0][i] * r); o1[i] = gelu_f(acc[ai][bj][m][1][i] * r); }
                        *(u32x4*)(rowp + base + bj * 128 + cl) = pack8(o0, o1); }
                }
            }
    }
};
struct EpiRes {
    static constexpr bool PERM = true, AFTER_DRAIN = false;
    const float* resid; float* out; bf16_t* xb;
    __device__ __forceinline__ void operator()(const f32x4 (&acc)[2][2][4][2], const Unit& u, int wr, int wc, int fr, int fq) const {
        const int row0 = u.pm * 256 + wr * 64 + fr, col0 = u.pn * 256 + wc * 32 + 8 * fq;
#pragma unroll
        for (int ai = 0; ai < 2; ++ai)
#pragma unroll
            for (int m = 0; m < 4; ++m) {
                const size_t off = (size_t)(row0 + ai * 128 + m * 16) * 1024 + col0;
#pragma unroll
                for (int bj = 0; bj < 2; ++bj) {
                    const f32x4 r0 = *(const f32x4*)(resid + off + bj * 128), r1 = *(const f32x4*)(resid + off + bj * 128 + 4);
                    const f32x4 v0 = acc[ai][bj][m][0] + r0, v1 = acc[ai][bj][m][1] + r1;
                    *(f32x4*)(out + off + bj * 128) = v0; *(f32x4*)(out + off + bj * 128 + 4) = v1;
                    *(u32x4*)(xb + off + bj * 128) = pack8(v0, v1);
                }
            }
    }
};
struct EpiO1 {
    static constexpr bool PERM = true, AFTER_DRAIN = false;
    bf16_t* P; const float* rs; float* ssqq; float* ssqkv; bf16_t* kpe; const f32x2* rope;
    __device__ __forceinline__ void operator()(const f32x4 (&acc)[2][2][4][2], const Unit& u, int wr, int wc, int fr, int fq) const {
        const int row0 = u.pm * 256 + wr * 64 + fr, cl = wc * 32 + 8 * fq;
#pragma unroll
        for (int ai = 0; ai < 2; ++ai)
#pragma unroll
            for (int m = 0; m < 4; ++m) {
                const int row = row0 + ai * 128 + m * 16; const float r = rs[row]; bf16_t* rowp = P + (size_t)row * 1280 + u.pn * 256 + cl;
                f32x4 v[2][2];
#pragma unroll
                for (int bj = 0; bj < 2; ++bj) { v[bj][0] = acc[ai][bj][m][0] * r; v[bj][1] = acc[ai][bj][m][1] * r; *(u32x4*)(rowp + bj * 128) = pack8(v[bj][0], v[bj][1]); }
                if (u.pn <= 1) {
                    float s = 0.f;
#pragma unroll
                    for (int i = 0; i < 4; ++i) { s += v[0][0][i] * v[0][0][i] + v[0][1][i] * v[0][1][i]; if (u.pn == 0) s += v[1][0][i] * v[1][0][i] + v[1][1][i] * v[1][1][i]; }
                    s += __shfl_xor(s, 16); s += __shfl_xor(s, 32);
                    if (fq == 0) (u.pn == 0 ? ssqq : ssqkv)[(size_t)row * 4 + wc] = s;
                }
                if (u.pn == 1 && wc == 0) {
                    const int pos = row & (S - 1); f32x4 o[2];
#pragma unroll
                    for (int n = 0; n < 2; ++n)
#pragma unroll
                        for (int i = 0; i < 4; ++i) { const float x = v[1][n][i], y = __shfl_xor(x, 32); const f32x2 cs = rope[pos * 16 + ((8 * fq + 4 * n + i) & 15)];
                            o[n][i] = (fq < 2) ? (x * cs.x - y * cs.y) : (x * cs.x + y * cs.y); }
                    *(u32x4*)(kpe + (size_t)row * 32 + 8 * fq) = pack8(o[0], o[1]);
                }
                asm volatile("" ::: "memory");
            }
    }
};
struct O2Order : pg8::StaticOrder {
    __device__ bool next(int i, Unit& u) const { const bool ok = pg8::StaticOrder::next(i, u); if (ok) u.aoff = (u.pn >= 3) ? 512 : 0; return ok; }
};
struct EpiO2 {
    static constexpr bool PERM = true, AFTER_DRAIN = false;
    bf16_t* Q; bf16_t* KV; const float* ssqq; const float* ssqkv;
    __device__ __forceinline__ void operator()(const f32x4 (&acc)[2][2][4][2], const Unit& u, int wr, int wc, int fr, int fq) const {
        const int row0 = u.pm * 256 + wr * 64 + fr, cl = wc * 32 + 8 * fq;
        const bool isq = u.pn < 3; const float* ssq = isq ? ssqq : ssqkv; const float inv_n = isq ? (1.f / 256.f) : (1.f / 128.f);
        bf16_t* O = isq ? (Q + u.pn * 256 + cl) : (KV + (u.pn - 3) * 256 + cl); const int ldo = isq ? 768 : 1024;
#pragma unroll
        for (int ai = 0; ai < 2; ++ai)
#pragma unroll
            for (int m = 0; m < 4; ++m) {
                const int row = row0 + ai * 128 + m * 16; const f32x4 sq = *(const f32x4*)(ssq + (size_t)row * 4);
                const float r = __builtin_amdgcn_rsqf(((sq[0] + sq[1]) + (sq[2] + sq[3])) * inv_n + EPS);
                bf16_t* rowp = O + (size_t)row * ldo;
#pragma unroll
                for (int bj = 0; bj < 2; ++bj) *(u32x4*)(rowp + bj * 128) = pack8(acc[ai][bj][m][0] * r, acc[ai][bj][m][1] * r);
                asm volatile("" ::: "memory");
            }
    }
};
}
namespace mk {
__device__ __forceinline__ void e2_conv_unit(const Frame& F, int tt, int grp, const bf16_t* ACT, bf16_t* MBo) {
    LAS bf16_t* tile = (LAS bf16_t*)F.lds;
    const int t0 = tt * 128, s0 = t0 & (S - 1);
    for (int idx = F.tid; idx < 158 * 16; idx += NTHR) { const int r = idx >> 4, c = idx & 15; const int sp = s0 + r - 15;
        u32x4 v = {0u, 0u, 0u, 0u};
        if (sp >= 0 && sp < S) v = *(const GAS u32x4*)(ACT + (size_t)(t0 + r - 15) * 1536 + grp * 128 + c * 8);
        *(LAS u32x4*)(tile + r * 128 + c * 8) = v; }
    __syncthreads();
    const int ch = grp * 128 + 2 * F.lane;
    const float* cw = F.in[5]; float w0[31], w1[31];
#pragma unroll
    for (int q = 0; q < 31; ++q) { const f32x2 wv = *(const f32x2*)(cw + q * 512 + ch); w0[q] = wv.x; w1[q] = wv.y; }
    const f32x2 bias = *(const f32x2*)(F.in[6] + ch);
    float a0[16], a1[16];
#pragma unroll
    for (int k = 0; k < 16; ++k) { a0[k] = bias.x; a1[k] = bias.y; }
    const LAS unsigned* src = (const LAS unsigned*)(tile + (16 * F.wave) * 128 + 2 * F.lane);
#pragma unroll
    for (int i = 0; i < 46; ++i) { const unsigned x = src[i * 64]; const float x0 = bf2f(x & 0xffffu), x1 = bf2f(x >> 16);
#pragma unroll
        for (int k = 0; k < 16; ++k) { const int q = i - k; if (q >= 0 && q <= 30) { a0[k] = fmaf(x0, w0[q], a0[k]); a1[k] = fmaf(x1, w1[q], a1[k]); } } }
    const f32x2 g = *(const f32x2*)(F.in[7] + ch), bt = *(const f32x2*)(F.in[8] + ch);
    LAS float* scr = (LAS float*)(F.lds + 49152) + F.wave * 32;
    const bool b5 = (F.lane & 32) != 0, b4 = (F.lane & 16) != 0, b3 = (F.lane & 8) != 0, b2 = (F.lane & 4) != 0;
    const int tk = (b5 ? 8 : 0) + (b4 ? 4 : 0) + (b3 ? 2 : 0) + (b2 ? 1 : 0);
#define E2_BFLY(S, OUT) do { float v8_[8], v4_[4], v2_[2]; \
        _Pragma("unroll") for (int k = 0; k < 8; ++k) { const float kp = b5 ? S[k + 8] : S[k], sd = b5 ? S[k] : S[k + 8]; v8_[k] = kp + __shfl_xor(sd, 32); } \
        _Pragma("unroll") for (int k = 0; k < 4; ++k) { const float kp = b4 ? v8_[k + 4] : v8_[k], sd = b4 ? v8_[k] : v8_[k + 4]; v4_[k] = kp + __shfl_xor(sd, 16); } \
        _Pragma("unroll") for (int k = 0; k < 2; ++k) { const float kp = b3 ? v4_[k + 2] : v4_[k], sd = b3 ? v4_[k] : v4_[k + 2]; v2_[k] = kp + __shfl_xor(sd, 8); } \
        { const float kp = b2 ? v2_[1] : v2_[0], sd = b2 ? v2_[0] : v2_[1]; OUT = kp + __shfl_xor(sd, 4); } \
        OUT += __shfl_xor(OUT, 2); OUT += __shfl_xor(OUT, 1); } while (0)
    float st[16], tot;
#pragma unroll
    for (int k = 0; k < 16; ++k) st[k] = a0[k] + a1[k];
    E2_BFLY(st, tot);
    if ((F.lane & 3) == 0) scr[tk] = tot * (1.f / 128.f);
    LDS_WAIT(); asm volatile("" ::: "memory");
    float mu[16];
#pragma unroll
    for (int k4 = 0; k4 < 4; ++k4) { const f32x4 m4 = *(const LAS f32x4*)(scr + 4 * k4); mu[4 * k4] = m4.x; mu[4 * k4 + 1] = m4.y; mu[4 * k4 + 2] = m4.z; mu[4 * k4 + 3] = m4.w; }
#pragma unroll
    for (int k = 0; k < 16; ++k) { a0[k] -= mu[k]; a1[k] -= mu[k]; st[k] = a0[k] * a0[k] + a1[k] * a1[k]; }
    E2_BFLY(st, tot);
    if ((F.lane & 3) == 0) scr[16 + tk] = 1.0f / sqrtf(tot * (1.f / 128.f) + EPS);
    LDS_WAIT(); asm volatile("" ::: "memory");
#undef E2_BFLY
#pragma unroll
    for (int k4 = 0; k4 < 4; ++k4) { const f32x4 r4 = *(const LAS f32x4*)(scr + 16 + 4 * k4);
#pragma unroll
        for (int i = 0; i < 4; ++i) { const int k = 4 * k4 + i; const float rs = r4[i];
            const float y0 = silu_f(a0[k] * rs * g.x + bt.x), y1 = silu_f(a1[k] * rs * g.y + bt.y);
            *(GAS unsigned*)(MBo + (size_t)(t0 + 16 * F.wave + k) * 1024 + ch) = pk2(y0, y1); } }
    __syncthreads();
}
__device__ __forceinline__ void e2_sgu_unit(const Frame& F, int chunk, int h, const bf16_t* ACT, bf16_t* MBo) {
    constexpr int LD = 136, LDO = 132;
    LAS bf16_t* WSl = (LAS bf16_t*)F.lds;
    LAS bf16_t* VTl = (LAS bf16_t*)(F.lds + 34816);
    LAS float* OUTl = (LAS float*)(F.lds + 69632);
    const int t0 = chunk * 128;
    const float* wsp = F.in[11] + (size_t)h * 128 * 128;
    for (int idx = F.tid; idx < 4096; idx += NTHR) { const int r = idx >> 5, c4 = idx & 31; const f32x4 v = *(const GAS f32x4*)(wsp + r * 128 + 4 * c4);
        u32x2 w; w.x = pk2(v.x, v.y); w.y = pk2(v.z, v.w); *(LAS u32x2*)(WSl + r * LD + 4 * c4) = w; }
#pragma unroll
    for (int it = 0; it < 4; ++it) { const int idx = F.tid + NTHR * it, s = idx >> 4, c = idx & 15;
        const u32x4 raw = *(const GAS u32x4*)(ACT + (size_t)(t0 + s) * 1536 + 1024 + h * 128 + 8 * c);
        float x[8]; x[0] = bf2f(raw.x & 0xffffu); x[1] = bf2f(raw.x >> 16); x[2] = bf2f(raw.y & 0xffffu); x[3] = bf2f(raw.y >> 16);
        x[4] = bf2f(raw.z & 0xffffu); x[5] = bf2f(raw.z >> 16); x[6] = bf2f(raw.w & 0xffffu); x[7] = bf2f(raw.w >> 16);
        float sm = 0.f;
#pragma unroll
        for (int i = 0; i < 8; ++i) sm += x[i];
        sm += __shfl_xor(sm, 1); sm += __shfl_xor(sm, 2); sm += __shfl_xor(sm, 4); sm += __shfl_xor(sm, 8);
        const float mu = sm * (1.f / 128.f); float q = 0.f;
#pragma unroll
        for (int i = 0; i < 8; ++i) { x[i] -= mu; q += x[i] * x[i]; }
        q += __shfl_xor(q, 1); q += __shfl_xor(q, 2); q += __shfl_xor(q, 4); q += __shfl_xor(q, 8);
        const float rs = 1.0f / sqrtf(q * (1.f / 128.f) + EPS);
        const float* vg = F.in[9] + h * 128 + 8 * c; const float* vb = F.in[10] + h * 128 + 8 * c;
#pragma unroll
        for (int i = 0; i < 8; ++i) { const float y = x[i] * rs * vg[i] + vb[i]; VTl[(8 * c + i) * LD + s] = (bf16_t)f2bf(y); }
    }
    __syncthreads();
    const int wt = F.wave >> 1, wc = F.wave & 1, r32 = F.lane & 31, hi = F.lane >> 5;
    f32x16 acc[2]; acc[0] = f32x16{}; acc[1] = f32x16{};
#pragma unroll
    for (int ks = 0; ks < 8; ++ks) {
        const bf16x8 a = *(const LAS bf16x8*)(WSl + (32 * wt + r32) * LD + 16 * ks + 8 * hi);
#pragma unroll
        for (int ct = 0; ct < 2; ++ct) { const bf16x8 b = *(const LAS bf16x8*)(VTl + (64 * wc + 32 * ct + r32) * LD + 16 * ks + 8 * hi);
            acc[ct] = __builtin_amdgcn_mfma_f32_32x32x16_bf16(a, b, acc[ct], 0, 0, 0); }
    }
    const float* bsp = F.in[12] + h * 128;
#pragma unroll
    for (int ct = 0; ct < 2; ++ct)
#pragma unroll
        for (int r = 0; r < 16; ++r) { const int trow = 32 * wt + (r & 3) + 8 * (r >> 2) + 4 * hi; OUTl[trow * LDO + 64 * wc + 32 * ct + r32] = acc[ct][r] + bsp[trow]; }
    __syncthreads();
#pragma unroll
    for (int it = 0; it < 4; ++it) { const int idx = F.tid + NTHR * it, t = idx >> 4, c = idx & 15;
        const u32x4 raw = *(const GAS u32x4*)(ACT + (size_t)(t0 + t) * 1536 + 512 + h * 128 + 8 * c);
        const f32x4 s0 = *(const LAS f32x4*)(OUTl + t * LDO + 8 * c), s1 = *(const LAS f32x4*)(OUTl + t * LDO + 8 * c + 4);
        u32x4 o; o.x = pk2(bf2f(raw.x & 0xffffu) * s0.x, bf2f(raw.x >> 16) * s0.y); o.y = pk2(bf2f(raw.y & 0xffffu) * s0.z, bf2f(raw.y >> 16) * s0.w);
        o.z = pk2(bf2f(raw.z & 0xffffu) * s1.x, bf2f(raw.z >> 16) * s1.y); o.w = pk2(bf2f(raw.w & 0xffffu) * s1.z, bf2f(raw.w >> 16) * s1.w);
        *(GAS u32x4*)(MBo + (size_t)(t0 + t) * 1024 + 512 + h * 128 + 8 * c) = o; }
    __syncthreads();
}
__device__ __forceinline__ void phase_e2(const Frame& F) {
    const bf16_t* ACT = (const bf16_t*)F.out; bf16_t* MBo = (bf16_t*)(F.ws + WS_MB);
    for (int u = F.vcu; u < 1024; u += F.G) {
        if (u < 512) e2_conv_unit(F, u >> 2, u & 3, ACT, MBo);
        else e2_sgu_unit(F, (u - 512) >> 2, (u - 512) & 3, ACT, MBo);
    }
}
template <bool FINAL> __device__ __forceinline__ void combine_rows(const Frame& F) {
    const int gw = F.vcu * NWAVES + F.wave, NGW = F.G * NWAVES;
    const bf16_t* Y = (const bf16_t*)(F.ws + WS_Y);
    for (int m = gw; m < T; m += NGW) {
        GAS f32x4* xr = (GAS f32x4*)(F.out + (size_t)m * D) + F.lane;
        const GAS u32x2* y0 = (const GAS u32x2*)(Y + (size_t)(2 * m) * D) + F.lane; const GAS u32x2* y1 = (const GAS u32x2*)(Y + (size_t)(2 * m + 1) * D) + F.lane;
        f32x4 v[4]; float s = 0.f;
#pragma unroll
        for (int j = 0; j < 4; ++j) { v[j] = xr[64 * j]; const u32x2 a = y0[64 * j], b = y1[64 * j];
            v[j].x += bf2f(a.x & 0xffffu) + bf2f(b.x & 0xffffu); v[j].y += bf2f(a.x >> 16) + bf2f(b.x >> 16);
            v[j].z += bf2f(a.y & 0xffffu) + bf2f(b.y & 0xffffu); v[j].w += bf2f(a.y >> 16) + bf2f(b.y >> 16);
            s += (v[j].x * v[j].x + v[j].y * v[j].y) + (v[j].z * v[j].z + v[j].w * v[j].w); }
        s = wave_sum(s);
        const float rs = 1.0f / sqrtf(s * (1.f / 1024.f) + EPS);
        if (FINAL) {
            const GAS f32x4* g = (const GAS f32x4*)F.in[3] + F.lane;
#pragma unroll
            for (int j = 0; j < 4; ++j) { const f32x4 gg = g[64 * j]; xr[64 * j] = v[j] * rs * gg; }
        } else {
            GAS u32x2* o8 = (GAS u32x2*)((bf16_t*)(F.ws + WS_XB) + (size_t)m * D) + F.lane;
#pragma unroll
            for (int j = 0; j < 4; ++j) { xr[64 * j] = v[j]; u32x2 w; w.x = pk2(v[j].x, v[j].y); w.y = pk2(v[j].z, v[j].w); o8[64 * j] = w; }
            if (F.lane == 0) ((float*)(F.ws + WS_RS0))[m] = rs;
        }
    }
}
}
namespace mk {
typedef float f32x4v __attribute__((ext_vector_type(4)));
__device__ __forceinline__ void phase_router(const Frame& F, int layer) {
    LAS float* red = (LAS float*)F.lds;
    LAS float* ssqr = (LAS float*)(F.lds + 98304);
    LAS float* lg = (LAS float*)(F.lds + 100352);
    LAS float* rsl = (LAS float*)(F.lds + 112640);
    LAS int* sel = (LAS int*)(F.lds + 112896);
    LAS float* gwl = (LAS float*)(F.lds + 113408);
    LAS int* basel = (LAS int*)(F.lds + 113920);
    const bf16_t* RH = (const bf16_t*)(F.ws + WS_ROUTER) + (size_t)(layer * 2) * 49152 + (size_t)F.wave * 6144;
    const bf16_t* RL = RH + 49152;
    unsigned* gcnt = (unsigned*)(F.ws + WS_CTL) + CW_ECNT + layer * 32 * 64;
    const int r = F.lane & 15, q = F.lane >> 4;
    for (int unit = F.vcu; unit < T / 64; unit += F.G) {
        const int tok0 = unit * 64;
        const float* X = F.out + (size_t)tok0 * D + 128 * F.wave + 8 * q;
        f32x4 acc[4][3]; float ssq[4];
#pragma unroll
        for (int tt = 0; tt < 4; ++tt) { ssq[tt] = 0.f;
#pragma unroll
            for (int ct = 0; ct < 3; ++ct) acc[tt][ct] = (f32x4){0.f, 0.f, 0.f, 0.f}; }
#pragma unroll 1
        for (int ks = 0; ks < 4; ++ks) {
            bf16x8 bh[3], bl[3];
#pragma unroll
            for (int ct = 0; ct < 3; ++ct) { bh[ct] = *(const GAS bf16x8*)(RH + ((ks * 3 + ct) * 64 + F.lane) * 8); bl[ct] = *(const GAS bf16x8*)(RL + ((ks * 3 + ct) * 64 + F.lane) * 8); }
#pragma unroll
            for (int tt = 0; tt < 4; ++tt) {
                const float* xp = X + (size_t)(16 * tt + r) * D + 32 * ks;
                const f32x4 x0 = *(const GAS f32x4*)xp, x1 = *(const GAS f32x4*)(xp + 4);
                float xv[8] = {x0.x, x0.y, x0.z, x0.w, x1.x, x1.y, x1.z, x1.w};
                unsigned hh[8], ll[8];
#pragma unroll
                for (int j = 0; j < 8; ++j) { ssq[tt] = fmaf(xv[j], xv[j], ssq[tt]); hh[j] = f2bf(xv[j]); ll[j] = f2bf(xv[j] - bf2f(hh[j])); }
                u32x4 ahw, alw;
                ahw.x = hh[0] | (hh[1] << 16); ahw.y = hh[2] | (hh[3] << 16); ahw.z = hh[4] | (hh[5] << 16); ahw.w = hh[6] | (hh[7] << 16);
                alw.x = ll[0] | (ll[1] << 16); alw.y = ll[2] | (ll[3] << 16); alw.z = ll[4] | (ll[5] << 16); alw.w = ll[6] | (ll[7] << 16);
                const bf16x8 ah = __builtin_bit_cast(bf16x8, ahw), al = __builtin_bit_cast(bf16x8, alw);
#pragma unroll
                for (int ct = 0; ct < 3; ++ct) {
                    acc[tt][ct] = __builtin_amdgcn_mfma_f32_16x16x32_bf16(ah, bh[ct], acc[tt][ct], 0, 0, 0);
                    acc[tt][ct] = __builtin_amdgcn_mfma_f32_16x16x32_bf16(al, bh[ct], acc[tt][ct], 0, 0, 0);
                    acc[tt][ct] = __builtin_amdgcn_mfma_f32_16x16x32_bf16(ah, bl[ct], acc[tt][ct], 0, 0, 0);
                }
            }
        }
#pragma unroll
        for (int tt = 0; tt < 4; ++tt) {
#pragma unroll
            for (int ct = 0; ct < 3; ++ct)
#pragma unroll
                for (int i = 0; i < 4; ++i) red[(F.wave * 64 + 16 * tt + 4 * q + i) * 48 + 16 * ct + r] = acc[tt][ct][i];
            float s = ssq[tt]; s += __shfl_xor(s, 16); s += __shfl_xor(s, 32);
            if (q == 0) ssqr[F.wave * 64 + 16 * tt + r] = s;
        }
        __syncthreads();
        for (int idx = F.tid; idx < 3072; idx += NTHR) { float s = 0.f;
#pragma unroll
            for (int w = 0; w < 8; ++w) s += red[w * 3072 + idx];
            lg[idx] = s; }
        if (F.tid < 64) { float s = 0.f;
#pragma unroll
            for (int w = 0; w < 8; ++w) s += ssqr[w * 64 + F.tid];
            rsl[F.tid] = 1.0f / sqrtf(s * (1.f / 1024.f) + EPS); }
        __syncthreads();
        if (F.tid < 64) {
            const int t = tok0 + F.tid; const float rs = rsl[F.tid]; const LAS float* L = lg + F.tid * 48;
            const float* bg = F.in[22] + layer * 4; const float* br = F.in[24] + layer * 32;
            float gl[4];
#pragma unroll
            for (int j = 0; j < 4; ++j) gl[j] = L[j] * rs + bg[j];
            int gi = 0; float gm = gl[0];
#pragma unroll
            for (int j = 1; j < 4; ++j) if (gl[j] > gm) { gm = gl[j]; gi = j; }
            float den = 0.f;
#pragma unroll
            for (int j = 0; j < 4; ++j) den += __expf(gl[j] - gm);
            const float gp = 1.f / den;
            float el[8];
#pragma unroll
            for (int e = 0; e < 8; ++e) el[e] = L[4 + 8 * gi + e] * rs + br[gi * 8 + e];
            int i1 = 0; float v1 = el[0];
#pragma unroll
            for (int e = 1; e < 8; ++e) if (el[e] > v1) { v1 = el[e]; i1 = e; }
            int i2 = 0; float v2 = -3.0e38f;
#pragma unroll
            for (int e = 0; e < 8; ++e) if (e != i1 && el[e] > v2) { v2 = el[e]; i2 = e; }
            const float e2 = __expf(v2 - v1);
            sel[2 * F.tid] = gi * 8 + i1; sel[2 * F.tid + 1] = gi * 8 + i2;
            gwl[2 * F.tid] = gp / (1.f + e2); gwl[2 * F.tid + 1] = gp * e2 / (1.f + e2);
            ((float*)(F.ws + WS_RSM))[t] = rs;
        }
        __syncthreads();
        int pos = 0, myexp = 0;
        if (F.tid < 128) { myexp = sel[F.tid]; for (int j = 0; j < F.tid; ++j) pos += (sel[j] == myexp) ? 1 : 0; }
        if (F.tid >= 128 && F.tid < 160) { const int e = F.tid - 128; int c = 0; for (int j = 0; j < 128; ++j) c += (sel[j] == e) ? 1 : 0;
            basel[e] = c ? (int)__hip_atomic_fetch_add(gcnt + e * 64, (unsigned)c, __ATOMIC_RELAXED, __HIP_MEMORY_SCOPE_AGENT) : 0; }
        __syncthreads();
        if (F.tid < 128) { const size_t dst = (size_t)myexp * T + basel[myexp] + pos;
            ((int*)(F.ws + WS_LSLOT))[dst] = 2 * (tok0 + (F.tid >> 1)) + (F.tid & 1);
            ((float*)(F.ws + WS_LGW))[dst] = gwl[F.tid]; }
        __syncthreads();
    }
}

template <int NT> __device__ __forceinline__ void moe_segment_t(const Frame& F, int e, int l0, int n) {
    constexpr int PF = MK_PF1, PF2 = MK_PF2;
    LAS unsigned char* XR = F.lds;
    LAS unsigned char* HID = F.lds + 65536;
    LAS int* s_tok = (LAS int*)(F.lds + 131072);
    LAS int* s_slot = s_tok + 128;
    LAS float* s_gw = (LAS float*)(s_slot + 128);
    LAS float* s_rs = s_gw + 128;
    const int r32 = F.lane & 31, hi = F.lane >> 5, w = F.wave;
    const bf16_t* W1e = (const bf16_t*)(F.ws + WS_WMOE) + (size_t)e * W1_EXP + (size_t)w * 65536 + F.lane * 8;
    const bf16_t* W2e = (const bf16_t*)(F.ws + WS_WMOE) + 32 * W1_EXP + (size_t)e * W2_EXP + (size_t)w * 16384 + F.lane * 8;
    bf16x8 wb[PF > PF2 ? PF : PF2][2];
#pragma unroll
    for (int s = 0; s < PF; ++s) { wb[s][0] = *(const GAS bf16x8*)(W1e + (size_t)(s * 2) * 512); wb[s][1] = *(const GAS bf16x8*)(W1e + (size_t)(s * 2 + 1) * 512); }
    if (F.tid < 128) { const int idx = F.tid < n ? F.tid : 0; const size_t li = (size_t)e * T + l0 + idx;
        const int slot = ((const int*)(F.ws + WS_LSLOT))[li]; const int tok = slot >> 1;
        s_tok[F.tid] = tok; s_slot[F.tid] = F.tid < n ? slot : -1; s_gw[F.tid] = F.tid < n ? ((const float*)(F.ws + WS_LGW))[li] : 0.f;
        s_rs[F.tid] = ((const float*)(F.ws + WS_RSM))[tok]; }
    __syncthreads();
    const bf16_t* xrow = (const bf16_t*)(F.ws + WS_XB) + (size_t)s_tok[F.tid & 127] * D + (F.tid >> 7) * 8;
    const int xoff = ((F.tid >> 7) * 128 + (F.tid & 127)) * 16;
    u32x4 xs[2];
#pragma unroll
    for (int i = 0; i < 4; ++i) { xs[0] = *(const GAS u32x4*)(xrow + 32 * i); *(LAS u32x4*)(XR + xoff + i * 8192) = xs[0]; }
    __syncthreads();
    f32x16 accg[NT], accu[NT];
#pragma unroll
    for (int i = 0; i < NT; ++i) { accg[i] = f32x16{}; accu[i] = f32x16{}; }
    for (int kc = 0; kc < 8; ++kc) {
        const LAS unsigned char* buf = XR + (kc & 1) * 32768 + (hi * 128 + r32) * 16;
        LAS unsigned char* nb = XR + ((kc + 1) & 1) * 32768 + xoff;
#pragma unroll
        for (int ks = 0; ks < 8; ++ks) {
            if (kc < 7) {
                if (ks == 0) { xs[0] = *(const GAS u32x4*)(xrow + (kc + 1) * 128); xs[1] = *(const GAS u32x4*)(xrow + (kc + 1) * 128 + 32); }
                if (ks == 3) { *(LAS u32x4*)(nb) = xs[0]; *(LAS u32x4*)(nb + 8192) = xs[1]; }
                if (ks == 4) { xs[0] = *(const GAS u32x4*)(xrow + (kc + 1) * 128 + 64); xs[1] = *(const GAS u32x4*)(xrow + (kc + 1) * 128 + 96); }
                if (ks == 7) { *(LAS u32x4*)(nb + 16384) = xs[0]; *(LAS u32x4*)(nb + 24576) = xs[1]; }
            }
            const bf16x8 wg = wb[ks % PF][0], wu = wb[ks % PF][1];
            if (ks < 8 - PF || kc < 7) { const size_t o = (size_t)((kc * 8 + ks + PF) * 2) * 512;
                wb[ks % PF][0] = *(const GAS bf16x8*)(W1e + o); wb[ks % PF][1] = *(const GAS bf16x8*)(W1e + o + 512); }
#pragma unroll
            for (int i = 0; i < NT; ++i) {
                const bf16x8 xf = *(const LAS bf16x8*)(buf + (2 * ks * 128 + 32 * i) * 16);
                accg[i] = __builtin_amdgcn_mfma_f32_32x32x16_bf16(wg, xf, accg[i], 0, 0, 0);
                accu[i] = __builtin_amdgcn_mfma_f32_32x32x16_bf16(wu, xf, accu[i], 0, 0, 0);
            }
        }
        __syncthreads();
    }
#pragma unroll
    for (int i = 0; i < NT; ++i) {
        const float rs = s_rs[32 * i + r32], gw = s_gw[32 * i + r32];
#pragma unroll
        for (int s = 0; s < 2; ++s) { float hv[8];
#pragma unroll
            for (int j = 0; j < 8; ++j) { const float g = accg[i][8 * s + j] * rs, u = accu[i][8 * s + j] * rs; hv[j] = silu_f(g) * u * gw; }
            u32x4 o; o.x = pk2(hv[0], hv[1]); o.y = pk2(hv[2], hv[3]); o.z = pk2(hv[4], hv[5]); o.w = pk2(hv[6], hv[7]);
            *(LAS u32x4*)(HID + (((2 * w + s) * 2 + hi) * 128 + 32 * i + r32) * 16) = o; }
    }
    __syncthreads();
#pragma unroll
    for (int s = 0; s < PF2; ++s) { wb[s][0] = *(const GAS bf16x8*)(W2e + (size_t)s * 1024); wb[s][1] = *(const GAS bf16x8*)(W2e + (size_t)s * 1024 + 512); }
    bf16_t* Y = (bf16_t*)(F.ws + WS_Y);
    const LAS unsigned char* hb = HID + (hi * 128 + r32) * 16;
#pragma unroll 1
    for (int p = 0; p < 2; ++p) {
        f32x16 acc2[NT][2];
#pragma unroll
        for (int i = 0; i < NT; ++i) { acc2[i][0] = f32x16{}; acc2[i][1] = f32x16{}; }
#pragma unroll
        for (int kk = 0; kk < 16; ++kk) {
            const bf16x8 a0 = wb[kk % PF2][0], a1 = wb[kk % PF2][1];
            if (kk < 16 - PF2 || p < 1) { const size_t o = (kk < 16 - PF2) ? ((size_t)p * 131072 + (size_t)(kk + PF2) * 1024) : ((size_t)(p + 1) * 131072 + (size_t)(kk + PF2 - 16) * 1024);
                wb[kk % PF2][0] = *(const GAS bf16x8*)(W2e + o); wb[kk % PF2][1] = *(const GAS bf16x8*)(W2e + o + 512); }
#pragma unroll
            for (int i = 0; i < NT; ++i) {
                const bf16x8 hf = *(const LAS bf16x8*)(hb + (kk * 2 * 128 + 32 * i) * 16);
                acc2[i][0] = __builtin_amdgcn_mfma_f32_32x32x16_bf16(a0, hf, acc2[i][0], 0, 0, 0);
                acc2[i][1] = __builtin_amdgcn_mfma_f32_32x32x16_bf16(a1, hf, acc2[i][1], 0, 0, 0);
            }
        }
#pragma unroll
        for (int i = 0; i < NT; ++i) {
            const int slot = s_slot[32 * i + r32];
            if (slot >= 0) {
                bf16_t* yr = Y + (size_t)slot * D + 512 * p + 64 * w + 4 * hi;
#pragma unroll
                for (int dt = 0; dt < 2; ++dt)
#pragma unroll
                    for (int qd = 0; qd < 4; ++qd) { u32x2 o; o.x = pk2(acc2[i][dt][4 * qd], acc2[i][dt][4 * qd + 1]); o.y = pk2(acc2[i][dt][4 * qd + 2], acc2[i][dt][4 * qd + 3]);
                        *(GAS u32x2*)(yr + 32 * dt + 8 * qd) = o; }
            }
        }
    }
    __syncthreads();
}
__device__ __forceinline__ void moe_segment(const Frame& F, int e, int l0, int n) {
    const int nt = (n + 31) >> 5;
    if (nt == 4) moe_segment_t<4>(F, e, l0, n); else if (nt == 3) moe_segment_t<3>(F, e, l0, n); else if (nt == 2) moe_segment_t<2>(F, e, l0, n); else moe_segment_t<1>(F, e, l0, n);
}
__device__ __forceinline__ void phase_moe(const Frame& F, int layer) {
    unsigned* gcnt = (unsigned*)(F.ws + WS_CTL) + CW_ECNT + layer * 32 * 64;
    for (int unit = F.vcu; unit < 256; unit += F.G) {
        const int v0 = 128 * unit, v1 = v0 + 128; int vb = 0;
        for (int e = 0; e < 32; ++e) {
            const int ne = (int)__builtin_amdgcn_readfirstlane(__hip_atomic_load(gcnt + e * 64, __ATOMIC_RELAXED, __HIP_MEMORY_SCOPE_AGENT));
            const int lo = v0 > vb ? v0 : vb, hi_ = v1 < vb + ne ? v1 : vb + ne;
            if (lo < hi_) moe_segment(F, e, lo - vb, hi_ - lo);
            vb += ne;
        }
    }
}
}
namespace mk {
__device__ __forceinline__ int crow(int r, int hi) { return (r & 3) + 8 * (r >> 2) + 4 * hi; }
__device__ __forceinline__ s16x4 vtr(const LAS unsigned char* p) {
    typedef short v4i16_t __attribute__((ext_vector_type(4)));
    return __builtin_bit_cast(s16x4, __builtin_amdgcn_ds_read_tr16_b64_v4i16((LAS v4i16_t*)p));
}
constexpr float ATT_THR = 8.f;

template <int MODE> __device__ __forceinline__ void attn_unit(const Frame& F, int unit) {
    constexpr int NKC = MODE == 0 ? 12 : 8, ND0 = NKC / 2, KBYTES = NKC * 1024, BUF = KBYTES + 8192;
    const int lane = F.lane, w = F.wave, r32 = lane & 31, hi = lane >> 5;
    LAS unsigned char* lds = F.lds;
    LAS float* wsf = (LAS float*)(lds + 2 * BUF) + w * 64;
    LAS bf16_t* stg = (LAS bf16_t*)(lds + 2 * BUF + 2048) + w * 2048;
    const bf16_t* Qb = (const bf16_t*)(F.ws + WS_Q); const bf16_t* KVb = (const bf16_t*)(F.ws + WS_KV); const bf16_t* KPE = (const bf16_t*)(F.ws + WS_KPE);
    const bf16_t* Pb = (const bf16_t*)(F.ws + WS_P); bf16_t* Ob = (bf16_t*)(F.ws + WS_MB);
    int b, h = 0, g = 0, hq = 0, tq0, j_lo, j_hi, kbase0, ocol, qpos0 = 0;
    if (MODE == 0) { b = unit >> 6; h = (unit >> 3) & 7; const int qb = unit & 7; tq0 = b * S + 256 * qb + 32 * w; j_lo = 0; j_hi = 32; kbase0 = b * S; ocol = h * 64; }
    else { b = unit >> 6; const int rem = unit & 63; g = rem >> 5; const int qblk = (rem >> 1) & 15, hp = rem & 1; hq = 4 * g + 2 * hp + (w >> 2);
        qpos0 = 128 * qblk + 32 * (w & 3); tq0 = b * S + qpos0; j_lo = (qblk == 0) ? 2 : 0; j_hi = (qblk == 15) ? 4 : 6; kbase0 = b * S + 128 * qblk - 128; ocol = 512 + hq * 64; }
    bf16x8 qr[ND0];
    if (MODE == 0) { const bf16_t* qrow = Qb + (size_t)(tq0 + r32) * 768;
#pragma unroll
        for (int d0 = 0; d0 < 4; ++d0) qr[d0] = *(const GAS bf16x8*)(qrow + h * 64 + 16 * d0 + 8 * hi);
#pragma unroll
        for (int d0 = 4; d0 < 6; ++d0) qr[d0] = *(const GAS bf16x8*)(qrow + 512 + h * 32 + 16 * (d0 - 4) + 8 * hi);
        {
            const f32x2* rp = (const f32x2*)(F.ws + WS_ROPE) + ((tq0 + r32) & (S - 1)) * 16 + 8 * hi;
            bf16x8 a4 = qr[4], a5 = qr[5];
#pragma unroll
            for (int j = 0; j < 8; ++j) { const f32x2 cs = rp[j]; const float x = bf2f((unsigned short)a4[j]), y = bf2f((unsigned short)a5[j]);
                a4[j] = (short)f2bf(x * cs.x - y * cs.y); a5[j] = (short)f2bf(y * cs.x + x * cs.y); }
            qr[4] = a4; qr[5] = a5; }
    } else { const bf16_t* qrow = Pb + (size_t)(tq0 + r32) * 1280 + 512 + hq * 64;
#pragma unroll
        for (int d0 = 0; d0 < ND0; ++d0) qr[d0] = *(const GAS bf16x8*)(qrow + 16 * d0 + 8 * hi);
    }
    const bf16_t *ksrc0, *ksrc1 = nullptr, *vsrc; size_t kstride, kstride1 = 0, vstride;
    const int vrow = 16 * (w & 3) + (lane >> 2), vcol = (w >> 2) * 32 + (lane & 3) * 8;
    if (MODE == 0) { ksrc0 = KVb + (size_t)(kbase0 + lane) * 1024 + h * 64 + w * 8; kstride = 64 * 1024;
        ksrc1 = KPE + (size_t)(kbase0 + lane) * 32 + (w & 3) * 8; kstride1 = 64 * 32;
        vsrc = KVb + (size_t)(kbase0 + vrow) * 1024 + 512 + h * 64 + vcol; vstride = 64 * 1024; }
    else { ksrc0 = Pb + (size_t)((long)kbase0 + lane) * 1280 + 1024 + g * 64 + w * 8; kstride = 64 * 1280;
        vsrc = Pb + (size_t)((long)kbase0 + vrow) * 1280 + 1152 + g * 64 + vcol; vstride = 64 * 1280; }
    const bool two_k = (MODE == 0) && (w < 4);
    u32x4 ks0, ks1 = {0u, 0u, 0u, 0u}, vs;
#define ATT_LOAD(j) do { ks0 = *(const GAS u32x4*)(ksrc0 + (size_t)(j) * kstride); if (two_k) ks1 = *(const GAS u32x4*)(ksrc1 + (size_t)(j) * kstride1); vs = *(const GAS u32x4*)(vsrc + (size_t)(j) * vstride); } while (0)
#define ATT_WRITE(bufo) do { *(LAS u32x4*)(lds + (bufo) + w * 1024 + lane * 16) = ks0; if (two_k) *(LAS u32x4*)(lds + (bufo) + (8 + w) * 1024 + lane * 16) = ks1; \
        *(LAS u32x4*)(lds + (bufo) + KBYTES + w * 1024 + lane * 16) = vs; } while (0)
    float m_run, l_run; f32x16 o[2]; o[0] = f32x16{}; o[1] = f32x16{};
    float slope2 = 0.f;
    if (MODE == 1) { m_run = F.in[19][hq] * LOG2E; l_run = (hi == 0) ? 1.f : 0.f; slope2 = exp2f(-(float)(hq + 1)) * LOG2E; }
    else { m_run = -1e30f; l_run = 0.f; }
    ATT_LOAD(j_lo); ATT_WRITE(0); __syncthreads();
    const int voff = KBYTES + ((lane >> 4) & 1) * 32 + (lane & 3) * 8 + (4 * hi + ((lane & 15) >> 2)) * 64;
    for (int j = j_lo; j < j_hi; ++j) {
        const int bo = ((j - j_lo) & 1) * BUF;
        if (j + 1 < j_hi) ATT_LOAD(j + 1);
        f32x16 p0 = f32x16{}, p1 = f32x16{};
        const LAS unsigned char* kb = lds + bo + hi * 1024 + r32 * 16;
#pragma unroll
        for (int d0 = 0; d0 < ND0; ++d0) {
            const bf16x8 b0 = *(const LAS bf16x8*)(kb + d0 * 2048), b1 = *(const LAS bf16x8*)(kb + d0 * 2048 + 512);
            p0 = __builtin_amdgcn_mfma_f32_32x32x16_bf16(b0, qr[d0], p0, 0, 0, 0);
            p1 = __builtin_amdgcn_mfma_f32_32x32x16_bf16(b1, qr[d0], p1, 0, 0, 0);
        }
        if (MODE == 1) {
            const int qp = qpos0 + r32, kp = 128 * ((unit >> 1) & 15) - 128 + 64 * j;
#pragma unroll
            for (int r = 0; r < 16; ++r) { const int k0 = kp + crow(r, hi); int d0_ = qp - k0; d0_ = d0_ < 0 ? -d0_ : d0_; int d1_ = qp - (k0 + 32); d1_ = d1_ < 0 ? -d1_ : d1_;
                p0[r] = (d0_ <= 128) ? p0[r] - slope2 * (float)d0_ : -1e30f; p1[r] = (d1_ <= 128) ? p1[r] - slope2 * (float)d1_ : -1e30f; }
        }
        float pmax = p0[0];
#pragma unroll
        for (int r = 1; r < 16; ++r) pmax = fmaxf(pmax, p0[r]);
#pragma unroll
        for (int r = 0; r < 16; ++r) pmax = fmaxf(pmax, p1[r]);
        pmax = fmaxf(pmax, __shfl_xor(pmax, 32));
        if (!__all(pmax - m_run <= ATT_THR)) {
            const float mn = fmaxf(m_run, pmax), alpha = fast_exp2(m_run - mn); m_run = mn; l_run *= alpha;
            if (hi == 0) wsf[r32] = alpha;
            LDS_WAIT(); asm volatile("" ::: "memory");
#pragma unroll
            for (int r = 0; r < 16; ++r) { const float a = wsf[crow(r, hi)]; o[0][r] *= a; o[1][r] *= a; }
        }
        float ps = 0.f;
#pragma unroll
        for (int r = 0; r < 16; ++r) { p0[r] = fast_exp2(p0[r] - m_run); p1[r] = fast_exp2(p1[r] - m_run); ps += p0[r] + p1[r]; }
        l_run += ps;
        u32x4 pw[4];
        pw[0] = (u32x4){pk2(p0[0], p0[1]), pk2(p0[2], p0[3]), pk2(p0[4], p0[5]), pk2(p0[6], p0[7])};
        pw[1] = (u32x4){pk2(p0[8], p0[9]), pk2(p0[10], p0[11]), pk2(p0[12], p0[13]), pk2(p0[14], p0[15])};
        pw[2] = (u32x4){pk2(p1[0], p1[1]), pk2(p1[2], p1[3]), pk2(p1[4], p1[5]), pk2(p1[6], p1[7])};
        pw[3] = (u32x4){pk2(p1[8], p1[9]), pk2(p1[10], p1[11]), pk2(p1[12], p1[13]), pk2(p1[14], p1[15])};
        const LAS unsigned char* vp = lds + bo + voff;
#pragma unroll
        for (int d0 = 0; d0 < 2; ++d0)
#pragma unroll
            for (int ks = 0; ks < 4; ++ks) {
                const s16x4 vlo = vtr(vp + d0 * 4096 + ks * 1024), vhi = vtr(vp + d0 * 4096 + ks * 1024 + 512);
                const bf16x8 vf = (bf16x8){vlo[0], vlo[1], vlo[2], vlo[3], vhi[0], vhi[1], vhi[2], vhi[3]};
                o[d0] = __builtin_amdgcn_mfma_f32_32x32x16_bf16(__builtin_bit_cast(bf16x8, pw[ks]), vf, o[d0], 0, 0, 0);
            }
        if (j + 1 < j_hi) ATT_WRITE(BUF - bo);
        __syncthreads();
    }
#undef ATT_LOAD
#undef ATT_WRITE
    const float lt = l_run + __shfl_xor(l_run, 32);
    if (hi == 0) wsf[32 + r32] = lt;
    LDS_WAIT(); asm volatile("" ::: "memory");
#pragma unroll
    for (int r = 0; r < 16; ++r) { const int orow = crow(r, hi); const float rl = fast_rcp(wsf[32 + orow]);
        stg[orow * 64 + r32] = (bf16_t)f2bf(o[0][r] * rl); stg[orow * 64 + 32 + r32] = (bf16_t)f2bf(o[1][r] * rl); }
    LDS_WAIT(); asm volatile("" ::: "memory");
    bf16_t* Ow = Ob + (size_t)tq0 * 1024 + ocol;
#pragma unroll
    for (int i = 0; i < 4; ++i) { const int row = i * 8 + (lane >> 3), ch = lane & 7; const u32x4 v = *(const LAS u32x4*)(stg + row * 64 + ch * 8); *(GAS u32x4*)(Ow + (size_t)row * 1024 + ch * 8) = v; }
    __syncthreads();
}
__device__ __forceinline__ void phase_attn(const Frame& F) {
    for (int u = F.vcu; u < 1024; u += F.G) { if (u < 512) attn_unit<0>(F, u); else attn_unit<1>(F, u - 512); }
}
}
namespace mk {
constexpr int N_PHASES = 14;
__global__ void __launch_bounds__(NTHR, 2) fwd_mega(Args args) {
    extern __shared__ __attribute__((aligned(16))) unsigned char lds_raw[];
    Frame F;
    F.lds = (LAS unsigned char*)lds_raw;
    F.tid = threadIdx.x; F.lane = F.tid & 63; F.wave = __builtin_amdgcn_readfirstlane(F.tid >> 6);
    F.G = gridDim.x; { const int bx = blockIdx.x; F.vcu = (F.G % 8 == 0) ? (bx % 8) * (F.G / 8) + bx / 8 : bx; }
    F.in = args.in; F.out = args.out; F.ws = args.ws;
    volatile LAS unsigned* MISC = (volatile LAS unsigned*)(F.lds + MISC_OFF);
    if (F.tid < 64) MISC[F.tid] = 0u;
    __syncthreads();
    unsigned* ctl = (unsigned*)(F.ws + WS_CTL);
    const int lo = args.ph_lo, hi = args.ph_hi;
    XcdBarrier bar; bar.bar = ctl + CW_BAR; bar.x = 0; bar.st = nullptr;
    if (hi - lo > 1) bar = xcd_barrier_post(ctl + CW_BAR, MISC + 8);
#ifndef MK_PHASE_MASK
#define MK_PHASE_MASK 0x3fff
#endif
#define IN(k) (((MK_PHASE_MASK >> (k)) & 1) && lo <= (k) && (k) < hi)
#ifndef MK_DUP_MASK
#define MK_DUP_MASK 0
#endif
#define REP(k) for (int rep_ = 0; rep_ <= ((MK_DUP_MASK >> (k)) & 1); ++rep_)
#define FRESH() do { int t_ = threadIdx.x; asm volatile("" : "+v"(t_)); F.tid = t_; F.lane = t_ & 63; F.wave = __builtin_amdgcn_readfirstlane(t_ >> 6); } while (0)
#define SEAM(k) do { if (IN(k) && IN((k) + 1)) xcd_barrier(bar); } while (0)
    bf16_t* XB = (bf16_t*)(F.ws + WS_XB); bf16_t* MBp = (bf16_t*)(F.ws + WS_MB); bf16_t* Pp = (bf16_t*)(F.ws + WS_P);
    float* RS0 = (float*)(F.ws + WS_RS0);
    const f32x2* rope = (const f32x2*)(F.ws + WS_ROPE);
    const int bid = (int)blockIdx.x;

    if (IN(0)) REP(0) { FRESH(); phase_p0(F); } SEAM(0);
    if (IN(1)) REP(1) { FRESH(); pg8::Gemm g{XB, (const bf16_t*)(F.ws + WS_WINE), T, 2048, 1024, 1024, 1024}; pg8::StaticOrder So; So.init(T, 2048, F.G, bid);
        EpiE1 E{(bf16_t*)F.out, RS0}; pg8::gemm_phase<EpiE1, pg8::StaticOrder, true, true>(F.lds, g, So, E); } SEAM(1);
    if (IN(2)) REP(2) { FRESH(); phase_e2(F); } SEAM(2);
    if (IN(3)) REP(3) { FRESH(); pg8::Gemm g{MBp, (const bf16_t*)(F.ws + WS_WOUTE), T, 1024, 1024, 1024, 1024}; pg8::StaticOrder So; So.init(T, 1024, F.G, bid);
        EpiRes E{F.in[0], F.out, XB}; pg8::gemm_phase<EpiRes, pg8::StaticOrder, true, true>(F.lds, g, So, E); } SEAM(3);
    if (IN(4)) REP(4) { FRESH(); phase_router(F, 0); } SEAM(4);
    if (IN(5)) REP(5) { FRESH(); phase_moe(F, 0); } SEAM(5);
    if (IN(6)) REP(6) { FRESH(); combine_rows<false>(F);
 } SEAM(6);
    if (IN(7)) REP(7) { FRESH(); pg8::Gemm g{XB, (const bf16_t*)(F.ws + WS_WINO), T, 1280, 1024, 1024, 1024}; pg8::StaticOrder So; So.init(T, 1280, F.G, bid);
        EpiO1 E{Pp, RS0, (float*)(F.ws + WS_SSQQ), (float*)(F.ws + WS_SSQKV), (bf16_t*)(F.ws + WS_KPE), rope};
        pg8::gemm_phase<EpiO1, pg8::StaticOrder, true, true>(F.lds, g, So, E);
        if (rep_ == 0 && (F.G != 256 || bid >= 64)) { LAS float* scr = (LAS float*)(F.lds + F.wave * 16384); CvtRegs R;
            const int nw = (F.G == 256) ? 192 * NWAVES : F.G * NWAVES, gw = ((F.G == 256) ? (bid - 64) : bid) * NWAVES + F.wave;
            int it = gw; if (it < MOE_CVT_ITEMS) moe_cvt_load(F, 1, it, R);
            for (; it < MOE_CVT_ITEMS; it += nw) { moe_cvt_stage(F, 1, it, R, scr); if (it + nw < MOE_CVT_ITEMS) moe_cvt_load(F, 1, it + nw, R); moe_cvt_emit(F, it, scr); } } } SEAM(7);
    if (IN(8)) REP(8) { FRESH(); pg8::Gemm g{Pp, (const bf16_t*)(F.ws + WS_WUQ), T, 1792, 256, 1280, 256}; O2Order So; So.init(T, 1792, F.G, bid);
        EpiO2 E{(bf16_t*)(F.ws + WS_Q), (bf16_t*)(F.ws + WS_KV), (const float*)(F.ws + WS_SSQQ), (const float*)(F.ws + WS_SSQKV)};
        pg8::gemm_phase<EpiO2, O2Order, true, true>(F.lds, g, So, E);
    } SEAM(8);
    if (IN(9)) REP(9) { FRESH(); phase_attn(F); } SEAM(9);
    if (IN(10)) REP(10) { FRESH(); pg8::Gemm g{MBp, (const bf16_t*)(F.ws + WS_WOUTO), T, 1024, 1024, 1024, 1024}; pg8::StaticOrder So; So.init(T, 1024, F.G, bid);
        EpiRes E{F.out, F.out, XB}; pg8::gemm_phase<EpiRes, pg8::StaticOrder, true, true>(F.lds, g, So, E); } SEAM(10);
    if (IN(11)) REP(11) { FRESH(); phase_router(F, 1); } SEAM(11);
    if (IN(12)) REP(12) { FRESH(); phase_moe(F, 1); } SEAM(12);
    if (IN(13)) REP(13) { FRESH(); combine_rows<true>(F); }
#undef IN
#undef SEAM
}

static int g_grid = 0;
static bool setup() {
    if (g_grid) return g_grid > 0;
    int dev = 0, cus = 0;
    if (hipGetDevice(&dev) != hipSuccess || hipDeviceGetAttribute(&cus, hipDeviceAttributeMultiprocessorCount, dev) != hipSuccess) { g_grid = -1; return false; }
    if (hipFuncSetAttribute((const void*)fwd_mega, hipFuncAttributeMaxDynamicSharedMemorySize, LDS_BYTES) != hipSuccess) { fprintf(stderr, "hipFuncSetAttribute failed\n"); g_grid = -1; return false; }
    int per_cu = 0;
    if (hipOccupancyMaxActiveBlocksPerMultiprocessor(&per_cu, (const void*)fwd_mega, NTHR, LDS_BYTES) != hipSuccess || per_cu < 1) { fprintf(stderr, "occupancy query: %d\n", per_cu); }
    (void)hipGetLastError();
    g_grid = cus;
    return true;
}
static void launch_range(void* const* d_in, float* out, unsigned char* ws, int lo, int hi, hipStream_t st) {
    Args a{};
    for (int i = 0; i < 28; ++i) a.in[i] = (const float*)d_in[i];
    a.out = out; a.ws = ws; a.ph_lo = lo; a.ph_hi = hi;
    hipLaunchKernelGGL(fwd_mega, dim3(g_grid), dim3(NTHR), LDS_BYTES, st, a);
}
}
extern "C" void kernel_launch(void* const* d_in, const int* in_sizes, int n_in, void* d_out, int out_size, void* d_ws, size_t ws_size, hipStream_t stream) {
    if (n_in != 28 || out_size != mk::T * mk::D || ws_size < mk::WS_END) { fprintf(stderr, "kernel_launch: unexpected shapes n_in %d out %d ws %zu\n", n_in, out_size, ws_size); return; }
    if (!mk::setup()) return;
    if (hipMemsetAsync((unsigned char*)d_ws + mk::WS_CTL, 0, mk::CTL_ZERO_BYTES, stream) != hipSuccess) { fprintf(stderr, "kernel_launch: memset failed\n"); return; }
    mk::launch_range(d_in, (float*)d_out, (unsigned char*)d_ws, 0, mk::N_PHASES, stream);
}
```

```cpp
#define MK_PF1 2
#define MK_PF2 2
#include <hip/hip_runtime.h>
#include <hip/hip_bf16.h>
#include <cstdio>
#include <cstdint>
namespace pg8 {
#define PG8_LAS __attribute__((address_space(3)))
typedef unsigned short bf16_t;
typedef short bf16x8 __attribute__((ext_vector_type(8)));
typedef float f32x4 __attribute__((ext_vector_type(4)));
typedef unsigned u32x4 __attribute__((ext_vector_type(4)));
constexpr int BM = 256, BK = 64, HALF = 128, HTB = HALF * BK * 2  , STAGE_BYTES = 8 * HTB, NXCD = 8, WGM = 8;

__host__ __device__ __forceinline__ int lds_byte(int r, int c) { const int st = (r >> 4) * 2 + (c >> 5), rr = r & 15, cc = c & 31, ob = rr * 64 + cc * 2; return st * 1024 + (ob ^ (((ob >> 9) & 1) << 5)); }
__host__ __device__ __forceinline__ void stage_rc(int b, int& R, int& C) { const int st = b / 1024, sb = b % 1024, swz = sb ^ (((sb >> 9) & 1) << 5); R = (st >> 1) * 16 + swz / 64; C = (st & 1) * 32 + (swz % 64) / 2; }
__host__ __device__ __forceinline__ int perm32(int rho) { const int n = rho >> 4, i = rho & 15; return 8 * (i >> 2) + 4 * n + (i & 3); }

struct Unit { int pm, pn, aoff; };
struct Gemm { const bf16_t* A; const bf16_t* Bt; int M, N, K, lda, ldb; };

struct StaticOrder {
    int nM, nN, nwg, G, c;
    __host__ __device__ void init(int M, int N, int G_, int c_) { nM = M / BM; nN = N / BM; nwg = nM * nN; G = G_; c = c_; }
    __host__ __device__ bool next(int i, Unit& u) const {
        const long L = (long)i * G + c; if (L >= nwg) return false;
        int wgid = (int)L; { const int q = nwg / NXCD, r = nwg % NXCD, xcd = wgid % NXCD, off = wgid / NXCD; wgid = (xcd < r ? xcd * (q + 1) : r * (q + 1) + (xcd - r) * q) + off; }
        const int nig = WGM * nN, gid = wgid / nig, fm = gid * WGM, gsz = (nM - fm) < WGM ? (nM - fm) : WGM;
        u.pm = fm + ((wgid % nig) % gsz); u.pn = (wgid % nig) / gsz; u.aoff = 0; return true;
    }
    __device__ __forceinline__ void a_ready(const Unit&) const {}
    __device__ __forceinline__ void done(const Unit&) const {}
};

__device__ __forceinline__ unsigned cvt_pk_bf16(float lo, float hi) { unsigned r; asm volatile("v_cvt_pk_bf16_f32 %0, %1, %2" : "=v"(r) : "v"(lo), "v"(hi)); return r; }
typedef float f32x2 __attribute__((ext_vector_type(2)));
template <class Epi, class Sched, bool ALIGN_EPI = false, bool SP2 = false>
__device__ __forceinline__ void gemm_phase(PG8_LAS unsigned char* lds, const Gemm g, const Sched& S, const Epi& E) {
    int tid_ = threadIdx.x; asm volatile("" : "+v"(tid_));
    const int tid = tid_, wid = __builtin_amdgcn_readfirstlane(tid >> 6), lane = tid & 63, wr = wid >> 2, wc = wid & 3, fr = lane & 15, fq = lane >> 4;
    const int K = g.K, nt = K / BK;
    unsigned voffA[2], voffB[2];
#pragma unroll
    for (int i = 0; i < 2; ++i) { int R, C; stage_rc(tid * 16 + i * 8192, R, C); const int Rb = Epi::PERM ? ((R & ~31) + perm32(R & 31)) : R;
        voffA[i] = (unsigned)(R * g.lda + C) * 2u; voffB[i] = (unsigned)(Rb * g.ldb + C) * 2u; }
    const size_t kstep = (size_t)(BK * 2);
    const size_t hstepA = (size_t)HALF * g.lda * 2, hstepB = (size_t)HALF * g.ldb * 2;
    const size_t tstepA = 2 * hstepA, tstepB = 2 * hstepB;
    const unsigned ldsw = (unsigned)wid * 1024u;
    const int aoff = lds_byte(wr * 64 + fr, fq * 8), boff = lds_byte(wc * 32 + fr, fq * 8);
#define PG8_SA(b, h) (((b) * 2 + (h)) * HTB)
#define PG8_SB(b, h) ((4 + (b) * 2 + (h)) * HTB)
#define PG8_STAGE(bufoff, gbase, voff) do { _Pragma("unroll") for (int _i = 0; _i < 2; ++_i) \
        __builtin_amdgcn_global_load_lds((const unsigned*)((const char*)(gbase) + (voff)[_i]), (PG8_LAS unsigned*)(lds + (bufoff) + ldsw + _i * 8192), 16, 0, 0); } while (0)
#define PG8_LDA(dst, b, h) do { _Pragma("unroll") for (int m = 0; m < 4; ++m) _Pragma("unroll") for (int k = 0; k < 2; ++k) dst[m][k] = *(const PG8_LAS bf16x8*)(lds + PG8_SA(b, h) + aoff + m * 2048 + k * 1024); } while (0)
#define PG8_LDB(dst, b, h) do { _Pragma("unroll") for (int n = 0; n < 2; ++n) _Pragma("unroll") for (int k = 0; k < 2; ++k) dst[n][k] = *(const PG8_LAS bf16x8*)(lds + PG8_SB(b, h) + boff + n * 2048 + k * 1024); } while (0)
#define PG8_MMA(ai, bj, At, Bt) do { __builtin_amdgcn_s_setprio(1); _Pragma("unroll") for (int m = 0; m < 4; ++m) _Pragma("unroll") for (int n = 0; n < 2; ++n) _Pragma("unroll") for (int k = 0; k < 2; ++k) \
        acc[ai][bj][m][n] = __builtin_amdgcn_mfma_f32_16x16x32_bf16(Bt[n][k], At[m][k], acc[ai][bj][m][n], 0, 0, 0); __builtin_amdgcn_s_setprio(0); } while (0)
#define PG8_WAIT_V(n) asm volatile("s_waitcnt vmcnt(" #n ")" ::: "memory")
#define PG8_WAIT_L(n) asm volatile("s_waitcnt lgkmcnt(" #n ")" ::: "memory")
#define PG8_BAR __builtin_amdgcn_s_barrier()
#define PG8_SCHED __builtin_amdgcn_sched_barrier(0)
    Unit cur, nxt; int ui = 0;
    if (!S.next(0, cur)) return;
    f32x4 acc[2][2][4][2];
#pragma unroll
    for (int a = 0; a < 2; ++a)
#pragma unroll
        for (int b = 0; b < 2; ++b)
#pragma unroll
            for (int m = 0; m < 4; ++m)
#pragma unroll
                for (int n = 0; n < 2; ++n) acc[a][b][m][n] = (f32x4){0.f, 0.f, 0.f, 0.f};
    bf16x8 At[4][2], B0[2][2], B1[2][2];
    const char* cA = (const char*)g.A + (size_t)cur.pm * tstepA + cur.aoff; const char* cB = (const char*)g.Bt + (size_t)cur.pn * tstepB;
    S.a_ready(cur);
    if constexpr (SP2) {
        PG8_STAGE(PG8_SB(0, 0), cB, voffB); PG8_STAGE(PG8_SB(0, 1), cB + hstepB, voffB); PG8_STAGE(PG8_SA(0, 0), cA, voffA); PG8_STAGE(PG8_SA(0, 1), cA + hstepA, voffA);
        if (wr == 1) PG8_BAR;
        PG8_WAIT_V(2); PG8_BAR;
        PG8_STAGE(PG8_SB(1, 0), cB + kstep, voffB); PG8_STAGE(PG8_SA(1, 0), cA + kstep, voffA); PG8_STAGE(PG8_SB(1, 1), cB + hstepB + kstep, voffB);
        PG8_WAIT_V(6); PG8_BAR;
    } else {
        PG8_STAGE(PG8_SB(0, 0), cB, voffB); PG8_STAGE(PG8_SA(0, 0), cA, voffA); PG8_STAGE(PG8_SB(0, 1), cB + hstepB, voffB); PG8_STAGE(PG8_SA(0, 1), cA + hstepA, voffA);
        if (wr == 1) PG8_BAR;
        PG8_WAIT_V(4); PG8_BAR;
        PG8_STAGE(PG8_SB(1, 0), cB + kstep, voffB); PG8_STAGE(PG8_SA(1, 0), cA + kstep, voffA); PG8_STAGE(PG8_SB(1, 1), cB + hstepB + kstep, voffB);
        PG8_WAIT_V(6); PG8_BAR;
    }
    for (;;) {
        const bool has_next = S.next(ui + 1, nxt);
        const char* nA = has_next ? (const char*)g.A + (size_t)nxt.pm * tstepA + nxt.aoff : cA; const char* nB = has_next ? (const char*)g.Bt + (size_t)nxt.pn * tstepB : cB;
        for (int t = 0; t < nt; t += 2) {
            const bool last = (t == nt - 2);
            const char* a1 = cA + (size_t)(t + 1) * kstep;
            const char* a2 = last ? nA : cA + (size_t)(t + 2) * kstep; const char* b2 = last ? nB : cB + (size_t)(t + 2) * kstep;
            const char* a3 = a2 + kstep; const char* b3 = b2 + kstep;
            if (last && has_next) S.a_ready(nxt);
            if constexpr (SP2) {
            PG8_LDB(B0, 0, 0); PG8_LDB(B1, 0, 1); PG8_SCHED; PG8_LDA(At, 0, 0); PG8_STAGE(PG8_SA(1, 1), a1 + hstepA, voffA);
            PG8_WAIT_V(8); PG8_WAIT_L(0); PG8_BAR; PG8_MMA(0, 0, At, B0); PG8_MMA(0, 1, At, B1); PG8_BAR; PG8_SCHED;
            PG8_LDA(At, 0, 1); PG8_STAGE(PG8_SB(0, 0), b2, voffB); PG8_STAGE(PG8_SB(0, 1), b2 + hstepB, voffB); PG8_STAGE(PG8_SA(0, 0), a2, voffA);
            PG8_WAIT_V(8); PG8_WAIT_L(0); PG8_BAR; PG8_MMA(1, 0, At, B0); PG8_MMA(1, 1, At, B1); PG8_BAR; PG8_SCHED;
            PG8_LDB(B0, 1, 0); PG8_LDB(B1, 1, 1); PG8_SCHED; PG8_LDA(At, 1, 0); PG8_STAGE(PG8_SA(0, 1), a2 + hstepA, voffA);
            PG8_WAIT_V(8); PG8_WAIT_L(0); PG8_BAR; PG8_MMA(0, 0, At, B0); PG8_MMA(0, 1, At, B1); PG8_BAR; PG8_SCHED;
            PG8_LDA(At, 1, 1); PG8_STAGE(PG8_SB(1, 0), b3, voffB); PG8_STAGE(PG8_SB(1, 1), b3 + hstepB, voffB); PG8_STAGE(PG8_SA(1, 0), a3, voffA);
            PG8_WAIT_V(8); PG8_WAIT_L(0); PG8_BAR; PG8_MMA(1, 0, At, B0); PG8_MMA(1, 1, At, B1); PG8_BAR; PG8_SCHED;
            } else {
            PG8_LDB(B0, 0, 0); PG8_SCHED; PG8_LDA(At, 0, 0); PG8_STAGE(PG8_SA(1, 1), a1 + hstepA, voffA);
            PG8_WAIT_L(8); PG8_BAR; PG8_WAIT_L(0); PG8_MMA(0, 0, At, B0); PG8_BAR; PG8_SCHED;
            PG8_LDB(B1, 0, 1); PG8_STAGE(PG8_SB(0, 0), b2, voffB);
            PG8_BAR; PG8_WAIT_L(0); PG8_MMA(0, 1, At, B1); PG8_BAR;
            PG8_LDA(At, 0, 1); PG8_STAGE(PG8_SA(0, 0), a2, voffA);
            PG8_BAR; PG8_WAIT_L(0); PG8_MMA(1, 0, At, B0); PG8_BAR; PG8_SCHED;
            PG8_STAGE(PG8_SB(0, 1), b2 + hstepB, voffB);
            PG8_WAIT_V(6); PG8_BAR; PG8_MMA(1, 1, At, B1); PG8_BAR;
            PG8_LDB(B0, 1, 0); PG8_SCHED; PG8_LDA(At, 1, 0); PG8_STAGE(PG8_SA(0, 1), a2 + hstepA, voffA);
            PG8_WAIT_L(8); PG8_BAR; PG8_WAIT_L(0); PG8_MMA(0, 0, At, B0); PG8_BAR; PG8_SCHED;
            PG8_LDB(B1, 1, 1); PG8_STAGE(PG8_SB(1, 0), b3, voffB);
            PG8_BAR; PG8_WAIT_L(0); PG8_MMA(0, 1, At, B1); PG8_BAR;
            PG8_LDA(At, 1, 1); PG8_STAGE(PG8_SA(1, 0), a3, voffA);
            PG8_BAR; PG8_WAIT_L(0); PG8_MMA(1, 0, At, B0); PG8_BAR; PG8_SCHED;
            PG8_STAGE(PG8_SB(1, 1), b3 + hstepB, voffB);
            PG8_WAIT_V(6); PG8_BAR; PG8_MMA(1, 1, At, B1); PG8_BAR;
            }
        }
        if constexpr (ALIGN_EPI) { if (wr == 0) PG8_BAR; }
        if constexpr (!Epi::AFTER_DRAIN) { E(acc, cur, wr, wc, fr, fq); S.done(cur); }
        if (!has_next) break;
#pragma unroll
        for (int a = 0; a < 2; ++a)
#pragma unroll
            for (int b = 0; b < 2; ++b)
#pragma unroll
                for (int m = 0; m < 4; ++m)
#pragma unroll
                    for (int n = 0; n < 2; ++n) acc[a][b][m][n] = (f32x4){0.f, 0.f, 0.f, 0.f};
        cur = nxt; cA = nA; cB = nB; ++ui;
        if constexpr (ALIGN_EPI) { if (wr == 1) PG8_BAR; }
    }
    PG8_WAIT_V(0);
    if constexpr (!ALIGN_EPI) { if (wr == 0) PG8_BAR; }
    PG8_BAR;
    if constexpr (Epi::AFTER_DRAIN) { E.fused(acc, cur, wr, wc, fr, fq, lds, wid, lane); S.done(cur); }
#undef PG8_SA
#undef PG8_SB
#undef PG8_STAGE
#undef PG8_LDA
#undef PG8_LDB
#undef PG8_MMA
#undef PG8_WAIT_V
#undef PG8_WAIT_L
#undef PG8_BAR
#undef PG8_SCHED
}
}
namespace mk {
using pg8::bf16_t; using pg8::bf16x8; using pg8::f32x4; using pg8::u32x4; using pg8::f32x2;
typedef float f32x16 __attribute__((ext_vector_type(16)));
typedef unsigned u32x2 __attribute__((ext_vector_type(2)));
typedef short s16x4 __attribute__((ext_vector_type(4)));
#define GAS __attribute__((address_space(1)))
#define LAS __attribute__((address_space(3)))
typedef GAS unsigned gu32;
#define RLX_AGENT __ATOMIC_RELAXED, __HIP_MEMORY_SCOPE_AGENT
#define LDS_WAIT() asm volatile("s_waitcnt lgkmcnt(0)" ::: "memory")
#define VM_WAIT() asm volatile("s_waitcnt vmcnt(0)" ::: "memory")

constexpr int T = 16384, D = 1024, S = 2048, NB = 8;
constexpr int NWAVES = 8, NTHR = 512;
constexpr float EPS = 1e-6f;
constexpr float LOG2E = 1.4426950408889634f;
constexpr float C2M = 0.10206207261596575f * LOG2E;
constexpr float C2S = 0.125f * LOG2E;

constexpr size_t MiB = (size_t)1 << 20;
constexpr size_t WS_CTL = 0, CTL_ZERO_BYTES = 1 * MiB;
constexpr size_t WS_WINE = 1 * MiB;
constexpr size_t WS_WOUTE = 5 * MiB;
constexpr size_t WS_WINO = 7 * MiB;
constexpr size_t WS_WUQ = 10 * MiB;
constexpr size_t WS_WUKV = 10 * MiB + 393216;
constexpr size_t WS_WOUTO = 11 * MiB;
constexpr size_t WS_ROUTER = 13 * MiB;
constexpr size_t WS_ROPE = 14 * MiB;
constexpr size_t WS_RS0 = 14 * MiB + 512 * 1024;
constexpr size_t WS_RSM = WS_RS0 + 64 * 1024;
constexpr size_t WS_SSQQ = 15 * MiB;
constexpr size_t WS_SSQKV = 15 * MiB + 256 * 1024;
constexpr size_t WS_WMOE = 16 * MiB;
constexpr size_t WS_XB = 64 * MiB;
constexpr size_t WS_MB = 96 * MiB;
constexpr size_t WS_Y = 128 * MiB;
constexpr size_t WS_Q = 128 * MiB;
constexpr size_t WS_KV = 152 * MiB;
constexpr size_t WS_P = 192 * MiB;
constexpr size_t WS_LSLOT = 232 * MiB;
constexpr size_t WS_LGW = 234 * MiB;
constexpr size_t WS_KPE = 236 * MiB;
constexpr size_t WS_END = 240 * MiB;
constexpr size_t W1_EXP = 524288, W2_EXP = 262144;

constexpr int CW_TMO = 0;
constexpr int CW_BAR = 4096;
constexpr int CW_CVT = 8192;
constexpr int CW_ECNT = 16384;

constexpr int LDS_BYTES = 160 * 1024;
constexpr int RING_BYTES = 131072;
constexpr int MISC_OFF = 159 * 1024;

__device__ __forceinline__ unsigned f2bf(float f) { unsigned u = __builtin_bit_cast(unsigned, f); return (u + 0x7fffu + ((u >> 16) & 1u)) >> 16; }
__device__ __forceinline__ float bf2f(unsigned h) { return __builtin_bit_cast(float, h << 16); }
__device__ __forceinline__ unsigned pk2(float lo, float hi) { return pg8::cvt_pk_bf16(lo, hi); }
__device__ __forceinline__ float wave_sum(float v) {
#pragma unroll
    for (int o = 1; o < 64; o <<= 1) v += __shfl_xor(v, o);
    return v;
}
__device__ __forceinline__ float fast_exp2(float x) { return __builtin_amdgcn_exp2f(x); }
__device__ __forceinline__ float fast_rcp(float x) { return __builtin_amdgcn_rcpf(x); }
__device__ __forceinline__ float sigmoid_f(float x) { return fast_rcp(1.f + fast_exp2(-x * LOG2E)); }
__device__ __forceinline__ float silu_f(float x) { return x * sigmoid_f(x); }
__device__ __forceinline__ float gelu_f(float x) { const float u = 0.7978845608028654f * (x + 0.044715f * x * x * x); return x * sigmoid_f(2.f * u); }

#define XB_TMO      128
#define XB_XCNT(j)  (256  + 64 * (j))
#define XB_XSUB(j)  (1280 + 64 * (j))
#define XB_XGEN(j)  (2304 + 64 * (j))
#define XB_TOP      3328
#define XB_TOPGEN   3392
#define XCD_BAR_WORDS 3456
#define XB_SPIN_CAP (1u << 18)
__device__ __forceinline__ unsigned xb_ld(unsigned* p)              { return __hip_atomic_load(p, __ATOMIC_RELAXED, __HIP_MEMORY_SCOPE_AGENT); }
__device__ __forceinline__ unsigned xb_add(unsigned* p, unsigned v) { return __hip_atomic_fetch_add(p, v, __ATOMIC_RELAXED, __HIP_MEMORY_SCOPE_AGENT); }
__device__ __forceinline__ unsigned xb_xcc_id() { return (unsigned)__builtin_amdgcn_s_getreg((3 << 11) | 20) & 0xFu; }
#define XB_SPIN(cond, bar) do { unsigned _sp = 0; while (cond) { __builtin_amdgcn_s_sleep(1); \
    if ((++_sp & 255u) == 0u) { if (xb_ld(&(bar)[XB_TMO])) break; if (_sp > XB_SPIN_CAP) { atomicAdd(&(bar)[XB_TMO], 1u); break; } } } } while (0)
struct XcdBarrier { unsigned* bar; unsigned x; volatile LAS unsigned* st; };
__device__ __forceinline__ XcdBarrier xcd_barrier_post(unsigned* bar, volatile LAS unsigned* st) {
    XcdBarrier b; b.bar = bar; b.x = xb_xcc_id(); b.st = st;
    if (threadIdx.x == 0) (void)xb_add(&bar[XB_XCNT(b.x)], 1u);
    return b;
}
__device__ __forceinline__ void xcd_barrier_complete(unsigned* bar, unsigned x, unsigned& nloc, unsigned& nx) {
    const unsigned G = gridDim.x * gridDim.y * gridDim.z;
    unsigned sum, cnt, mine, sp = 0u;
    for (;;) {
        sum = 0u; cnt = 0u; mine = 0u;
#pragma unroll
        for (unsigned j = 0; j < 16; ++j) { const unsigned c = xb_ld(&bar[XB_XCNT(j)]); sum += c; cnt += (c > 0u) ? 1u : 0u; mine = (j == x) ? c : mine; }
        if (sum == G) break;
        __builtin_amdgcn_s_sleep(1);
        if ((++sp & 255u) == 0u) { if (xb_ld(&bar[XB_TMO])) break; if (sp > XB_SPIN_CAP) { atomicAdd(&bar[XB_TMO], 1u); break; } }
    }
    nloc = mine > 0u ? mine : 1u; nx = cnt > 0u ? cnt : 1u;
}
__device__ __forceinline__ void xcd_barrier(const XcdBarrier& b) {
    asm volatile("s_waitcnt vmcnt(0)" ::: "memory");
    __syncthreads();
    if (threadIdx.x == 0) {
        unsigned* bar = b.bar;
        __builtin_amdgcn_s_waitcnt(0);
        unsigned nloc = b.st[0], nx = b.st[1];
        if (nloc == 0u) { xcd_barrier_complete(bar, b.x, nloc, nx); b.st[0] = nloc; b.st[1] = nx; }
        const unsigned old = xb_add(&bar[XB_XSUB(b.x)], 1u);
        const unsigned gen = old / nloc;
        if (old + 1u == (gen + 1u) * nloc) {
            __builtin_amdgcn_fence(__ATOMIC_RELEASE, "agent");
            asm volatile("s_waitcnt vmcnt(0)" ::: "memory");
            const unsigned og = xb_add(&bar[XB_TOP], 1u);
            const unsigned tg = og / nx;
            if (og + 1u == (tg + 1u) * nx) xb_add(&bar[XB_TOPGEN], 1u);
            else XB_SPIN(xb_ld(&bar[XB_TOPGEN]) == tg, bar);
            __builtin_amdgcn_fence(__ATOMIC_ACQUIRE, "agent");
            xb_add(&bar[XB_XGEN(b.x)], 1u);
            asm volatile("s_waitcnt vmcnt(0)" ::: "memory");
        } else {
            XB_SPIN(xb_ld(&bar[XB_XGEN(b.x)]) == gen, bar);
            __builtin_amdgcn_fence(__ATOMIC_ACQUIRE, "agent");
            asm volatile("s_waitcnt vmcnt(0)" ::: "memory");
        }
    }
    __syncthreads();
}

struct Args { const float* in[28]; float* out; unsigned char* ws; int ph_lo, ph_hi; };

struct Frame {
    LAS unsigned char* lds;
    int tid, lane, wave, vcu, G;
    const float* const* in;
    float* out; unsigned char* ws;
};
}
namespace mk {
__device__ __forceinline__ void p0_transpose_item(const float* W, int ldn, int k0, int src_n0, bf16_t* WT, int ldk, int dst_n0,
                                                  const float* gain, float scale, LAS float* scr, int lane) {
    if (src_n0 >= 0) {
#pragma unroll 8
        for (int i = 0; i < 32; ++i) { const int kk = 2 * i + (lane >> 5);
            float v = W[(size_t)(k0 + kk) * ldn + src_n0 + (lane & 31)] * scale; if (gain) v *= gain[k0 + kk];
            scr[kk * 33 + (lane & 31)] = v; }
    } else {
#pragma unroll 8
        for (int i = 0; i < 32; ++i) { const int kk = 2 * i + (lane >> 5); scr[kk * 33 + (lane & 31)] = 0.f; }
    }
    LDS_WAIT(); asm volatile("" ::: "memory");
    const int c = lane & 7;
#pragma unroll
    for (int j = 0; j < 4; ++j) { const int n = (lane >> 3) + 8 * j; const LAS float* s = scr + (8 * c) * 33 + n;
        u32x4 o; o.x = pk2(s[0 * 33], s[1 * 33]); o.y = pk2(s[2 * 33], s[3 * 33]); o.z = pk2(s[4 * 33], s[5 * 33]); o.w = pk2(s[6 * 33], s[7 * 33]);
        *(GAS u32x4*)(WT + (size_t)(dst_n0 + n) * ldk + k0 + 8 * c) = o; }
    LDS_WAIT(); asm volatile("" ::: "memory");
}
template <bool STAGE2>
__device__ __forceinline__ void moe_cvt_tile(const float* src, int ld, const float* gain16, bf16_t* dst0, size_t piece_stride  , LAS float* scr, int lane) {
#pragma unroll 4
    for (int i = 0; i < 16; ++i) { f32x4 v = *(const GAS f32x4*)(src + (size_t)i * ld + 4 * lane); if (gain16) v = v * gain16[i]; *(LAS f32x4*)(scr + i * 256 + 4 * lane) = v; }
    LDS_WAIT(); asm volatile("" ::: "memory");
    const int r = lane & 31, h = lane >> 5;
#pragma unroll
    for (int c = 0; c < 8; ++c) {
        float v[8];
#pragma unroll
        for (int j = 0; j < 8; ++j) { const int row = STAGE2 ? (8 * (j >> 2) + 4 * h + (j & 3)) : (8 * h + j); v[j] = scr[row * 256 + 32 * c + r]; }
        u32x4 o; o.x = pk2(v[0], v[1]); o.y = pk2(v[2], v[3]); o.z = pk2(v[4], v[5]); o.w = pk2(v[6], v[7]);
        *(GAS u32x4*)(dst0 + (size_t)c * piece_stride + (size_t)lane * 8) = o;
    }
    LDS_WAIT(); asm volatile("" ::: "memory");
}
constexpr int MOE_CVT_ITEMS = 6144;
struct CvtRegs { f32x4 v[16]; };
__device__ __forceinline__ void moe_cvt_load(const Frame& F, int layer, int it, CvtRegs& R) {
    const float* src; int ld;
    if (it < 4096) { const int gu = it >> 11, r = it & 2047, e = r >> 6, ks = r & 63; src = (gu ? F.in[26] : F.in[25]) + ((size_t)(layer * 32 + e) * 1024 + 16 * ks) * 256; ld = 256; }
    else { const int r = it - 4096, e = r >> 6, kk = (r >> 2) & 15, dq = r & 3; src = F.in[27] + ((size_t)(layer * 32 + e) * 256 + 16 * kk) * 1024 + 256 * dq; ld = 1024; }
#pragma unroll
    for (int i = 0; i < 16; ++i) R.v[i] = *(const GAS f32x4*)(src + (size_t)i * ld + 4 * F.lane);
}
__device__ __forceinline__ void moe_cvt_stage(const Frame& F, int layer, int it, const CvtRegs& R, LAS float* scr) {
    if (it < 4096) { const int ks = it & 63; const float* gain = F.in[2] + layer * 1024 + 16 * ks;
#pragma unroll
        for (int i = 0; i < 16; ++i) *(LAS f32x4*)(scr + i * 256 + 4 * F.lane) = R.v[i] * gain[i];
    } else {
#pragma unroll
        for (int i = 0; i < 16; ++i) *(LAS f32x4*)(scr + i * 256 + 4 * F.lane) = R.v[i];
    }
    LDS_WAIT(); asm volatile("" ::: "memory");
}
__device__ __forceinline__ void moe_cvt_emit(const Frame& F, int it, LAS float* scr) {
    bf16_t* W1 = (bf16_t*)(F.ws + WS_WMOE); bf16_t* W2 = W1 + 32 * W1_EXP;
    const int rr = F.lane & 31, h = F.lane >> 5;
    const bool s2 = it >= 4096;
    bf16_t* base; size_t st_c2, st_dt;
    if (!s2) { const int gu = it >> 11, r = it & 2047, e = r >> 6, ks = r & 63; base = W1 + (size_t)e * W1_EXP + ((size_t)ks * 2 + gu) * 512; st_c2 = 2 * 65536; st_dt = 65536; }
    else { const int r = it - 4096, e = r >> 6, kk = (r >> 2) & 15, dq = r & 3; const int p = dq >> 1, w0 = (dq & 1) * 4;
        base = W2 + (size_t)e * W2_EXP + ((size_t)(p * 8 + w0) * 16 + kk) * 1024; st_c2 = 16 * 1024; st_dt = 512; }
#pragma unroll
    for (int c = 0; c < 8; ++c) {
        float v[8];
#pragma unroll
        for (int j = 0; j < 8; ++j) { const int row = s2 ? (8 * (j >> 2) + 4 * h + (j & 3)) : (8 * h + j); v[j] = scr[row * 256 + 32 * c + rr]; }
        u32x4 o; o.x = pk2(v[0], v[1]); o.y = pk2(v[2], v[3]); o.z = pk2(v[4], v[5]); o.w = pk2(v[6], v[7]);
        *(GAS u32x4*)(base + (size_t)(c >> 1) * st_c2 + (size_t)(c & 1) * st_dt + (size_t)F.lane * 8) = o;
    }
    LDS_WAIT(); asm volatile("" ::: "memory");
}
__device__ __forceinline__ void row_to_bf16_rs(const float* xrow, bf16_t* orow, float* rs, int lane) {
    const GAS f32x4* xr = (const GAS f32x4*)xrow + lane;
    f32x4 v[4]; float s = 0.f;
#pragma unroll
    for (int j = 0; j < 4; ++j) { v[j] = xr[64 * j]; s += (v[j].x * v[j].x + v[j].y * v[j].y) + (v[j].z * v[j].z + v[j].w * v[j].w); }
    s = wave_sum(s);
    GAS u32x2* o8 = (GAS u32x2*)orow + lane;
#pragma unroll
    for (int j = 0; j < 4; ++j) { u32x2 w; w.x = pk2(v[j].x, v[j].y); w.y = pk2(v[j].z, v[j].w); o8[64 * j] = w; }
    if (lane == 0) *rs = 1.0f / sqrtf(s * (1.f / 1024.f) + EPS);
}

struct DenseDesc { int src_idx, K, ldn, nblk, ldk; size_t dst; int kind; };
__device__ __forceinline__ void p0_dense_item(const Frame& F, int it, LAS float* scr) {
    int r = it;
    if (r < 1024) { const int kb = r >> 6, nb = r & 63; const int n = 32 * nb; int src;
        if (n < 1024) { const int j = n >> 8, c = n & 255; src = (c < 128) ? (128 * j + c) : (512 + 128 * j + (c - 128)); } else src = n;
        p0_transpose_item(F.in[4], 2048, 64 * kb, src, (bf16_t*)(F.ws + WS_WINE), 1024, n, F.in[1], 1.f, scr, F.lane); return; } r -= 1024;
    if (r < 512) { const int kb = r >> 5, nb = r & 31;
        p0_transpose_item(F.in[13], 1024, 64 * kb, 32 * nb, (bf16_t*)(F.ws + WS_WOUTE), 1024, 32 * nb, nullptr, 1.f, scr, F.lane); return; } r -= 512;
    if (r < 640) { const int kb = r / 40, nb = r % 40; const int n = 32 * nb; int src; float sc = 1.f;
        if (n < 416) src = n; else if (n < 512) src = -1; else if (n < 1024) { src = 416 + (n - 512); sc = C2S; } else if (n < 1152) src = 928 + (n - 1024); else src = 1056 + (n - 1152);
        p0_transpose_item(F.in[14], 1184, 64 * kb, src, (bf16_t*)(F.ws + WS_WINO), 1024, n, F.in[1] + 1024, sc, scr, F.lane); return; } r -= 640;
    if (r < 96) { const int kb = r / 24, nb = r % 24; const int n = 32 * nb; int src;
        if (n < 512) src = 96 * (n >> 6) + (n & 63); else src = 96 * ((n - 512) >> 5) + 64;
        p0_transpose_item(F.in[16], 768, 64 * kb, src, (bf16_t*)(F.ws + WS_WUQ), 256, n, F.in[15], C2M, scr, F.lane); return; } r -= 96;
    if (r < 128) { const int kb = r >> 5, nb = r & 31; const int n = 32 * nb; int src;
        if (n < 512) src = 128 * (n >> 6) + (n & 63); else src = 128 * ((n - 512) >> 6) + 64 + ((n - 512) & 63);
        if (kb >= 2) src = -1;
        p0_transpose_item(F.in[18], 1024, kb >= 2 ? 0 : 64 * kb, src, (bf16_t*)(F.ws + WS_WUKV) + (kb >= 2 ? 64 * kb : 0), 256, n, F.in[17], 1.f, scr, F.lane); return; } r -= 128;
    { const int kb = r >> 5, nb = r & 31;
        p0_transpose_item(F.in[20], 1024, 64 * kb, 32 * nb, (bf16_t*)(F.ws + WS_WOUTO), 1024, 32 * nb, nullptr, 1.f, scr, F.lane); }
}
constexpr int DENSE_ITEMS = 2912;

__device__ __forceinline__ void phase_p0(const Frame& F) {
    LAS float* scr = (LAS float*)(F.lds + F.wave * 16384);
    const int gw = F.vcu * NWAVES + F.wave, NGW = F.G * NWAVES;
    { CvtRegs R; int it = gw; if (it < MOE_CVT_ITEMS) moe_cvt_load(F, 0, it, R);
      for (; it < MOE_CVT_ITEMS; it += NGW) { moe_cvt_stage(F, 0, it, R, scr); if (it + NGW < MOE_CVT_ITEMS) moe_cvt_load(F, 0, it + NGW, R); moe_cvt_emit(F, it, scr); } }
    for (int it = gw; it < DENSE_ITEMS; it += NGW) p0_dense_item(F, it, scr);
    for (int m = gw; m < T; m += NGW) row_to_bf16_rs(F.in[0] + (size_t)m * D, (bf16_t*)(F.ws + WS_XB) + (size_t)m * D, (float*)(F.ws + WS_RS0) + m, F.lane);
    const int gt = gw * 64 + F.lane, NGT = NGW * 64;
    for (int idx = gt; idx < 2 * 49152; idx += NGT) {
        const int layer = idx / 49152, li = idx % 49152;
        const int j = li & 7, ln = (li >> 3) & 63, blk = li >> 9, ct = blk % 3, ks = (blk / 3) & 3, w = blk / 12;
        const int k = 128 * w + 32 * ks + 8 * (ln >> 4) + j, col = 16 * ct + (ln & 15);
        float v = 0.f;
        if (col < 4) v = F.in[21][((size_t)layer * 1024 + k) * 4 + col];
        else if (col < 36) v = F.in[23][(((size_t)layer * 4 + ((col - 4) >> 3)) * 1024 + k) * 8 + ((col - 4) & 7)];
        v *= F.in[2][layer * 1024 + k];
        const unsigned hi = f2bf(v); const unsigned lo = f2bf(v - bf2f(hi));
        bf16_t* R = (bf16_t*)(F.ws + WS_ROUTER);
        R[(size_t)(layer * 2 + 0) * 49152 + li] = (bf16_t)hi;
        R[(size_t)(layer * 2 + 1) * 49152 + li] = (bf16_t)lo;
    }
    for (int idx = gt; idx < S * 16; idx += NGT) {
        const int pos = idx >> 4, j = idx & 15;
        const double inv = pow(10000.0, -(double)(2 * j) / 32.0), ang = (double)pos * inv;
        f32x2 cs; cs.x = (float)cos(ang); cs.y = (float)sin(ang);
        ((f32x2*)(F.ws + WS_ROPE))[idx] = cs;
    }
}
}
namespace mk {
using pg8::Unit;
__device__ __forceinline__ u32x4 pack8(const f32x4& a, const f32x4& b) { u32x4 w; w.x = pk2(a[0], a[1]); w.y = pk2(a[2], a[3]); w.z = pk2(b[0], b[1]); w.w = pk2(b[2], b[3]); return w; }

struct EpiE1 {
    static constexpr bool PERM = true, AFTER_DRAIN = false;
    bf16_t* ACT; const float* rs;
    __device__ __forceinline__ void operator()(const f32x4 (&acc)[2][2][4][2], const Unit& u, int wr, int wc, int fr, int fq) const {
        const int row0 = u.pm * 256 + wr * 64 + fr, cl = wc * 32 + 8 * fq;
#pragma unroll
        for (int ai = 0; ai < 2; ++ai)
#pragma unroll
            for (int m = 0; m < 4; ++m) {
                const int row = row0 + ai * 128 + m * 16; const float r = rs[row]; bf16_t* rowp = ACT + (size_t)row * 1536;
                if (u.pn < 4) {
                    f32x4 o0, o1;
#pragma unroll
                    for (int i = 0; i < 4; ++i) { o0[i] = acc[ai][0][m][0][i] * r * sigmoid_f(acc[ai][1][m][0][i] * r); o1[i] = acc[ai][0][m][1][i] * r * sigmoid_f(acc[ai][1][m][1][i] * r); }
                    *(u32x4*)(rowp + 128 * u.pn + cl) = pack8(o0, o1);
                } else {
                    const int base = (u.pn < 6) ? (512 + (u.pn - 4) * 256) : (1024 + (u.pn - 6) * 256);
#pragma unroll
                    for (int bj = 0; bj < 2; ++bj) { f32x4 o0, o1;
#pragma unroll
                        for (int i = 0; i < 4; ++i) { o0[i] = gelu_f(acc[ai][bj][m][0][i] * r); o1[i] = gelu_f(acc[ai][bj][m][1][i] * r); }
                        *(u32x4*)(rowp + base + bj * 128 + cl) = pack8(o0, o1); }
                }
            }
    }
};
struct EpiRes {
    static constexpr bool PERM = true, AFTER_DRAIN = false;
    const float* resid; float* out; bf16_t* xb;
    __device__ __forceinline__ void operator()(const f32x4 (&acc)[2][2][4][2], const Unit& u, int wr, int wc, int fr, int fq) const {
        const int row0 = u.pm * 256 + wr * 64 + fr, col0 = u.pn * 256 + wc * 32 + 8 * fq;
#pragma unroll
        for (int ai = 0; ai < 2; ++ai)
#pragma unroll
            for (int m = 0; m < 4; ++m) {
                const size_t off = (size_t)(row0 + ai * 128 + m * 16) * 1024 + col0;
#pragma unroll
                for (int bj = 0; bj < 2; ++bj) {
                    const f32x4 r0 = *(const f32x4*)(resid + off + bj * 128), r1 = *(const f32x4*)(resid + off + bj * 128 + 4);
                    const f32x4 v0 = acc[ai][bj][m][0] + r0, v1 = acc[ai][bj][m][1] + r1;
                    *(f32x4*)(out + off + bj * 128) = v0; *(f32x4*)(out + off + bj * 128 + 4) = v1;
                    *(u32x4*)(xb + off + bj * 128) = pack8(v0, v1);
                }
            }
    }
};
struct EpiO1 {
    static constexpr bool PERM = true, AFTER_DRAIN = false;
    bf16_t* P; const float* rs; float* ssqq; float* ssqkv; bf16_t* kpe; const f32x2* rope;
    __device__ __forceinline__ void operator()(const f32x4 (&acc)[2][2][4][2], const Unit& u, int wr, int wc, int fr, int fq) const {
        const int row0 = u.pm * 256 + wr * 64 + fr, cl = wc * 32 + 8 * fq;
#pragma unroll
        for (int ai = 0; ai < 2; ++ai)
#pragma unroll
            for (int m = 0; m < 4; ++m) {
                const int row = row0 + ai * 128 + m * 16; const float r = rs[row]; bf16_t* rowp = P + (size_t)row * 1280 + u.pn * 256 + cl;
                f32x4 v[2][2];
#pragma unroll
                for (int bj = 0; bj < 2; ++bj) { v[bj][0] = acc[ai][bj][m][0] * r; v[bj][1] = acc[ai][bj][m][1] * r; *(u32x4*)(rowp + bj * 128) = pack8(v[bj][0], v[bj][1]); }
                if (u.pn <= 1) {
                    float s = 0.f;
#pragma unroll
                    for (int i = 0; i < 4; ++i) { s += v[0][0][i] * v[0][0][i] + v[0][1][i] * v[0][1][i]; if (u.pn == 0) s += v[1][0][i] * v[1][0][i] + v[1][1][i] * v[1][1][i]; }
                    s += __shfl_xor(s, 16); s += __shfl_xor(s, 32);
                    if (fq == 0) (u.pn == 0 ? ssqq : ssqkv)[(size_t)row * 4 + wc] = s;
                }
                if (u.pn == 1 && wc == 0) {
                    const int pos = row & (S - 1); f32x4 o[2];
#pragma unroll
                    for (int n = 0; n < 2; ++n)
#pragma unroll
                        for (int i = 0; i < 4; ++i) { const float x = v[1][n][i], y = __shfl_xor(x, 32); const f32x2 cs = rope[pos * 16 + ((8 * fq + 4 * n + i) & 15)];
                            o[n][i] = (fq < 2) ? (x * cs.x - y * cs.y) : (x * cs.x + y * cs.y); }
                    *(u32x4*)(kpe + (size_t)row * 32 + 8 * fq) = pack8(o[0], o[1]);
                }
                asm volatile("" ::: "memory");
            }
    }
};
struct O2Order : pg8::StaticOrder {
    __device__ bool next(int i, Unit& u) const { const bool ok = pg8::StaticOrder::next(i, u); if (ok) u.aoff = (u.pn >= 3) ? 512 : 0; return ok; }
};
struct EpiO2 {
    static constexpr bool PERM = true, AFTER_DRAIN = false;
    bf16_t* Q; bf16_t* KV; const float* ssqq; const float* ssqkv;
    __device__ __forceinline__ void operator()(const f32x4 (&acc)[2][2][4][2], const Unit& u, int wr, int wc, int fr, int fq) const {
        const int row0 = u.pm * 256 + wr * 64 + fr, cl = wc * 32 + 8 * fq;
        const bool isq = u.pn < 3; const float* ssq = isq ? ssqq : ssqkv; const float inv_n = isq ? (1.f / 256.f) : (1.f / 128.f);
        bf16_t* O = isq ? (Q + u.pn * 256 + cl) : (KV + (u.pn - 3) * 256 + cl); const int ldo = isq ? 768 : 1024;
#pragma unroll
        for (int ai = 0; ai < 2; ++ai)
#pragma unroll
            for (int m = 0; m < 4; ++m) {
                const int row = row0 + ai * 128 + m * 16; const f32x4 sq = *(const f32x4*)(ssq + (size_t)row * 4);
                const float r = __builtin_amdgcn_rsqf(((sq[0] + sq[1]) + (sq[2] + sq[3])) * inv_n + EPS);
                bf16_t* rowp = O + (size_t)row * ldo;
#pragma unroll
                for (int bj = 0; bj < 2; ++bj) *(u32x4*)(rowp + bj * 128) = pack8(acc[ai][bj][m][0] * r, acc[ai][bj][m][1] * r);
                asm volatile("" ::: "memory");
            }
    }
};
}
namespace mk {
__device__ __forceinline__ void e2_conv_unit(const Frame& F, int tt, int grp, const bf16_t* ACT, bf16_t* MBo) {
    LAS bf16_t* tile = (LAS bf16_t*)F.lds;
    const int t0 = tt * 128, s0 = t0 & (S - 1);
    for (int idx = F.tid; idx < 158 * 16; idx += NTHR) { const int r = idx >> 4, c = idx & 15; const int sp = s0 + r - 15;
        u32x4 v = {0u, 0u, 0u, 0u};
        if (sp >= 0 && sp < S) v = *(const GAS u32x4*)(ACT + (size_t)(t0 + r - 15) * 1536 + grp * 128 + c * 8);
        *(LAS u32x4*)(tile + r * 128 + c * 8) = v; }
    __syncthreads();
    const int ch = grp * 128 + 2 * F.lane;
    const float* cw = F.in[5]; float w0[31], w1[31];
#pragma unroll
    for (int q = 0; q < 31; ++q) { const f32x2 wv = *(const f32x2*)(cw + q * 512 + ch); w0[q] = wv.x; w1[q] = wv.y; }
    const f32x2 bias = *(const f32x2*)(F.in[6] + ch);
    float a0[16], a1[16];
#pragma unroll
    for (int k = 0; k < 16; ++k) { a0[k] = bias.x; a1[k] = bias.y; }
    const LAS unsigned* src = (const LAS unsigned*)(tile + (16 * F.wave) * 128 + 2 * F.lane);
#pragma unroll
    for (int i = 0; i < 46; ++i) { const unsigned x = src[i * 64]; const float x0 = bf2f(x & 0xffffu), x1 = bf2f(x >> 16);
#pragma unroll
        for (int k = 0; k < 16; ++k) { const int q = i - k; if (q >= 0 && q <= 30) { a0[k] = fmaf(x0, w0[q], a0[k]); a1[k] = fmaf(x1, w1[q], a1[k]); } } }
    const f32x2 g = *(const f32x2*)(F.in[7] + ch), bt = *(const f32x2*)(F.in[8] + ch);
    LAS float* scr = (LAS float*)(F.lds + 49152) + F.wave * 32;
    const bool b5 = (F.lane & 32) != 0, b4 = (F.lane & 16) != 0, b3 = (F.lane & 8) != 0, b2 = (F.lane & 4) != 0;
    const int tk = (b5 ? 8 : 0) + (b4 ? 4 : 0) + (b3 ? 2 : 0) + (b2 ? 1 : 0);
#define E2_BFLY(S, OUT) do { float v8_[8], v4_[4], v2_[2]; \
        _Pragma("unroll") for (int k = 0; k < 8; ++k) { const float kp = b5 ? S[k + 8] : S[k], sd = b5 ? S[k] : S[k + 8]; v8_[k] = kp + __shfl_xor(sd, 32); } \
        _Pragma("unroll") for (int k = 0; k < 4; ++k) { const float kp = b4 ? v8_[k + 4] : v8_[k], sd = b4 ? v8_[k] : v8_[k + 4]; v4_[k] = kp + __shfl_xor(sd, 16); } \
        _Pragma("unroll") for (int k = 0; k < 2; ++k) { const float kp = b3 ? v4_[k + 2] : v4_[k], sd = b3 ? v4_[k] : v4_[k + 2]; v2_[k] = kp + __shfl_xor(sd, 8); } \
        { const float kp = b2 ? v2_[1] : v2_[0], sd = b2 ? v2_[0] : v2_[1]; OUT = kp + __shfl_xor(sd, 4); } \
        OUT += __shfl_xor(OUT, 2); OUT += __shfl_xor(OUT, 1); } while (0)
    float st[16], tot;
#pragma unroll
    for (int k = 0; k < 16; ++k) st[k] = a0[k] + a1[k];
    E2_BFLY(st, tot);
    if ((F.lane & 3) == 0) scr[tk] = tot * (1.f / 128.f);
    LDS_WAIT(); asm volatile("" ::: "memory");
    float mu[16];
#pragma unroll
    for (int k4 = 0; k4 < 4; ++k4) { const f32x4 m4 = *(const LAS f32x4*)(scr + 4 * k4); mu[4 * k4] = m4.x; mu[4 * k4 + 1] = m4.y; mu[4 * k4 + 2] = m4.z; mu[4 * k4 + 3] = m4.w; }
#pragma unroll
    for (int k = 0; k < 16; ++k) { a0[k] -= mu[k]; a1[k] -= mu[k]; st[k] = a0[k] * a0[k] + a1[k] * a1[k]; }
    E2_BFLY(st, tot);
    if ((F.lane & 3) == 0) scr[16 + tk] = 1.0f / sqrtf(tot * (1.f / 128.f) + EPS);
    LDS_WAIT(); asm volatile("" ::: "memory");
#undef E2_BFLY
#pragma unroll
    for (int k4 = 0; k4 < 4; ++k4) { const f32x4 r4 = *(const LAS f32x4*)(scr + 16 + 4 * k4);
#pragma unroll
        for (int i = 0; i < 4; ++i) { const int k = 4 * k4 + i; const float rs = r4[i];
            const float y0 = silu_f(a0[k] * rs * g.x + bt.x), y1 = silu_f(a1[k] * rs * g.y + bt.y);
            *(GAS unsigned*)(MBo + (size_t)(t0 + 16 * F.wave + k) * 1024 + ch) = pk2(y0, y1); } }
    __syncthreads();
}
__device__ __forceinline__ void e2_sgu_unit(const Frame& F, int chunk, int h, const bf16_t* ACT, bf16_t* MBo) {
    constexpr int LD = 136, LDO = 132;
    LAS bf16_t* WSl = (LAS bf16_t*)F.lds;
    LAS bf16_t* VTl = (LAS bf16_t*)(F.lds + 34816);
    LAS float* OUTl = (LAS float*)(F.lds + 69632);
    const int t0 = chunk * 128;
    const float* wsp = F.in[11] + (size_t)h * 128 * 128;
    for (int idx = F.tid; idx < 4096; idx += NTHR) { const int r = idx >> 5, c4 = idx & 31; const f32x4 v = *(const GAS f32x4*)(wsp + r * 128 + 4 * c4);
        u32x2 w; w.x = pk2(v.x, v.y); w.y = pk2(v.z, v.w); *(LAS u32x2*)(WSl + r * LD + 4 * c4) = w; }
#pragma unroll
    for (int it = 0; it < 4; ++it) { const int idx = F.tid + NTHR * it, s = idx >> 4, c = idx & 15;
        const u32x4 raw = *(const GAS u32x4*)(ACT + (size_t)(t0 + s) * 1536 + 1024 + h * 128 + 8 * c);
        float x[8]; x[0] = bf2f(raw.x & 0xffffu); x[1] = bf2f(raw.x >> 16); x[2] = bf2f(raw.y & 0xffffu); x[3] = bf2f(raw.y >> 16);
        x[4] = bf2f(raw.z & 0xffffu); x[5] = bf2f(raw.z >> 16); x[6] = bf2f(raw.w & 0xffffu); x[7] = bf2f(raw.w >> 16);
        float sm = 0.f;
#pragma unroll
        for (int i = 0; i < 8; ++i) sm += x[i];
        sm += __shfl_xor(sm, 1); sm += __shfl_xor(sm, 2); sm += __shfl_xor(sm, 4); sm += __shfl_xor(sm, 8);
        const float mu = sm * (1.f / 128.f); float q = 0.f;
#pragma unroll
        for (int i = 0; i < 8; ++i) { x[i] -= mu; q += x[i] * x[i]; }
        q += __shfl_xor(q, 1); q += __shfl_xor(q, 2); q += __shfl_xor(q, 4); q += __shfl_xor(q, 8);
        const float rs = 1.0f / sqrtf(q * (1.f / 128.f) + EPS);
        const float* vg = F.in[9] + h * 128 + 8 * c; const float* vb = F.in[10] + h * 128 + 8 * c;
#pragma unroll
        for (int i = 0; i < 8; ++i) { const float y = x[i] * rs * vg[i] + vb[i]; VTl[(8 * c + i) * LD + s] = (bf16_t)f2bf(y); }
    }
    __syncthreads();
    const int wt = F.wave >> 1, wc = F.wave & 1, r32 = F.lane & 31, hi = F.lane >> 5;
    f32x16 acc[2]; acc[0] = f32x16{}; acc[1] = f32x16{};
#pragma unroll
    for (int ks = 0; ks < 8; ++ks) {
        const bf16x8 a = *(const LAS bf16x8*)(WSl + (32 * wt + r32) * LD + 16 * ks + 8 * hi);
#pragma unroll
        for (int ct = 0; ct < 2; ++ct) { const bf16x8 b = *(const LAS bf16x8*)(VTl + (64 * wc + 32 * ct + r32) * LD + 16 * ks + 8 * hi);
            acc[ct] = __builtin_amdgcn_mfma_f32_32x32x16_bf16(a, b, acc[ct], 0, 0, 0); }
    }
    const float* bsp = F.in[12] + h * 128;
#pragma unroll
    for (int ct = 0; ct < 2; ++ct)
#pragma unroll
        for (int r = 0; r < 16; ++r) { const int trow = 32 * wt + (r & 3) + 8 * (r >> 2) + 4 * hi; OUTl[trow * LDO + 64 * wc + 32 * ct + r32] = acc[ct][r] + bsp[trow]; }
    __syncthreads();
#pragma unroll
    for (int it = 0; it < 4; ++it) { const int idx = F.tid + NTHR * it, t = idx >> 4, c = idx & 15;
        const u32x4 raw = *(const GAS u32x4*)(ACT + (size_t)(t0 + t) * 1536 + 512 + h * 128 + 8 * c);
        const f32x4 s0 = *(const LAS f32x4*)(OUTl + t * LDO + 8 * c), s1 = *(const LAS f32x4*)(OUTl + t * LDO + 8 * c + 4);
        u32x4 o; o.x = pk2(bf2f(raw.x & 0xffffu) * s0.x, bf2f(raw.x >> 16) * s0.y); o.y = pk2(bf2f(raw.y & 0xffffu) * s0.z, bf2f(raw.y >> 16) * s0.w);
        o.z = pk2(bf2f(raw.z & 0xffffu) * s1.x, bf2f(raw.z >> 16) * s1.y); o.w = pk2(bf2f(raw.w & 0xffffu) * s1.z, bf2f(raw.w >> 16) * s1.w);
        *(GAS u32x4*)(MBo + (size_t)(t0 + t) * 1024 + 512 + h * 128 + 8 * c) = o; }
    __syncthreads();
}
__device__ __forceinline__ void phase_e2(const Frame& F) {
    const bf16_t* ACT = (const bf16_t*)F.out; bf16_t* MBo = (bf16_t*)(F.ws + WS_MB);
    for (int u = F.vcu; u < 1024; u += F.G) {
        if (u < 512) e2_conv_unit(F, u >> 2, u & 3, ACT, MBo);
        else e2_sgu_unit(F, (u - 512) >> 2, (u - 512) & 3, ACT, MBo);
    }
}
template <bool FINAL> __device__ __forceinline__ void combine_rows(const Frame& F) {
    const int gw = F.vcu * NWAVES + F.wave, NGW = F.G * NWAVES;
    const bf16_t* Y = (const bf16_t*)(F.ws + WS_Y);
    for (int m = gw; m < T; m += NGW) {
        GAS f32x4* xr = (GAS f32x4*)(F.out + (size_t)m * D) + F.lane;
        const GAS u32x2* y0 = (const GAS u32x2*)(Y + (size_t)(2 * m) * D) + F.lane; const GAS u32x2* y1 = (const GAS u32x2*)(Y + (size_t)(2 * m + 1) * D) + F.lane;
        f32x4 v[4]; float s = 0.f;
#pragma unroll
        for (int j = 0; j < 4; ++j) { v[j] = xr[64 * j]; const u32x2 a = y0[64 * j], b = y1[64 * j];
            v[j].x += bf2f(a.x & 0xffffu) + bf2f(b.x & 0xffffu); v[j].y += bf2f(a.x >> 16) + bf2f(b.x >> 16);
            v[j].z += bf2f(a.y & 0xffffu) + bf2f(b.y & 0xffffu); v[j].w += bf2f(a.y >> 16) + bf2f(b.y >> 16);
            s += (v[j].x * v[j].x + v[j].y * v[j].y) + (v[j].z * v[j].z + v[j].w * v[j].w); }
        s = wave_sum(s);
        const float rs = 1.0f / sqrtf(s * (1.f / 1024.f) + EPS);
        if (FINAL) {
            const GAS f32x4* g = (const GAS f32x4*)F.in[3] + F.lane;
#pragma unroll
            for (int j = 0; j < 4; ++j) { const f32x4 gg = g[64 * j]; xr[64 * j] = v[j] * rs * gg; }
        } else {
            GAS u32x2* o8 = (GAS u32x2*)((bf16_t*)(F.ws + WS_XB) + (size_t)m * D) + F.lane;
#pragma unroll
            for (int j = 0; j < 4; ++j) { xr[64 * j] = v[j]; u32x2 w; w.x = pk2(v[j].x, v[j].y); w.y = pk2(v[j].z, v[j].w); o8[64 * j] = w; }
            if (F.lane == 0) ((float*)(F.ws + WS_RS0))[m] = rs;
        }
    }
}
}
namespace mk {
typedef float f32x4v __attribute__((ext_vector_type(4)));
__device__ __forceinline__ void phase_router(const Frame& F, int layer) {
    LAS float* red = (LAS float*)F.lds;
    LAS float* ssqr = (LAS float*)(F.lds + 98304);
    LAS float* lg = (LAS float*)(F.lds + 100352);
    LAS float* rsl = (LAS float*)(F.lds + 112640);
    LAS int* sel = (LAS int*)(F.lds + 112896);
    LAS float* gwl = (LAS float*)(F.lds + 113408);
    LAS int* basel = (LAS int*)(F.lds + 113920);
    const bf16_t* RH = (const bf16_t*)(F.ws + WS_ROUTER) + (size_t)(layer * 2) * 49152 + (size_t)F.wave * 6144;
    const bf16_t* RL = RH + 49152;
    unsigned* gcnt = (unsigned*)(F.ws + WS_CTL) + CW_ECNT + layer * 32 * 64;
    const int r = F.lane & 15, q = F.lane >> 4;
    for (int unit = F.vcu; unit < T / 64; unit += F.G) {
        const int tok0 = unit * 64;
        const float* X = F.out + (size_t)tok0 * D + 128 * F.wave + 8 * q;
        f32x4 acc[4][3]; float ssq[4];
#pragma unroll
        for (int tt = 0; tt < 4; ++tt) { ssq[tt] = 0.f;
#pragma unroll
            for (int ct = 0; ct < 3; ++ct) acc[tt][ct] = (f32x4){0.f, 0.f, 0.f, 0.f}; }
#pragma unroll 1
        for (int ks = 0; ks < 4; ++ks) {
            bf16x8 bh[3], bl[3];
#pragma unroll
            for (int ct = 0; ct < 3; ++ct) { bh[ct] = *(const GAS bf16x8*)(RH + ((ks * 3 + ct) * 64 + F.lane) * 8); bl[ct] = *(const GAS bf16x8*)(RL + ((ks * 3 + ct) * 64 + F.lane) * 8); }
#pragma unroll
            for (int tt = 0; tt < 4; ++tt) {
                const float* xp = X + (size_t)(16 * tt + r) * D + 32 * ks;
                const f32x4 x0 = *(const GAS f32x4*)xp, x1 = *(const GAS f32x4*)(xp + 4);
                float xv[8] = {x0.x, x0.y, x0.z, x0.w, x1.x, x1.y, x1.z, x1.w};
                unsigned hh[8], ll[8];
#pragma unroll
                for (int j = 0; j < 8; ++j) { ssq[tt] = fmaf(xv[j], xv[j], ssq[tt]); hh[j] = f2bf(xv[j]); ll[j] = f2bf(xv[j] - bf2f(hh[j])); }
                u32x4 ahw, alw;
                ahw.x = hh[0] | (hh[1] << 16); ahw.y = hh[2] | (hh[3] << 16); ahw.z = hh[4] | (hh[5] << 16); ahw.w = hh[6] | (hh[7] << 16);
                alw.x = ll[0] | (ll[1] << 16); alw.y = ll[2] | (ll[3] << 16); alw.z = ll[4] | (ll[5] << 16); alw.w = ll[6] | (ll[7] << 16);
                const bf16x8 ah = __builtin_bit_cast(bf16x8, ahw), al = __builtin_bit_cast(bf16x8, alw);
#pragma unroll
                for (int ct = 0; ct < 3; ++ct) {
                    acc[tt][ct] = __builtin_amdgcn_mfma_f32_16x16x32_bf16(ah, bh[ct], acc[tt][ct], 0, 0, 0);
                    acc[tt][ct] = __builtin_amdgcn_mfma_f32_16x16x32_bf16(al, bh[ct], acc[tt][ct], 0, 0, 0);
                    acc[tt][ct] = __builtin_amdgcn_mfma_f32_16x16x32_bf16(ah, bl[ct], acc[tt][ct], 0, 0, 0);
                }
            }
        }
#pragma unroll
        for (int tt = 0; tt < 4; ++tt) {
#pragma unroll
            for (int ct = 0; ct < 3; ++ct)
#pragma unroll
                for (int i = 0; i < 4; ++i) red[(F.wave * 64 + 16 * tt + 4 * q + i) * 48 + 16 * ct + r] = acc[tt][ct][i];
            float s = ssq[tt]; s += __shfl_xor(s, 16); s += __shfl_xor(s, 32);
            if (q == 0) ssqr[F.wave * 64 + 16 * tt + r] = s;
        }
        __syncthreads();
        for (int idx = F.tid; idx < 3072; idx += NTHR) { float s = 0.f;
#pragma unroll
            for (int w = 0; w < 8; ++w) s += red[w * 3072 + idx];
            lg[idx] = s; }
        if (F.tid < 64) { float s = 0.f;
#pragma unroll
            for (int w = 0; w < 8; ++w) s += ssqr[w * 64 + F.tid];
            rsl[F.tid] = 1.0f / sqrtf(s * (1.f / 1024.f) + EPS); }
        __syncthreads();
        if (F.tid < 64) {
            const int t = tok0 + F.tid; const float rs = rsl[F.tid]; const LAS float* L = lg + F.tid * 48;
            const float* bg = F.in[22] + layer * 4; const float* br = F.in[24] + layer * 32;
            float gl[4];
#pragma unroll
            for (int j = 0; j < 4; ++j) gl[j] = L[j] * rs + bg[j];
            int gi = 0; float gm = gl[0];
#pragma unroll
            for (int j = 1; j < 4; ++j) if (gl[j] > gm) { gm = gl[j]; gi = j; }
            float den = 0.f;
#pragma unroll
            for (int j = 0; j < 4; ++j) den += __expf(gl[j] - gm);
            const float gp = 1.f / den;
            float el[8];
#pragma unroll
            for (int e = 0; e < 8; ++e) el[e] = L[4 + 8 * gi + e] * rs + br[gi * 8 + e];
            int i1 = 0; float v1 = el[0];
#pragma unroll
            for (int e = 1; e < 8; ++e) if (el[e] > v1) { v1 = el[e]; i1 = e; }
            int i2 = 0; float v2 = -3.0e38f;
#pragma unroll
            for (int e = 0; e < 8; ++e) if (e != i1 && el[e] > v2) { v2 = el[e]; i2 = e; }
            const float e2 = __expf(v2 - v1);
            sel[2 * F.tid] = gi * 8 + i1; sel[2 * F.tid + 1] = gi * 8 + i2;
            gwl[2 * F.tid] = gp / (1.f + e2); gwl[2 * F.tid + 1] = gp * e2 / (1.f + e2);
            ((float*)(F.ws + WS_RSM))[t] = rs;
        }
        __syncthreads();
        int pos = 0, myexp = 0;
        if (F.tid < 128) { myexp = sel[F.tid]; for (int j = 0; j < F.tid; ++j) pos += (sel[j] == myexp) ? 1 : 0; }
        if (F.tid >= 128 && F.tid < 160) { const int e = F.tid - 128; int c = 0; for (int j = 0; j < 128; ++j) c += (sel[j] == e) ? 1 : 0;
            basel[e] = c ? (int)__hip_atomic_fetch_add(gcnt + e * 64, (unsigned)c, __ATOMIC_RELAXED, __HIP_MEMORY_SCOPE_AGENT) : 0; }
        __syncthreads();
        if (F.tid < 128) { const size_t dst = (size_t)myexp * T + basel[myexp] + pos;
            ((int*)(F.ws + WS_LSLOT))[dst] = 2 * (tok0 + (F.tid >> 1)) + (F.tid & 1);
            ((float*)(F.ws + WS_LGW))[dst] = gwl[F.tid]; }
        __syncthreads();
    }
}

#define MOE_VMWAIT(n) asm volatile("s_waitcnt vmcnt(" #n ")" ::: "memory")
template <int NT> __device__ __forceinline__ void moe_segment_t(const Frame& F, int e, int l0, int n) {
    constexpr int RW = 5;
    LAS unsigned char* XR = F.lds;
    LAS unsigned char* HID = F.lds;
    LAS unsigned char* RING = F.lds + 65536 + F.wave * (RW * 2048);
    LAS int* s_tok = (LAS int*)(F.lds + 65536 + 8 * RW * 2048);
    LAS int* s_slot = s_tok + 128;
    LAS float* s_gw = (LAS float*)(s_slot + 128);
    LAS float* s_rs = s_gw + 128;
    const int lane = F.lane, r32 = lane & 31, hi = lane >> 5, w = F.wave;
    const char* w1p = (const char*)((const bf16_t*)(F.ws + WS_WMOE) + (size_t)e * W1_EXP + (size_t)w * 65536) + lane * 16;
    const char* w2p = (const char*)((const bf16_t*)(F.ws + WS_WMOE) + 32 * W1_EXP + (size_t)e * W2_EXP + (size_t)w * 16384) + lane * 16;
#define MOE_WSRC(t) (((t) < 64) ? (w1p + (size_t)(t) * 2048) : (w2p + (size_t)(((t) - 64) >> 4) * 262144 + (size_t)(((t) - 64) & 15) * 2048))
#define MOE_WDMA(t, slot) do { const char* s_ = MOE_WSRC(t); LAS unsigned char* d_ = RING + (slot) * 2048; \
        __builtin_amdgcn_global_load_lds((const GAS unsigned*)s_, (LAS unsigned*)d_, 16, 0, 0); \
        __builtin_amdgcn_global_load_lds((const GAS unsigned*)(s_ + 1024), (LAS unsigned*)(d_ + 1024), 16, 0, 0); } while (0)
    MOE_WDMA(0, 0); MOE_WDMA(1, 1); MOE_WDMA(2, 2); MOE_WDMA(3, 3);
    if (F.tid < 128) { const int idx = F.tid < n ? F.tid : 0; const size_t li = (size_t)e * T + l0 + idx;
        const int slot = ((const int*)(F.ws + WS_LSLOT))[li]; const int tok = slot >> 1;
        s_tok[F.tid] = tok; s_slot[F.tid] = F.tid < n ? slot : -1; s_gw[F.tid] = F.tid < n ? ((const float*)(F.ws + WS_LGW))[li] : 0.f;
        s_rs[F.tid] = ((const float*)(F.ws + WS_RSM))[tok]; }
    __syncthreads();
    const char* xp0 = (const char*)((const bf16_t*)(F.ws + WS_XB) + (size_t)s_tok[lane] * D) + (2 * w) * 16;
    const char* xp1 = (const char*)((const bf16_t*)(F.ws + WS_XB) + (size_t)s_tok[64 + lane] * D) + (2 * w) * 16;
#define MOE_XDMA(kc, bufsel) do { LAS unsigned char* xb_ = XR + (bufsel) * 32768 + (2 * w) * 2048; const size_t ko_ = (size_t)(kc) * 256; \
        __builtin_amdgcn_global_load_lds((const GAS unsigned*)(xp0 + ko_), (LAS unsigned*)(xb_), 16, 0, 0); \
        __builtin_amdgcn_global_load_lds((const GAS unsigned*)(xp1 + ko_), (LAS unsigned*)(xb_ + 1024), 16, 0, 0); \
        __builtin_amdgcn_global_load_lds((const GAS unsigned*)(xp0 + ko_ + 16), (LAS unsigned*)(xb_ + 2048), 16, 0, 0); \
        __builtin_amdgcn_global_load_lds((const GAS unsigned*)(xp1 + ko_ + 16), (LAS unsigned*)(xb_ + 3072), 16, 0, 0); } while (0)
    MOE_XDMA(0, 0);
    MOE_VMWAIT(0); __builtin_amdgcn_s_barrier(); asm volatile("" ::: "memory");
    int wr_slot = 4, rd_slot = 0;
    f32x16 accg[NT], accu[NT];
#pragma unroll
    for (int i = 0; i < NT; ++i) { accg[i] = f32x16{}; accu[i] = f32x16{}; }
    for (int kc = 0; kc < 8; ++kc) {
        const LAS unsigned char* buf = XR + (kc & 1) * 32768 + (hi * 128 + r32) * 16;
#pragma unroll
        for (int ks = 0; ks < 8; ++ks) {
            MOE_WDMA(kc * 8 + ks + 4, wr_slot); wr_slot = (wr_slot == RW - 1) ? 0 : wr_slot + 1;
            if (ks == 0 && kc < 7) MOE_XDMA(kc + 1, (kc + 1) & 1);
            if (ks <= 4 && kc < 7) MOE_VMWAIT(12); else MOE_VMWAIT(8);
            const LAS unsigned char* rp = RING + rd_slot * 2048 + lane * 16; rd_slot = (rd_slot == RW - 1) ? 0 : rd_slot + 1;
            const bf16x8 wg = *(const LAS bf16x8*)rp, wu = *(const LAS bf16x8*)(rp + 1024);
#pragma unroll
            for (int i = 0; i < NT; ++i) {
                const bf16x8 xf = *(const LAS bf16x8*)(buf + (2 * ks * 128 + 32 * i) * 16);
                accg[i] = __builtin_amdgcn_mfma_f32_32x32x16_bf16(wg, xf, accg[i], 0, 0, 0);
                accu[i] = __builtin_amdgcn_mfma_f32_32x32x16_bf16(wu, xf, accu[i], 0, 0, 0);
            }
        }
        asm volatile("s_waitcnt lgkmcnt(0)" ::: "memory"); __builtin_amdgcn_s_barrier(); asm volatile("" ::: "memory");
    }
#pragma unroll
    for (int i = 0; i < NT; ++i) {
        const float rs = s_rs[32 * i + r32], gw = s_gw[32 * i + r32];
#pragma unroll
        for (int s = 0; s < 2; ++s) { float hv[8];
#pragma unroll
            for (int j = 0; j < 8; ++j) { const float g = accg[i][8 * s + j] * rs, u = accu[i][8 * s + j] * rs; hv[j] = silu_f(g) * u * gw; }
            u32x4 o; o.x = pk2(hv[0], hv[1]); o.y = pk2(hv[2], hv[3]); o.z = pk2(hv[4], hv[5]); o.w = pk2(hv[6], hv[7]);
            *(LAS u32x4*)(HID + (((2 * w + s) * 2 + hi) * 128 + 32 * i + r32) * 16) = o; }
    }
    asm volatile("s_waitcnt lgkmcnt(0)" ::: "memory"); __builtin_amdgcn_s_barrier(); asm volatile("" ::: "memory");
    bf16_t* Y = (bf16_t*)(F.ws + WS_Y);
    const LAS unsigned char* hb = HID + (hi * 128 + r32) * 16;
#pragma unroll 1
    for (int p = 0; p < 2; ++p) {
        f32x16 acc2[NT][2];
#pragma unroll
        for (int i = 0; i < NT; ++i) { acc2[i][0] = f32x16{}; acc2[i][1] = f32x16{}; }
#pragma unroll
        for (int kk = 0; kk < 16; ++kk) {
            if (p == 0 || kk < 12) { MOE_WDMA(64 + 16 * p + kk + 4, wr_slot); wr_slot = (wr_slot == RW - 1) ? 0 : wr_slot + 1; MOE_VMWAIT(8); }
            else if (kk == 12) MOE_VMWAIT(6); else if (kk == 13) MOE_VMWAIT(4); else if (kk == 14) MOE_VMWAIT(2); else MOE_VMWAIT(0);
            const LAS unsigned char* rp = RING + rd_slot * 2048 + lane * 16; rd_slot = (rd_slot == RW - 1) ? 0 : rd_slot + 1;
            const bf16x8 a0 = *(const LAS bf16x8*)rp, a1 = *(const LAS bf16x8*)(rp + 1024);
#pragma unroll
            for (int i = 0; i < NT; ++i) {
                const bf16x8 hf = *(const LAS bf16x8*)(hb + (kk * 2 * 128 + 32 * i) * 16);
                acc2[i][0] = __builtin_amdgcn_mfma_f32_32x32x16_bf16(a0, hf, acc2[i][0], 0, 0, 0);
                acc2[i][1] = __builtin_amdgcn_mfma_f32_32x32x16_bf16(a1, hf, acc2[i][1], 0, 0, 0);
            }
        }
#pragma unroll
        for (int i = 0; i < NT; ++i) {
            const int slot = s_slot[32 * i + r32];
            if (slot >= 0) {
                bf16_t* yr = Y + (size_t)slot * D + 512 * p + 64 * w + 4 * hi;
#pragma unroll
                for (int dt = 0; dt < 2; ++dt)
#pragma unroll
                    for (int qd = 0; qd < 4; ++qd) { u32x2 o; o.x = pk2(acc2[i][dt][4 * qd], acc2[i][dt][4 * qd + 1]); o.y = pk2(acc2[i][dt][4 * qd + 2], acc2[i][dt][4 * qd + 3]);
                        *(GAS u32x2*)(yr + 32 * dt + 8 * qd) = o; }
            }
        }
    }
    asm volatile("s_waitcnt lgkmcnt(0)" ::: "memory"); __builtin_amdgcn_s_barrier(); asm volatile("" ::: "memory");
#undef MOE_WSRC
#undef MOE_WDMA
#undef MOE_XDMA
}
__device__ __forceinline__ void moe_segment(const Frame& F, int e, int l0, int n) {
    const int nt = (n + 31) >> 5;
    if (nt == 4) moe_segment_t<4>(F, e, l0, n); else if (nt == 3) moe_segment_t<3>(F, e, l0, n); else if (nt == 2) moe_segment_t<2>(F, e, l0, n); else moe_segment_t<1>(F, e, l0, n);
}
__device__ __forceinline__ void phase_moe(const Frame& F, int layer) {
    unsigned* gcnt = (unsigned*)(F.ws + WS_CTL) + CW_ECNT + layer * 32 * 64;
    for (int unit = F.vcu; unit < 256; unit += F.G) {
        const int v0 = 128 * unit, v1 = v0 + 128; int vb = 0;
        for (int e = 0; e < 32; ++e) {
            const int ne = (int)__builtin_amdgcn_readfirstlane(__hip_atomic_load(gcnt + e * 64, __ATOMIC_RELAXED, __HIP_MEMORY_SCOPE_AGENT));
            const int lo = v0 > vb ? v0 : vb, hi_ = v1 < vb + ne ? v1 : vb + ne;
            if (lo < hi_) moe_segment(F, e, lo - vb, hi_ - lo);
            vb += ne;
        }
    }
}
}
namespace mk {
__device__ __forceinline__ int crow(int r, int hi) { return (r & 3) + 8 * (r >> 2) + 4 * hi; }
__device__ __forceinline__ s16x4 vtr(const LAS unsigned char* p) {
    typedef short v4i16_t __attribute__((ext_vector_type(4)));
    return __builtin_bit_cast(s16x4, __builtin_amdgcn_ds_read_tr16_b64_v4i16((LAS v4i16_t*)p));
}
constexpr float ATT_THR = 8.f;

template <int MODE> __device__ __forceinline__ void attn_unit(const Frame& F, int unit) {
    constexpr int NKC = MODE == 0 ? 12 : 8, ND0 = NKC / 2, KBYTES = NKC * 1024, BUF = KBYTES + 8192;
    const int lane = F.lane, w = F.wave, r32 = lane & 31, hi = lane >> 5;
    LAS unsigned char* lds = F.lds;
    LAS float* wsf = (LAS float*)(lds + 2 * BUF) + w * 64;
    LAS bf16_t* stg = (LAS bf16_t*)(lds + 2 * BUF + 2048) + w * 2048;
    const bf16_t* Qb = (const bf16_t*)(F.ws + WS_Q); const bf16_t* KVb = (const bf16_t*)(F.ws + WS_KV); const bf16_t* KPE = (const bf16_t*)(F.ws + WS_KPE);
    const bf16_t* Pb = (const bf16_t*)(F.ws + WS_P); bf16_t* Ob = (bf16_t*)(F.ws + WS_MB);
    int b, h = 0, g = 0, hq = 0, tq0, j_lo, j_hi, kbase0, ocol, qpos0 = 0;
    if (MODE == 0) { b = unit >> 6; h = (unit >> 3) & 7; const int qb = unit & 7; tq0 = b * S + 256 * qb + 32 * w; j_lo = 0; j_hi = 32; kbase0 = b * S; ocol = h * 64; }
    else { b = unit >> 6; const int rem = unit & 63; g = rem >> 5; const int qblk = (rem >> 1) & 15, hp = rem & 1; hq = 4 * g + 2 * hp + (w >> 2);
        qpos0 = 128 * qblk + 32 * (w & 3); tq0 = b * S + qpos0; j_lo = (qblk == 0) ? 2 : 0; j_hi = (qblk == 15) ? 4 : 6; kbase0 = b * S + 128 * qblk - 128; ocol = 512 + hq * 64; }
    bf16x8 qr[ND0];
    if (MODE == 0) { const bf16_t* qrow = Qb + (size_t)(tq0 + r32) * 768;
#pragma unroll
        for (int d0 = 0; d0 < 4; ++d0) qr[d0] = *(const GAS bf16x8*)(qrow + h * 64 + 16 * d0 + 8 * hi);
#pragma unroll
        for (int d0 = 4; d0 < 6; ++d0) qr[d0] = *(const GAS bf16x8*)(qrow + 512 + h * 32 + 16 * (d0 - 4) + 8 * hi);
        {
            const f32x2* rp = (const f32x2*)(F.ws + WS_ROPE) + ((tq0 + r32) & (S - 1)) * 16 + 8 * hi;
            bf16x8 a4 = qr[4], a5 = qr[5];
#pragma unroll
            for (int j = 0; j < 8; ++j) { const f32x2 cs = rp[j]; const float x = bf2f((unsigned short)a4[j]), y = bf2f((unsigned short)a5[j]);
                a4[j] = (short)f2bf(x * cs.x - y * cs.y); a5[j] = (short)f2bf(y * cs.x + x * cs.y); }
            qr[4] = a4; qr[5] = a5; }
    } else { const bf16_t* qrow = Pb + (size_t)(tq0 + r32) * 1280 + 512 + hq * 64;
#pragma unroll
        for (int d0 = 0; d0 < ND0; ++d0) qr[d0] = *(const GAS bf16x8*)(qrow + 16 * d0 + 8 * hi);
    }
    const bf16_t *ksrc0, *ksrc1 = nullptr, *vsrc; size_t kstride, kstride1 = 0, vstride;
    const int vrow = 16 * (w & 3) + (lane >> 2), vcol = (w >> 2) * 32 + (lane & 3) * 8;
    if (MODE == 0) { ksrc0 = KVb + (size_t)(kbase0 + lane) * 1024 + h * 64 + w * 8; kstride = 64 * 1024;
        ksrc1 = KPE + (size_t)(kbase0 + lane) * 32 + (w & 3) * 8; kstride1 = 64 * 32;
        vsrc = KVb + (size_t)(kbase0 + vrow) * 1024 + 512 + h * 64 + vcol; vstride = 64 * 1024; }
    else { ksrc0 = Pb + (size_t)((long)kbase0 + lane) * 1280 + 1024 + g * 64 + w * 8; kstride = 64 * 1280;
        vsrc = Pb + (size_t)((long)kbase0 + vrow) * 1280 + 1152 + g * 64 + vcol; vstride = 64 * 1280; }
    const bool two_k = (MODE == 0) && (w < 4);
    u32x4 ks0, ks1 = {0u, 0u, 0u, 0u}, vs;
#define ATT_LOAD(j) do { ks0 = *(const GAS u32x4*)(ksrc0 + (size_t)(j) * kstride); if (two_k) ks1 = *(const GAS u32x4*)(ksrc1 + (size_t)(j) * kstride1); vs = *(const GAS u32x4*)(vsrc + (size_t)(j) * vstride); } while (0)
#define ATT_WRITE(bufo) do { *(LAS u32x4*)(lds + (bufo) + w * 1024 + lane * 16) = ks0; if (two_k) *(LAS u32x4*)(lds + (bufo) + (8 + w) * 1024 + lane * 16) = ks1; \
        *(LAS u32x4*)(lds + (bufo) + KBYTES + w * 1024 + lane * 16) = vs; } while (0)
    float m_run, l_run; f32x16 o[2]; o[0] = f32x16{}; o[1] = f32x16{};
    float slope2 = 0.f;
    if (MODE == 1) { m_run = F.in[19][hq] * LOG2E; l_run = (hi == 0) ? 1.f : 0.f; slope2 = exp2f(-(float)(hq + 1)) * LOG2E; }
    else { m_run = -1e30f; l_run = 0.f; }
    ATT_LOAD(j_lo); ATT_WRITE(0); __syncthreads();
    const int voff = KBYTES + ((lane >> 4) & 1) * 32 + (lane & 3) * 8 + (4 * hi + ((lane & 15) >> 2)) * 64;
    for (int j = j_lo; j < j_hi; ++j) {
        const int bo = ((j - j_lo) & 1) * BUF;
        if (j + 1 < j_hi) ATT_LOAD(j + 1);
        f32x16 p0 = f32x16{}, p1 = f32x16{};
        const LAS unsigned char* kb = lds + bo + hi * 1024 + r32 * 16;
#pragma unroll
        for (int d0 = 0; d0 < ND0; ++d0) {
            const bf16x8 b0 = *(const LAS bf16x8*)(kb + d0 * 2048), b1 = *(const LAS bf16x8*)(kb + d0 * 2048 + 512);
            p0 = __builtin_amdgcn_mfma_f32_32x32x16_bf16(b0, qr[d0], p0, 0, 0, 0);
            p1 = __builtin_amdgcn_mfma_f32_32x32x16_bf16(b1, qr[d0], p1, 0, 0, 0);
        }
        if (MODE == 1) {
            const int qp = qpos0 + r32, kp = 128 * ((unit >> 1) & 15) - 128 + 64 * j;
#pragma unroll
            for (int r = 0; r < 16; ++r) { const int k0 = kp + crow(r, hi); int d0_ = qp - k0; d0_ = d0_ < 0 ? -d0_ : d0_; int d1_ = qp - (k0 + 32); d1_ = d1_ < 0 ? -d1_ : d1_;
                p0[r] = (d0_ <= 128) ? p0[r] - slope2 * (float)d0_ : -1e30f; p1[r] = (d1_ <= 128) ? p1[r] - slope2 * (float)d1_ : -1e30f; }
        }
        float pmax = p0[0];
#pragma unroll
        for (int r = 1; r < 16; ++r) pmax = fmaxf(pmax, p0[r]);
#pragma unroll
        for (int r = 0; r < 16; ++r) pmax = fmaxf(pmax, p1[r]);
        pmax = fmaxf(pmax, __shfl_xor(pmax, 32));
        if (!__all(pmax - m_run <= ATT_THR)) {
            const float mn = fmaxf(m_run, pmax), alpha = fast_exp2(m_run - mn); m_run = mn; l_run *= alpha;
            if (hi == 0) wsf[r32] = alpha;
            LDS_WAIT(); asm volatile("" ::: "memory");
#pragma unroll
            for (int r = 0; r < 16; ++r) { const float a = wsf[crow(r, hi)]; o[0][r] *= a; o[1][r] *= a; }
        }
        float ps = 0.f;
#pragma unroll
        for (int r = 0; r < 16; ++r) { p0[r] = fast_exp2(p0[r] - m_run); p1[r] = fast_exp2(p1[r] - m_run); ps += p0[r] + p1[r]; }
        l_run += ps;
        u32x4 pw[4];
        pw[0] = (u32x4){pk2(p0[0], p0[1]), pk2(p0[2], p0[3]), pk2(p0[4], p0[5]), pk2(p0[6], p0[7])};
        pw[1] = (u32x4){pk2(p0[8], p0[9]), pk2(p0[10], p0[11]), pk2(p0[12], p0[13]), pk2(p0[14], p0[15])};
        pw[2] = (u32x4){pk2(p1[0], p1[1]), pk2(p1[2], p1[3]), pk2(p1[4], p1[5]), pk2(p1[6], p1[7])};
        pw[3] = (u32x4){pk2(p1[8], p1[9]), pk2(p1[10], p1[11]), pk2(p1[12], p1[13]), pk2(p1[14], p1[15])};
        const LAS unsigned char* vp = lds + bo + voff;
#pragma unroll
        for (int d0 = 0; d0 < 2; ++d0)
#pragma unroll
            for (int ks = 0; ks < 4; ++ks) {
                const s16x4 vlo = vtr(vp + d0 * 4096 + ks * 1024), vhi = vtr(vp + d0 * 4096 + ks * 1024 + 512);
                const bf16x8 vf = (bf16x8){vlo[0], vlo[1], vlo[2], vlo[3], vhi[0], vhi[1], vhi[2], vhi[3]};
                o[d0] = __builtin_amdgcn_mfma_f32_32x32x16_bf16(__builtin_bit_cast(bf16x8, pw[ks]), vf, o[d0], 0, 0, 0);
            }
        if (j + 1 < j_hi) ATT_WRITE(BUF - bo);
        __syncthreads();
    }
#undef ATT_LOAD
#undef ATT_WRITE
    const float lt = l_run + __shfl_xor(l_run, 32);
    if (hi == 0) wsf[32 + r32] = lt;
    LDS_WAIT(); asm volatile("" ::: "memory");
#pragma unroll
    for (int r = 0; r < 16; ++r) { const int orow = crow(r, hi); const float rl = fast_rcp(wsf[32 + orow]);
        stg[orow * 64 + r32] = (bf16_t)f2bf(o[0][r] * rl); stg[orow * 64 + 32 + r32] = (bf16_t)f2bf(o[1][r] * rl); }
    LDS_WAIT(); asm volatile("" ::: "memory");
    bf16_t* Ow = Ob + (size_t)tq0 * 1024 + ocol;
#pragma unroll
    for (int i = 0; i < 4; ++i) { const int row = i * 8 + (lane >> 3), ch = lane & 7; const u32x4 v = *(const LAS u32x4*)(stg + row * 64 + ch * 8); *(GAS u32x4*)(Ow + (size_t)row * 1024 + ch * 8) = v; }
    __syncthreads();
}
__device__ __forceinline__ void phase_attn(const Frame& F) {
    for (int u = F.vcu; u < 1024; u += F.G) { if (u < 512) attn_unit<0>(F, u); else attn_unit<1>(F, u - 512); }
}
}
namespace mk {
constexpr int N_PHASES = 14;
__global__ void __launch_bounds__(NTHR, 2) fwd_mega(Args args) {
    extern __shared__ __attribute__((aligned(16))) unsigned char lds_raw[];
    Frame F;
    F.lds = (LAS unsigned char*)lds_raw;
    F.tid = threadIdx.x; F.lane = F.tid & 63; F.wave = __builtin_amdgcn_readfirstlane(F.tid >> 6);
    F.G = gridDim.x; { const int bx = blockIdx.x; F.vcu = (F.G % 8 == 0) ? (bx % 8) * (F.G / 8) + bx / 8 : bx; }
    F.in = args.in; F.out = args.out; F.ws = args.ws;
    volatile LAS unsigned* MISC = (volatile LAS unsigned*)(F.lds + MISC_OFF);
    if (F.tid < 64) MISC[F.tid] = 0u;
    __syncthreads();
    unsigned* ctl = (unsigned*)(F.ws + WS_CTL);
    const int lo = args.ph_lo, hi = args.ph_hi;
    XcdBarrier bar; bar.bar = ctl + CW_BAR; bar.x = 0; bar.st = nullptr;
    if (hi - lo > 1) bar = xcd_barrier_post(ctl + CW_BAR, MISC + 8);
#ifndef MK_PHASE_MASK
#define MK_PHASE_MASK 0x3fff
#endif
#define IN(k) (((MK_PHASE_MASK >> (k)) & 1) && lo <= (k) && (k) < hi)
#ifndef MK_DUP_MASK
#define MK_DUP_MASK 0
#endif
#define REP(k) for (int rep_ = 0; rep_ <= ((MK_DUP_MASK >> (k)) & 1); ++rep_)
#define FRESH() do { int t_ = threadIdx.x; asm volatile("" : "+v"(t_)); F.tid = t_; F.lane = t_ & 63; F.wave = __builtin_amdgcn_readfirstlane(t_ >> 6); } while (0)
#define SEAM(k) do { if (IN(k) && IN((k) + 1)) xcd_barrier(bar); } while (0)
    bf16_t* XB = (bf16_t*)(F.ws + WS_XB); bf16_t* MBp = (bf16_t*)(F.ws + WS_MB); bf16_t* Pp = (bf16_t*)(F.ws + WS_P);
    float* RS0 = (float*)(F.ws + WS_RS0);
    const f32x2* rope = (const f32x2*)(F.ws + WS_ROPE);
    const int bid = (int)blockIdx.x;

    if (IN(0)) REP(0) { FRESH(); phase_p0(F); } SEAM(0);
    if (IN(1)) REP(1) { FRESH(); pg8::Gemm g{XB, (const bf16_t*)(F.ws + WS_WINE), T, 2048, 1024, 1024, 1024}; pg8::StaticOrder So; So.init(T, 2048, F.G, bid);
        EpiE1 E{(bf16_t*)F.out, RS0}; pg8::gemm_phase<EpiE1, pg8::StaticOrder, true, true>(F.lds, g, So, E); } SEAM(1);
    if (IN(2)) REP(2) { FRESH(); phase_e2(F); } SEAM(2);
    if (IN(3)) REP(3) { FRESH(); pg8::Gemm g{MBp, (const bf16_t*)(F.ws + WS_WOUTE), T, 1024, 1024, 1024, 1024}; pg8::StaticOrder So; So.init(T, 1024, F.G, bid);
        EpiRes E{F.in[0], F.out, XB}; pg8::gemm_phase<EpiRes, pg8::StaticOrder, true, true>(F.lds, g, So, E); } SEAM(3);
    if (IN(4)) REP(4) { FRESH(); phase_router(F, 0); } SEAM(4);
    if (IN(5)) REP(5) { FRESH(); phase_moe(F, 0); } SEAM(5);
    if (IN(6)) REP(6) { FRESH(); combine_rows<false>(F);
 } SEAM(6);
    if (IN(7)) REP(7) { FRESH(); pg8::Gemm g{XB, (const bf16_t*)(F.ws + WS_WINO), T, 1280, 1024, 1024, 1024}; pg8::StaticOrder So; So.init(T, 1280, F.G, bid);
        EpiO1 E{Pp, RS0, (float*)(F.ws + WS_SSQQ), (float*)(F.ws + WS_SSQKV), (bf16_t*)(F.ws + WS_KPE), rope};
        pg8::gemm_phase<EpiO1, pg8::StaticOrder, true, true>(F.lds, g, So, E);
        if (rep_ == 0 && (F.G != 256 || bid >= 64)) { LAS float* scr = (LAS float*)(F.lds + F.wave * 16384); CvtRegs R;
            const int nw = (F.G == 256) ? 192 * NWAVES : F.G * NWAVES, gw = ((F.G == 256) ? (bid - 64) : bid) * NWAVES + F.wave;
            int it = gw; if (it < MOE_CVT_ITEMS) moe_cvt_load(F, 1, it, R);
            for (; it < MOE_CVT_ITEMS; it += nw) { moe_cvt_stage(F, 1, it, R, scr); if (it + nw < MOE_CVT_ITEMS) moe_cvt_load(F, 1, it + nw, R); moe_cvt_emit(F, it, scr); } } } SEAM(7);
    if (IN(8)) REP(8) { FRESH(); pg8::Gemm g{Pp, (const bf16_t*)(F.ws + WS_WUQ), T, 1792, 256, 1280, 256}; O2Order So; So.init(T, 1792, F.G, bid);
        EpiO2 E{(bf16_t*)(F.ws + WS_Q), (bf16_t*)(F.ws + WS_KV), (const float*)(F.ws + WS_SSQQ), (const float*)(F.ws + WS_SSQKV)};
        pg8::gemm_phase<EpiO2, O2Order, true, true>(F.lds, g, So, E);
    } SEAM(8);
    if (IN(9)) REP(9) { FRESH(); phase_attn(F); } SEAM(9);
    if (IN(10)) REP(10) { FRESH(); pg8::Gemm g{MBp, (const bf16_t*)(F.ws + WS_WOUTO), T, 1024, 1024, 1024, 1024}; pg8::StaticOrder So; So.init(T, 1024, F.G, bid);
        EpiRes E{F.out, F.out, XB}; pg8::gemm_phase<EpiRes, pg8::StaticOrder, true, true>(F.lds, g, So, E); } SEAM(10);
    if (IN(11)) REP(11) { FRESH(); phase_router(F, 1); } SEAM(11);
    if (IN(12)) REP(12) { FRESH(); phase_moe(F, 1); } SEAM(12);
    if (IN(13)) REP(13) { FRESH(); combine_rows<true>(F); }
#undef IN
#undef SEAM
}

static int g_grid = 0;
static bool setup() {
    if (g_grid) return g_grid > 0;
    int dev = 0, cus = 0;
    if (hipGetDevice(&dev) != hipSuccess || hipDeviceGetAttribute(&cus, hipDeviceAttributeMultiprocessorCount, dev) != hipSuccess) { g_grid = -1; return false; }
    if (hipFuncSetAttribute((const void*)fwd_mega, hipFuncAttributeMaxDynamicSharedMemorySize, LDS_BYTES) != hipSuccess) { fprintf(stderr, "hipFuncSetAttribute failed\n"); g_grid = -1; return false; }
    int per_cu = 0;
    if (hipOccupancyMaxActiveBlocksPerMultiprocessor(&per_cu, (const void*)fwd_mega, NTHR, LDS_BYTES) != hipSuccess || per_cu < 1) { fprintf(stderr, "occupancy query: %d\n", per_cu); }
    (void)hipGetLastError();
    g_grid = cus;
    return true;
}
static void launch_range(void* const* d_in, float* out, unsigned char* ws, int lo, int hi, hipStream_t st) {
    Args a{};
    for (int i = 0; i < 28; ++i) a.in[i] = (const float*)d_in[i];
    a.out = out; a.ws = ws; a.ph_lo = lo; a.ph_hi = hi;
    hipLaunchKernelGGL(fwd_mega, dim3(g_grid), dim3(NTHR), LDS_BYTES, st, a);
}
}
extern "C" void kernel_launch(void* const* d_in, const int* in_sizes, int n_in, void* d_out, int out_size, void* d_ws, size_t ws_size, hipStream_t stream) {
    if (n_in != 28 || out_size != mk::T * mk::D || ws_size < mk::WS_END) { fprintf(stderr, "kernel_launch: unexpected shapes n_in %d out %d ws %zu\n", n_in, out_size, ws_size); return; }
    if (!mk::setup()) return;
    if (hipMemsetAsync((unsigned char*)d_ws + mk::WS_CTL, 0, mk::CTL_ZERO_BYTES, stream) != hipSuccess) { fprintf(stderr, "kernel_launch: memset failed\n"); return; }
    mk::launch_range(d_in, (float*)d_out, (unsigned char*)d_ws, 0, mk::N_PHASES, stream);
}
```

```cpp
#define MK_PF1 2
#define MK_PF2 2
#include <hip/hip_runtime.h>
#include <hip/hip_bf16.h>
#include <cstdio>
#include <cstdint>
namespace pg8 {
#define PG8_LAS __attribute__((address_space(3)))
typedef unsigned short bf16_t;
typedef short bf16x8 __attribute__((ext_vector_type(8)));
typedef float f32x4 __attribute__((ext_vector_type(4)));
typedef unsigned u32x4 __attribute__((ext_vector_type(4)));
constexpr int BM = 256, BK = 64, HALF = 128, HTB = HALF * BK * 2  , STAGE_BYTES = 8 * HTB, NXCD = 8, WGM = 8;

__host__ __device__ __forceinline__ int lds_byte(int r, int c) { const int st = (r >> 4) * 2 + (c >> 5), rr = r & 15, cc = c & 31, ob = rr * 64 + cc * 2; return st * 1024 + (ob ^ (((ob >> 9) & 1) << 5)); }
__host__ __device__ __forceinline__ void stage_rc(int b, int& R, int& C) { const int st = b / 1024, sb = b % 1024, swz = sb ^ (((sb >> 9) & 1) << 5); R = (st >> 1) * 16 + swz / 64; C = (st & 1) * 32 + (swz % 64) / 2; }
__host__ __device__ __forceinline__ int perm32(int rho) { const int n = rho >> 4, i = rho & 15; return 8 * (i >> 2) + 4 * n + (i & 3); }

struct Unit { int pm, pn, aoff; };
struct Gemm { const bf16_t* A; const bf16_t* Bt; int M, N, K, lda, ldb; };

struct StaticOrder {
    int nM, nN, nwg, G, c;
    __host__ __device__ void init(int M, int N, int G_, int c_) { nM = M / BM; nN = N / BM; nwg = nM * nN; G = G_; c = c_; }
    __host__ __device__ bool next(int i, Unit& u) const {
        const long L = (long)i * G + c; if (L >= nwg) return false;
        int wgid = (int)L; { const int q = nwg / NXCD, r = nwg % NXCD, xcd = wgid % NXCD, off = wgid / NXCD; wgid = (xcd < r ? xcd * (q + 1) : r * (q + 1) + (xcd - r) * q) + off; }
        const int nig = WGM * nN, gid = wgid / nig, fm = gid * WGM, gsz = (nM - fm) < WGM ? (nM - fm) : WGM;
        u.pm = fm + ((wgid % nig) % gsz); u.pn = (wgid % nig) / gsz; u.aoff = 0; return true;
    }
    __device__ __forceinline__ void a_ready(const Unit&) const {}
    __device__ __forceinline__ void done(const Unit&) const {}
};

__device__ __forceinline__ unsigned cvt_pk_bf16(float lo, float hi) { unsigned r; asm volatile("v_cvt_pk_bf16_f32 %0, %1, %2" : "=v"(r) : "v"(lo), "v"(hi)); return r; }
typedef float f32x2 __attribute__((ext_vector_type(2)));
template <class Epi, class Sched, bool ALIGN_EPI = false, bool SP2 = false>
__device__ __forceinline__ void gemm_phase(PG8_LAS unsigned char* lds, const Gemm g, const Sched& S, const Epi& E) {
    int tid_ = threadIdx.x; asm volatile("" : "+v"(tid_));
    const int tid = tid_, wid = __builtin_amdgcn_readfirstlane(tid >> 6), lane = tid & 63, wr = wid >> 2, wc = wid & 3, fr = lane & 15, fq = lane >> 4;
    const int K = g.K, nt = K / BK;
    unsigned voffA[2], voffB[2];
#pragma unroll
    for (int i = 0; i < 2; ++i) { int R, C; stage_rc(tid * 16 + i * 8192, R, C); const int Rb = Epi::PERM ? ((R & ~31) + perm32(R & 31)) : R;
        voffA[i] = (unsigned)(R * g.lda + C) * 2u; voffB[i] = (unsigned)(Rb * g.ldb + C) * 2u; }
    const size_t kstep = (size_t)(BK * 2);
    const size_t hstepA = (size_t)HALF * g.lda * 2, hstepB = (size_t)HALF * g.ldb * 2;
    const size_t tstepA = 2 * hstepA, tstepB = 2 * hstepB;
    const unsigned ldsw = (unsigned)wid * 1024u;
    const int aoff = lds_byte(wr * 64 + fr, fq * 8), boff = lds_byte(wc * 32 + fr, fq * 8);
#define PG8_SA(b, h) (((b) * 2 + (h)) * HTB)
#define PG8_SB(b, h) ((4 + (b) * 2 + (h)) * HTB)
#define PG8_STAGE(bufoff, gbase, voff) do { _Pragma("unroll") for (int _i = 0; _i < 2; ++_i) \
        __builtin_amdgcn_global_load_lds((const unsigned*)((const char*)(gbase) + (voff)[_i]), (PG8_LAS unsigned*)(lds + (bufoff) + ldsw + _i * 8192), 16, 0, 0); } while (0)
#define PG8_LDA(dst, b, h) do { _Pragma("unroll") for (int m = 0; m < 4; ++m) _Pragma("unroll") for (int k = 0; k < 2; ++k) dst[m][k] = *(const PG8_LAS bf16x8*)(lds + PG8_SA(b, h) + aoff + m * 2048 + k * 1024); } while (0)
#define PG8_LDB(dst, b, h) do { _Pragma("unroll") for (int n = 0; n < 2; ++n) _Pragma("unroll") for (int k = 0; k < 2; ++k) dst[n][k] = *(const PG8_LAS bf16x8*)(lds + PG8_SB(b, h) + boff + n * 2048 + k * 1024); } while (0)
#define PG8_MMA(ai, bj, At, Bt) do { __builtin_amdgcn_s_setprio(1); _Pragma("unroll") for (int m = 0; m < 4; ++m) _Pragma("unroll") for (int n = 0; n < 2; ++n) _Pragma("unroll") for (int k = 0; k < 2; ++k) \
        acc[ai][bj][m][n] = __builtin_amdgcn_mfma_f32_16x16x32_bf16(Bt[n][k], At[m][k], acc[ai][bj][m][n], 0, 0, 0); __builtin_amdgcn_s_setprio(0); } while (0)
#define PG8_WAIT_V(n) asm volatile("s_waitcnt vmcnt(" #n ")" ::: "memory")
#define PG8_WAIT_L(n) asm volatile("s_waitcnt lgkmcnt(" #n ")" ::: "memory")
#define PG8_BAR __builtin_amdgcn_s_barrier()
#define PG8_SCHED __builtin_amdgcn_sched_barrier(0)
    Unit cur, nxt; int ui = 0;
    if (!S.next(0, cur)) return;
    f32x4 acc[2][2][4][2];
#pragma unroll
    for (int a = 0; a < 2; ++a)
#pragma unroll
        for (int b = 0; b < 2; ++b)
#pragma unroll
            for (int m = 0; m < 4; ++m)
#pragma unroll
                for (int n = 0; n < 2; ++n) acc[a][b][m][n] = (f32x4){0.f, 0.f, 0.f, 0.f};
    bf16x8 At[4][2], B0[2][2], B1[2][2];
    const char* cA = (const char*)g.A + (size_t)cur.pm * tstepA + cur.aoff; const char* cB = (const char*)g.Bt + (size_t)cur.pn * tstepB;
    S.a_ready(cur);
    if constexpr (SP2) {
        PG8_STAGE(PG8_SB(0, 0), cB, voffB); PG8_STAGE(PG8_SB(0, 1), cB + hstepB, voffB); PG8_STAGE(PG8_SA(0, 0), cA, voffA); PG8_STAGE(PG8_SA(0, 1), cA + hstepA, voffA);
        if (wr == 1) PG8_BAR;
        PG8_WAIT_V(2); PG8_BAR;
        PG8_STAGE(PG8_SB(1, 0), cB + kstep, voffB); PG8_STAGE(PG8_SA(1, 0), cA + kstep, voffA); PG8_STAGE(PG8_SB(1, 1), cB + hstepB + kstep, voffB);
        PG8_WAIT_V(6); PG8_BAR;
    } else {
        PG8_STAGE(PG8_SB(0, 0), cB, voffB); PG8_STAGE(PG8_SA(0, 0), cA, voffA); PG8_STAGE(PG8_SB(0, 1), cB + hstepB, voffB); PG8_STAGE(PG8_SA(0, 1), cA + hstepA, voffA);
        if (wr == 1) PG8_BAR;
        PG8_WAIT_V(4); PG8_BAR;
        PG8_STAGE(PG8_SB(1, 0), cB + kstep, voffB); PG8_STAGE(PG8_SA(1, 0), cA + kstep, voffA); PG8_STAGE(PG8_SB(1, 1), cB + hstepB + kstep, voffB);
        PG8_WAIT_V(6); PG8_BAR;
    }
    for (;;) {
        const bool has_next = S.next(ui + 1, nxt);
        const char* nA = has_next ? (const char*)g.A + (size_t)nxt.pm * tstepA + nxt.aoff : cA; const char* nB = has_next ? (const char*)g.Bt + (size_t)nxt.pn * tstepB : cB;
        for (int t = 0; t < nt; t += 2) {
            const bool last = (t == nt - 2);
            const char* a1 = cA + (size_t)(t + 1) * kstep;
            const char* a2 = last ? nA : cA + (size_t)(t + 2) * kstep; const char* b2 = last ? nB : cB + (size_t)(t + 2) * kstep;
            const char* a3 = a2 + kstep; const char* b3 = b2 + kstep;
            if (last && has_next) S.a_ready(nxt);
            if constexpr (SP2) {
            PG8_LDB(B0, 0, 0); PG8_LDB(B1, 0, 1); PG8_SCHED; PG8_LDA(At, 0, 0); PG8_STAGE(PG8_SA(1, 1), a1 + hstepA, voffA);
            PG8_WAIT_V(8); PG8_WAIT_L(0); PG8_BAR; PG8_MMA(0, 0, At, B0); PG8_MMA(0, 1, At, B1); PG8_BAR; PG8_SCHED;
            PG8_LDA(At, 0, 1); PG8_STAGE(PG8_SB(0, 0), b2, voffB); PG8_STAGE(PG8_SB(0, 1), b2 + hstepB, voffB); PG8_STAGE(PG8_SA(0, 0), a2, voffA);
            PG8_WAIT_V(8); PG8_WAIT_L(0); PG8_BAR; PG8_MMA(1, 0, At, B0); PG8_MMA(1, 1, At, B1); PG8_BAR; PG8_SCHED;
            PG8_LDB(B0, 1, 0); PG8_LDB(B1, 1, 1); PG8_SCHED; PG8_LDA(At, 1, 0); PG8_STAGE(PG8_SA(0, 1), a2 + hstepA, voffA);
            PG8_WAIT_V(8); PG8_WAIT_L(0); PG8_BAR; PG8_MMA(0, 0, At, B0); PG8_MMA(0, 1, At, B1); PG8_BAR; PG8_SCHED;
            PG8_LDA(At, 1, 1); PG8_STAGE(PG8_SB(1, 0), b3, voffB); PG8_STAGE(PG8_SB(1, 1), b3 + hstepB, voffB); PG8_STAGE(PG8_SA(1, 0), a3, voffA);
            PG8_WAIT_V(8); PG8_WAIT_L(0); PG8_BAR; PG8_MMA(1, 0, At, B0); PG8_MMA(1, 1, At, B1); PG8_BAR; PG8_SCHED;
            } else {
            PG8_LDB(B0, 0, 0); PG8_SCHED; PG8_LDA(At, 0, 0); PG8_STAGE(PG8_SA(1, 1), a1 + hstepA, voffA);
            PG8_WAIT_L(8); PG8_BAR; PG8_WAIT_L(0); PG8_MMA(0, 0, At, B0); PG8_BAR; PG8_SCHED;
            PG8_LDB(B1, 0, 1); PG8_STAGE(PG8_SB(0, 0), b2, voffB);
            PG8_BAR; PG8_WAIT_L(0); PG8_MMA(0, 1, At, B1); PG8_BAR;
            PG8_LDA(At, 0, 1); PG8_STAGE(PG8_SA(0, 0), a2, voffA);
            PG8_BAR; PG8_WAIT_L(0); PG8_MMA(1, 0, At, B0); PG8_BAR; PG8_SCHED;
            PG8_STAGE(PG8_SB(0, 1), b2 + hstepB, voffB);
            PG8_WAIT_V(6); PG8_BAR; PG8_MMA(1, 1, At, B1); PG8_BAR;
            PG8_LDB(B0, 1, 0); PG8_SCHED; PG8_LDA(At, 1, 0); PG8_STAGE(PG8_SA(0, 1), a2 + hstepA, voffA);
            PG8_WAIT_L(8); PG8_BAR; PG8_WAIT_L(0); PG8_MMA(0, 0, At, B0); PG8_BAR; PG8_SCHED;
            PG8_LDB(B1, 1, 1); PG8_STAGE(PG8_SB(1, 0), b3, voffB);
            PG8_BAR; PG8_WAIT_L(0); PG8_MMA(0, 1, At, B1); PG8_BAR;
            PG8_LDA(At, 1, 1); PG8_STAGE(PG8_SA(1, 0), a3, voffA);
            PG8_BAR; PG8_WAIT_L(0); PG8_MMA(1, 0, At, B0); PG8_BAR; PG8_SCHED;
            PG8_STAGE(PG8_SB(1, 1), b3 + hstepB, voffB);
            PG8_WAIT_V(6); PG8_BAR; PG8_MMA(1, 1, At, B1); PG8_BAR;
            }
        }
        if constexpr (ALIGN_EPI) { if (wr == 0) PG8_BAR; }
        if constexpr (!Epi::AFTER_DRAIN) { E(acc, cur, wr, wc, fr, fq); S.done(cur); }
        if (!has_next) break;
#pragma unroll
        for (int a = 0; a < 2; ++a)
#pragma unroll
            for (int b = 0; b < 2; ++b)
#pragma unroll
                for (int m = 0; m < 4; ++m)
#pragma unroll
                    for (int n = 0; n < 2; ++n) acc[a][b][m][n] = (f32x4){0.f, 0.f, 0.f, 0.f};
        cur = nxt; cA = nA; cB = nB; ++ui;
        if constexpr (ALIGN_EPI) { if (wr == 1) PG8_BAR; }
    }
    PG8_WAIT_V(0);
    if constexpr (!ALIGN_EPI) { if (wr == 0) PG8_BAR; }
    PG8_BAR;
    if constexpr (Epi::AFTER_DRAIN) { E.fused(acc, cur, wr, wc, fr, fq, lds, wid, lane); S.done(cur); }
#undef PG8_SA
#undef PG8_SB
#undef PG8_STAGE
#undef PG8_LDA
#undef PG8_LDB
#undef PG8_MMA
#undef PG8_WAIT_V
#undef PG8_WAIT_L
#undef PG8_BAR
#undef PG8_SCHED
}
}
namespace mk {
using pg8::bf16_t; using pg8::bf16x8; using pg8::f32x4; using pg8::u32x4; using pg8::f32x2;
typedef float f32x16 __attribute__((ext_vector_type(16)));
typedef unsigned u32x2 __attribute__((ext_vector_type(2)));
typedef short s16x4 __attribute__((ext_vector_type(4)));
#define GAS __attribute__((address_space(1)))
#define LAS __attribute__((address_space(3)))
typedef GAS unsigned gu32;
#define RLX_AGENT __ATOMIC_RELAXED, __HIP_MEMORY_SCOPE_AGENT
#define LDS_WAIT() asm volatile("s_waitcnt lgkmcnt(0)" ::: "memory")
#define VM_WAIT() asm volatile("s_waitcnt vmcnt(0)" ::: "memory")

constexpr int T = 16384, D = 1024, S = 2048, NB = 8;
constexpr int NWAVES = 8, NTHR = 512;
constexpr float EPS = 1e-6f;
constexpr float LOG2E = 1.4426950408889634f;
constexpr float C2M = 0.10206207261596575f * LOG2E;
constexpr float C2S = 0.125f * LOG2E;

constexpr size_t MiB = (size_t)1 << 20;
constexpr size_t WS_CTL = 0, CTL_ZERO_BYTES = 1 * MiB;
constexpr size_t WS_WINE = 1 * MiB;
constexpr size_t WS_WOUTE = 5 * MiB;
constexpr size_t WS_WINO = 7 * MiB;
constexpr size_t WS_WUQ = 10 * MiB;
constexpr size_t WS_WUKV = 10 * MiB + 393216;
constexpr size_t WS_WOUTO = 11 * MiB;
constexpr size_t WS_ROUTER = 13 * MiB;
constexpr size_t WS_ROPE = 14 * MiB;
constexpr size_t WS_RS0 = 14 * MiB + 512 * 1024;
constexpr size_t WS_RSM = WS_RS0 + 64 * 1024;
constexpr size_t WS_SSQQ = 15 * MiB;
constexpr size_t WS_SSQKV = 15 * MiB + 256 * 1024;
constexpr size_t WS_WMOE = 16 * MiB;
constexpr size_t WS_XB = 64 * MiB;
constexpr size_t WS_MB = 96 * MiB;
constexpr size_t WS_Y = 128 * MiB;
constexpr size_t WS_Q = 128 * MiB;
constexpr size_t WS_KV = 152 * MiB;
constexpr size_t WS_P = 192 * MiB;
constexpr size_t WS_LSLOT = 232 * MiB;
constexpr size_t WS_LGW = 234 * MiB;
constexpr size_t WS_KPE = 236 * MiB;
constexpr size_t WS_END = 240 * MiB;
constexpr size_t W1_EXP = 524288, W2_EXP = 262144;

constexpr int CW_TMO = 0;
constexpr int CW_BAR = 4096;
constexpr int CW_CVT = 8192;
constexpr int CW_ECNT = 16384;

constexpr int LDS_BYTES = 160 * 1024;
constexpr int RING_BYTES = 131072;
constexpr int MISC_OFF = 159 * 1024;

__device__ __forceinline__ unsigned f2bf(float f) { unsigned u = __builtin_bit_cast(unsigned, f); return (u + 0x7fffu + ((u >> 16) & 1u)) >> 16; }
__device__ __forceinline__ float bf2f(unsigned h) { return __builtin_bit_cast(float, h << 16); }
__device__ __forceinline__ unsigned pk2(float lo, float hi) { return pg8::cvt_pk_bf16(lo, hi); }
__device__ __forceinline__ float wave_sum(float v) {
#pragma unroll
    for (int o = 1; o < 64; o <<= 1) v += __shfl_xor(v, o);
    return v;
}
__device__ __forceinline__ float fast_exp2(float x) { return __builtin_amdgcn_exp2f(x); }
__device__ __forceinline__ float fast_rcp(float x) { return __builtin_amdgcn_rcpf(x); }
__device__ __forceinline__ float sigmoid_f(float x) { return fast_rcp(1.f + fast_exp2(-x * LOG2E)); }
__device__ __forceinline__ float silu_f(float x) { return x * sigmoid_f(x); }
__device__ __forceinline__ float gelu_f(float x) { const float u = 0.7978845608028654f * (x + 0.044715f * x * x * x); return x * sigmoid_f(2.f * u); }

#define XB_TMO      128
#define XB_XCNT(j)  (256  + 64 * (j))
#define XB_XSUB(j)  (1280 + 64 * (j))
#define XB_XGEN(j)  (2304 + 64 * (j))
#define XB_TOP      3328
#define XB_TOPGEN   3392
#define XCD_BAR_WORDS 3456
#define XB_SPIN_CAP (1u << 18)
__device__ __forceinline__ unsigned xb_ld(unsigned* p)              { return __hip_atomic_load(p, __ATOMIC_RELAXED, __HIP_MEMORY_SCOPE_AGENT); }
__device__ __forceinline__ unsigned xb_add(unsigned* p, unsigned v) { return __hip_atomic_fetch_add(p, v, __ATOMIC_RELAXED, __HIP_MEMORY_SCOPE_AGENT); }
__device__ __forceinline__ unsigned xb_xcc_id() { return (unsigned)__builtin_amdgcn_s_getreg((3 << 11) | 20) & 0xFu; }
#define XB_SPIN(cond, bar) do { unsigned _sp = 0; while (cond) { __builtin_amdgcn_s_sleep(1); \
    if ((++_sp & 255u) == 0u) { if (xb_ld(&(bar)[XB_TMO])) break; if (_sp > XB_SPIN_CAP) { atomicAdd(&(bar)[XB_TMO], 1u); break; } } } } while (0)
struct XcdBarrier { unsigned* bar; unsigned x; volatile LAS unsigned* st; };
__device__ __forceinline__ XcdBarrier xcd_barrier_post(unsigned* bar, volatile LAS unsigned* st) {
    XcdBarrier b; b.bar = bar; b.x = xb_xcc_id(); b.st = st;
    if (threadIdx.x == 0) (void)xb_add(&bar[XB_XCNT(b.x)], 1u);
    return b;
}
__device__ __forceinline__ void xcd_barrier_complete(unsigned* bar, unsigned x, unsigned& nloc, unsigned& nx) {
    const unsigned G = gridDim.x * gridDim.y * gridDim.z;
    unsigned sum, cnt, mine, sp = 0u;
    for (;;) {
        sum = 0u; cnt = 0u; mine = 0u;
#pragma unroll
        for (unsigned j = 0; j < 16; ++j) { const unsigned c = xb_ld(&bar[XB_XCNT(j)]); sum += c; cnt += (c > 0u) ? 1u : 0u; mine = (j == x) ? c : mine; }
        if (sum == G) break;
        __builtin_amdgcn_s_sleep(1);
        if ((++sp & 255u) == 0u) { if (xb_ld(&bar[XB_TMO])) break; if (sp > XB_SPIN_CAP) { atomicAdd(&bar[XB_TMO], 1u); break; } }
    }
    nloc = mine > 0u ? mine : 1u; nx = cnt > 0u ? cnt : 1u;
}
__device__ __forceinline__ void xcd_barrier(const XcdBarrier& b) {
    asm volatile("s_waitcnt vmcnt(0)" ::: "memory");
    __syncthreads();
    if (threadIdx.x == 0) {
        unsigned* bar = b.bar;
        __builtin_amdgcn_s_waitcnt(0);
        unsigned nloc = b.st[0], nx = b.st[1];
        if (nloc == 0u) { xcd_barrier_complete(bar, b.x, nloc, nx); b.st[0] = nloc; b.st[1] = nx; }
        const unsigned old = xb_add(&bar[XB_XSUB(b.x)], 1u);
        const unsigned gen = old / nloc;
        if (old + 1u == (gen + 1u) * nloc) {
            __builtin_amdgcn_fence(__ATOMIC_RELEASE, "agent");
            asm volatile("s_waitcnt vmcnt(0)" ::: "memory");
            const unsigned og = xb_add(&bar[XB_TOP], 1u);
            const unsigned tg = og / nx;
            if (og + 1u == (tg + 1u) * nx) xb_add(&bar[XB_TOPGEN], 1u);
            else XB_SPIN(xb_ld(&bar[XB_TOPGEN]) == tg, bar);
            __builtin_amdgcn_fence(__ATOMIC_ACQUIRE, "agent");
            xb_add(&bar[XB_XGEN(b.x)], 1u);
            asm volatile("s_waitcnt vmcnt(0)" ::: "memory");
        } else {
            XB_SPIN(xb_ld(&bar[XB_XGEN(b.x)]) == gen, bar);
            __builtin_amdgcn_fence(__ATOMIC_ACQUIRE, "agent");
            asm volatile("s_waitcnt vmcnt(0)" ::: "memory");
        }
    }
    __syncthreads();
}

struct Args { const float* in[28]; float* out; unsigned char* ws; int ph_lo, ph_hi; };

struct Frame {
    LAS unsigned char* lds;
    int tid, lane, wave, vcu, G;
    const float* const* in;
    float* out; unsigned char* ws;
};
}
namespace mk {
__device__ __forceinline__ void p0_transpose_item(const float* W, int ldn, int k0, int src_n0, bf16_t* WT, int ldk, int dst_n0,
                                                  const float* gain, float scale, LAS float* scr, int lane) {
    if (src_n0 >= 0) {
#pragma unroll 8
        for (int i = 0; i < 32; ++i) { const int kk = 2 * i + (lane >> 5);
            float v = W[(size_t)(k0 + kk) * ldn + src_n0 + (lane & 31)] * scale; if (gain) v *= gain[k0 + kk];
            scr[kk * 33 + (lane & 31)] = v; }
    } else {
#pragma unroll 8
        for (int i = 0; i < 32; ++i) { const int kk = 2 * i + (lane >> 5); scr[kk * 33 + (lane & 31)] = 0.f; }
    }
    LDS_WAIT(); asm volatile("" ::: "memory");
    const int c = lane & 7;
#pragma unroll
    for (int j = 0; j < 4; ++j) { const int n = (lane >> 3) + 8 * j; const LAS float* s = scr + (8 * c) * 33 + n;
        u32x4 o; o.x = pk2(s[0 * 33], s[1 * 33]); o.y = pk2(s[2 * 33], s[3 * 33]); o.z = pk2(s[4 * 33], s[5 * 33]); o.w = pk2(s[6 * 33], s[7 * 33]);
        *(GAS u32x4*)(WT + (size_t)(dst_n0 + n) * ldk + k0 + 8 * c) = o; }
    LDS_WAIT(); asm volatile("" ::: "memory");
}
template <bool STAGE2>
__device__ __forceinline__ void moe_cvt_tile(const float* src, int ld, const float* gain16, bf16_t* dst0, size_t piece_stride  , LAS float* scr, int lane) {
#pragma unroll 4
    for (int i = 0; i < 16; ++i) { f32x4 v = *(const GAS f32x4*)(src + (size_t)i * ld + 4 * lane); if (gain16) v = v * gain16[i]; *(LAS f32x4*)(scr + i * 256 + 4 * lane) = v; }
    LDS_WAIT(); asm volatile("" ::: "memory");
    const int r = lane & 31, h = lane >> 5;
#pragma unroll
    for (int c = 0; c < 8; ++c) {
        float v[8];
#pragma unroll
        for (int j = 0; j < 8; ++j) { const int row = STAGE2 ? (8 * (j >> 2) + 4 * h + (j & 3)) : (8 * h + j); v[j] = scr[row * 256 + 32 * c + r]; }
        u32x4 o; o.x = pk2(v[0], v[1]); o.y = pk2(v[2], v[3]); o.z = pk2(v[4], v[5]); o.w = pk2(v[6], v[7]);
        *(GAS u32x4*)(dst0 + (size_t)c * piece_stride + (size_t)lane * 8) = o;
    }
    LDS_WAIT(); asm volatile("" ::: "memory");
}
constexpr int MOE_CVT_ITEMS = 6144;
struct CvtRegs { f32x4 v[16]; };
__device__ __forceinline__ void moe_cvt_load(const Frame& F, int layer, int it, CvtRegs& R) {
    const float* src; int ld;
    if (it < 4096) { const int gu = it >> 11, r = it & 2047, e = r >> 6, ks = r & 63; src = (gu ? F.in[26] : F.in[25]) + ((size_t)(layer * 32 + e) * 1024 + 16 * ks) * 256; ld = 256; }
    else { const int r = it - 4096, e = r >> 6, kk = (r >> 2) & 15, dq = r & 3; src = F.in[27] + ((size_t)(layer * 32 + e) * 256 + 16 * kk) * 1024 + 256 * dq; ld = 1024; }
#pragma unroll
    for (int i = 0; i < 16; ++i) R.v[i] = *(const GAS f32x4*)(src + (size_t)i * ld + 4 * F.lane);
}
__device__ __forceinline__ void moe_cvt_stage(const Frame& F, int layer, int it, const CvtRegs& R, LAS float* scr) {
    if (it < 4096) { const int ks = it & 63; const float* gain = F.in[2] + layer * 1024 + 16 * ks;
#pragma unroll
        for (int i = 0; i < 16; ++i) *(LAS f32x4*)(scr + i * 256 + 4 * F.lane) = R.v[i] * gain[i];
    } else {
#pragma unroll
        for (int i = 0; i < 16; ++i) *(LAS f32x4*)(scr + i * 256 + 4 * F.lane) = R.v[i];
    }
    LDS_WAIT(); asm volatile("" ::: "memory");
}
__device__ __forceinline__ void moe_cvt_emit(const Frame& F, int it, LAS float* scr) {
    bf16_t* W1 = (bf16_t*)(F.ws + WS_WMOE); bf16_t* W2 = W1 + 32 * W1_EXP;
    const int rr = F.lane & 31, h = F.lane >> 5;
    const bool s2 = it >= 4096;
    bf16_t* base; size_t st_c2, st_dt;
    if (!s2) { const int gu = it >> 11, r = it & 2047, e = r >> 6, ks = r & 63; base = W1 + (size_t)e * W1_EXP + ((size_t)ks * 2 + gu) * 512; st_c2 = 2 * 65536; st_dt = 65536; }
    else { const int r = it - 4096, e = r >> 6, kk = (r >> 2) & 15, dq = r & 3; const int p = dq >> 1, w0 = (dq & 1) * 4;
        base = W2 + (size_t)e * W2_EXP + ((size_t)(p * 8 + w0) * 16 + kk) * 1024; st_c2 = 16 * 1024; st_dt = 512; }
#pragma unroll
    for (int c = 0; c < 8; ++c) {
        float v[8];
#pragma unroll
        for (int j = 0; j < 8; ++j) { const int row = s2 ? (8 * (j >> 2) + 4 * h + (j & 3)) : (8 * h + j); v[j] = scr[row * 256 + 32 * c + rr]; }
        u32x4 o; o.x = pk2(v[0], v[1]); o.y = pk2(v[2], v[3]); o.z = pk2(v[4], v[5]); o.w = pk2(v[6], v[7]);
        *(GAS u32x4*)(base + (size_t)(c >> 1) * st_c2 + (size_t)(c & 1) * st_dt + (size_t)F.lane * 8) = o;
    }
    LDS_WAIT(); asm volatile("" ::: "memory");
}
__device__ __forceinline__ void row_to_bf16_rs(const float* xrow, bf16_t* orow, float* rs, int lane) {
    const GAS f32x4* xr = (const GAS f32x4*)xrow + lane;
    f32x4 v[4]; float s = 0.f;
#pragma unroll
    for (int j = 0; j < 4; ++j) { v[j] = xr[64 * j]; s += (v[j].x * v[j].x + v[j].y * v[j].y) + (v[j].z * v[j].z + v[j].w * v[j].w); }
    s = wave_sum(s);
    GAS u32x2* o8 = (GAS u32x2*)orow + lane;
#pragma unroll
    for (int j = 0; j < 4; ++j) { u32x2 w; w.x = pk2(v[j].x, v[j].y); w.y = pk2(v[j].z, v[j].w); o8[64 * j] = w; }
    if (lane == 0) *rs = 1.0f / sqrtf(s * (1.f / 1024.f) + EPS);
}

struct DenseDesc { int src_idx, K, ldn, nblk, ldk; size_t dst; int kind; };
__device__ __forceinline__ void p0_dense_item(const Frame& F, int it, LAS float* scr) {
    int r = it;
    if (r < 1024) { const int kb = r >> 6, nb = r & 63; const int n = 32 * nb; int src;
        if (n < 1024) { const int j = n >> 8, c = n & 255; src = (c < 128) ? (128 * j + c) : (512 + 128 * j + (c - 128)); } else src = n;
        p0_transpose_item(F.in[4], 2048, 64 * kb, src, (bf16_t*)(F.ws + WS_WINE), 1024, n, F.in[1], 1.f, scr, F.lane); return; } r -= 1024;
    if (r < 512) { const int kb = r >> 5, nb = r & 31;
        p0_transpose_item(F.in[13], 1024, 64 * kb, 32 * nb, (bf16_t*)(F.ws + WS_WOUTE), 1024, 32 * nb, nullptr, 1.f, scr, F.lane); return; } r -= 512;
    if (r < 640) { const int kb = r / 40, nb = r % 40; const int n = 32 * nb; int src; float sc = 1.f;
        if (n < 416) src = n; else if (n < 512) src = -1; else if (n < 1024) { src = 416 + (n - 512); sc = C2S; } else if (n < 1152) src = 928 + (n - 1024); else src = 1056 + (n - 1152);
        p0_transpose_item(F.in[14], 1184, 64 * kb, src, (bf16_t*)(F.ws + WS_WINO), 1024, n, F.in[1] + 1024, sc, scr, F.lane); return; } r -= 640;
    if (r < 96) { const int kb = r / 24, nb = r % 24; const int n = 32 * nb; int src;
        if (n < 512) src = 96 * (n >> 6) + (n & 63); else src = 96 * ((n - 512) >> 5) + 64;
        p0_transpose_item(F.in[16], 768, 64 * kb, src, (bf16_t*)(F.ws + WS_WUQ), 256, n, F.in[15], C2M, scr, F.lane); return; } r -= 96;
    if (r < 128) { const int kb = r >> 5, nb = r & 31; const int n = 32 * nb; int src;
        if (n < 512) src = 128 * (n >> 6) + (n & 63); else src = 128 * ((n - 512) >> 6) + 64 + ((n - 512) & 63);
        if (kb >= 2) src = -1;
        p0_transpose_item(F.in[18], 1024, kb >= 2 ? 0 : 64 * kb, src, (bf16_t*)(F.ws + WS_WUKV) + (kb >= 2 ? 64 * kb : 0), 256, n, F.in[17], 1.f, scr, F.lane); return; } r -= 128;
    { const int kb = r >> 5, nb = r & 31;
        p0_transpose_item(F.in[20], 1024, 64 * kb, 32 * nb, (bf16_t*)(F.ws + WS_WOUTO), 1024, 32 * nb, nullptr, 1.f, scr, F.lane); }
}
constexpr int DENSE_ITEMS = 2912;

__device__ __forceinline__ void phase_p0(const Frame& F) {
    LAS float* scr = (LAS float*)(F.lds + F.wave * 16384);
    const int gw = F.vcu * NWAVES + F.wave, NGW = F.G * NWAVES;
    { CvtRegs R; int it = gw; if (it < MOE_CVT_ITEMS) moe_cvt_load(F, 0, it, R);
      for (; it < MOE_CVT_ITEMS; it += NGW) { moe_cvt_stage(F, 0, it, R, scr); if (it + NGW < MOE_CVT_ITEMS) moe_cvt_load(F, 0, it + NGW, R); moe_cvt_emit(F, it, scr); } }
    for (int it = gw; it < DENSE_ITEMS; it += NGW) p0_dense_item(F, it, scr);
    for (int m = gw; m < T; m += NGW) row_to_bf16_rs(F.in[0] + (size_t)m * D, (bf16_t*)(F.ws + WS_XB) + (size_t)m * D, (float*)(F.ws + WS_RS0) + m, F.lane);
    const int gt = gw * 64 + F.lane, NGT = NGW * 64;
    for (int idx = gt; idx < 2 * 49152; idx += NGT) {
        const int layer = idx / 49152, li = idx % 49152;
        const int j = li & 7, ln = (li >> 3) & 63, blk = li >> 9, ct = blk % 3, ks = (blk / 3) & 3, w = blk / 12;
        const int k = 128 * w + 32 * ks + 8 * (ln >> 4) + j, col = 16 * ct + (ln & 15);
        float v = 0.f;
        if (col < 4) v = F.in[21][((size_t)layer * 1024 + k) * 4 + col];
        else if (col < 36) v = F.in[23][(((size_t)layer * 4 + ((col - 4) >> 3)) * 1024 + k) * 8 + ((col - 4) & 7)];
        v *= F.in[2][layer * 1024 + k];
        const unsigned hi = f2bf(v); const unsigned lo = f2bf(v - bf2f(hi));
        bf16_t* R = (bf16_t*)(F.ws + WS_ROUTER);
        R[(size_t)(layer * 2 + 0) * 49152 + li] = (bf16_t)hi;
        R[(size_t)(layer * 2 + 1) * 49152 + li] = (bf16_t)lo;
    }
    for (int idx = gt; idx < S * 16; idx += NGT) {
        const int pos = idx >> 4, j = idx & 15;
        const double inv = pow(10000.0, -(double)(2 * j) / 32.0), ang = (double)pos * inv;
        f32x2 cs; cs.x = (float)cos(ang); cs.y = (float)sin(ang);
        ((f32x2*)(F.ws + WS_ROPE))[idx] = cs;
    }
}
}
namespace mk {
using pg8::Unit;
__device__ __forceinline__ u32x4 pack8(const f32x4& a, const f32x4& b) { u32x4 w; w.x = pk2(a[0], a[1]); w.y = pk2(a[2], a[3]); w.z = pk2(b[0], b[1]); w.w = pk2(b[2], b[3]); return w; }

struct EpiE1 {
    static constexpr bool PERM = true, AFTER_DRAIN = false;
    bf16_t* ACT; const float* rs;
    __device__ __forceinline__ void operator()(const f32x4 (&acc)[2][2][4][2], const Unit& u, int wr, int wc, int fr, int fq) const {
        const int row0 = u.pm * 256 + wr * 64 + fr, cl = wc * 32 + 8 * fq;
#pragma unroll
        for (int ai = 0; ai < 2; ++ai)
#pragma unroll
            for (int m = 0; m < 4; ++m) {
                const int row = row0 + ai * 128 + m * 16; const float r = rs[row]; bf16_t* rowp = ACT + (size_t)row * 1536;
                if (u.pn < 4) {
                    f32x4 o0, o1;
#pragma unroll
                    for (int i = 0; i < 4; ++i) { o0[i] = acc[ai][0][m][0][i] * r * sigmoid_f(acc[ai][1][m][0][i] * r); o1[i] = acc[ai][0][m][1][i] * r * sigmoid_f(acc[ai][1][m][1][i] * r); }
                    *(u32x4*)(rowp + 128 * u.pn + cl) = pack8(o0, o1);
                } else {
                    const int base = (u.pn < 6) ? (512 + (u.pn - 4) * 256) : (1024 + (u.pn - 6) * 256);
#pragma unroll
                    for (int bj = 0; bj < 2; ++bj) { f32x4 o0, o1;
#pragma unroll
                        for (int i = 0; i < 4; ++i) { o0[i] = gelu_f(acc[ai][bj][m][0][i] * r); o1[i] = gelu_f(acc[ai][bj][m][1][i] * r); }
                        *(u32x4*)(rowp + base + bj * 128 + cl) = pack8(o0, o1); }
                }
            }
    }
};
struct EpiRes {
    static constexpr bool PERM = true, AFTER_DRAIN = false;
    const float* resid; float* out; bf16_t* xb;
    __device__ __forceinline__ void operator()(const f32x4 (&acc)[2][2][4][2], const Unit& u, int wr, int wc, int fr, int fq) const {
        const int row0 = u.pm * 256 + wr * 64 + fr, col0 = u.pn * 256 + wc * 32 + 8 * fq;
#pragma unroll
        for (int ai = 0; ai < 2; ++ai)
#pragma unroll
            for (int m = 0; m < 4; ++m) {
                const size_t off = (size_t)(row0 + ai * 128 + m * 16) * 1024 + col0;
#pragma unroll
                for (int bj = 0; bj < 2; ++bj) {
                    const f32x4 r0 = *(const f32x4*)(resid + off + bj * 128), r1 = *(const f32x4*)(resid + off + bj * 128 + 4);
                    const f32x4 v0 = acc[ai][bj][m][0] + r0, v1 = acc[ai][bj][m][1] + r1;
                    *(f32x4*)(out + off + bj * 128) = v0; *(f32x4*)(out + off + bj * 128 + 4) = v1;
                    *(u32x4*)(xb + off + bj * 128) = pack8(v0, v1);
                }
            }
    }
};
struct EpiO1 {
    static constexpr bool PERM = true, AFTER_DRAIN = false;
    bf16_t* P; const float* rs; float* ssqq; float* ssqkv; bf16_t* kpe; const f32x2* rope;
    __device__ __forceinline__ void operator()(const f32x4 (&acc)[2][2][4][2], const Unit& u, int wr, int wc, int fr, int fq) const {
        const int row0 = u.pm * 256 + wr * 64 + fr, cl = wc * 32 + 8 * fq;
#pragma unroll
        for (int ai = 0; ai < 2; ++ai)
#pragma unroll
            for (int m = 0; m < 4; ++m) {
                const int row = row0 + ai * 128 + m * 16; const float r = rs[row]; bf16_t* rowp = P + (size_t)row * 1280 + u.pn * 256 + cl;
                f32x4 v[2][2];
#pragma unroll
                for (int bj = 0; bj < 2; ++bj) { v[bj][0] = acc[ai][bj][m][0] * r; v[bj][1] = acc[ai][bj][m][1] * r; *(u32x4*)(rowp + bj * 128) = pack8(v[bj][0], v[bj][1]); }
                if (u.pn <= 1) {
                    float s = 0.f;
#pragma unroll
                    for (int i = 0; i < 4; ++i) { s += v[0][0][i] * v[0][0][i] + v[0][1][i] * v[0][1][i]; if (u.pn == 0) s += v[1][0][i] * v[1][0][i] + v[1][1][i] * v[1][1][i]; }
                    s += __shfl_xor(s, 16); s += __shfl_xor(s, 32);
                    if (fq == 0) (u.pn == 0 ? ssqq : ssqkv)[(size_t)row * 4 + wc] = s;
                }
                if (u.pn == 1 && wc == 0) {
                    const int pos = row & (S - 1); f32x4 o[2];
#pragma unroll
                    for (int n = 0; n < 2; ++n)
#pragma unroll
                        for (int i = 0; i < 4; ++i) { const float x = v[1][n][i], y = __shfl_xor(x, 32); const f32x2 cs = rope[pos * 16 + ((8 * fq + 4 * n + i) & 15)];
                            o[n][i] = (fq < 2) ? (x * cs.x - y * cs.y) : (x * cs.x + y * cs.y); }
                    *(u32x4*)(kpe + (size_t)row * 32 + 8 * fq) = pack8(o[0], o[1]);
                }
                asm volatile("" ::: "memory");
            }
    }
};
struct O2Order : pg8::StaticOrder {
    __device__ bool next(int i, Unit& u) const { const bool ok = pg8::StaticOrder::next(i, u); if (ok) u.aoff = (u.pn >= 3) ? 512 : 0; return ok; }
};
struct EpiO2 {
    static constexpr bool PERM = true, AFTER_DRAIN = false;
    bf16_t* Q; bf16_t* KV; const float* ssqq; const float* ssqkv;
    __device__ __forceinline__ void operator()(const f32x4 (&acc)[2][2][4][2], const Unit& u, int wr, int wc, int fr, int fq) const {
        const int row0 = u.pm * 256 + wr * 64 + fr, cl = wc * 32 + 8 * fq;
        const bool isq = u.pn < 3; const float* ssq = isq ? ssqq : ssqkv; const float inv_n = isq ? (1.f / 256.f) : (1.f / 128.f);
        bf16_t* O = isq ? (Q + u.pn * 256 + cl) : (KV + (u.pn - 3) * 256 + cl); const int ldo = isq ? 768 : 1024;
#pragma unroll
        for (int ai = 0; ai < 2; ++ai)
#pragma unroll
            for (int m = 0; m < 4; ++m) {
                const int row = row0 + ai * 128 + m * 16; const f32x4 sq = *(const f32x4*)(ssq + (size_t)row * 4);
                const float r = __builtin_amdgcn_rsqf(((sq[0] + sq[1]) + (sq[2] + sq[3])) * inv_n + EPS);
                bf16_t* rowp = O + (size_t)row * ldo;
#pragma unroll
                for (int bj = 0; bj < 2; ++bj) *(u32x4*)(rowp + bj * 128) = pack8(acc[ai][bj][m][0] * r, acc[ai][bj][m][1] * r);
                asm volatile("" ::: "memory");
            }
    }
};
}
namespace mk {
__device__ __forceinline__ void e2_conv_unit(const Frame& F, int tt, int grp, const bf16_t* ACT, bf16_t* MBo) {
    LAS bf16_t* tile = (LAS bf16_t*)F.lds;
    const int t0 = tt * 128, s0 = t0 & (S - 1);
    for (int idx = F.tid; idx < 158 * 16; idx += NTHR) { const int r = idx >> 4, c = idx & 15; const int sp = s0 + r - 15;
        u32x4 v = {0u, 0u, 0u, 0u};
        if (sp >= 0 && sp < S) v = *(const GAS u32x4*)(ACT + (size_t)(t0 + r - 15) * 1536 + grp * 128 + c * 8);
        *(LAS u32x4*)(tile + r * 128 + c * 8) = v; }
    __syncthreads();
    const int ch = grp * 128 + 2 * F.lane;
    const float* cw = F.in[5]; float w0[31], w1[31];
#pragma unroll
    for (int q = 0; q < 31; ++q) { const f32x2 wv = *(const f32x2*)(cw + q * 512 + ch); w0[q] = wv.x; w1[q] = wv.y; }
    const f32x2 bias = *(const f32x2*)(F.in[6] + ch);
    float a0[16], a1[16];
#pragma unroll
    for (int k = 0; k < 16; ++k) { a0[k] = bias.x; a1[k] = bias.y; }
    const LAS unsigned* src = (const LAS unsigned*)(tile + (16 * F.wave) * 128 + 2 * F.lane);
#pragma unroll
    for (int i = 0; i < 46; ++i) { const unsigned x = src[i * 64]; const float x0 = bf2f(x & 0xffffu), x1 = bf2f(x >> 16);
#pragma unroll
        for (int k = 0; k < 16; ++k) { const int q = i - k; if (q >= 0 && q <= 30) { a0[k] = fmaf(x0, w0[q], a0[k]); a1[k] = fmaf(x1, w1[q], a1[k]); } } }
    const f32x2 g = *(const f32x2*)(F.in[7] + ch), bt = *(const f32x2*)(F.in[8] + ch);
    LAS float* scr = (LAS float*)(F.lds + 49152) + F.wave * 32;
    const bool b5 = (F.lane & 32) != 0, b4 = (F.lane & 16) != 0, b3 = (F.lane & 8) != 0, b2 = (F.lane & 4) != 0;
    const int tk = (b5 ? 8 : 0) + (b4 ? 4 : 0) + (b3 ? 2 : 0) + (b2 ? 1 : 0);
#define E2_BFLY(S, OUT) do { float v8_[8], v4_[4], v2_[2]; \
        _Pragma("unroll") for (int k = 0; k < 8; ++k) { const float kp = b5 ? S[k + 8] : S[k], sd = b5 ? S[k] : S[k + 8]; v8_[k] = kp + __shfl_xor(sd, 32); } \
        _Pragma("unroll") for (int k = 0; k < 4; ++k) { const float kp = b4 ? v8_[k + 4] : v8_[k], sd = b4 ? v8_[k] : v8_[k + 4]; v4_[k] = kp + __shfl_xor(sd, 16); } \
        _Pragma("unroll") for (int k = 0; k < 2; ++k) { const float kp = b3 ? v4_[k + 2] : v4_[k], sd = b3 ? v4_[k] : v4_[k + 2]; v2_[k] = kp + __shfl_xor(sd, 8); } \
        { const float kp = b2 ? v2_[1] : v2_[0], sd = b2 ? v2_[0] : v2_[1]; OUT = kp + __shfl_xor(sd, 4); } \
        OUT += __shfl_xor(OUT, 2); OUT += __shfl_xor(OUT, 1); } while (0)
    float st[16], tot;
#pragma unroll
    for (int k = 0; k < 16; ++k) st[k] = a0[k] + a1[k];
    E2_BFLY(st, tot);
    if ((F.lane & 3) == 0) scr[tk] = tot * (1.f / 128.f);
    LDS_WAIT(); asm volatile("" ::: "memory");
    float mu[16];
#pragma unroll
    for (int k4 = 0; k4 < 4; ++k4) { const f32x4 m4 = *(const LAS f32x4*)(scr + 4 * k4); mu[4 * k4] = m4.x; mu[4 * k4 + 1] = m4.y; mu[4 * k4 + 2] = m4.z; mu[4 * k4 + 3] = m4.w; }
#pragma unroll
    for (int k = 0; k < 16; ++k) { a0[k] -= mu[k]; a1[k] -= mu[k]; st[k] = a0[k] * a0[k] + a1[k] * a1[k]; }
    E2_BFLY(st, tot);
    if ((F.lane & 3) == 0) scr[16 + tk] = 1.0f / sqrtf(tot * (1.f / 128.f) + EPS);
    LDS_WAIT(); asm volatile("" ::: "memory");
#undef E2_BFLY
#pragma unroll
    for (int k4 = 0; k4 < 4; ++k4) { const f32x4 r4 = *(const LAS f32x4*)(scr + 16 + 4 * k4);
#pragma unroll
        for (int i = 0; i < 4; ++i) { const int k = 4 * k4 + i; const float rs = r4[i];
            const float y0 = silu_f(a0[k] * rs * g.x + bt.x), y1 = silu_f(a1[k] * rs * g.y + bt.y);
            *(GAS unsigned*)(MBo + (size_t)(t0 + 16 * F.wave + k) * 1024 + ch) = pk2(y0, y1); } }
    __syncthreads();
}
__device__ __forceinline__ void e2_sgu_unit(const Frame& F, int chunk, int h, const bf16_t* ACT, bf16_t* MBo) {
    constexpr int LD = 136, LDO = 132;
    LAS bf16_t* WSl = (LAS bf16_t*)F.lds;
    LAS bf16_t* VTl = (LAS bf16_t*)(F.lds + 34816);
    LAS float* OUTl = (LAS float*)(F.lds + 69632);
    const int t0 = chunk * 128;
    const float* wsp = F.in[11] + (size_t)h * 128 * 128;
    for (int idx = F.tid; idx < 4096; idx += NTHR) { const int r = idx >> 5, c4 = idx & 31; const f32x4 v = *(const GAS f32x4*)(wsp + r * 128 + 4 * c4);
        u32x2 w; w.x = pk2(v.x, v.y); w.y = pk2(v.z, v.w); *(LAS u32x2*)(WSl + r * LD + 4 * c4) = w; }
#pragma unroll
    for (int it = 0; it < 4; ++it) { const int idx = F.tid + NTHR * it, s = idx >> 4, c = idx & 15;
        const u32x4 raw = *(const GAS u32x4*)(ACT + (size_t)(t0 + s) * 1536 + 1024 + h * 128 + 8 * c);
        float x[8]; x[0] = bf2f(raw.x & 0xffffu); x[1] = bf2f(raw.x >> 16); x[2] = bf2f(raw.y & 0xffffu); x[3] = bf2f(raw.y >> 16);
        x[4] = bf2f(raw.z & 0xffffu); x[5] = bf2f(raw.z >> 16); x[6] = bf2f(raw.w & 0xffffu); x[7] = bf2f(raw.w >> 16);
        float sm = 0.f;
#pragma unroll
        for (int i = 0; i < 8; ++i) sm += x[i];
        sm += __shfl_xor(sm, 1); sm += __shfl_xor(sm, 2); sm += __shfl_xor(sm, 4); sm += __shfl_xor(sm, 8);
        const float mu = sm * (1.f / 128.f); float q = 0.f;
#pragma unroll
        for (int i = 0; i < 8; ++i) { x[i] -= mu; q += x[i] * x[i]; }
        q += __shfl_xor(q, 1); q += __shfl_xor(q, 2); q += __shfl_xor(q, 4); q += __shfl_xor(q, 8);
        const float rs = 1.0f / sqrtf(q * (1.f / 128.f) + EPS);
        const float* vg = F.in[9] + h * 128 + 8 * c; const float* vb = F.in[10] + h * 128 + 8 * c;
#pragma unroll
        for (int i = 0; i < 8; ++i) { const float y = x[i] * rs * vg[i] + vb[i]; VTl[(8 * c + i) * LD + s] = (bf16_t)f2bf(y); }
    }
    __syncthreads();
    const int wt = F.wave >> 1, wc = F.wave & 1, r32 = F.lane & 31, hi = F.lane >> 5;
    f32x16 acc[2]; acc[0] = f32x16{}; acc[1] = f32x16{};
#pragma unroll
    for (int ks = 0; ks < 8; ++ks) {
        const bf16x8 a = *(const LAS bf16x8*)(WSl + (32 * wt + r32) * LD + 16 * ks + 8 * hi);
#pragma unroll
        for (int ct = 0; ct < 2; ++ct) { const bf16x8 b = *(const LAS bf16x8*)(VTl + (64 * wc + 32 * ct + r32) * LD + 16 * ks + 8 * hi);
            acc[ct] = __builtin_amdgcn_mfma_f32_32x32x16_bf16(a, b, acc[ct], 0, 0, 0); }
    }
    const float* bsp = F.in[12] + h * 128;
#pragma unroll
    for (int ct = 0; ct < 2; ++ct)
#pragma unroll
        for (int r = 0; r < 16; ++r) { const int trow = 32 * wt + (r & 3) + 8 * (r >> 2) + 4 * hi; OUTl[trow * LDO + 64 * wc + 32 * ct + r32] = acc[ct][r] + bsp[trow]; }
    __syncthreads();
#pragma unroll
    for (int it = 0; it < 4; ++it) { const int idx = F.tid + NTHR * it, t = idx >> 4, c = idx & 15;
        const u32x4 raw = *(const GAS u32x4*)(ACT + (size_t)(t0 + t) * 1536 + 512 + h * 128 + 8 * c);
        const f32x4 s0 = *(const LAS f32x4*)(OUTl + t * LDO + 8 * c), s1 = *(const LAS f32x4*)(OUTl + t * LDO + 8 * c + 4);
        u32x4 o; o.x = pk2(bf2f(raw.x & 0xffffu) * s0.x, bf2f(raw.x >> 16) * s0.y); o.y = pk2(bf2f(raw.y & 0xffffu) * s0.z, bf2f(raw.y >> 16) * s0.w);
        o.z = pk2(bf2f(raw.z & 0xffffu) * s1.x, bf2f(raw.z >> 16) * s1.y); o.w = pk2(bf2f(raw.w & 0xffffu) * s1.z, bf2f(raw.w >> 16) * s1.w);
        *(GAS u32x4*)(MBo + (size_t)(t0 + t) * 1024 + 512 + h * 128 + 8 * c) = o; }
    __syncthreads();
}
__device__ __forceinline__ void phase_e2(const Frame& F) {
    const bf16_t* ACT = (const bf16_t*)F.out; bf16_t* MBo = (bf16_t*)(F.ws + WS_MB);
    for (int u = F.vcu; u < 1024; u += F.G) {
        if (u < 512) e2_conv_unit(F, u >> 2, u & 3, ACT, MBo);
        else e2_sgu_unit(F, (u - 512) >> 2, (u - 512) & 3, ACT, MBo);
    }
}
template <bool FINAL> __device__ __forceinline__ void combine_rows(const Frame& F) {
    const int gw = F.vcu * NWAVES + F.wave, NGW = F.G * NWAVES;
    const bf16_t* Y = (const bf16_t*)(F.ws + WS_Y);
    for (int m = gw; m < T; m += NGW) {
        GAS f32x4* xr = (GAS f32x4*)(F.out + (size_t)m * D) + F.lane;
        const GAS u32x2* y0 = (const GAS u32x2*)(Y + (size_t)(2 * m) * D) + F.lane; const GAS u32x2* y1 = (const GAS u32x2*)(Y + (size_t)(2 * m + 1) * D) + F.lane;
        f32x4 v[4]; float s = 0.f;
#pragma unroll
        for (int j = 0; j < 4; ++j) { v[j] = xr[64 * j]; const u32x2 a = y0[64 * j], b = y1[64 * j];
            v[j].x += bf2f(a.x & 0xffffu) + bf2f(b.x & 0xffffu); v[j].y += bf2f(a.x >> 16) + bf2f(b.x >> 16);
            v[j].z += bf2f(a.y & 0xffffu) + bf2f(b.y & 0xffffu); v[j].w += bf2f(a.y >> 16) + bf2f(b.y >> 16);
            s += (v[j].x * v[j].x + v[j].y * v[j].y) + (v[j].z * v[j].z + v[j].w * v[j].w); }
        s = wave_sum(s);
        const float rs = 1.0f / sqrtf(s * (1.f / 1024.f) + EPS);
        if (FINAL) {
            const GAS f32x4* g = (const GAS f32x4*)F.in[3] + F.lane;
#pragma unroll
            for (int j = 0; j < 4; ++j) { const f32x4 gg = g[64 * j]; xr[64 * j] = v[j] * rs * gg; }
        } else {
            GAS u32x2* o8 = (GAS u32x2*)((bf16_t*)(F.ws + WS_XB) + (size_t)m * D) + F.lane;
#pragma unroll
            for (int j = 0; j < 4; ++j) { xr[64 * j] = v[j]; u32x2 w; w.x = pk2(v[j].x, v[j].y); w.y = pk2(v[j].z, v[j].w); o8[64 * j] = w; }
            if (F.lane == 0) ((float*)(F.ws + WS_RS0))[m] = rs;
        }
    }
}
}
namespace mk {
typedef float f32x4v __attribute__((ext_vector_type(4)));
__device__ __forceinline__ void phase_router(const Frame& F, int layer) {
    LAS float* red = (LAS float*)F.lds;
    LAS float* ssqr = (LAS float*)(F.lds + 98304);
    LAS float* lg = (LAS float*)(F.lds + 100352);
    LAS float* rsl = (LAS float*)(F.lds + 112640);
    LAS int* sel = (LAS int*)(F.lds + 112896);
    LAS float* gwl = (LAS float*)(F.lds + 113408);
    LAS int* basel = (LAS int*)(F.lds + 113920);
    const bf16_t* RH = (const bf16_t*)(F.ws + WS_ROUTER) + (size_t)(layer * 2) * 49152 + (size_t)F.wave * 6144;
    const bf16_t* RL = RH + 49152;
    unsigned* gcnt = (unsigned*)(F.ws + WS_CTL) + CW_ECNT + layer * 32 * 64;
    const int r = F.lane & 15, q = F.lane >> 4;
    for (int unit = F.vcu; unit < T / 64; unit += F.G) {
        const int tok0 = unit * 64;
        const float* X = F.out + (size_t)tok0 * D + 128 * F.wave + 8 * q;
        f32x4 acc[4][3]; float ssq[4];
#pragma unroll
        for (int tt = 0; tt < 4; ++tt) { ssq[tt] = 0.f;
#pragma unroll
            for (int ct = 0; ct < 3; ++ct) acc[tt][ct] = (f32x4){0.f, 0.f, 0.f, 0.f}; }
#pragma unroll 1
        for (int ks = 0; ks < 4; ++ks) {
            bf16x8 bh[3], bl[3];
#pragma unroll
            for (int ct = 0; ct < 3; ++ct) { bh[ct] = *(const GAS bf16x8*)(RH + ((ks * 3 + ct) * 64 + F.lane) * 8); bl[ct] = *(const GAS bf16x8*)(RL + ((ks * 3 + ct) * 64 + F.lane) * 8); }
#pragma unroll
            for (int tt = 0; tt < 4; ++tt) {
                const float* xp = X + (size_t)(16 * tt + r) * D + 32 * ks;
                const f32x4 x0 = *(const GAS f32x4*)xp, x1 = *(const GAS f32x4*)(xp + 4);
                float xv[8] = {x0.x, x0.y, x0.z, x0.w, x1.x, x1.y, x1.z, x1.w};
                unsigned hh[8], ll[8];
#pragma unroll
                for (int j = 0; j < 8; ++j) { ssq[tt] = fmaf(xv[j], xv[j], ssq[tt]); hh[j] = f2bf(xv[j]); ll[j] = f2bf(xv[j] - bf2f(hh[j])); }
                u32x4 ahw, alw;
                ahw.x = hh[0] | (hh[1] << 16); ahw.y = hh[2] | (hh[3] << 16); ahw.z = hh[4] | (hh[5] << 16); ahw.w = hh[6] | (hh[7] << 16);
                alw.x = ll[0] | (ll[1] << 16); alw.y = ll[2] | (ll[3] << 16); alw.z = ll[4] | (ll[5] << 16); alw.w = ll[6] | (ll[7] << 16);
                const bf16x8 ah = __builtin_bit_cast(bf16x8, ahw), al = __builtin_bit_cast(bf16x8, alw);
#pragma unroll
                for (int ct = 0; ct < 3; ++ct) {
                    acc[tt][ct] = __builtin_amdgcn_mfma_f32_16x16x32_bf16(ah, bh[ct], acc[tt][ct], 0, 0, 0);
                    acc[tt][ct] = __builtin_amdgcn_mfma_f32_16x16x32_bf16(al, bh[ct], acc[tt][ct], 0, 0, 0);
                    acc[tt][ct] = __builtin_amdgcn_mfma_f32_16x16x32_bf16(ah, bl[ct], acc[tt][ct], 0, 0, 0);
                }
            }
        }
#pragma unroll
        for (int tt = 0; tt < 4; ++tt) {
#pragma unroll
            for (int ct = 0; ct < 3; ++ct)
#pragma unroll
                for (int i = 0; i < 4; ++i) red[(F.wave * 64 + 16 * tt + 4 * q + i) * 48 + 16 * ct + r] = acc[tt][ct][i];
            float s = ssq[tt]; s += __shfl_xor(s, 16); s += __shfl_xor(s, 32);
            if (q == 0) ssqr[F.wave * 64 + 16 * tt + r] = s;
        }
        __syncthreads();
        for (int idx = F.tid; idx < 3072; idx += NTHR) { float s = 0.f;
#pragma unroll
            for (int w = 0; w < 8; ++w) s += red[w * 3072 + idx];
            lg[idx] = s; }
        if (F.tid < 64) { float s = 0.f;
#pragma unroll
            for (int w = 0; w < 8; ++w) s += ssqr[w * 64 + F.tid];
            rsl[F.tid] = 1.0f / sqrtf(s * (1.f / 1024.f) + EPS); }
        __syncthreads();
        if (F.tid < 64) {
            const int t = tok0 + F.tid; const float rs = rsl[F.tid]; const LAS float* L = lg + F.tid * 48;
            const float* bg = F.in[22] + layer * 4; const float* br = F.in[24] + layer * 32;
            float gl[4];
#pragma unroll
            for (int j = 0; j < 4; ++j) gl[j] = L[j] * rs + bg[j];
            int gi = 0; float gm = gl[0];
#pragma unroll
            for (int j = 1; j < 4; ++j) if (gl[j] > gm) { gm = gl[j]; gi = j; }
            float den = 0.f;
#pragma unroll
            for (int j = 0; j < 4; ++j) den += __expf(gl[j] - gm);
            const float gp = 1.f / den;
            float el[8];
#pragma unroll
            for (int e = 0; e < 8; ++e) el[e] = L[4 + 8 * gi + e] * rs + br[gi * 8 + e];
            int i1 = 0; float v1 = el[0];
#pragma unroll
            for (int e = 1; e < 8; ++e) if (el[e] > v1) { v1 = el[e]; i1 = e; }
            int i2 = 0; float v2 = -3.0e38f;
#pragma unroll
            for (int e = 0; e < 8; ++e) if (e != i1 && el[e] > v2) { v2 = el[e]; i2 = e; }
            const float e2 = __expf(v2 - v1);
            sel[2 * F.tid] = gi * 8 + i1; sel[2 * F.tid + 1] = gi * 8 + i2;
            gwl[2 * F.tid] = gp / (1.f + e2); gwl[2 * F.tid + 1] = gp * e2 / (1.f + e2);
            ((float*)(F.ws + WS_RSM))[t] = rs;
        }
        __syncthreads();
        int pos = 0, myexp = 0;
        if (F.tid < 128) { myexp = sel[F.tid]; for (int j = 0; j < F.tid; ++j) pos += (sel[j] == myexp) ? 1 : 0; }
        if (F.tid >= 128 && F.tid < 160) { const int e = F.tid - 128; int c = 0; for (int j = 0; j < 128; ++j) c += (sel[j] == e) ? 1 : 0;
            basel[e] = c ? (int)__hip_atomic_fetch_add(gcnt + e * 64, (unsigned)c, __ATOMIC_RELAXED, __HIP_MEMORY_SCOPE_AGENT) : 0; }
        __syncthreads();
        if (F.tid < 128) { const size_t dst = (size_t)myexp * T + basel[myexp] + pos;
            ((int*)(F.ws + WS_LSLOT))[dst] = 2 * (tok0 + (F.tid >> 1)) + (F.tid & 1);
            ((float*)(F.ws + WS_LGW))[dst] = gwl[F.tid]; }
        __syncthreads();
    }
}

#define MOE_VMWAIT(n) asm volatile("s_waitcnt vmcnt(" #n ")" ::: "memory")
template <int NT, int PROBE = 0> __device__ __forceinline__ void moe_segment_t(const Frame& F, int e, int l0, int n) {
    constexpr int RW = 5;
    LAS unsigned char* XR = F.lds;
    LAS unsigned char* HID = F.lds;
    LAS unsigned char* RING = F.lds + 65536 + F.wave * (RW * 2048);
    LAS int* s_tok = (LAS int*)(F.lds + 65536 + 8 * RW * 2048);
    LAS int* s_slot = s_tok + 128;
    LAS float* s_gw = (LAS float*)(s_slot + 128);
    LAS float* s_rs = s_gw + 128;
    const int lane = F.lane, r32 = lane & 31, hi = lane >> 5, w = F.wave;
    const char* w1p = (const char*)((const bf16_t*)(F.ws + WS_WMOE) + (size_t)e * W1_EXP + (size_t)w * 65536) + lane * 16;
    const char* w2p = (const char*)((const bf16_t*)(F.ws + WS_WMOE) + 32 * W1_EXP + (size_t)e * W2_EXP + (size_t)w * 16384) + lane * 16;
#define MOE_WSRC(t) ((PROBE == 1) ? (w1p + (size_t)((t) & 3) * 2048) : (((t) < 64) ? (w1p + (size_t)(t) * 2048) : (w2p + (size_t)(((t) - 64) >> 4) * 262144 + (size_t)(((t) - 64) & 15) * 2048)))
#define MOE_WDMA(t, slot) do { const char* s_ = MOE_WSRC(t); LAS unsigned char* d_ = RING + (slot) * 2048; \
        __builtin_amdgcn_global_load_lds((const GAS unsigned*)s_, (LAS unsigned*)d_, 16, 0, 0); \
        __builtin_amdgcn_global_load_lds((const GAS unsigned*)(s_ + 1024), (LAS unsigned*)(d_ + 1024), 16, 0, 0); } while (0)
    MOE_WDMA(0, 0); MOE_WDMA(1, 1); MOE_WDMA(2, 2); MOE_WDMA(3, 3);
    if (F.tid < 128) { const int idx = F.tid < n ? F.tid : 0; const size_t li = (size_t)e * T + l0 + idx;
        const int slot = ((const int*)(F.ws + WS_LSLOT))[li]; const int tok = slot >> 1;
        s_tok[F.tid] = tok; s_slot[F.tid] = F.tid < n ? slot : -1; s_gw[F.tid] = F.tid < n ? ((const float*)(F.ws + WS_LGW))[li] : 0.f;
        s_rs[F.tid] = ((const float*)(F.ws + WS_RSM))[tok]; }
    __syncthreads();
    const char* xp0 = (const char*)((const bf16_t*)(F.ws + WS_XB) + (size_t)s_tok[lane] * D) + (2 * w) * 16;
    const char* xp1 = (const char*)((const bf16_t*)(F.ws + WS_XB) + (size_t)s_tok[64 + lane] * D) + (2 * w) * 16;
#define MOE_XDMA(kc, bufsel) do { LAS unsigned char* xb_ = XR + (bufsel) * 32768 + (2 * w) * 2048; const size_t ko_ = (PROBE == 2) ? 0 : (size_t)(kc) * 256; \
        __builtin_amdgcn_global_load_lds((const GAS unsigned*)(xp0 + ko_), (LAS unsigned*)(xb_), 16, 0, 0); \
        __builtin_amdgcn_global_load_lds((const GAS unsigned*)(xp1 + ko_), (LAS unsigned*)(xb_ + 1024), 16, 0, 0); \
        __builtin_amdgcn_global_load_lds((const GAS unsigned*)(xp0 + ko_ + 16), (LAS unsigned*)(xb_ + 2048), 16, 0, 0); \
        __builtin_amdgcn_global_load_lds((const GAS unsigned*)(xp1 + ko_ + 16), (LAS unsigned*)(xb_ + 3072), 16, 0, 0); } while (0)
    MOE_XDMA(0, 0);
    MOE_VMWAIT(0); __builtin_amdgcn_s_barrier(); asm volatile("" ::: "memory");
    int wr_slot = 4, rd_slot = 0;
    f32x16 accg[NT], accu[NT];
#pragma unroll
    for (int i = 0; i < NT; ++i) { accg[i] = f32x16{}; accu[i] = f32x16{}; }
    bf16x8 wf[2][2], xf[2][NT];
#define MOE_RDW(par) do { const LAS unsigned char* rp_ = RING + rd_slot * 2048 + lane * 16; rd_slot = (rd_slot == RW - 1) ? 0 : rd_slot + 1; \
        wf[par][0] = *(const LAS bf16x8*)rp_; wf[par][1] = *(const LAS bf16x8*)(rp_ + 1024); } while (0)
    { const LAS unsigned char* b0 = XR + (hi * 128 + r32) * 16;
      MOE_RDW(0);
#pragma unroll
      for (int i = 0; i < NT; ++i) xf[0][i] = *(const LAS bf16x8*)(b0 + (32 * i) * 16); }
    for (int kc = 0; kc < 8; ++kc) {
        const LAS unsigned char* buf = XR + (kc & 1) * 32768 + (hi * 128 + r32) * 16;
        const LAS unsigned char* nbuf = XR + ((kc + 1) & 1) * 32768 + (hi * 128 + r32) * 16;
#pragma unroll
        for (int ks = 0; ks < 8; ++ks) {
            constexpr int dummy_ = 0; (void)dummy_;
            const int cur = ks & 1, nxt = cur ^ 1;
            MOE_WDMA(kc * 8 + ks + 4, wr_slot); wr_slot = (wr_slot == RW - 1) ? 0 : wr_slot + 1;
            if (ks == 0 && kc < 7) MOE_XDMA(kc + 1, (kc + 1) & 1);
            if (ks <= 3 && kc < 7) MOE_VMWAIT(10); else MOE_VMWAIT(6);
            if (ks == 7) { asm volatile("s_waitcnt lgkmcnt(0)" ::: "memory"); __builtin_amdgcn_s_barrier(); asm volatile("" ::: "memory"); }
            if (ks < 7 || kc < 7) {
                MOE_RDW(nxt);
                const LAS unsigned char* xb_ = (ks < 7) ? (buf + (2 * (ks + 1) * 128) * 16) : nbuf;
#pragma unroll
                for (int i = 0; i < NT; ++i) xf[nxt][i] = *(const LAS bf16x8*)(xb_ + (32 * i) * 16);
            }
#pragma unroll
            for (int i = 0; i < NT; ++i) {
                accg[i] = __builtin_amdgcn_mfma_f32_32x32x16_bf16(wf[cur][0], xf[cur][i], accg[i], 0, 0, 0);
                accu[i] = __builtin_amdgcn_mfma_f32_32x32x16_bf16(wf[cur][1], xf[cur][i], accu[i], 0, 0, 0);
            }
        }
    }
#pragma unroll
    for (int i = 0; i < NT; ++i) {
        const float rs = s_rs[32 * i + r32], gw = s_gw[32 * i + r32];
#pragma unroll
        for (int s = 0; s < 2; ++s) { float hv[8];
#pragma unroll
            for (int j = 0; j < 8; ++j) { const float g = accg[i][8 * s + j] * rs, u = accu[i][8 * s + j] * rs; hv[j] = silu_f(g) * u * gw; }
            u32x4 o; o.x = pk2(hv[0], hv[1]); o.y = pk2(hv[2], hv[3]); o.z = pk2(hv[4], hv[5]); o.w = pk2(hv[6], hv[7]);
            *(LAS u32x4*)(HID + (((2 * w + s) * 2 + hi) * 128 + 32 * i + r32) * 16) = o; }
    }
    asm volatile("s_waitcnt lgkmcnt(0)" ::: "memory"); __builtin_amdgcn_s_barrier(); asm volatile("" ::: "memory");
    bf16_t* Y = (bf16_t*)(F.ws + WS_Y);
    const LAS unsigned char* hb = HID + (hi * 128 + r32) * 16;
    MOE_VMWAIT(6);
    MOE_RDW(0);
#pragma unroll
    for (int i = 0; i < NT; ++i) xf[0][i] = *(const LAS bf16x8*)(hb + (32 * i) * 16);
#pragma unroll 1
    for (int p = 0; p < 2; ++p) {
        f32x16 acc2[NT][2];
#pragma unroll
        for (int i = 0; i < NT; ++i) { acc2[i][0] = f32x16{}; acc2[i][1] = f32x16{}; }
#pragma unroll
        for (int kk = 0; kk < 16; ++kk) {
            const int cur = kk & 1, nxt = cur ^ 1;
            if (p == 0 || kk < 12) { MOE_WDMA(64 + 16 * p + kk + 4, wr_slot); wr_slot = (wr_slot == RW - 1) ? 0 : wr_slot + 1; MOE_VMWAIT(6); }
            else if (kk == 12) MOE_VMWAIT(4); else if (kk == 13) MOE_VMWAIT(2); else if (kk == 14) MOE_VMWAIT(0);
            if (p == 0 || kk < 15) {
                MOE_RDW(nxt);
                const LAS unsigned char* hb_ = hb + (((kk + 1) & 15) * 2 * 128) * 16;
#pragma unroll
                for (int i = 0; i < NT; ++i) xf[nxt][i] = *(const LAS bf16x8*)(hb_ + (32 * i) * 16);
            }
#pragma unroll
            for (int i = 0; i < NT; ++i) {
                acc2[i][0] = __builtin_amdgcn_mfma_f32_32x32x16_bf16(wf[cur][0], xf[cur][i], acc2[i][0], 0, 0, 0);
                acc2[i][1] = __builtin_amdgcn_mfma_f32_32x32x16_bf16(wf[cur][1], xf[cur][i], acc2[i][1], 0, 0, 0);
            }
        }
#pragma unroll
        for (int i = 0; i < NT; ++i) {
            const int slot = s_slot[32 * i + r32];
            if (PROBE != 0) { asm volatile("" :: "v"(acc2[i][0]), "v"(acc2[i][1])); } else if (slot >= 0) {
                bf16_t* yr = Y + (size_t)slot * D + 512 * p + 64 * w + 4 * hi;
#pragma unroll
                for (int dt = 0; dt < 2; ++dt)
#pragma unroll
                    for (int qd = 0; qd < 4; ++qd) { u32x2 o; o.x = pk2(acc2[i][dt][4 * qd], acc2[i][dt][4 * qd + 1]); o.y = pk2(acc2[i][dt][4 * qd + 2], acc2[i][dt][4 * qd + 3]);
                        *(GAS u32x2*)(yr + 32 * dt + 8 * qd) = o; }
            }
        }
    }
    asm volatile("s_waitcnt lgkmcnt(0)" ::: "memory"); __builtin_amdgcn_s_barrier(); asm volatile("" ::: "memory");
#undef MOE_RDW
#undef MOE_WSRC
#undef MOE_WDMA
#undef MOE_XDMA
}
template <int PROBE = 0> __device__ __forceinline__ void moe_segment(const Frame& F, int e, int l0, int n) {
    const int nt = (n + 31) >> 5;
    if (nt == 4) moe_segment_t<4, PROBE>(F, e, l0, n); else if (nt == 3) moe_segment_t<3, PROBE>(F, e, l0, n); else if (nt == 2) moe_segment_t<2, PROBE>(F, e, l0, n); else moe_segment_t<1, PROBE>(F, e, l0, n);
}
__device__ __forceinline__ void phase_moe(const Frame& F, int layer) {
    unsigned* gcnt = (unsigned*)(F.ws + WS_CTL) + CW_ECNT + layer * 32 * 64;
    for (int unit = F.vcu; unit < 256; unit += F.G) {
        const int v0 = 128 * unit, v1 = v0 + 128; int vb = 0;
        for (int e = 0; e < 32; ++e) {
            const int ne = (int)__builtin_amdgcn_readfirstlane(__hip_atomic_load(gcnt + e * 64, __ATOMIC_RELAXED, __HIP_MEMORY_SCOPE_AGENT));
            const int lo = v0 > vb ? v0 : vb, hi_ = v1 < vb + ne ? v1 : vb + ne;
            if (lo < hi_) moe_segment<0>(F, e, lo - vb, hi_ - lo);
            vb += ne;
        }
#ifdef MK_MOE_PROBE
        if (layer == 0) { vb = 0;
        for (int e = 0; e < 32; ++e) {
            const int ne = (int)__builtin_amdgcn_readfirstlane(__hip_atomic_load(gcnt + e * 64, __ATOMIC_RELAXED, __HIP_MEMORY_SCOPE_AGENT));
            const int lo = v0 > vb ? v0 : vb, hi_ = v1 < vb + ne ? v1 : vb + ne;
            if (lo < hi_) moe_segment<MK_MOE_PROBE>(F, e, lo - vb, hi_ - lo);
            vb += ne;
        } }
#endif
    }
}
}
namespace mk {
__device__ __forceinline__ int crow(int r, int hi) { return (r & 3) + 8 * (r >> 2) + 4 * hi; }
__device__ __forceinline__ s16x4 vtr(const LAS unsigned char* p) {
    typedef short v4i16_t __attribute__((ext_vector_type(4)));
    return __builtin_bit_cast(s16x4, __builtin_amdgcn_ds_read_tr16_b64_v4i16((LAS v4i16_t*)p));
}
constexpr float ATT_THR = 8.f;

template <int MODE> __device__ __forceinline__ void attn_unit(const Frame& F, int unit) {
    constexpr int NKC = MODE == 0 ? 12 : 8, ND0 = NKC / 2, KBYTES = NKC * 1024, BUF = KBYTES + 8192;
    const int lane = F.lane, w = F.wave, r32 = lane & 31, hi = lane >> 5;
    LAS unsigned char* lds = F.lds;
    LAS float* wsf = (LAS float*)(lds + 2 * BUF) + w * 64;
    LAS bf16_t* stg = (LAS bf16_t*)(lds + 2 * BUF + 2048) + w * 2048;
    const bf16_t* Qb = (const bf16_t*)(F.ws + WS_Q); const bf16_t* KVb = (const bf16_t*)(F.ws + WS_KV); const bf16_t* KPE = (const bf16_t*)(F.ws + WS_KPE);
    const bf16_t* Pb = (const bf16_t*)(F.ws + WS_P); bf16_t* Ob = (bf16_t*)(F.ws + WS_MB);
    int b, h = 0, g = 0, hq = 0, tq0, j_lo, j_hi, kbase0, ocol, qpos0 = 0;
    if (MODE == 0) { b = unit >> 6; h = (unit >> 3) & 7; const int qb = unit & 7; tq0 = b * S + 256 * qb + 32 * w; j_lo = 0; j_hi = 32; kbase0 = b * S; ocol = h * 64; }
    else { b = unit >> 6; const int rem = unit & 63; g = rem >> 5; const int qblk = (rem >> 1) & 15, hp = rem & 1; hq = 4 * g + 2 * hp + (w >> 2);
        qpos0 = 128 * qblk + 32 * (w & 3); tq0 = b * S + qpos0; j_lo = (qblk == 0) ? 2 : 0; j_hi = (qblk == 15) ? 4 : 6; kbase0 = b * S + 128 * qblk - 128; ocol = 512 + hq * 64; }
    bf16x8 qr[ND0];
    if (MODE == 0) { const bf16_t* qrow = Qb + (size_t)(tq0 + r32) * 768;
#pragma unroll
        for (int d0 = 0; d0 < 4; ++d0) qr[d0] = *(const GAS bf16x8*)(qrow + h * 64 + 16 * d0 + 8 * hi);
#pragma unroll
        for (int d0 = 4; d0 < 6; ++d0) qr[d0] = *(const GAS bf16x8*)(qrow + 512 + h * 32 + 16 * (d0 - 4) + 8 * hi);
        {
            const f32x2* rp = (const f32x2*)(F.ws + WS_ROPE) + ((tq0 + r32) & (S - 1)) * 16 + 8 * hi;
            bf16x8 a4 = qr[4], a5 = qr[5];
#pragma unroll
            for (int j = 0; j < 8; ++j) { const f32x2 cs = rp[j]; const float x = bf2f((unsigned short)a4[j]), y = bf2f((unsigned short)a5[j]);
                a4[j] = (short)f2bf(x * cs.x - y * cs.y); a5[j] = (short)f2bf(y * cs.x + x * cs.y); }
            qr[4] = a4; qr[5] = a5; }
    } else { const bf16_t* qrow = Pb + (size_t)(tq0 + r32) * 1280 + 512 + hq * 64;
#pragma unroll
        for (int d0 = 0; d0 < ND0; ++d0) qr[d0] = *(const GAS bf16x8*)(qrow + 16 * d0 + 8 * hi);
    }
    const bf16_t *ksrc0, *ksrc1 = nullptr, *vsrc; size_t kstride, kstride1 = 0, vstride;
    const int vrow = 16 * (w & 3) + (lane >> 2), vcol = (w >> 2) * 32 + (lane & 3) * 8;
    if (MODE == 0) { ksrc0 = KVb + (size_t)(kbase0 + lane) * 1024 + h * 64 + w * 8; kstride = 64 * 1024;
        ksrc1 = KPE + (size_t)(kbase0 + lane) * 32 + (w & 3) * 8; kstride1 = 64 * 32;
        vsrc = KVb + (size_t)(kbase0 + vrow) * 1024 + 512 + h * 64 + vcol; vstride = 64 * 1024; }
    else { ksrc0 = Pb + (size_t)((long)kbase0 + lane) * 1280 + 1024 + g * 64 + w * 8; kstride = 64 * 1280;
        vsrc = Pb + (size_t)((long)kbase0 + vrow) * 1280 + 1152 + g * 64 + vcol; vstride = 64 * 1280; }
    const bool two_k = (MODE == 0) && (w < 4);
    u32x4 ks0, ks1 = {0u, 0u, 0u, 0u}, vs;
#define ATT_LOAD(j) do { ks0 = *(const GAS u32x4*)(ksrc0 + (size_t)(j) * kstride); if (two_k) ks1 = *(const GAS u32x4*)(ksrc1 + (size_t)(j) * kstride1); vs = *(const GAS u32x4*)(vsrc + (size_t)(j) * vstride); } while (0)
#define ATT_WRITE(bufo) do { *(LAS u32x4*)(lds + (bufo) + w * 1024 + lane * 16) = ks0; if (two_k) *(LAS u32x4*)(lds + (bufo) + (8 + w) * 1024 + lane * 16) = ks1; \
        *(LAS u32x4*)(lds + (bufo) + KBYTES + w * 1024 + lane * 16) = vs; } while (0)
    float m_run, l_run; f32x16 o[2]; o[0] = f32x16{}; o[1] = f32x16{};
    float slope2 = 0.f;
    if (MODE == 1) { m_run = F.in[19][hq] * LOG2E; l_run = (hi == 0) ? 1.f : 0.f; slope2 = exp2f(-(float)(hq + 1)) * LOG2E; }
    else { m_run = -1e30f; l_run = 0.f; }
    ATT_LOAD(j_lo); ATT_WRITE(0); __syncthreads();
    const int voff = KBYTES + ((lane >> 4) & 1) * 32 + (lane & 3) * 8 + (4 * hi + ((lane & 15) >> 2)) * 64;
    for (int j = j_lo; j < j_hi; ++j) {
        const int bo = ((j - j_lo) & 1) * BUF;
        if (j + 1 < j_hi) ATT_LOAD(j + 1);
        f32x16 p0 = f32x16{}, p1 = f32x16{};
        const LAS unsigned char* kb = lds + bo + hi * 1024 + r32 * 16;
#pragma unroll
        for (int d0 = 0; d0 < ND0; ++d0) {
            const bf16x8 b0 = *(const LAS bf16x8*)(kb + d0 * 2048), b1 = *(const LAS bf16x8*)(kb + d0 * 2048 + 512);
            p0 = __builtin_amdgcn_mfma_f32_32x32x16_bf16(b0, qr[d0], p0, 0, 0, 0);
            p1 = __builtin_amdgcn_mfma_f32_32x32x16_bf16(b1, qr[d0], p1, 0, 0, 0);
        }
        if (MODE == 1) {
            const int qp = qpos0 + r32, kp = 128 * ((unit >> 1) & 15) - 128 + 64 * j;
#pragma unroll
            for (int r = 0; r < 16; ++r) { const int k0 = kp + crow(r, hi); int d0_ = qp - k0; d0_ = d0_ < 0 ? -d0_ : d0_; int d1_ = qp - (k0 + 32); d1_ = d1_ < 0 ? -d1_ : d1_;
                p0[r] = (d0_ <= 128) ? p0[r] - slope2 * (float)d0_ : -1e30f; p1[r] = (d1_ <= 128) ? p1[r] - slope2 * (float)d1_ : -1e30f; }
        }
        float pmax = p0[0];
#pragma unroll
        for (int r = 1; r < 16; ++r) pmax = fmaxf(pmax, p0[r]);
#pragma unroll
        for (int r = 0; r < 16; ++r) pmax = fmaxf(pmax, p1[r]);
        pmax = fmaxf(pmax, __shfl_xor(pmax, 32));
        if (!__all(pmax - m_run <= ATT_THR)) {
            const float mn = fmaxf(m_run, pmax), alpha = fast_exp2(m_run - mn); m_run = mn; l_run *= alpha;
            if (hi == 0) wsf[r32] = alpha;
            LDS_WAIT(); asm volatile("" ::: "memory");
#pragma unroll
            for (int r = 0; r < 16; ++r) { const float a = wsf[crow(r, hi)]; o[0][r] *= a; o[1][r] *= a; }
        }
        float ps = 0.f;
#pragma unroll
        for (int r = 0; r < 16; ++r) { p0[r] = fast_exp2(p0[r] - m_run); p1[r] = fast_exp2(p1[r] - m_run); ps += p0[r] + p1[r]; }
        l_run += ps;
        u32x4 pw[4];
        pw[0] = (u32x4){pk2(p0[0], p0[1]), pk2(p0[2], p0[3]), pk2(p0[4], p0[5]), pk2(p0[6], p0[7])};
        pw[1] = (u32x4){pk2(p0[8], p0[9]), pk2(p0[10], p0[11]), pk2(p0[12], p0[13]), pk2(p0[14], p0[15])};
        pw[2] = (u32x4){pk2(p1[0], p1[1]), pk2(p1[2], p1[3]), pk2(p1[4], p1[5]), pk2(p1[6], p1[7])};
        pw[3] = (u32x4){pk2(p1[8], p1[9]), pk2(p1[10], p1[11]), pk2(p1[12], p1[13]), pk2(p1[14], p1[15])};
        const LAS unsigned char* vp = lds + bo + voff;
#pragma unroll
        for (int d0 = 0; d0 < 2; ++d0)
#pragma unroll
            for (int ks = 0; ks < 4; ++ks) {
                const s16x4 vlo = vtr(vp + d0 * 4096 + ks * 1024), vhi = vtr(vp + d0 * 4096 + ks * 1024 + 512);
                const bf16x8 vf = (bf16x8){vlo[0], vlo[1], vlo[2], vlo[3], vhi[0], vhi[1], vhi[2], vhi[3]};
                o[d0] = __builtin_amdgcn_mfma_f32_32x32x16_bf16(__builtin_bit_cast(bf16x8, pw[ks]), vf, o[d0], 0, 0, 0);
            }
        if (j + 1 < j_hi) ATT_WRITE(BUF - bo);
        __syncthreads();
    }
#undef ATT_LOAD
#undef ATT_WRITE
    const float lt = l_run + __shfl_xor(l_run, 32);
    if (hi == 0) wsf[32 + r32] = lt;
    LDS_WAIT(); asm volatile("" ::: "memory");
#pragma unroll
    for (int r = 0; r < 16; ++r) { const int orow = crow(r, hi); const float rl = fast_rcp(wsf[32 + orow]);
        stg[orow * 64 + r32] = (bf16_t)f2bf(o[0][r] * rl); stg[orow * 64 + 32 + r32] = (bf16_t)f2bf(o[1][r] * rl); }
    LDS_WAIT(); asm volatile("" ::: "memory");
    bf16_t* Ow = Ob + (size_t)tq0 * 1024 + ocol;
#pragma unroll
    for (int i = 0; i < 4; ++i) { const int row = i * 8 + (lane >> 3), ch = lane & 7; const u32x4 v = *(const LAS u32x4*)(stg + row * 64 + ch * 8); *(GAS u32x4*)(Ow + (size_t)row * 1024 + ch * 8) = v; }
    __syncthreads();
}
__device__ __forceinline__ void phase_attn(const Frame& F) {
    for (int u = F.vcu; u < 1024; u += F.G) { if (u < 512) attn_unit<0>(F, u); else attn_unit<1>(F, u - 512); }
}
}
namespace mk {
constexpr int N_PHASES = 14;
__global__ void __launch_bounds__(NTHR, 2) fwd_mega(Args args) {
    extern __shared__ __attribute__((aligned(16))) unsigned char lds_raw[];
    Frame F;
    F.lds = (LAS unsigned char*)lds_raw;
    F.tid = threadIdx.x; F.lane = F.tid & 63; F.wave = __builtin_amdgcn_readfirstlane(F.tid >> 6);
    F.G = gridDim.x; { const int bx = blockIdx.x; F.vcu = (F.G % 8 == 0) ? (bx % 8) * (F.G / 8) + bx / 8 : bx; }
    F.in = args.in; F.out = args.out; F.ws = args.ws;
    volatile LAS unsigned* MISC = (volatile LAS unsigned*)(F.lds + MISC_OFF);
    if (F.tid < 64) MISC[F.tid] = 0u;
    __syncthreads();
    unsigned* ctl = (unsigned*)(F.ws + WS_CTL);
    const int lo = args.ph_lo, hi = args.ph_hi;
    XcdBarrier bar; bar.bar = ctl + CW_BAR; bar.x = 0; bar.st = nullptr;
    if (hi - lo > 1) bar = xcd_barrier_post(ctl + CW_BAR, MISC + 8);
#ifndef MK_PHASE_MASK
#define MK_PHASE_MASK 0x3fff
#endif
#define IN(k) (((MK_PHASE_MASK >> (k)) & 1) && lo <= (k) && (k) < hi)
#ifndef MK_DUP_MASK
#define MK_DUP_MASK 0
#endif
#define REP(k) for (int rep_ = 0; rep_ <= ((MK_DUP_MASK >> (k)) & 1); ++rep_)
#define FRESH() do { int t_ = threadIdx.x; asm volatile("" : "+v"(t_)); F.tid = t_; F.lane = t_ & 63; F.wave = __builtin_amdgcn_readfirstlane(t_ >> 6); } while (0)
#define SEAM(k) do { if (IN(k) && IN((k) + 1)) xcd_barrier(bar); } while (0)
    bf16_t* XB = (bf16_t*)(F.ws + WS_XB); bf16_t* MBp = (bf16_t*)(F.ws + WS_MB); bf16_t* Pp = (bf16_t*)(F.ws + WS_P);
    float* RS0 = (float*)(F.ws + WS_RS0);
    const f32x2* rope = (const f32x2*)(F.ws + WS_ROPE);
    const int bid = (int)blockIdx.x;

    if (IN(0)) REP(0) { FRESH(); phase_p0(F); } SEAM(0);
    if (IN(1)) REP(1) { FRESH(); pg8::Gemm g{XB, (const bf16_t*)(F.ws + WS_WINE), T, 2048, 1024, 1024, 1024}; pg8::StaticOrder So; So.init(T, 2048, F.G, bid);
        EpiE1 E{(bf16_t*)F.out, RS0}; pg8::gemm_phase<EpiE1, pg8::StaticOrder, true, true>(F.lds, g, So, E); } SEAM(1);
    if (IN(2)) REP(2) { FRESH(); phase_e2(F); } SEAM(2);
    if (IN(3)) REP(3) { FRESH(); pg8::Gemm g{MBp, (const bf16_t*)(F.ws + WS_WOUTE), T, 1024, 1024, 1024, 1024}; pg8::StaticOrder So; So.init(T, 1024, F.G, bid);
        EpiRes E{F.in[0], F.out, XB}; pg8::gemm_phase<EpiRes, pg8::StaticOrder, true, true>(F.lds, g, So, E); } SEAM(3);
    if (IN(4)) REP(4) { FRESH(); phase_router(F, 0); } SEAM(4);
    if (IN(5)) REP(5) { FRESH(); phase_moe(F, 0); } SEAM(5);
    if (IN(6)) REP(6) { FRESH(); combine_rows<false>(F);
 } SEAM(6);
    if (IN(7)) REP(7) { FRESH(); pg8::Gemm g{XB, (const bf16_t*)(F.ws + WS_WINO), T, 1280, 1024, 1024, 1024}; pg8::StaticOrder So; So.init(T, 1280, F.G, bid);
        EpiO1 E{Pp, RS0, (float*)(F.ws + WS_SSQQ), (float*)(F.ws + WS_SSQKV), (bf16_t*)(F.ws + WS_KPE), rope};
        pg8::gemm_phase<EpiO1, pg8::StaticOrder, true, true>(F.lds, g, So, E);
        if (rep_ == 0 && (F.G != 256 || bid >= 64)) { LAS float* scr = (LAS float*)(F.lds + F.wave * 16384); CvtRegs R;
            const int nw = (F.G == 256) ? 192 * NWAVES : F.G * NWAVES, gw = ((F.G == 256) ? (bid - 64) : bid) * NWAVES + F.wave;
            int it = gw; if (it < MOE_CVT_ITEMS) moe_cvt_load(F, 1, it, R);
            for (; it < MOE_CVT_ITEMS; it += nw) { moe_cvt_stage(F, 1, it, R, scr); if (it + nw < MOE_CVT_ITEMS) moe_cvt_load(F, 1, it + nw, R); moe_cvt_emit(F, it, scr); } } } SEAM(7);
    if (IN(8)) REP(8) { FRESH(); pg8::Gemm g{Pp, (const bf16_t*)(F.ws + WS_WUQ), T, 1792, 256, 1280, 256}; O2Order So; So.init(T, 1792, F.G, bid);
        EpiO2 E{(bf16_t*)(F.ws + WS_Q), (bf16_t*)(F.ws + WS_KV), (const float*)(F.ws + WS_SSQQ), (const float*)(F.ws + WS_SSQKV)};
        pg8::gemm_phase<EpiO2, O2Order, true, true>(F.lds, g, So, E);
    } SEAM(8);
    if (IN(9)) REP(9) { FRESH(); phase_attn(F); } SEAM(9);
    if (IN(10)) REP(10) { FRESH(); pg8::Gemm g{MBp, (const bf16_t*)(F.ws + WS_WOUTO), T, 1024, 1024, 1024, 1024}; pg8::StaticOrder So; So.init(T, 1024, F.G, bid);
        EpiRes E{F.out, F.out, XB}; pg8::gemm_phase<EpiRes, pg8::StaticOrder, true, true>(F.lds, g, So, E); } SEAM(10);
    if (IN(11)) REP(11) { FRESH(); phase_router(F, 1); } SEAM(11);
    if (IN(12)) REP(12) { FRESH(); phase_moe(F, 1); } SEAM(12);
    if (IN(13)) REP(13) { FRESH(); combine_rows<true>(F); }
#undef IN
#undef SEAM
}

static int g_grid = 0;
static bool setup() {
    if (g_grid) return g_grid > 0;
    int dev = 0, cus = 0;
    if (hipGetDevice(&dev) != hipSuccess || hipDeviceGetAttribute(&cus, hipDeviceAttributeMultiprocessorCount, dev) != hipSuccess) { g_grid = -1; return false; }
    if (hipFuncSetAttribute((const void*)fwd_mega, hipFuncAttributeMaxDynamicSharedMemorySize, LDS_BYTES) != hipSuccess) { fprintf(stderr, "hipFuncSetAttribute failed\n"); g_grid = -1; return false; }
    int per_cu = 0;
    if (hipOccupancyMaxActiveBlocksPerMultiprocessor(&per_cu, (const void*)fwd_mega, NTHR, LDS_BYTES) != hipSuccess || per_cu < 1) { fprintf(stderr, "occupancy query: %d\n", per_cu); }
    (void)hipGetLastError();
    g_grid = cus;
    return true;
}
static void launch_range(void* const* d_in, float* out, unsigned char* ws, int lo, int hi, hipStream_t st) {
    Args a{};
    for (int i = 0; i < 28; ++i) a.in[i] = (const float*)d_in[i];
    a.out = out; a.ws = ws; a.ph_lo = lo; a.ph_hi = hi;
    hipLaunchKernelGGL(fwd_mega, dim3(g_grid), dim3(NTHR), LDS_BYTES, st, a);
}
}
extern "C" void kernel_launch(void* const* d_in, const int* in_sizes, int n_in, void* d_out, int out_size, void* d_ws, size_t ws_size, hipStream_t stream) {
    if (n_in != 28 || out_size != mk::T * mk::D || ws_size < mk::WS_END) { fprintf(stderr, "kernel_launch: unexpected shapes n_in %d out %d ws %zu\n", n_in, out_size, ws_size); return; }
    if (!mk::setup()) return;
    if (hipMemsetAsync((unsigned char*)d_ws + mk::WS_CTL, 0, mk::CTL_ZERO_BYTES, stream) != hipSuccess) { fprintf(stderr, "kernel_launch: memset failed\n"); return; }
    mk::launch_range(d_in, (float*)d_out, (unsigned char*)d_ws, 0, mk::N_PHASES, stream);
}
```

```cpp
#define MK_PF1 2
#define MK_PF2 2
#include <hip/hip_runtime.h>
#include <hip/hip_bf16.h>
#include <cstdio>
#include <cstdint>
namespace pg8 {
#define PG8_LAS __attribute__((address_space(3)))
typedef unsigned short bf16_t;
typedef short bf16x8 __attribute__((ext_vector_type(8)));
typedef float f32x4 __attribute__((ext_vector_type(4)));
typedef unsigned u32x4 __attribute__((ext_vector_type(4)));
constexpr int BM = 256, BK = 64, HALF = 128, HTB = HALF * BK * 2  , STAGE_BYTES = 8 * HTB, NXCD = 8, WGM = 8;

__host__ __device__ __forceinline__ int lds_byte(int r, int c) { const int st = (r >> 4) * 2 + (c >> 5), rr = r & 15, cc = c & 31, ob = rr * 64 + cc * 2; return st * 1024 + (ob ^ (((ob >> 9) & 1) << 5)); }
__host__ __device__ __forceinline__ void stage_rc(int b, int& R, int& C) { const int st = b / 1024, sb = b % 1024, swz = sb ^ (((sb >> 9) & 1) << 5); R = (st >> 1) * 16 + swz / 64; C = (st & 1) * 32 + (swz % 64) / 2; }
__host__ __device__ __forceinline__ int perm32(int rho) { const int n = rho >> 4, i = rho & 15; return 8 * (i >> 2) + 4 * n + (i & 3); }

struct Unit { int pm, pn, aoff; };
struct Gemm { const bf16_t* A; const bf16_t* Bt; int M, N, K, lda, ldb; };

struct StaticOrder {
    int nM, nN, nwg, G, c;
    __host__ __device__ void init(int M, int N, int G_, int c_) { nM = M / BM; nN = N / BM; nwg = nM * nN; G = G_; c = c_; }
    __host__ __device__ bool next(int i, Unit& u) const {
        const long L = (long)i * G + c; if (L >= nwg) return false;
        int wgid = (int)L; { const int q = nwg / NXCD, r = nwg % NXCD, xcd = wgid % NXCD, off = wgid / NXCD; wgid = (xcd < r ? xcd * (q + 1) : r * (q + 1) + (xcd - r) * q) + off; }
        const int nig = WGM * nN, gid = wgid / nig, fm = gid * WGM, gsz = (nM - fm) < WGM ? (nM - fm) : WGM;
        u.pm = fm + ((wgid % nig) % gsz); u.pn = (wgid % nig) / gsz; u.aoff = 0; return true;
    }
    __device__ __forceinline__ void a_ready(const Unit&) const {}
    __device__ __forceinline__ void done(const Unit&) const {}
};

__device__ __forceinline__ unsigned cvt_pk_bf16(float lo, float hi) { unsigned r; asm volatile("v_cvt_pk_bf16_f32 %0, %1, %2" : "=v"(r) : "v"(lo), "v"(hi)); return r; }
typedef float f32x2 __attribute__((ext_vector_type(2)));
template <class Epi, class Sched, bool ALIGN_EPI = false, bool SP2 = false>
__device__ __forceinline__ void gemm_phase(PG8_LAS unsigned char* lds, const Gemm g, const Sched& S, const Epi& E) {
    int tid_ = threadIdx.x; asm volatile("" : "+v"(tid_));
    const int tid = tid_, wid = __builtin_amdgcn_readfirstlane(tid >> 6), lane = tid & 63, wr = wid >> 2, wc = wid & 3, fr = lane & 15, fq = lane >> 4;
    const int K = g.K, nt = K / BK;
    unsigned voffA[2], voffB[2];
#pragma unroll
    for (int i = 0; i < 2; ++i) { int R, C; stage_rc(tid * 16 + i * 8192, R, C); const int Rb = Epi::PERM ? ((R & ~31) + perm32(R & 31)) : R;
        voffA[i] = (unsigned)(R * g.lda + C) * 2u; voffB[i] = (unsigned)(Rb * g.ldb + C) * 2u; }
    const size_t kstep = (size_t)(BK * 2);
    const size_t hstepA = (size_t)HALF * g.lda * 2, hstepB = (size_t)HALF * g.ldb * 2;
    const size_t tstepA = 2 * hstepA, tstepB = 2 * hstepB;
    const unsigned ldsw = (unsigned)wid * 1024u;
    const int aoff = lds_byte(wr * 64 + fr, fq * 8), boff = lds_byte(wc * 32 + fr, fq * 8);
#define PG8_SA(b, h) (((b) * 2 + (h)) * HTB)
#define PG8_SB(b, h) ((4 + (b) * 2 + (h)) * HTB)
#define PG8_STAGE(bufoff, gbase, voff) do { _Pragma("unroll") for (int _i = 0; _i < 2; ++_i) \
        __builtin_amdgcn_global_load_lds((const unsigned*)((const char*)(gbase) + (voff)[_i]), (PG8_LAS unsigned*)(lds + (bufoff) + ldsw + _i * 8192), 16, 0, 0); } while (0)
#define PG8_LDA(dst, b, h) do { _Pragma("unroll") for (int m = 0; m < 4; ++m) _Pragma("unroll") for (int k = 0; k < 2; ++k) dst[m][k] = *(const PG8_LAS bf16x8*)(lds + PG8_SA(b, h) + aoff + m * 2048 + k * 1024); } while (0)
#define PG8_LDB(dst, b, h) do { _Pragma("unroll") for (int n = 0; n < 2; ++n) _Pragma("unroll") for (int k = 0; k < 2; ++k) dst[n][k] = *(const PG8_LAS bf16x8*)(lds + PG8_SB(b, h) + boff + n * 2048 + k * 1024); } while (0)
#define PG8_MMA(ai, bj, At, Bt) do { __builtin_amdgcn_s_setprio(1); _Pragma("unroll") for (int m = 0; m < 4; ++m) _Pragma("unroll") for (int n = 0; n < 2; ++n) _Pragma("unroll") for (int k = 0; k < 2; ++k) \
        acc[ai][bj][m][n] = __builtin_amdgcn_mfma_f32_16x16x32_bf16(Bt[n][k], At[m][k], acc[ai][bj][m][n], 0, 0, 0); __builtin_amdgcn_s_setprio(0); } while (0)
#define PG8_WAIT_V(n) asm volatile("s_waitcnt vmcnt(" #n ")" ::: "memory")
#define PG8_WAIT_L(n) asm volatile("s_waitcnt lgkmcnt(" #n ")" ::: "memory")
#define PG8_BAR __builtin_amdgcn_s_barrier()
#define PG8_SCHED __builtin_amdgcn_sched_barrier(0)
    Unit cur, nxt; int ui = 0;
    if (!S.next(0, cur)) return;
    f32x4 acc[2][2][4][2];
#pragma unroll
    for (int a = 0; a < 2; ++a)
#pragma unroll
        for (int b = 0; b < 2; ++b)
#pragma unroll
            for (int m = 0; m < 4; ++m)
#pragma unroll
                for (int n = 0; n < 2; ++n) acc[a][b][m][n] = (f32x4){0.f, 0.f, 0.f, 0.f};
    bf16x8 At[4][2], B0[2][2], B1[2][2];
    const char* cA = (const char*)g.A + (size_t)cur.pm * tstepA + cur.aoff; const char* cB = (const char*)g.Bt + (size_t)cur.pn * tstepB;
    S.a_ready(cur);
    if constexpr (SP2) {
        PG8_STAGE(PG8_SB(0, 0), cB, voffB); PG8_STAGE(PG8_SB(0, 1), cB + hstepB, voffB); PG8_STAGE(PG8_SA(0, 0), cA, voffA); PG8_STAGE(PG8_SA(0, 1), cA + hstepA, voffA);
        if (wr == 1) PG8_BAR;
        PG8_WAIT_V(2); PG8_BAR;
        PG8_STAGE(PG8_SB(1, 0), cB + kstep, voffB); PG8_STAGE(PG8_SA(1, 0), cA + kstep, voffA); PG8_STAGE(PG8_SB(1, 1), cB + hstepB + kstep, voffB);
        PG8_WAIT_V(6); PG8_BAR;
    } else {
        PG8_STAGE(PG8_SB(0, 0), cB, voffB); PG8_STAGE(PG8_SA(0, 0), cA, voffA); PG8_STAGE(PG8_SB(0, 1), cB + hstepB, voffB); PG8_STAGE(PG8_SA(0, 1), cA + hstepA, voffA);
        if (wr == 1) PG8_BAR;
        PG8_WAIT_V(4); PG8_BAR;
        PG8_STAGE(PG8_SB(1, 0), cB + kstep, voffB); PG8_STAGE(PG8_SA(1, 0), cA + kstep, voffA); PG8_STAGE(PG8_SB(1, 1), cB + hstepB + kstep, voffB);
        PG8_WAIT_V(6); PG8_BAR;
    }
    for (;;) {
        const bool has_next = S.next(ui + 1, nxt);
        const char* nA = has_next ? (const char*)g.A + (size_t)nxt.pm * tstepA + nxt.aoff : cA; const char* nB = has_next ? (const char*)g.Bt + (size_t)nxt.pn * tstepB : cB;
        for (int t = 0; t < nt; t += 2) {
            const bool last = (t == nt - 2);
            const char* a1 = cA + (size_t)(t + 1) * kstep;
            const char* a2 = last ? nA : cA + (size_t)(t + 2) * kstep; const char* b2 = last ? nB : cB + (size_t)(t + 2) * kstep;
            const char* a3 = a2 + kstep; const char* b3 = b2 + kstep;
            if (last && has_next) S.a_ready(nxt);
            if constexpr (SP2) {
            PG8_LDB(B0, 0, 0); PG8_LDB(B1, 0, 1); PG8_SCHED; PG8_LDA(At, 0, 0); PG8_STAGE(PG8_SA(1, 1), a1 + hstepA, voffA);
            PG8_WAIT_V(8); PG8_WAIT_L(0); PG8_BAR; PG8_MMA(0, 0, At, B0); PG8_MMA(0, 1, At, B1); PG8_BAR; PG8_SCHED;
            PG8_LDA(At, 0, 1); PG8_STAGE(PG8_SB(0, 0), b2, voffB); PG8_STAGE(PG8_SB(0, 1), b2 + hstepB, voffB); PG8_STAGE(PG8_SA(0, 0), a2, voffA);
            PG8_WAIT_V(8); PG8_WAIT_L(0); PG8_BAR; PG8_MMA(1, 0, At, B0); PG8_MMA(1, 1, At, B1); PG8_BAR; PG8_SCHED;
            PG8_LDB(B0, 1, 0); PG8_LDB(B1, 1, 1); PG8_SCHED; PG8_LDA(At, 1, 0); PG8_STAGE(PG8_SA(0, 1), a2 + hstepA, voffA);
            PG8_WAIT_V(8); PG8_WAIT_L(0); PG8_BAR; PG8_MMA(0, 0, At, B0); PG8_MMA(0, 1, At, B1); PG8_BAR; PG8_SCHED;
            PG8_LDA(At, 1, 1); PG8_STAGE(PG8_SB(1, 0), b3, voffB); PG8_STAGE(PG8_SB(1, 1), b3 + hstepB, voffB); PG8_STAGE(PG8_SA(1, 0), a3, voffA);
            PG8_WAIT_V(8); PG8_WAIT_L(0); PG8_BAR; PG8_MMA(1, 0, At, B0); PG8_MMA(1, 1, At, B1); PG8_BAR; PG8_SCHED;
            } else {
            PG8_LDB(B0, 0, 0); PG8_SCHED; PG8_LDA(At, 0, 0); PG8_STAGE(PG8_SA(1, 1), a1 + hstepA, voffA);
            PG8_WAIT_L(8); PG8_BAR; PG8_WAIT_L(0); PG8_MMA(0, 0, At, B0); PG8_BAR; PG8_SCHED;
            PG8_LDB(B1, 0, 1); PG8_STAGE(PG8_SB(0, 0), b2, voffB);
            PG8_BAR; PG8_WAIT_L(0); PG8_MMA(0, 1, At, B1); PG8_BAR;
            PG8_LDA(At, 0, 1); PG8_STAGE(PG8_SA(0, 0), a2, voffA);
            PG8_BAR; PG8_WAIT_L(0); PG8_MMA(1, 0, At, B0); PG8_BAR; PG8_SCHED;
            PG8_STAGE(PG8_SB(0, 1), b2 + hstepB, voffB);
            PG8_WAIT_V(6); PG8_BAR; PG8_MMA(1, 1, At, B1); PG8_BAR;
            PG8_LDB(B0, 1, 0); PG8_SCHED; PG8_LDA(At, 1, 0); PG8_STAGE(PG8_SA(0, 1), a2 + hstepA, voffA);
            PG8_WAIT_L(8); PG8_BAR; PG8_WAIT_L(0); PG8_MMA(0, 0, At, B0); PG8_BAR; PG8_SCHED;
            PG8_LDB(B1, 1, 1); PG8_STAGE(PG8_SB(1, 0), b3, voffB);
            PG8_BAR; PG8_WAIT_L(0); PG8_MMA(0, 1, At, B1); PG8_BAR;
            PG8_LDA(At, 1, 1); PG8_STAGE(PG8_SA(1, 0), a3, voffA);
            PG8_BAR; PG8_WAIT_L(0); PG8_MMA(1, 0, At, B0); PG8_BAR; PG8_SCHED;
            PG8_STAGE(PG8_SB(1, 1), b3 + hstepB, voffB);
            PG8_WAIT_V(6); PG8_BAR; PG8_MMA(1, 1, At, B1); PG8_BAR;
            }
        }
        if constexpr (ALIGN_EPI) { if (wr == 0) PG8_BAR; }
        if constexpr (!Epi::AFTER_DRAIN) { E(acc, cur, wr, wc, fr, fq); S.done(cur); }
        if (!has_next) break;
#pragma unroll
        for (int a = 0; a < 2; ++a)
#pragma unroll
            for (int b = 0; b < 2; ++b)
#pragma unroll
                for (int m = 0; m < 4; ++m)
#pragma unroll
                    for (int n = 0; n < 2; ++n) acc[a][b][m][n] = (f32x4){0.f, 0.f, 0.f, 0.f};
        cur = nxt; cA = nA; cB = nB; ++ui;
        if constexpr (ALIGN_EPI) { if (wr == 1) PG8_BAR; }
    }
    PG8_WAIT_V(0);
    if constexpr (!ALIGN_EPI) { if (wr == 0) PG8_BAR; }
    PG8_BAR;
    if constexpr (Epi::AFTER_DRAIN) { E.fused(acc, cur, wr, wc, fr, fq, lds, wid, lane); S.done(cur); }
#undef PG8_SA
#undef PG8_SB
#undef PG8_STAGE
#undef PG8_LDA
#undef PG8_LDB
#undef PG8_MMA
#undef PG8_WAIT_V
#undef PG8_WAIT_L
#undef PG8_BAR
#undef PG8_SCHED
}
}
namespace mk {
using pg8::bf16_t; using pg8::bf16x8; using pg8::f32x4; using pg8::u32x4; using pg8::f32x2;
typedef float f32x16 __attribute__((ext_vector_type(16)));
typedef unsigned u32x2 __attribute__((ext_vector_type(2)));
typedef short s16x4 __attribute__((ext_vector_type(4)));
#define GAS __attribute__((address_space(1)))
#define LAS __attribute__((address_space(3)))
typedef GAS unsigned gu32;
#define RLX_AGENT __ATOMIC_RELAXED, __HIP_MEMORY_SCOPE_AGENT
#define LDS_WAIT() asm volatile("s_waitcnt lgkmcnt(0)" ::: "memory")
#define VM_WAIT() asm volatile("s_waitcnt vmcnt(0)" ::: "memory")

constexpr int T = 16384, D = 1024, S = 2048, NB = 8;
constexpr int NWAVES = 8, NTHR = 512;
constexpr float EPS = 1e-6f;
constexpr float LOG2E = 1.4426950408889634f;
constexpr float C2M = 0.10206207261596575f * LOG2E;
constexpr float C2S = 0.125f * LOG2E;

constexpr size_t MiB = (size_t)1 << 20;
constexpr size_t WS_CTL = 0, CTL_ZERO_BYTES = 1 * MiB;
constexpr size_t WS_WINE = 1 * MiB;
constexpr size_t WS_WOUTE = 5 * MiB;
constexpr size_t WS_WINO = 7 * MiB;
constexpr size_t WS_WUQ = 10 * MiB;
constexpr size_t WS_WUKV = 10 * MiB + 393216;
constexpr size_t WS_WOUTO = 11 * MiB;
constexpr size_t WS_ROUTER = 13 * MiB;
constexpr size_t WS_ROPE = 14 * MiB;
constexpr size_t WS_RS0 = 14 * MiB + 512 * 1024;
constexpr size_t WS_RSM = WS_RS0 + 64 * 1024;
constexpr size_t WS_SSQQ = 15 * MiB;
constexpr size_t WS_SSQKV = 15 * MiB + 256 * 1024;
constexpr size_t WS_WMOE = 16 * MiB;
constexpr size_t WS_XB = 64 * MiB;
constexpr size_t WS_MB = 96 * MiB;
constexpr size_t WS_Y = 128 * MiB;
constexpr size_t WS_Q = 128 * MiB;
constexpr size_t WS_KV = 152 * MiB;
constexpr size_t WS_P = 192 * MiB;
constexpr size_t WS_LSLOT = 232 * MiB;
constexpr size_t WS_LGW = 234 * MiB;
constexpr size_t WS_KPE = 236 * MiB;
constexpr size_t WS_END = 240 * MiB;
constexpr size_t W1_EXP = 524288, W2_EXP = 262144;

constexpr int CW_TMO = 0;
constexpr int CW_BAR = 4096;
constexpr int CW_CVT = 8192;
constexpr int CW_ECNT = 16384;

constexpr int LDS_BYTES = 160 * 1024;
constexpr int RING_BYTES = 131072;
constexpr int MISC_OFF = 159 * 1024;

__device__ __forceinline__ unsigned f2bf(float f) { unsigned u = __builtin_bit_cast(unsigned, f); return (u + 0x7fffu + ((u >> 16) & 1u)) >> 16; }
__device__ __forceinline__ float bf2f(unsigned h) { return __builtin_bit_cast(float, h << 16); }
__device__ __forceinline__ unsigned pk2(float lo, float hi) { return pg8::cvt_pk_bf16(lo, hi); }
__device__ __forceinline__ float wave_sum(float v) {
#pragma unroll
    for (int o = 1; o < 64; o <<= 1) v += __shfl_xor(v, o);
    return v;
}
__device__ __forceinline__ float fast_exp2(float x) { return __builtin_amdgcn_exp2f(x); }
__device__ __forceinline__ float fast_rcp(float x) { return __builtin_amdgcn_rcpf(x); }
__device__ __forceinline__ float sigmoid_f(float x) { return fast_rcp(1.f + fast_exp2(-x * LOG2E)); }
__device__ __forceinline__ float silu_f(float x) { return x * sigmoid_f(x); }
__device__ __forceinline__ float gelu_f(float x) { const float u = 0.7978845608028654f * (x + 0.044715f * x * x * x); return x * sigmoid_f(2.f * u); }

#define XB_TMO      128
#define XB_XCNT(j)  (256  + 64 * (j))
#define XB_XSUB(j)  (1280 + 64 * (j))
#define XB_XGEN(j)  (2304 + 64 * (j))
#define XB_TOP      3328
#define XB_TOPGEN   3392
#define XCD_BAR_WORDS 3456
#define XB_SPIN_CAP (1u << 18)
__device__ __forceinline__ unsigned xb_ld(unsigned* p)              { return __hip_atomic_load(p, __ATOMIC_RELAXED, __HIP_MEMORY_SCOPE_AGENT); }
__device__ __forceinline__ unsigned xb_add(unsigned* p, unsigned v) { return __hip_atomic_fetch_add(p, v, __ATOMIC_RELAXED, __HIP_MEMORY_SCOPE_AGENT); }
__device__ __forceinline__ unsigned xb_xcc_id() { return (unsigned)__builtin_amdgcn_s_getreg((3 << 11) | 20) & 0xFu; }
#define XB_SPIN(cond, bar) do { unsigned _sp = 0; while (cond) { __builtin_amdgcn_s_sleep(1); \
    if ((++_sp & 255u) == 0u) { if (xb_ld(&(bar)[XB_TMO])) break; if (_sp > XB_SPIN_CAP) { atomicAdd(&(bar)[XB_TMO], 1u); break; } } } } while (0)
struct XcdBarrier { unsigned* bar; unsigned x; volatile LAS unsigned* st; };
__device__ __forceinline__ XcdBarrier xcd_barrier_post(unsigned* bar, volatile LAS unsigned* st) {
    XcdBarrier b; b.bar = bar; b.x = xb_xcc_id(); b.st = st;
    if (threadIdx.x == 0) (void)xb_add(&bar[XB_XCNT(b.x)], 1u);
    return b;
}
__device__ __forceinline__ void xcd_barrier_complete(unsigned* bar, unsigned x, unsigned& nloc, unsigned& nx) {
    const unsigned G = gridDim.x * gridDim.y * gridDim.z;
    unsigned sum, cnt, mine, sp = 0u;
    for (;;) {
        sum = 0u; cnt = 0u; mine = 0u;
#pragma unroll
        for (unsigned j = 0; j < 16; ++j) { const unsigned c = xb_ld(&bar[XB_XCNT(j)]); sum += c; cnt += (c > 0u) ? 1u : 0u; mine = (j == x) ? c : mine; }
        if (sum == G) break;
        __builtin_amdgcn_s_sleep(1);
        if ((++sp & 255u) == 0u) { if (xb_ld(&bar[XB_TMO])) break; if (sp > XB_SPIN_CAP) { atomicAdd(&bar[XB_TMO], 1u); break; } }
    }
    nloc = mine > 0u ? mine : 1u; nx = cnt > 0u ? cnt : 1u;
}
__device__ __forceinline__ void xcd_barrier(const XcdBarrier& b) {
    asm volatile("s_waitcnt vmcnt(0)" ::: "memory");
    __syncthreads();
    if (threadIdx.x == 0) {
        unsigned* bar = b.bar;
        __builtin_amdgcn_s_waitcnt(0);
        unsigned nloc = b.st[0], nx = b.st[1];
        if (nloc == 0u) { xcd_barrier_complete(bar, b.x, nloc, nx); b.st[0] = nloc; b.st[1] = nx; }
        const unsigned old = xb_add(&bar[XB_XSUB(b.x)], 1u);
        const unsigned gen = old / nloc;
        if (old + 1u == (gen + 1u) * nloc) {
            __builtin_amdgcn_fence(__ATOMIC_RELEASE, "agent");
            asm volatile("s_waitcnt vmcnt(0)" ::: "memory");
            const unsigned og = xb_add(&bar[XB_TOP], 1u);
            const unsigned tg = og / nx;
            if (og + 1u == (tg + 1u) * nx) xb_add(&bar[XB_TOPGEN], 1u);
            else XB_SPIN(xb_ld(&bar[XB_TOPGEN]) == tg, bar);
            __builtin_amdgcn_fence(__ATOMIC_ACQUIRE, "agent");
            xb_add(&bar[XB_XGEN(b.x)], 1u);
            asm volatile("s_waitcnt vmcnt(0)" ::: "memory");
        } else {
            XB_SPIN(xb_ld(&bar[XB_XGEN(b.x)]) == gen, bar);
            __builtin_amdgcn_fence(__ATOMIC_ACQUIRE, "agent");
            asm volatile("s_waitcnt vmcnt(0)" ::: "memory");
        }
    }
    __syncthreads();
}

struct Args { const float* in[28]; float* out; unsigned char* ws; int ph_lo, ph_hi; };

struct Frame {
    LAS unsigned char* lds;
    int tid, lane, wave, vcu, G;
    const float* const* in;
    float* out; unsigned char* ws;
};
}
namespace mk {
__device__ __forceinline__ void p0_transpose_item(const float* W, int ldn, int k0, int src_n0, bf16_t* WT, int ldk, int dst_n0,
                                                  const float* gain, float scale, LAS float* scr, int lane) {
    if (src_n0 >= 0) {
#pragma unroll 8
        for (int i = 0; i < 32; ++i) { const int kk = 2 * i + (lane >> 5);
            float v = W[(size_t)(k0 + kk) * ldn + src_n0 + (lane & 31)] * scale; if (gain) v *= gain[k0 + kk];
            scr[kk * 33 + (lane & 31)] = v; }
    } else {
#pragma unroll 8
        for (int i = 0; i < 32; ++i) { const int kk = 2 * i + (lane >> 5); scr[kk * 33 + (lane & 31)] = 0.f; }
    }
    LDS_WAIT(); asm volatile("" ::: "memory");
    const int c = lane & 7;
#pragma unroll
    for (int j = 0; j < 4; ++j) { const int n = (lane >> 3) + 8 * j; const LAS float* s = scr + (8 * c) * 33 + n;
        u32x4 o; o.x = pk2(s[0 * 33], s[1 * 33]); o.y = pk2(s[2 * 33], s[3 * 33]); o.z = pk2(s[4 * 33], s[5 * 33]); o.w = pk2(s[6 * 33], s[7 * 33]);
        *(GAS u32x4*)(WT + (size_t)(dst_n0 + n) * ldk + k0 + 8 * c) = o; }
    LDS_WAIT(); asm volatile("" ::: "memory");
}
template <bool STAGE2>
__device__ __forceinline__ void moe_cvt_tile(const float* src, int ld, const float* gain16, bf16_t* dst0, size_t piece_stride  , LAS float* scr, int lane) {
#pragma unroll 4
    for (int i = 0; i < 16; ++i) { f32x4 v = *(const GAS f32x4*)(src + (size_t)i * ld + 4 * lane); if (gain16) v = v * gain16[i]; *(LAS f32x4*)(scr + i * 256 + 4 * lane) = v; }
    LDS_WAIT(); asm volatile("" ::: "memory");
    const int r = lane & 31, h = lane >> 5;
#pragma unroll
    for (int c = 0; c < 8; ++c) {
        float v[8];
#pragma unroll
        for (int j = 0; j < 8; ++j) { const int row = STAGE2 ? (8 * (j >> 2) + 4 * h + (j & 3)) : (8 * h + j); v[j] = scr[row * 256 + 32 * c + r]; }
        u32x4 o; o.x = pk2(v[0], v[1]); o.y = pk2(v[2], v[3]); o.z = pk2(v[4], v[5]); o.w = pk2(v[6], v[7]);
        *(GAS u32x4*)(dst0 + (size_t)c * piece_stride + (size_t)lane * 8) = o;
    }
    LDS_WAIT(); asm volatile("" ::: "memory");
}
constexpr int MOE_CVT_ITEMS = 6144;
struct CvtRegs { f32x4 v[16]; };
__device__ __forceinline__ void moe_cvt_load(const Frame& F, int layer, int it, CvtRegs& R) {
    const float* src; int ld;
    if (it < 4096) { const int gu = it >> 11, r = it & 2047, e = r >> 6, ks = r & 63; src = (gu ? F.in[26] : F.in[25]) + ((size_t)(layer * 32 + e) * 1024 + 16 * ks) * 256; ld = 256; }
    else { const int r = it - 4096, e = r >> 6, kk = (r >> 2) & 15, dq = r & 3; src = F.in[27] + ((size_t)(layer * 32 + e) * 256 + 16 * kk) * 1024 + 256 * dq; ld = 1024; }
#pragma unroll
    for (int i = 0; i < 16; ++i) R.v[i] = *(const GAS f32x4*)(src + (size_t)i * ld + 4 * F.lane);
}
__device__ __forceinline__ void moe_cvt_stage(const Frame& F, int layer, int it, const CvtRegs& R, LAS float* scr) {
    if (it < 4096) { const int ks = it & 63; const float* gain = F.in[2] + layer * 1024 + 16 * ks;
#pragma unroll
        for (int i = 0; i < 16; ++i) *(LAS f32x4*)(scr + i * 256 + 4 * F.lane) = R.v[i] * gain[i];
    } else {
#pragma unroll
        for (int i = 0; i < 16; ++i) *(LAS f32x4*)(scr + i * 256 + 4 * F.lane) = R.v[i];
    }
    LDS_WAIT(); asm volatile("" ::: "memory");
}
__device__ __forceinline__ void moe_cvt_emit(const Frame& F, int it, LAS float* scr) {
    bf16_t* W1 = (bf16_t*)(F.ws + WS_WMOE); bf16_t* W2 = W1 + 32 * W1_EXP;
    const int rr = F.lane & 31, h = F.lane >> 5;
    const bool s2 = it >= 4096;
    bf16_t* base; size_t st_c2, st_dt;
    if (!s2) { const int gu = it >> 11, r = it & 2047, e = r >> 6, ks = r & 63; base = W1 + (size_t)e * W1_EXP + ((size_t)ks * 2 + gu) * 512; st_c2 = 2 * 65536; st_dt = 65536; }
    else { const int r = it - 4096, e = r >> 6, kk = (r >> 2) & 15, dq = r & 3; const int p = dq >> 1, w0 = (dq & 1) * 4;
        base = W2 + (size_t)e * W2_EXP + ((size_t)(p * 8 + w0) * 16 + kk) * 1024; st_c2 = 16 * 1024; st_dt = 512; }
#pragma unroll
    for (int c = 0; c < 8; ++c) {
        float v[8];
#pragma unroll
        for (int j = 0; j < 8; ++j) { const int row = s2 ? (8 * (j >> 2) + 4 * h + (j & 3)) : (8 * h + j); v[j] = scr[row * 256 + 32 * c + rr]; }
        u32x4 o; o.x = pk2(v[0], v[1]); o.y = pk2(v[2], v[3]); o.z = pk2(v[4], v[5]); o.w = pk2(v[6], v[7]);
        *(GAS u32x4*)(base + (size_t)(c >> 1) * st_c2 + (size_t)(c & 1) * st_dt + (size_t)F.lane * 8) = o;
    }
    LDS_WAIT(); asm volatile("" ::: "memory");
}
__device__ __forceinline__ void row_to_bf16_rs(const float* xrow, bf16_t* orow, float* rs, int lane) {
    const GAS f32x4* xr = (const GAS f32x4*)xrow + lane;
    f32x4 v[4]; float s = 0.f;
#pragma unroll
    for (int j = 0; j < 4; ++j) { v[j] = xr[64 * j]; s += (v[j].x * v[j].x + v[j].y * v[j].y) + (v[j].z * v[j].z + v[j].w * v[j].w); }
    s = wave_sum(s);
    GAS u32x2* o8 = (GAS u32x2*)orow + lane;
#pragma unroll
    for (int j = 0; j < 4; ++j) { u32x2 w; w.x = pk2(v[j].x, v[j].y); w.y = pk2(v[j].z, v[j].w); o8[64 * j] = w; }
    if (lane == 0) *rs = 1.0f / sqrtf(s * (1.f / 1024.f) + EPS);
}

struct DenseDesc { int src_idx, K, ldn, nblk, ldk; size_t dst; int kind; };
__device__ __forceinline__ void p0_dense_item(const Frame& F, int it, LAS float* scr) {
    int r = it;
    if (r < 1024) { const int kb = r >> 6, nb = r & 63; const int n = 32 * nb; int src;
        if (n < 1024) { const int j = n >> 8, c = n & 255; src = (c < 128) ? (128 * j + c) : (512 + 128 * j + (c - 128)); } else src = n;
        p0_transpose_item(F.in[4], 2048, 64 * kb, src, (bf16_t*)(F.ws + WS_WINE), 1024, n, F.in[1], 1.f, scr, F.lane); return; } r -= 1024;
    if (r < 512) { const int kb = r >> 5, nb = r & 31;
        p0_transpose_item(F.in[13], 1024, 64 * kb, 32 * nb, (bf16_t*)(F.ws + WS_WOUTE), 1024, 32 * nb, nullptr, 1.f, scr, F.lane); return; } r -= 512;
    if (r < 640) { const int kb = r / 40, nb = r % 40; const int n = 32 * nb; int src; float sc = 1.f;
        if (n < 416) src = n; else if (n < 512) src = -1; else if (n < 1024) { src = 416 + (n - 512); sc = C2S; } else if (n < 1152) src = 928 + (n - 1024); else src = 1056 + (n - 1152);
        p0_transpose_item(F.in[14], 1184, 64 * kb, src, (bf16_t*)(F.ws + WS_WINO), 1024, n, F.in[1] + 1024, sc, scr, F.lane); return; } r -= 640;
    if (r < 96) { const int kb = r / 24, nb = r % 24; const int n = 32 * nb; int src;
        if (n < 512) src = 96 * (n >> 6) + (n & 63); else src = 96 * ((n - 512) >> 5) + 64;
        p0_transpose_item(F.in[16], 768, 64 * kb, src, (bf16_t*)(F.ws + WS_WUQ), 256, n, F.in[15], C2M, scr, F.lane); return; } r -= 96;
    if (r < 128) { const int kb = r >> 5, nb = r & 31; const int n = 32 * nb; int src;
        if (n < 512) src = 128 * (n >> 6) + (n & 63); else src = 128 * ((n - 512) >> 6) + 64 + ((n - 512) & 63);
        if (kb >= 2) src = -1;
        p0_transpose_item(F.in[18], 1024, kb >= 2 ? 0 : 64 * kb, src, (bf16_t*)(F.ws + WS_WUKV) + (kb >= 2 ? 64 * kb : 0), 256, n, F.in[17], 1.f, scr, F.lane); return; } r -= 128;
    { const int kb = r >> 5, nb = r & 31;
        p0_transpose_item(F.in[20], 1024, 64 * kb, 32 * nb, (bf16_t*)(F.ws + WS_WOUTO), 1024, 32 * nb, nullptr, 1.f, scr, F.lane); }
}
constexpr int DENSE_ITEMS = 2912;

__device__ __forceinline__ void phase_p0(const Frame& F) {
    LAS float* scr = (LAS float*)(F.lds + F.wave * 16384);
    const int gw = F.vcu * NWAVES + F.wave, NGW = F.G * NWAVES;
    { CvtRegs R; int it = gw; if (it < MOE_CVT_ITEMS) moe_cvt_load(F, 0, it, R);
      for (; it < MOE_CVT_ITEMS; it += NGW) { moe_cvt_stage(F, 0, it, R, scr); if (it + NGW < MOE_CVT_ITEMS) moe_cvt_load(F, 0, it + NGW, R); moe_cvt_emit(F, it, scr); } }
    for (int it = gw; it < DENSE_ITEMS; it += NGW) p0_dense_item(F, it, scr);
    for (int m = gw; m < T; m += NGW) row_to_bf16_rs(F.in[0] + (size_t)m * D, (bf16_t*)(F.ws + WS_XB) + (size_t)m * D, (float*)(F.ws + WS_RS0) + m, F.lane);
    const int gt = gw * 64 + F.lane, NGT = NGW * 64;
    for (int idx = gt; idx < 2 * 49152; idx += NGT) {
        const int layer = idx / 49152, li = idx % 49152;
        const int j = li & 7, ln = (li >> 3) & 63, blk = li >> 9, ct = blk % 3, ks = (blk / 3) & 3, w = blk / 12;
        const int k = 128 * w + 32 * ks + 8 * (ln >> 4) + j, col = 16 * ct + (ln & 15);
        float v = 0.f;
        if (col < 4) v = F.in[21][((size_t)layer * 1024 + k) * 4 + col];
        else if (col < 36) v = F.in[23][(((size_t)layer * 4 + ((col - 4) >> 3)) * 1024 + k) * 8 + ((col - 4) & 7)];
        v *= F.in[2][layer * 1024 + k];
        const unsigned hi = f2bf(v); const unsigned lo = f2bf(v - bf2f(hi));
        bf16_t* R = (bf16_t*)(F.ws + WS_ROUTER);
        R[(size_t)(layer * 2 + 0) * 49152 + li] = (bf16_t)hi;
        R[(size_t)(layer * 2 + 1) * 49152 + li] = (bf16_t)lo;
    }
    for (int idx = gt; idx < S * 16; idx += NGT) {
        const int pos = idx >> 4, j = idx & 15;
        const double inv = pow(10000.0, -(double)(2 * j) / 32.0), ang = (double)pos * inv;
        f32x2 cs; cs.x = (float)cos(ang); cs.y = (float)sin(ang);
        ((f32x2*)(F.ws + WS_ROPE))[idx] = cs;
    }
}
}
namespace mk {
using pg8::Unit;
__device__ __forceinline__ u32x4 pack8(const f32x4& a, const f32x4& b) { u32x4 w; w.x = pk2(a[0], a[1]); w.y = pk2(a[2], a[3]); w.z = pk2(b[0], b[1]); w.w = pk2(b[2], b[3]); return w; }

struct EpiE1 {
    static constexpr bool PERM = true, AFTER_DRAIN = false;
    bf16_t* ACT; const float* rs;
    __device__ __forceinline__ void operator()(const f32x4 (&acc)[2][2][4][2], const Unit& u, int wr, int wc, int fr, int fq) const {
        const int row0 = u.pm * 256 + wr * 64 + fr, cl = wc * 32 + 8 * fq;
        float rsv[2][4];
#pragma unroll
        for (int ai = 0; ai < 2; ++ai)
#pragma unroll
            for (int m = 0; m < 4; ++m) rsv[ai][m] = rs[row0 + ai * 128 + m * 16];
#pragma unroll
        for (int ai = 0; ai < 2; ++ai)
#pragma unroll
            for (int m = 0; m < 4; ++m) {
                const int row = row0 + ai * 128 + m * 16; const float r = rsv[ai][m]; bf16_t* rowp = ACT + (size_t)row * 1536;
                if (u.pn < 4) {
                    f32x4 o0, o1;
#pragma unroll
                    for (int i = 0; i < 4; ++i) { o0[i] = acc[ai][0][m][0][i] * r * sigmoid_f(acc[ai][1][m][0][i] * r); o1[i] = acc[ai][0][m][1][i] * r * sigmoid_f(acc[ai][1][m][1][i] * r); }
                    *(u32x4*)(rowp + 128 * u.pn + cl) = pack8(o0, o1);
                } else {
                    const int base = (u.pn < 6) ? (512 + (u.pn - 4) * 256) : (1024 + (u.pn - 6) * 256);
#pragma unroll
                    for (int bj = 0; bj < 2; ++bj) { f32x4 o0, o1;
#pragma unroll
                        for (int i = 0; i < 4; ++i) { o0[i] = gelu_f(acc[ai][bj][m][0][i] * r); o1[i] = gelu_f(acc[ai][bj][m][1][i] * r); }
                        *(u32x4*)(rowp + base + bj * 128 + cl) = pack8(o0, o1); }
                }
            }
    }
};
struct EpiRes {
    static constexpr bool PERM = true, AFTER_DRAIN = false;
    const float* resid; float* out; bf16_t* xb;
    __device__ __forceinline__ void operator()(const f32x4 (&acc)[2][2][4][2], const Unit& u, int wr, int wc, int fr, int fq) const {
        const int row0 = u.pm * 256 + wr * 64 + fr, col0 = u.pn * 256 + wc * 32 + 8 * fq;
#pragma unroll
        for (int ai = 0; ai < 2; ++ai) {
            f32x4 rv[4][2][2];
#pragma unroll
            for (int m = 0; m < 4; ++m) { const size_t off = (size_t)(row0 + ai * 128 + m * 16) * 1024 + col0;
#pragma unroll
                for (int bj = 0; bj < 2; ++bj) { rv[m][bj][0] = *(const f32x4*)(resid + off + bj * 128); rv[m][bj][1] = *(const f32x4*)(resid + off + bj * 128 + 4); } }
            asm volatile("" ::: "memory");
#pragma unroll
            for (int m = 0; m < 4; ++m) {
                const size_t off = (size_t)(row0 + ai * 128 + m * 16) * 1024 + col0;
#pragma unroll
                for (int bj = 0; bj < 2; ++bj) {
                    const f32x4 v0 = acc[ai][bj][m][0] + rv[m][bj][0], v1 = acc[ai][bj][m][1] + rv[m][bj][1];
                    *(f32x4*)(out + off + bj * 128) = v0; *(f32x4*)(out + off + bj * 128 + 4) = v1;
                    *(u32x4*)(xb + off + bj * 128) = pack8(v0, v1);
                }
            }
            asm volatile("" ::: "memory");
        }
    }
};
struct EpiO1 {
    static constexpr bool PERM = true, AFTER_DRAIN = false;
    bf16_t* P; const float* rs; float* ssqq; float* ssqkv; bf16_t* kpe; const f32x2* rope;
    __device__ __forceinline__ void operator()(const f32x4 (&acc)[2][2][4][2], const Unit& u, int wr, int wc, int fr, int fq) const {
        const int row0 = u.pm * 256 + wr * 64 + fr, cl = wc * 32 + 8 * fq;
        float rsv[2][4];
#pragma unroll
        for (int ai = 0; ai < 2; ++ai)
#pragma unroll
            for (int m = 0; m < 4; ++m) rsv[ai][m] = rs[row0 + ai * 128 + m * 16];
#pragma unroll
        for (int ai = 0; ai < 2; ++ai)
#pragma unroll
            for (int m = 0; m < 4; ++m) {
                const int row = row0 + ai * 128 + m * 16; const float r = rsv[ai][m]; bf16_t* rowp = P + (size_t)row * 1280 + u.pn * 256 + cl;
                f32x4 v[2][2];
#pragma unroll
                for (int bj = 0; bj < 2; ++bj) { v[bj][0] = acc[ai][bj][m][0] * r; v[bj][1] = acc[ai][bj][m][1] * r; *(u32x4*)(rowp + bj * 128) = pack8(v[bj][0], v[bj][1]); }
                if (u.pn <= 1) {
                    float s = 0.f;
#pragma unroll
                    for (int i = 0; i < 4; ++i) { s += v[0][0][i] * v[0][0][i] + v[0][1][i] * v[0][1][i]; if (u.pn == 0) s += v[1][0][i] * v[1][0][i] + v[1][1][i] * v[1][1][i]; }
                    s += __shfl_xor(s, 16); s += __shfl_xor(s, 32);
                    if (fq == 0) (u.pn == 0 ? ssqq : ssqkv)[(size_t)row * 4 + wc] = s;
                }
                if (u.pn == 1 && wc == 0) {
                    const int pos = row & (S - 1); f32x4 o[2];
#pragma unroll
                    for (int n = 0; n < 2; ++n)
#pragma unroll
                        for (int i = 0; i < 4; ++i) { const float x = v[1][n][i], y = __shfl_xor(x, 32); const f32x2 cs = rope[pos * 16 + ((8 * fq + 4 * n + i) & 15)];
                            o[n][i] = (fq < 2) ? (x * cs.x - y * cs.y) : (x * cs.x + y * cs.y); }
                    *(u32x4*)(kpe + (size_t)row * 32 + 8 * fq) = pack8(o[0], o[1]);
                }
                asm volatile("" ::: "memory");
            }
    }
};
struct O2Order : pg8::StaticOrder {
    __device__ bool next(int i, Unit& u) const { const bool ok = pg8::StaticOrder::next(i, u); if (ok) u.aoff = (u.pn >= 3) ? 512 : 0; return ok; }
};
struct EpiO2 {
    static constexpr bool PERM = true, AFTER_DRAIN = false;
    bf16_t* Q; bf16_t* KV; const float* ssqq; const float* ssqkv;
    __device__ __forceinline__ void operator()(const f32x4 (&acc)[2][2][4][2], const Unit& u, int wr, int wc, int fr, int fq) const {
        const int row0 = u.pm * 256 + wr * 64 + fr, cl = wc * 32 + 8 * fq;
        const bool isq = u.pn < 3; const float* ssq = isq ? ssqq : ssqkv; const float inv_n = isq ? (1.f / 256.f) : (1.f / 128.f);
        bf16_t* O = isq ? (Q + u.pn * 256 + cl) : (KV + (u.pn - 3) * 256 + cl); const int ldo = isq ? 768 : 1024;
        f32x4 sqv[2][4];
#pragma unroll
        for (int ai = 0; ai < 2; ++ai)
#pragma unroll
            for (int m = 0; m < 4; ++m) sqv[ai][m] = *(const f32x4*)(ssq + (size_t)(row0 + ai * 128 + m * 16) * 4);
#pragma unroll
        for (int ai = 0; ai < 2; ++ai)
#pragma unroll
            for (int m = 0; m < 4; ++m) {
                const int row = row0 + ai * 128 + m * 16; const f32x4 sq = sqv[ai][m];
                const float r = __builtin_amdgcn_rsqf(((sq[0] + sq[1]) + (sq[2] + sq[3])) * inv_n + EPS);
                bf16_t* rowp = O + (size_t)row * ldo;
#pragma unroll
                for (int bj = 0; bj < 2; ++bj) *(u32x4*)(rowp + bj * 128) = pack8(acc[ai][bj][m][0] * r, acc[ai][bj][m][1] * r);
                asm volatile("" ::: "memory");
            }
    }
};
}
namespace mk {
__device__ __forceinline__ void e2_conv_unit(const Frame& F, int tt, int grp, const bf16_t* ACT, bf16_t* MBo) {
    LAS bf16_t* tile = (LAS bf16_t*)F.lds;
    const int t0 = tt * 128, s0 = t0 & (S - 1);
    for (int idx = F.tid; idx < 158 * 16; idx += NTHR) { const int r = idx >> 4, c = idx & 15; const int sp = s0 + r - 15;
        u32x4 v = {0u, 0u, 0u, 0u};
        if (sp >= 0 && sp < S) v = *(const GAS u32x4*)(ACT + (size_t)(t0 + r - 15) * 1536 + grp * 128 + c * 8);
        *(LAS u32x4*)(tile + r * 128 + c * 8) = v; }
    __syncthreads();
    const int ch = grp * 128 + 2 * F.lane;
    const float* cw = F.in[5]; float w0[31], w1[31];
#pragma unroll
    for (int q = 0; q < 31; ++q) { const f32x2 wv = *(const f32x2*)(cw + q * 512 + ch); w0[q] = wv.x; w1[q] = wv.y; }
    const f32x2 bias = *(const f32x2*)(F.in[6] + ch);
    float a0[16], a1[16];
#pragma unroll
    for (int k = 0; k < 16; ++k) { a0[k] = bias.x; a1[k] = bias.y; }
    const LAS unsigned* src = (const LAS unsigned*)(tile + (16 * F.wave) * 128 + 2 * F.lane);
#pragma unroll
    for (int i = 0; i < 46; ++i) { const unsigned x = src[i * 64]; const float x0 = bf2f(x & 0xffffu), x1 = bf2f(x >> 16);
#pragma unroll
        for (int k = 0; k < 16; ++k) { const int q = i - k; if (q >= 0 && q <= 30) { a0[k] = fmaf(x0, w0[q], a0[k]); a1[k] = fmaf(x1, w1[q], a1[k]); } } }
    const f32x2 g = *(const f32x2*)(F.in[7] + ch), bt = *(const f32x2*)(F.in[8] + ch);
    LAS float* scr = (LAS float*)(F.lds + 49152) + F.wave * 32;
    const bool b5 = (F.lane & 32) != 0, b4 = (F.lane & 16) != 0, b3 = (F.lane & 8) != 0, b2 = (F.lane & 4) != 0;
    const int tk = (b5 ? 8 : 0) + (b4 ? 4 : 0) + (b3 ? 2 : 0) + (b2 ? 1 : 0);
#define E2_BFLY(S, OUT) do { float v8_[8], v4_[4], v2_[2]; \
        _Pragma("unroll") for (int k = 0; k < 8; ++k) { const float kp = b5 ? S[k + 8] : S[k], sd = b5 ? S[k] : S[k + 8]; v8_[k] = kp + __shfl_xor(sd, 32); } \
        _Pragma("unroll") for (int k = 0; k < 4; ++k) { const float kp = b4 ? v8_[k + 4] : v8_[k], sd = b4 ? v8_[k] : v8_[k + 4]; v4_[k] = kp + __shfl_xor(sd, 16); } \
        _Pragma("unroll") for (int k = 0; k < 2; ++k) { const float kp = b3 ? v4_[k + 2] : v4_[k], sd = b3 ? v4_[k] : v4_[k + 2]; v2_[k] = kp + __shfl_xor(sd, 8); } \
        { const float kp = b2 ? v2_[1] : v2_[0], sd = b2 ? v2_[0] : v2_[1]; OUT = kp + __shfl_xor(sd, 4); } \
        OUT += __shfl_xor(OUT, 2); OUT += __shfl_xor(OUT, 1); } while (0)
    float st[16], tot;
#pragma unroll
    for (int k = 0; k < 16; ++k) st[k] = a0[k] + a1[k];
    E2_BFLY(st, tot);
    if ((F.lane & 3) == 0) scr[tk] = tot * (1.f / 128.f);
    LDS_WAIT(); asm volatile("" ::: "memory");
    float mu[16];
#pragma unroll
    for (int k4 = 0; k4 < 4; ++k4) { const f32x4 m4 = *(const LAS f32x4*)(scr + 4 * k4); mu[4 * k4] = m4.x; mu[4 * k4 + 1] = m4.y; mu[4 * k4 + 2] = m4.z; mu[4 * k4 + 3] = m4.w; }
#pragma unroll
    for (int k = 0; k < 16; ++k) { a0[k] -= mu[k]; a1[k] -= mu[k]; st[k] = a0[k] * a0[k] + a1[k] * a1[k]; }
    E2_BFLY(st, tot);
    if ((F.lane & 3) == 0) scr[16 + tk] = 1.0f / sqrtf(tot * (1.f / 128.f) + EPS);
    LDS_WAIT(); asm volatile("" ::: "memory");
#undef E2_BFLY
#pragma unroll
    for (int k4 = 0; k4 < 4; ++k4) { const f32x4 r4 = *(const LAS f32x4*)(scr + 16 + 4 * k4);
#pragma unroll
        for (int i = 0; i < 4; ++i) { const int k = 4 * k4 + i; const float rs = r4[i];
            const float y0 = silu_f(a0[k] * rs * g.x + bt.x), y1 = silu_f(a1[k] * rs * g.y + bt.y);
            *(GAS unsigned*)(MBo + (size_t)(t0 + 16 * F.wave + k) * 1024 + ch) = pk2(y0, y1); } }
    __syncthreads();
}
__device__ __forceinline__ void e2_sgu_unit(const Frame& F, int chunk, int h, const bf16_t* ACT, bf16_t* MBo) {
    constexpr int LD = 136, LDO = 132;
    LAS bf16_t* WSl = (LAS bf16_t*)F.lds;
    LAS bf16_t* VTl = (LAS bf16_t*)(F.lds + 34816);
    LAS float* OUTl = (LAS float*)(F.lds + 69632);
    const int t0 = chunk * 128;
    const float* wsp = F.in[11] + (size_t)h * 128 * 128;
    for (int idx = F.tid; idx < 4096; idx += NTHR) { const int r = idx >> 5, c4 = idx & 31; const f32x4 v = *(const GAS f32x4*)(wsp + r * 128 + 4 * c4);
        u32x2 w; w.x = pk2(v.x, v.y); w.y = pk2(v.z, v.w); *(LAS u32x2*)(WSl + r * LD + 4 * c4) = w; }
#pragma unroll
    for (int it = 0; it < 4; ++it) { const int idx = F.tid + NTHR * it, s = idx >> 4, c = idx & 15;
        const u32x4 raw = *(const GAS u32x4*)(ACT + (size_t)(t0 + s) * 1536 + 1024 + h * 128 + 8 * c);
        float x[8]; x[0] = bf2f(raw.x & 0xffffu); x[1] = bf2f(raw.x >> 16); x[2] = bf2f(raw.y & 0xffffu); x[3] = bf2f(raw.y >> 16);
        x[4] = bf2f(raw.z & 0xffffu); x[5] = bf2f(raw.z >> 16); x[6] = bf2f(raw.w & 0xffffu); x[7] = bf2f(raw.w >> 16);
        float sm = 0.f;
#pragma unroll
        for (int i = 0; i < 8; ++i) sm += x[i];
        sm += __shfl_xor(sm, 1); sm += __shfl_xor(sm, 2); sm += __shfl_xor(sm, 4); sm += __shfl_xor(sm, 8);
        const float mu = sm * (1.f / 128.f); float q = 0.f;
#pragma unroll
        for (int i = 0; i < 8; ++i) { x[i] -= mu; q += x[i] * x[i]; }
        q += __shfl_xor(q, 1); q += __shfl_xor(q, 2); q += __shfl_xor(q, 4); q += __shfl_xor(q, 8);
        const float rs = 1.0f / sqrtf(q * (1.f / 128.f) + EPS);
        const float* vg = F.in[9] + h * 128 + 8 * c; const float* vb = F.in[10] + h * 128 + 8 * c;
#pragma unroll
        for (int i = 0; i < 8; ++i) { const float y = x[i] * rs * vg[i] + vb[i]; VTl[(8 * c + i) * LD + s] = (bf16_t)f2bf(y); }
    }
    __syncthreads();
    const int wt = F.wave >> 1, wc = F.wave & 1, r32 = F.lane & 31, hi = F.lane >> 5;
    f32x16 acc[2]; acc[0] = f32x16{}; acc[1] = f32x16{};
#pragma unroll
    for (int ks = 0; ks < 8; ++ks) {
        const bf16x8 a = *(const LAS bf16x8*)(WSl + (32 * wt + r32) * LD + 16 * ks + 8 * hi);
#pragma unroll
        for (int ct = 0; ct < 2; ++ct) { const bf16x8 b = *(const LAS bf16x8*)(VTl + (64 * wc + 32 * ct + r32) * LD + 16 * ks + 8 * hi);
            acc[ct] = __builtin_amdgcn_mfma_f32_32x32x16_bf16(a, b, acc[ct], 0, 0, 0); }
    }
    const float* bsp = F.in[12] + h * 128;
#pragma unroll
    for (int ct = 0; ct < 2; ++ct)
#pragma unroll
        for (int r = 0; r < 16; ++r) { const int trow = 32 * wt + (r & 3) + 8 * (r >> 2) + 4 * hi; OUTl[trow * LDO + 64 * wc + 32 * ct + r32] = acc[ct][r] + bsp[trow]; }
    __syncthreads();
#pragma unroll
    for (int it = 0; it < 4; ++it) { const int idx = F.tid + NTHR * it, t = idx >> 4, c = idx & 15;
        const u32x4 raw = *(const GAS u32x4*)(ACT + (size_t)(t0 + t) * 1536 + 512 + h * 128 + 8 * c);
        const f32x4 s0 = *(const LAS f32x4*)(OUTl + t * LDO + 8 * c), s1 = *(const LAS f32x4*)(OUTl + t * LDO + 8 * c + 4);
        u32x4 o; o.x = pk2(bf2f(raw.x & 0xffffu) * s0.x, bf2f(raw.x >> 16) * s0.y); o.y = pk2(bf2f(raw.y & 0xffffu) * s0.z, bf2f(raw.y >> 16) * s0.w);
        o.z = pk2(bf2f(raw.z & 0xffffu) * s1.x, bf2f(raw.z >> 16) * s1.y); o.w = pk2(bf2f(raw.w & 0xffffu) * s1.z, bf2f(raw.w >> 16) * s1.w);
        *(GAS u32x4*)(MBo + (size_t)(t0 + t) * 1024 + 512 + h * 128 + 8 * c) = o; }
    __syncthreads();
}
__device__ __forceinline__ void phase_e2(const Frame& F) {
    const bf16_t* ACT = (const bf16_t*)F.out; bf16_t* MBo = (bf16_t*)(F.ws + WS_MB);
    for (int u = F.vcu; u < 1024; u += F.G) {
        if (u < 512) e2_conv_unit(F, u >> 2, u & 3, ACT, MBo);
        else e2_sgu_unit(F, (u - 512) >> 2, (u - 512) & 3, ACT, MBo);
    }
}
template <bool FINAL> __device__ __forceinline__ void combine_rows(const Frame& F) {
    const int gw = F.vcu * NWAVES + F.wave, NGW = F.G * NWAVES;
    const bf16_t* Y = (const bf16_t*)(F.ws + WS_Y);
    for (int m = gw; m < T; m += NGW) {
        GAS f32x4* xr = (GAS f32x4*)(F.out + (size_t)m * D) + F.lane;
        const GAS u32x2* y0 = (const GAS u32x2*)(Y + (size_t)(2 * m) * D) + F.lane; const GAS u32x2* y1 = (const GAS u32x2*)(Y + (size_t)(2 * m + 1) * D) + F.lane;
        f32x4 v[4]; float s = 0.f;
#pragma unroll
        for (int j = 0; j < 4; ++j) { v[j] = xr[64 * j]; const u32x2 a = y0[64 * j], b = y1[64 * j];
            v[j].x += bf2f(a.x & 0xffffu) + bf2f(b.x & 0xffffu); v[j].y += bf2f(a.x >> 16) + bf2f(b.x >> 16);
            v[j].z += bf2f(a.y & 0xffffu) + bf2f(b.y & 0xffffu); v[j].w += bf2f(a.y >> 16) + bf2f(b.y >> 16);
            s += (v[j].x * v[j].x + v[j].y * v[j].y) + (v[j].z * v[j].z + v[j].w * v[j].w); }
        s = wave_sum(s);
        const float rs = 1.0f / sqrtf(s * (1.f / 1024.f) + EPS);
        if (FINAL) {
            const GAS f32x4* g = (const GAS f32x4*)F.in[3] + F.lane;
#pragma unroll
            for (int j = 0; j < 4; ++j) { const f32x4 gg = g[64 * j]; xr[64 * j] = v[j] * rs * gg; }
        } else {
            GAS u32x2* o8 = (GAS u32x2*)((bf16_t*)(F.ws + WS_XB) + (size_t)m * D) + F.lane;
#pragma unroll
            for (int j = 0; j < 4; ++j) { xr[64 * j] = v[j]; u32x2 w; w.x = pk2(v[j].x, v[j].y); w.y = pk2(v[j].z, v[j].w); o8[64 * j] = w; }
            if (F.lane == 0) ((float*)(F.ws + WS_RS0))[m] = rs;
        }
    }
}
}
namespace mk {
typedef float f32x4v __attribute__((ext_vector_type(4)));
__device__ __forceinline__ void phase_router(const Frame& F, int layer) {
    LAS float* red = (LAS float*)F.lds;
    LAS float* ssqr = (LAS float*)(F.lds + 98304);
    LAS float* lg = (LAS float*)(F.lds + 100352);
    LAS float* rsl = (LAS float*)(F.lds + 112640);
    LAS int* sel = (LAS int*)(F.lds + 112896);
    LAS float* gwl = (LAS float*)(F.lds + 113408);
    LAS int* basel = (LAS int*)(F.lds + 113920);
    const bf16_t* RH = (const bf16_t*)(F.ws + WS_ROUTER) + (size_t)(layer * 2) * 49152 + (size_t)F.wave * 6144;
    const bf16_t* RL = RH + 49152;
    unsigned* gcnt = (unsigned*)(F.ws + WS_CTL) + CW_ECNT + layer * 32 * 64;
    const int r = F.lane & 15, q = F.lane >> 4;
    for (int unit = F.vcu; unit < T / 64; unit += F.G) {
        const int tok0 = unit * 64;
        const float* X = F.out + (size_t)tok0 * D + 128 * F.wave + 8 * q;
        f32x4 acc[4][3]; float ssq[4];
#pragma unroll
        for (int tt = 0; tt < 4; ++tt) { ssq[tt] = 0.f;
#pragma unroll
            for (int ct = 0; ct < 3; ++ct) acc[tt][ct] = (f32x4){0.f, 0.f, 0.f, 0.f}; }
#pragma unroll 1
        for (int ks = 0; ks < 4; ++ks) {
            bf16x8 bh[3], bl[3];
#pragma unroll
            for (int ct = 0; ct < 3; ++ct) { bh[ct] = *(const GAS bf16x8*)(RH + ((ks * 3 + ct) * 64 + F.lane) * 8); bl[ct] = *(const GAS bf16x8*)(RL + ((ks * 3 + ct) * 64 + F.lane) * 8); }
#pragma unroll
            for (int tt = 0; tt < 4; ++tt) {
                const float* xp = X + (size_t)(16 * tt + r) * D + 32 * ks;
                const f32x4 x0 = *(const GAS f32x4*)xp, x1 = *(const GAS f32x4*)(xp + 4);
                float xv[8] = {x0.x, x0.y, x0.z, x0.w, x1.x, x1.y, x1.z, x1.w};
                unsigned hh[8], ll[8];
#pragma unroll
                for (int j = 0; j < 8; ++j) { ssq[tt] = fmaf(xv[j], xv[j], ssq[tt]); hh[j] = f2bf(xv[j]); ll[j] = f2bf(xv[j] - bf2f(hh[j])); }
                u32x4 ahw, alw;
                ahw.x = hh[0] | (hh[1] << 16); ahw.y = hh[2] | (hh[3] << 16); ahw.z = hh[4] | (hh[5] << 16); ahw.w = hh[6] | (hh[7] << 16);
                alw.x = ll[0] | (ll[1] << 16); alw.y = ll[2] | (ll[3] << 16); alw.z = ll[4] | (ll[5] << 16); alw.w = ll[6] | (ll[7] << 16);
                const bf16x8 ah = __builtin_bit_cast(bf16x8, ahw), al = __builtin_bit_cast(bf16x8, alw);
#pragma unroll
                for (int ct = 0; ct < 3; ++ct) {
                    acc[tt][ct] = __builtin_amdgcn_mfma_f32_16x16x32_bf16(ah, bh[ct], acc[tt][ct], 0, 0, 0);
                    acc[tt][ct] = __builtin_amdgcn_mfma_f32_16x16x32_bf16(al, bh[ct], acc[tt][ct], 0, 0, 0);
                    acc[tt][ct] = __builtin_amdgcn_mfma_f32_16x16x32_bf16(ah, bl[ct], acc[tt][ct], 0, 0, 0);
                }
            }
        }
#pragma unroll
        for (int tt = 0; tt < 4; ++tt) {
#pragma unroll
            for (int ct = 0; ct < 3; ++ct)
#pragma unroll
                for (int i = 0; i < 4; ++i) red[(F.wave * 64 + 16 * tt + 4 * q + i) * 48 + 16 * ct + r] = acc[tt][ct][i];
            float s = ssq[tt]; s += __shfl_xor(s, 16); s += __shfl_xor(s, 32);
            if (q == 0) ssqr[F.wave * 64 + 16 * tt + r] = s;
        }
        __syncthreads();
        for (int idx = F.tid; idx < 3072; idx += NTHR) { float s = 0.f;
#pragma unroll
            for (int w = 0; w < 8; ++w) s += red[w * 3072 + idx];
            lg[idx] = s; }
        if (F.tid < 64) { float s = 0.f;
#pragma unroll
            for (int w = 0; w < 8; ++w) s += ssqr[w * 64 + F.tid];
            rsl[F.tid] = 1.0f / sqrtf(s * (1.f / 1024.f) + EPS); }
        __syncthreads();
        if (F.tid < 64) {
            const int t = tok0 + F.tid; const float rs = rsl[F.tid]; const LAS float* L = lg + F.tid * 48;
            const float* bg = F.in[22] + layer * 4; const float* br = F.in[24] + layer * 32;
            float gl[4];
#pragma unroll
            for (int j = 0; j < 4; ++j) gl[j] = L[j] * rs + bg[j];
            int gi = 0; float gm = gl[0];
#pragma unroll
            for (int j = 1; j < 4; ++j) if (gl[j] > gm) { gm = gl[j]; gi = j; }
            float den = 0.f;
#pragma unroll
            for (int j = 0; j < 4; ++j) den += __expf(gl[j] - gm);
            const float gp = 1.f / den;
            float el[8];
#pragma unroll
            for (int e = 0; e < 8; ++e) el[e] = L[4 + 8 * gi + e] * rs + br[gi * 8 + e];
            int i1 = 0; float v1 = el[0];
#pragma unroll
            for (int e = 1; e < 8; ++e) if (el[e] > v1) { v1 = el[e]; i1 = e; }
            int i2 = 0; float v2 = -3.0e38f;
#pragma unroll
            for (int e = 0; e < 8; ++e) if (e != i1 && el[e] > v2) { v2 = el[e]; i2 = e; }
            const float e2 = __expf(v2 - v1);
            sel[2 * F.tid] = gi * 8 + i1; sel[2 * F.tid + 1] = gi * 8 + i2;
            gwl[2 * F.tid] = gp / (1.f + e2); gwl[2 * F.tid + 1] = gp * e2 / (1.f + e2);
            ((float*)(F.ws + WS_RSM))[t] = rs;
        }
        __syncthreads();
        int pos = 0, myexp = 0;
        if (F.tid < 128) { myexp = sel[F.tid]; for (int j = 0; j < F.tid; ++j) pos += (sel[j] == myexp) ? 1 : 0; }
        if (F.tid >= 128 && F.tid < 160) { const int e = F.tid - 128; int c = 0; for (int j = 0; j < 128; ++j) c += (sel[j] == e) ? 1 : 0;
            basel[e] = c ? (int)__hip_atomic_fetch_add(gcnt + e * 64, (unsigned)c, __ATOMIC_RELAXED, __HIP_MEMORY_SCOPE_AGENT) : 0; }
        __syncthreads();
        if (F.tid < 128) { const size_t dst = (size_t)myexp * T + basel[myexp] + pos;
            ((int*)(F.ws + WS_LSLOT))[dst] = 2 * (tok0 + (F.tid >> 1)) + (F.tid & 1);
            ((float*)(F.ws + WS_LGW))[dst] = gwl[F.tid]; }
        __syncthreads();
    }
}

#define MOE_VMWAIT(n) asm volatile("s_waitcnt vmcnt(" #n ")" ::: "memory")
template <int NT, int PROBE = 0> __device__ __forceinline__ void moe_segment_t(const Frame& F, int e, int l0, int n) {
    constexpr int RW = 5;
    LAS unsigned char* XR = F.lds;
    LAS unsigned char* HID = F.lds;
    LAS unsigned char* RING = F.lds + 65536 + F.wave * (RW * 2048);
    LAS int* s_tok = (LAS int*)(F.lds + 65536 + 8 * RW * 2048);
    LAS int* s_slot = s_tok + 128;
    LAS float* s_gw = (LAS float*)(s_slot + 128);
    LAS float* s_rs = s_gw + 128;
    const int lane = F.lane, r32 = lane & 31, hi = lane >> 5, w = F.wave;
    const char* w1p = (const char*)((const bf16_t*)(F.ws + WS_WMOE) + (size_t)e * W1_EXP + (size_t)w * 65536) + lane * 16;
    const char* w2p = (const char*)((const bf16_t*)(F.ws + WS_WMOE) + 32 * W1_EXP + (size_t)e * W2_EXP + (size_t)w * 16384) + lane * 16;
#define MOE_WSRC(t) ((PROBE == 1) ? (w1p + (size_t)((t) & 3) * 2048) : (((t) < 64) ? (w1p + (size_t)(t) * 2048) : (w2p + (size_t)(((t) - 64) >> 4) * 262144 + (size_t)(((t) - 64) & 15) * 2048)))
#define MOE_WDMA(t, slot) do { const char* s_ = MOE_WSRC(t); LAS unsigned char* d_ = RING + (slot) * 2048; \
        __builtin_amdgcn_global_load_lds((const GAS unsigned*)s_, (LAS unsigned*)d_, 16, 0, 0); \
        __builtin_amdgcn_global_load_lds((const GAS unsigned*)(s_ + 1024), (LAS unsigned*)(d_ + 1024), 16, 0, 0); } while (0)
    MOE_WDMA(0, 0); MOE_WDMA(1, 1); MOE_WDMA(2, 2); MOE_WDMA(3, 3);
    if (F.tid < 128) { const int idx = F.tid < n ? F.tid : 0; const size_t li = (size_t)e * T + l0 + idx;
        const int slot = ((const int*)(F.ws + WS_LSLOT))[li]; const int tok = slot >> 1;
        s_tok[F.tid] = tok; s_slot[F.tid] = F.tid < n ? slot : -1; s_gw[F.tid] = F.tid < n ? ((const float*)(F.ws + WS_LGW))[li] : 0.f;
        s_rs[F.tid] = ((const float*)(F.ws + WS_RSM))[tok]; }
    __syncthreads();
    const char* xp0 = (const char*)((const bf16_t*)(F.ws + WS_XB) + (size_t)s_tok[lane] * D) + (2 * w) * 16;
    const char* xp1 = (const char*)((const bf16_t*)(F.ws + WS_XB) + (size_t)s_tok[64 + lane] * D) + (2 * w) * 16;
#define MOE_XDMA(kc, bufsel) do { LAS unsigned char* xb_ = XR + (bufsel) * 32768 + (2 * w) * 2048; const size_t ko_ = (PROBE == 2) ? 0 : (size_t)(kc) * 256; \
        __builtin_amdgcn_global_load_lds((const GAS unsigned*)(xp0 + ko_), (LAS unsigned*)(xb_), 16, 0, 0); \
        __builtin_amdgcn_global_load_lds((const GAS unsigned*)(xp1 + ko_), (LAS unsigned*)(xb_ + 1024), 16, 0, 0); \
        __builtin_amdgcn_global_load_lds((const GAS unsigned*)(xp0 + ko_ + 16), (LAS unsigned*)(xb_ + 2048), 16, 0, 0); \
        __builtin_amdgcn_global_load_lds((const GAS unsigned*)(xp1 + ko_ + 16), (LAS unsigned*)(xb_ + 3072), 16, 0, 0); } while (0)
    MOE_XDMA(0, 0);
    MOE_VMWAIT(0); __builtin_amdgcn_s_barrier(); asm volatile("" ::: "memory");
    int wr_slot = 4, rd_slot = 0;
    f32x16 accg[NT], accu[NT];
#pragma unroll
    for (int i = 0; i < NT; ++i) { accg[i] = f32x16{}; accu[i] = f32x16{}; }
    bf16x8 wf[2][2], xf[2][NT];
#define MOE_RDW(par) do { const LAS unsigned char* rp_ = RING + rd_slot * 2048 + lane * 16; rd_slot = (rd_slot == RW - 1) ? 0 : rd_slot + 1; \
        wf[par][0] = *(const LAS bf16x8*)rp_; wf[par][1] = *(const LAS bf16x8*)(rp_ + 1024); } while (0)
    { const LAS unsigned char* b0 = XR + (hi * 128 + r32) * 16;
      MOE_RDW(0);
#pragma unroll
      for (int i = 0; i < NT; ++i) xf[0][i] = *(const LAS bf16x8*)(b0 + (32 * i) * 16); }
    for (int kc = 0; kc < 8; ++kc) {
        const LAS unsigned char* buf = XR + (kc & 1) * 32768 + (hi * 128 + r32) * 16;
        const LAS unsigned char* nbuf = XR + ((kc + 1) & 1) * 32768 + (hi * 128 + r32) * 16;
#pragma unroll
        for (int ks = 0; ks < 8; ++ks) {
            constexpr int dummy_ = 0; (void)dummy_;
            const int cur = ks & 1, nxt = cur ^ 1;
            MOE_WDMA(kc * 8 + ks + 4, wr_slot); wr_slot = (wr_slot == RW - 1) ? 0 : wr_slot + 1;
            if (ks == 0 && kc < 7) MOE_XDMA(kc + 1, (kc + 1) & 1);
            if (ks <= 3 && kc < 7) MOE_VMWAIT(10); else MOE_VMWAIT(6);
            if (ks == 7) { asm volatile("s_waitcnt lgkmcnt(0)" ::: "memory"); __builtin_amdgcn_s_barrier(); asm volatile("" ::: "memory"); }
            if (ks < 7 || kc < 7) {
                MOE_RDW(nxt);
                const LAS unsigned char* xb_ = (ks < 7) ? (buf + (2 * (ks + 1) * 128) * 16) : nbuf;
#pragma unroll
                for (int i = 0; i < NT; ++i) xf[nxt][i] = *(const LAS bf16x8*)(xb_ + (32 * i) * 16);
            }
#pragma unroll
            for (int i = 0; i < NT; ++i) {
                accg[i] = __builtin_amdgcn_mfma_f32_32x32x16_bf16(wf[cur][0], xf[cur][i], accg[i], 0, 0, 0);
                accu[i] = __builtin_amdgcn_mfma_f32_32x32x16_bf16(wf[cur][1], xf[cur][i], accu[i], 0, 0, 0);
            }
        }
    }
#pragma unroll
    for (int i = 0; i < NT; ++i) {
        const float rs = s_rs[32 * i + r32], gw = s_gw[32 * i + r32];
#pragma unroll
        for (int s = 0; s < 2; ++s) { float hv[8];
#pragma unroll
            for (int j = 0; j < 8; ++j) { const float g = accg[i][8 * s + j] * rs, u = accu[i][8 * s + j] * rs; hv[j] = silu_f(g) * u * gw; }
            u32x4 o; o.x = pk2(hv[0], hv[1]); o.y = pk2(hv[2], hv[3]); o.z = pk2(hv[4], hv[5]); o.w = pk2(hv[6], hv[7]);
            *(LAS u32x4*)(HID + (((2 * w + s) * 2 + hi) * 128 + 32 * i + r32) * 16) = o; }
    }
    asm volatile("s_waitcnt lgkmcnt(0)" ::: "memory"); __builtin_amdgcn_s_barrier(); asm volatile("" ::: "memory");
    bf16_t* Y = (bf16_t*)(F.ws + WS_Y);
    const LAS unsigned char* hb = HID + (hi * 128 + r32) * 16;
    MOE_VMWAIT(6);
    MOE_RDW(0);
#pragma unroll
    for (int i = 0; i < NT; ++i) xf[0][i] = *(const LAS bf16x8*)(hb + (32 * i) * 16);
#pragma unroll 1
    for (int p = 0; p < 2; ++p) {
        f32x16 acc2[NT][2];
#pragma unroll
        for (int i = 0; i < NT; ++i) { acc2[i][0] = f32x16{}; acc2[i][1] = f32x16{}; }
#pragma unroll
        for (int kk = 0; kk < 16; ++kk) {
            const int cur = kk & 1, nxt = cur ^ 1;
            if (p == 0 || kk < 12) { MOE_WDMA(64 + 16 * p + kk + 4, wr_slot); wr_slot = (wr_slot == RW - 1) ? 0 : wr_slot + 1; MOE_VMWAIT(6); }
            else if (kk == 12) MOE_VMWAIT(4); else if (kk == 13) MOE_VMWAIT(2); else if (kk == 14) MOE_VMWAIT(0);
            if (p == 0 || kk < 15) {
                MOE_RDW(nxt);
                const LAS unsigned char* hb_ = hb + (((kk + 1) & 15) * 2 * 128) * 16;
#pragma unroll
                for (int i = 0; i < NT; ++i) xf[nxt][i] = *(const LAS bf16x8*)(hb_ + (32 * i) * 16);
            }
#pragma unroll
            for (int i = 0; i < NT; ++i) {
                acc2[i][0] = __builtin_amdgcn_mfma_f32_32x32x16_bf16(wf[cur][0], xf[cur][i], acc2[i][0], 0, 0, 0);
                acc2[i][1] = __builtin_amdgcn_mfma_f32_32x32x16_bf16(wf[cur][1], xf[cur][i], acc2[i][1], 0, 0, 0);
            }
        }
#pragma unroll
        for (int i = 0; i < NT; ++i) {
            const int slot = s_slot[32 * i + r32];
            if (PROBE != 0) { asm volatile("" :: "v"(acc2[i][0]), "v"(acc2[i][1])); } else if (slot >= 0) {
                bf16_t* yr = Y + (size_t)slot * D + 512 * p + 64 * w + 4 * hi;
#pragma unroll
                for (int dt = 0; dt < 2; ++dt)
#pragma unroll
                    for (int qd = 0; qd < 4; ++qd) { u32x2 o; o.x = pk2(acc2[i][dt][4 * qd], acc2[i][dt][4 * qd + 1]); o.y = pk2(acc2[i][dt][4 * qd + 2], acc2[i][dt][4 * qd + 3]);
                        *(GAS u32x2*)(yr + 32 * dt + 8 * qd) = o; }
            }
        }
    }
    asm volatile("s_waitcnt lgkmcnt(0)" ::: "memory"); __builtin_amdgcn_s_barrier(); asm volatile("" ::: "memory");
#undef MOE_RDW
#undef MOE_WSRC
#undef MOE_WDMA
#undef MOE_XDMA
}
template <int PROBE = 0> __device__ __forceinline__ void moe_segment(const Frame& F, int e, int l0, int n) {
    const int nt = (n + 31) >> 5;
    if (nt == 4) moe_segment_t<4, PROBE>(F, e, l0, n); else if (nt == 3) moe_segment_t<3, PROBE>(F, e, l0, n); else if (nt == 2) moe_segment_t<2, PROBE>(F, e, l0, n); else moe_segment_t<1, PROBE>(F, e, l0, n);
}
__device__ __forceinline__ void phase_moe(const Frame& F, int layer) {
    unsigned* gcnt = (unsigned*)(F.ws + WS_CTL) + CW_ECNT + layer * 32 * 64;
    for (int unit = F.vcu; unit < 256; unit += F.G) {
        const int v0 = 128 * unit, v1 = v0 + 128; int vb = 0;
        for (int e = 0; e < 32; ++e) {
            const int ne = (int)__builtin_amdgcn_readfirstlane(__hip_atomic_load(gcnt + e * 64, __ATOMIC_RELAXED, __HIP_MEMORY_SCOPE_AGENT));
            const int lo = v0 > vb ? v0 : vb, hi_ = v1 < vb + ne ? v1 : vb + ne;
            if (lo < hi_) moe_segment<0>(F, e, lo - vb, hi_ - lo);
            vb += ne;
        }
#ifdef MK_MOE_PROBE
        if (layer == 0) { vb = 0;
        for (int e = 0; e < 32; ++e) {
            const int ne = (int)__builtin_amdgcn_readfirstlane(__hip_atomic_load(gcnt + e * 64, __ATOMIC_RELAXED, __HIP_MEMORY_SCOPE_AGENT));
            const int lo = v0 > vb ? v0 : vb, hi_ = v1 < vb + ne ? v1 : vb + ne;
            if (lo < hi_) moe_segment<MK_MOE_PROBE>(F, e, lo - vb, hi_ - lo);
            vb += ne;
        } }
#endif
    }
}
}
namespace mk {
__device__ __forceinline__ int crow(int r, int hi) { return (r & 3) + 8 * (r >> 2) + 4 * hi; }
__device__ __forceinline__ s16x4 vtr(const LAS unsigned char* p) {
    typedef short v4i16_t __attribute__((ext_vector_type(4)));
    return __builtin_bit_cast(s16x4, __builtin_amdgcn_ds_read_tr16_b64_v4i16((LAS v4i16_t*)p));
}
constexpr float ATT_THR = 8.f;

template <int MODE> __device__ __forceinline__ void attn_unit(const Frame& F, int unit) {
    constexpr int NKC = MODE == 0 ? 12 : 8, ND0 = NKC / 2, KBYTES = NKC * 1024, BUF = KBYTES + 8192;
    const int lane = F.lane, w = F.wave, r32 = lane & 31, hi = lane >> 5;
    LAS unsigned char* lds = F.lds;
    LAS float* wsf = (LAS float*)(lds + 2 * BUF) + w * 64;
    LAS bf16_t* stg = (LAS bf16_t*)(lds + 2 * BUF + 2048) + w * 2048;
    const bf16_t* Qb = (const bf16_t*)(F.ws + WS_Q); const bf16_t* KVb = (const bf16_t*)(F.ws + WS_KV); const bf16_t* KPE = (const bf16_t*)(F.ws + WS_KPE);
    const bf16_t* Pb = (const bf16_t*)(F.ws + WS_P); bf16_t* Ob = (bf16_t*)(F.ws + WS_MB);
    int b, h = 0, g = 0, hq = 0, tq0, j_lo, j_hi, kbase0, ocol, qpos0 = 0;
    if (MODE == 0) { b = unit >> 6; h = (unit >> 3) & 7; const int qb = unit & 7; tq0 = b * S + 256 * qb + 32 * w; j_lo = 0; j_hi = 32; kbase0 = b * S; ocol = h * 64; }
    else { b = unit >> 6; const int rem = unit & 63; g = rem >> 5; const int qblk = (rem >> 1) & 15, hp = rem & 1; hq = 4 * g + 2 * hp + (w >> 2);
        qpos0 = 128 * qblk + 32 * (w & 3); tq0 = b * S + qpos0; j_lo = (qblk == 0) ? 2 : 0; j_hi = (qblk == 15) ? 4 : 6; kbase0 = b * S + 128 * qblk - 128; ocol = 512 + hq * 64; }
    bf16x8 qr[ND0];
    if (MODE == 0) { const bf16_t* qrow = Qb + (size_t)(tq0 + r32) * 768;
#pragma unroll
        for (int d0 = 0; d0 < 4; ++d0) qr[d0] = *(const GAS bf16x8*)(qrow + h * 64 + 16 * d0 + 8 * hi);
#pragma unroll
        for (int d0 = 4; d0 < 6; ++d0) qr[d0] = *(const GAS bf16x8*)(qrow + 512 + h * 32 + 16 * (d0 - 4) + 8 * hi);
        {
            const f32x2* rp = (const f32x2*)(F.ws + WS_ROPE) + ((tq0 + r32) & (S - 1)) * 16 + 8 * hi;
            bf16x8 a4 = qr[4], a5 = qr[5];
#pragma unroll
            for (int j = 0; j < 8; ++j) { const f32x2 cs = rp[j]; const float x = bf2f((unsigned short)a4[j]), y = bf2f((unsigned short)a5[j]);
                a4[j] = (short)f2bf(x * cs.x - y * cs.y); a5[j] = (short)f2bf(y * cs.x + x * cs.y); }
            qr[4] = a4; qr[5] = a5; }
    } else { const bf16_t* qrow = Pb + (size_t)(tq0 + r32) * 1280 + 512 + hq * 64;
#pragma unroll
        for (int d0 = 0; d0 < ND0; ++d0) qr[d0] = *(const GAS bf16x8*)(qrow + 16 * d0 + 8 * hi);
    }
    const bf16_t *ksrc0, *ksrc1 = nullptr, *vsrc; size_t kstride, kstride1 = 0, vstride;
    const int vrow = 16 * (w & 3) + (lane >> 2), vcol = (w >> 2) * 32 + (lane & 3) * 8;
    if (MODE == 0) { ksrc0 = KVb + (size_t)(kbase0 + lane) * 1024 + h * 64 + w * 8; kstride = 64 * 1024;
        ksrc1 = KPE + (size_t)(kbase0 + lane) * 32 + (w & 3) * 8; kstride1 = 64 * 32;
        vsrc = KVb + (size_t)(kbase0 + vrow) * 1024 + 512 + h * 64 + vcol; vstride = 64 * 1024; }
    else { ksrc0 = Pb + (size_t)((long)kbase0 + lane) * 1280 + 1024 + g * 64 + w * 8; kstride = 64 * 1280;
        vsrc = Pb + (size_t)((long)kbase0 + vrow) * 1280 + 1152 + g * 64 + vcol; vstride = 64 * 1280; }
    const bool two_k = (MODE == 0) && (w < 4);
    u32x4 ks0, ks1 = {0u, 0u, 0u, 0u}, vs;
#define ATT_LOAD(j) do { ks0 = *(const GAS u32x4*)(ksrc0 + (size_t)(j) * kstride); if (two_k) ks1 = *(const GAS u32x4*)(ksrc1 + (size_t)(j) * kstride1); vs = *(const GAS u32x4*)(vsrc + (size_t)(j) * vstride); } while (0)
#define ATT_WRITE(bufo) do { *(LAS u32x4*)(lds + (bufo) + w * 1024 + lane * 16) = ks0; if (two_k) *(LAS u32x4*)(lds + (bufo) + (8 + w) * 1024 + lane * 16) = ks1; \
        *(LAS u32x4*)(lds + (bufo) + KBYTES + w * 1024 + lane * 16) = vs; } while (0)
    float m_run, l_run; f32x16 o[2]; o[0] = f32x16{}; o[1] = f32x16{};
    float slope2 = 0.f;
    if (MODE == 1) { m_run = F.in[19][hq] * LOG2E; l_run = (hi == 0) ? 1.f : 0.f; slope2 = exp2f(-(float)(hq + 1)) * LOG2E; }
    else { m_run = -1e30f; l_run = 0.f; }
    ATT_LOAD(j_lo); ATT_WRITE(0); __syncthreads();
    const int voff = KBYTES + ((lane >> 4) & 1) * 32 + (lane & 3) * 8 + (4 * hi + ((lane & 15) >> 2)) * 64;
    for (int j = j_lo; j < j_hi; ++j) {
        const int bo = ((j - j_lo) & 1) * BUF;
        if (j + 1 < j_hi) ATT_LOAD(j + 1);
        f32x16 p0 = f32x16{}, p1 = f32x16{};
        const LAS unsigned char* kb = lds + bo + hi * 1024 + r32 * 16;
#pragma unroll
        for (int d0 = 0; d0 < ND0; ++d0) {
            const bf16x8 b0 = *(const LAS bf16x8*)(kb + d0 * 2048), b1 = *(const LAS bf16x8*)(kb + d0 * 2048 + 512);
            p0 = __builtin_amdgcn_mfma_f32_32x32x16_bf16(b0, qr[d0], p0, 0, 0, 0);
            p1 = __builtin_amdgcn_mfma_f32_32x32x16_bf16(b1, qr[d0], p1, 0, 0, 0);
        }
        if (MODE == 1) {
            const int qp = qpos0 + r32, kp = 128 * ((unit >> 1) & 15) - 128 + 64 * j;
#pragma unroll
            for (int r = 0; r < 16; ++r) { const int k0 = kp + crow(r, hi); int d0_ = qp - k0; d0_ = d0_ < 0 ? -d0_ : d0_; int d1_ = qp - (k0 + 32); d1_ = d1_ < 0 ? -d1_ : d1_;
                p0[r] = (d0_ <= 128) ? p0[r] - slope2 * (float)d0_ : -1e30f; p1[r] = (d1_ <= 128) ? p1[r] - slope2 * (float)d1_ : -1e30f; }
        }
        float pmax = p0[0];
#pragma unroll
        for (int r = 1; r < 16; ++r) pmax = fmaxf(pmax, p0[r]);
#pragma unroll
        for (int r = 0; r < 16; ++r) pmax = fmaxf(pmax, p1[r]);
        pmax = fmaxf(pmax, __shfl_xor(pmax, 32));
        if (!__all(pmax - m_run <= ATT_THR)) {
            const float mn = fmaxf(m_run, pmax), alpha = fast_exp2(m_run - mn); m_run = mn; l_run *= alpha;
            if (hi == 0) wsf[r32] = alpha;
            LDS_WAIT(); asm volatile("" ::: "memory");
#pragma unroll
            for (int r = 0; r < 16; ++r) { const float a = wsf[crow(r, hi)]; o[0][r] *= a; o[1][r] *= a; }
        }
        float ps = 0.f;
#pragma unroll
        for (int r = 0; r < 16; ++r) { p0[r] = fast_exp2(p0[r] - m_run); p1[r] = fast_exp2(p1[r] - m_run); ps += p0[r] + p1[r]; }
        l_run += ps;
        u32x4 pw[4];
        pw[0] = (u32x4){pk2(p0[0], p0[1]), pk2(p0[2], p0[3]), pk2(p0[4], p0[5]), pk2(p0[6], p0[7])};
        pw[1] = (u32x4){pk2(p0[8], p0[9]), pk2(p0[10], p0[11]), pk2(p0[12], p0[13]), pk2(p0[14], p0[15])};
        pw[2] = (u32x4){pk2(p1[0], p1[1]), pk2(p1[2], p1[3]), pk2(p1[4], p1[5]), pk2(p1[6], p1[7])};
        pw[3] = (u32x4){pk2(p1[8], p1[9]), pk2(p1[10], p1[11]), pk2(p1[12], p1[13]), pk2(p1[14], p1[15])};
        const LAS unsigned char* vp = lds + bo + voff;
#pragma unroll
        for (int d0 = 0; d0 < 2; ++d0)
#pragma unroll
            for (int ks = 0; ks < 4; ++ks) {
                const s16x4 vlo = vtr(vp + d0 * 4096 + ks * 1024), vhi = vtr(vp + d0 * 4096 + ks * 1024 + 512);
                const bf16x8 vf = (bf16x8){vlo[0], vlo[1], vlo[2], vlo[3], vhi[0], vhi[1], vhi[2], vhi[3]};
                o[d0] = __builtin_amdgcn_mfma_f32_32x32x16_bf16(__builtin_bit_cast(bf16x8, pw[ks]), vf, o[d0], 0, 0, 0);
            }
        if (j + 1 < j_hi) ATT_WRITE(BUF - bo);
        __syncthreads();
    }
#undef ATT_LOAD
#undef ATT_WRITE
    const float lt = l_run + __shfl_xor(l_run, 32);
    if (hi == 0) wsf[32 + r32] = lt;
    LDS_WAIT(); asm volatile("" ::: "memory");
#pragma unroll
    for (int r = 0; r < 16; ++r) { const int orow = crow(r, hi); const float rl = fast_rcp(wsf[32 + orow]);
        stg[orow * 64 + r32] = (bf16_t)f2bf(o[0][r] * rl); stg[orow * 64 + 32 + r32] = (bf16_t)f2bf(o[1][r] * rl); }
    LDS_WAIT(); asm volatile("" ::: "memory");
    bf16_t* Ow = Ob + (size_t)tq0 * 1024 + ocol;
#pragma unroll
    for (int i = 0; i < 4; ++i) { const int row = i * 8 + (lane >> 3), ch = lane & 7; const u32x4 v = *(const LAS u32x4*)(stg + row * 64 + ch * 8); *(GAS u32x4*)(Ow + (size_t)row * 1024 + ch * 8) = v; }
    __syncthreads();
}
__device__ __forceinline__ void phase_attn(const Frame& F) {
    for (int u = F.vcu; u < 1024; u += F.G) { if (u < 512) attn_unit<0>(F, u); else attn_unit<1>(F, u - 512); }
}
}
namespace mk {
constexpr int N_PHASES = 14;
__global__ void __launch_bounds__(NTHR, 2) fwd_mega(Args args) {
    extern __shared__ __attribute__((aligned(16))) unsigned char lds_raw[];
    Frame F;
    F.lds = (LAS unsigned char*)lds_raw;
    F.tid = threadIdx.x; F.lane = F.tid & 63; F.wave = __builtin_amdgcn_readfirstlane(F.tid >> 6);
    F.G = gridDim.x; { const int bx = blockIdx.x; F.vcu = (F.G % 8 == 0) ? (bx % 8) * (F.G / 8) + bx / 8 : bx; }
    F.in = args.in; F.out = args.out; F.ws = args.ws;
    volatile LAS unsigned* MISC = (volatile LAS unsigned*)(F.lds + MISC_OFF);
    if (F.tid < 64) MISC[F.tid] = 0u;
    __syncthreads();
    unsigned* ctl = (unsigned*)(F.ws + WS_CTL);
    const int lo = args.ph_lo, hi = args.ph_hi;
    XcdBarrier bar; bar.bar = ctl + CW_BAR; bar.x = 0; bar.st = nullptr;
    if (hi - lo > 1) bar = xcd_barrier_post(ctl + CW_BAR, MISC + 8);
#ifndef MK_PHASE_MASK
#define MK_PHASE_MASK 0x3fff
#endif
#define IN(k) (((MK_PHASE_MASK >> (k)) & 1) && lo <= (k) && (k) < hi)
#ifndef MK_DUP_MASK
#define MK_DUP_MASK 0
#endif
#define REP(k) for (int rep_ = 0; rep_ <= ((MK_DUP_MASK >> (k)) & 1); ++rep_)
#define FRESH() do { int t_ = threadIdx.x; asm volatile("" : "+v"(t_)); F.tid = t_; F.lane = t_ & 63; F.wave = __builtin_amdgcn_readfirstlane(t_ >> 6); } while (0)
#define SEAM(k) do { if (IN(k) && IN((k) + 1)) xcd_barrier(bar); } while (0)
    bf16_t* XB = (bf16_t*)(F.ws + WS_XB); bf16_t* MBp = (bf16_t*)(F.ws + WS_MB); bf16_t* Pp = (bf16_t*)(F.ws + WS_P);
    float* RS0 = (float*)(F.ws + WS_RS0);
    const f32x2* rope = (const f32x2*)(F.ws + WS_ROPE);
    const int bid = (int)blockIdx.x;

    if (IN(0)) REP(0) { FRESH(); phase_p0(F); } SEAM(0);
    if (IN(1)) REP(1) { FRESH(); pg8::Gemm g{XB, (const bf16_t*)(F.ws + WS_WINE), T, 2048, 1024, 1024, 1024}; pg8::StaticOrder So; So.init(T, 2048, F.G, bid);
        EpiE1 E{(bf16_t*)F.out, RS0}; pg8::gemm_phase<EpiE1, pg8::StaticOrder, true, true>(F.lds, g, So, E); } SEAM(1);
    if (IN(2)) REP(2) { FRESH(); phase_e2(F); } SEAM(2);
    if (IN(3)) REP(3) { FRESH(); pg8::Gemm g{MBp, (const bf16_t*)(F.ws + WS_WOUTE), T, 1024, 1024, 1024, 1024}; pg8::StaticOrder So; So.init(T, 1024, F.G, bid);
        EpiRes E{F.in[0], F.out, XB}; pg8::gemm_phase<EpiRes, pg8::StaticOrder, true, true>(F.lds, g, So, E); } SEAM(3);
    if (IN(4)) REP(4) { FRESH(); phase_router(F, 0); } SEAM(4);
    if (IN(5)) REP(5) { FRESH(); phase_moe(F, 0); } SEAM(5);
    if (IN(6)) REP(6) { FRESH(); combine_rows<false>(F);
 } SEAM(6);
    if (IN(7)) REP(7) { FRESH(); pg8::Gemm g{XB, (const bf16_t*)(F.ws + WS_WINO), T, 1280, 1024, 1024, 1024}; pg8::StaticOrder So; So.init(T, 1280, F.G, bid);
        EpiO1 E{Pp, RS0, (float*)(F.ws + WS_SSQQ), (float*)(F.ws + WS_SSQKV), (bf16_t*)(F.ws + WS_KPE), rope};
        pg8::gemm_phase<EpiO1, pg8::StaticOrder, true, true>(F.lds, g, So, E);
        if (rep_ == 0 && (F.G != 256 || bid >= 64)) { LAS float* scr = (LAS float*)(F.lds + F.wave * 16384); CvtRegs R;
            const int nw = (F.G == 256) ? 192 * NWAVES : F.G * NWAVES, gw = ((F.G == 256) ? (bid - 64) : bid) * NWAVES + F.wave;
            int it = gw; if (it < MOE_CVT_ITEMS) moe_cvt_load(F, 1, it, R);
            for (; it < MOE_CVT_ITEMS; it += nw) { moe_cvt_stage(F, 1, it, R, scr); if (it + nw < MOE_CVT_ITEMS) moe_cvt_load(F, 1, it + nw, R); moe_cvt_emit(F, it, scr); } } } SEAM(7);
    if (IN(8)) REP(8) { FRESH(); pg8::Gemm g{Pp, (const bf16_t*)(F.ws + WS_WUQ), T, 1792, 256, 1280, 256}; O2Order So; So.init(T, 1792, F.G, bid);
        EpiO2 E{(bf16_t*)(F.ws + WS_Q), (bf16_t*)(F.ws + WS_KV), (const float*)(F.ws + WS_SSQQ), (const float*)(F.ws + WS_SSQKV)};
        pg8::gemm_phase<EpiO2, O2Order, true, true>(F.lds, g, So, E);
    } SEAM(8);
    if (IN(9)) REP(9) { FRESH(); phase_attn(F); } SEAM(9);
    if (IN(10)) REP(10) { FRESH(); pg8::Gemm g{MBp, (const bf16_t*)(F.ws + WS_WOUTO), T, 1024, 1024, 1024, 1024}; pg8::StaticOrder So; So.init(T, 1024, F.G, bid);
        EpiRes E{F.out, F.out, XB}; pg8::gemm_phase<EpiRes, pg8::StaticOrder, true, true>(F.lds, g, So, E); } SEAM(10);
    if (IN(11)) REP(11) { FRESH(); phase_router(F, 1); } SEAM(11);
    if (IN(12)) REP(12) { FRESH(); phase_moe(F, 1); } SEAM(12);
    if (IN(13)) REP(13) { FRESH(); combine_rows<true>(F); }
#undef IN
#undef SEAM
}

static int g_grid = 0;
static bool setup() {
    if (g_grid) return g_grid > 0;
    int dev = 0, cus = 0;
    if (hipGetDevice(&dev) != hipSuccess || hipDeviceGetAttribute(&cus, hipDeviceAttributeMultiprocessorCount, dev) != hipSuccess) { g_grid = -1; return false; }
    if (hipFuncSetAttribute((const void*)fwd_mega, hipFuncAttributeMaxDynamicSharedMemorySize, LDS_BYTES) != hipSuccess) { fprintf(stderr, "hipFuncSetAttribute failed\n"); g_grid = -1; return false; }
    int per_cu = 0;
    if (hipOccupancyMaxActiveBlocksPerMultiprocessor(&per_cu, (const void*)fwd_mega, NTHR, LDS_BYTES) != hipSuccess || per_cu < 1) { fprintf(stderr, "occupancy query: %d\n", per_cu); }
    (void)hipGetLastError();
    g_grid = cus;
    return true;
}
static void launch_range(void* const* d_in, float* out, unsigned char* ws, int lo, int hi, hipStream_t st) {
    Args a{};
    for (int i = 0; i < 28; ++i) a.in[i] = (const float*)d_in[i];
    a.out = out; a.ws = ws; a.ph_lo = lo; a.ph_hi = hi;
    hipLaunchKernelGGL(fwd_mega, dim3(g_grid), dim3(NTHR), LDS_BYTES, st, a);
}
}
extern "C" void kernel_launch(void* const* d_in, const int* in_sizes, int n_in, void* d_out, int out_size, void* d_ws, size_t ws_size, hipStream_t stream) {
    if (n_in != 28 || out_size != mk::T * mk::D || ws_size < mk::WS_END) { fprintf(stderr, "kernel_launch: unexpected shapes n_in %d out %d ws %zu\n", n_in, out_size, ws_size); return; }
    if (!mk::setup()) return;
    if (hipMemsetAsync((unsigned char*)d_ws + mk::WS_CTL, 0, mk::CTL_ZERO_BYTES, stream) != hipSuccess) { fprintf(stderr, "kernel_launch: memset failed\n"); return; }
    mk::launch_range(d_in, (float*)d_out, (unsigned char*)d_ws, 0, mk::N_PHASES, stream);
}
```

```cpp
#define MK_PF1 8
#define MK_PF2 8
#include <hip/hip_runtime.h>
#include <hip/hip_bf16.h>
#include <cstdio>
#include <cstdint>
namespace pg8 {
#define PG8_LAS __attribute__((address_space(3)))
typedef unsigned short bf16_t;
typedef short bf16x8 __attribute__((ext_vector_type(8)));
typedef float f32x4 __attribute__((ext_vector_type(4)));
typedef unsigned u32x4 __attribute__((ext_vector_type(4)));
constexpr int BM = 256, BK = 64, HALF = 128, HTB = HALF * BK * 2  , STAGE_BYTES = 8 * HTB, NXCD = 8, WGM = 8;

__host__ __device__ __forceinline__ int lds_byte(int r, int c) { const int st = (r >> 4) * 2 + (c >> 5), rr = r & 15, cc = c & 31, ob = rr * 64 + cc * 2; return st * 1024 + (ob ^ (((ob >> 9) & 1) << 5)); }
__host__ __device__ __forceinline__ void stage_rc(int b, int& R, int& C) { const int st = b / 1024, sb = b % 1024, swz = sb ^ (((sb >> 9) & 1) << 5); R = (st >> 1) * 16 + swz / 64; C = (st & 1) * 32 + (swz % 64) / 2; }
__host__ __device__ __forceinline__ int perm32(int rho) { const int n = rho >> 4, i = rho & 15; return 8 * (i >> 2) + 4 * n + (i & 3); }

struct Unit { int pm, pn, aoff; };
struct Gemm { const bf16_t* A; const bf16_t* Bt; int M, N, K, lda, ldb; };

struct StaticOrder {
    int nM, nN, nwg, G, c;
    __host__ __device__ void init(int M, int N, int G_, int c_) { nM = M / BM; nN = N / BM; nwg = nM * nN; G = G_; c = c_; }
    __host__ __device__ bool next(int i, Unit& u) const {
        const long L = (long)i * G + c; if (L >= nwg) return false;
        int wgid = (int)L; { const int q = nwg / NXCD, r = nwg % NXCD, xcd = wgid % NXCD, off = wgid / NXCD; wgid = (xcd < r ? xcd * (q + 1) : r * (q + 1) + (xcd - r) * q) + off; }
        const int nig = WGM * nN, gid = wgid / nig, fm = gid * WGM, gsz = (nM - fm) < WGM ? (nM - fm) : WGM;
        u.pm = fm + ((wgid % nig) % gsz); u.pn = (wgid % nig) / gsz; u.aoff = 0; return true;
    }
    __device__ __forceinline__ void a_ready(const Unit&) const {}
    __device__ __forceinline__ void done(const Unit&) const {}
};

__device__ __forceinline__ unsigned cvt_pk_bf16(float lo, float hi) { unsigned r; asm volatile("v_cvt_pk_bf16_f32 %0, %1, %2" : "=v"(r) : "v"(lo), "v"(hi)); return r; }
typedef float f32x2 __attribute__((ext_vector_type(2)));
template <class Epi, class Sched, bool ALIGN_EPI = false, bool SP2 = false>
__device__ __forceinline__ void gemm_phase(PG8_LAS unsigned char* lds, const Gemm g, const Sched& S, const Epi& E) {
    int tid_ = threadIdx.x; asm volatile("" : "+v"(tid_));
    const int tid = tid_, wid = __builtin_amdgcn_readfirstlane(tid >> 6), lane = tid & 63, wr = wid >> 2, wc = wid & 3, fr = lane & 15, fq = lane >> 4;
    const int K = g.K, nt = K / BK;
    unsigned voffA[2], voffB[2];
#pragma unroll
    for (int i = 0; i < 2; ++i) { int R, C; stage_rc(tid * 16 + i * 8192, R, C); const int Rb = Epi::PERM ? ((R & ~31) + perm32(R & 31)) : R;
        voffA[i] = (unsigned)(R * g.lda + C) * 2u; voffB[i] = (unsigned)(Rb * g.ldb + C) * 2u; }
    const size_t kstep = (size_t)(BK * 2);
    const size_t hstepA = (size_t)HALF * g.lda * 2, hstepB = (size_t)HALF * g.ldb * 2;
    const size_t tstepA = 2 * hstepA, tstepB = 2 * hstepB;
    const unsigned ldsw = (unsigned)wid * 1024u;
    const int aoff = lds_byte(wr * 64 + fr, fq * 8), boff = lds_byte(wc * 32 + fr, fq * 8);
#define PG8_SA(b, h) (((b) * 2 + (h)) * HTB)
#define PG8_SB(b, h) ((4 + (b) * 2 + (h)) * HTB)
#define PG8_STAGE(bufoff, gbase, voff) do { _Pragma("unroll") for (int _i = 0; _i < 2; ++_i) \
        __builtin_amdgcn_global_load_lds((const unsigned*)((const char*)(gbase) + (voff)[_i]), (PG8_LAS unsigned*)(lds + (bufoff) + ldsw + _i * 8192), 16, 0, 0); } while (0)
#define PG8_LDA(dst, b, h) do { _Pragma("unroll") for (int m = 0; m < 4; ++m) _Pragma("unroll") for (int k = 0; k < 2; ++k) dst[m][k] = *(const PG8_LAS bf16x8*)(lds + PG8_SA(b, h) + aoff + m * 2048 + k * 1024); } while (0)
#define PG8_LDB(dst, b, h) do { _Pragma("unroll") for (int n = 0; n < 2; ++n) _Pragma("unroll") for (int k = 0; k < 2; ++k) dst[n][k] = *(const PG8_LAS bf16x8*)(lds + PG8_SB(b, h) + boff + n * 2048 + k * 1024); } while (0)
#define PG8_MMA(ai, bj, At, Bt) do { __builtin_amdgcn_s_setprio(1); _Pragma("unroll") for (int m = 0; m < 4; ++m) _Pragma("unroll") for (int n = 0; n < 2; ++n) _Pragma("unroll") for (int k = 0; k < 2; ++k) \
        acc[ai][bj][m][n] = __builtin_amdgcn_mfma_f32_16x16x32_bf16(Bt[n][k], At[m][k], acc[ai][bj][m][n], 0, 0, 0); __builtin_amdgcn_s_setprio(0); } while (0)
#define PG8_WAIT_V(n) asm volatile("s_waitcnt vmcnt(" #n ")" ::: "memory")
#define PG8_WAIT_L(n) asm volatile("s_waitcnt lgkmcnt(" #n ")" ::: "memory")
#define PG8_BAR __builtin_amdgcn_s_barrier()
#define PG8_SCHED __builtin_amdgcn_sched_barrier(0)
    Unit cur, nxt; int ui = 0;
    if (!S.next(0, cur)) return;
    f32x4 acc[2][2][4][2];
#pragma unroll
    for (int a = 0; a < 2; ++a)
#pragma unroll
        for (int b = 0; b < 2; ++b)
#pragma unroll
            for (int m = 0; m < 4; ++m)
#pragma unroll
                for (int n = 0; n < 2; ++n) acc[a][b][m][n] = (f32x4){0.f, 0.f, 0.f, 0.f};
    bf16x8 At[4][2], B0[2][2], B1[2][2];
    const char* cA = (const char*)g.A + (size_t)cur.pm * tstepA + cur.aoff; const char* cB = (const char*)g.Bt + (size_t)cur.pn * tstepB;
    S.a_ready(cur);
    if constexpr (SP2) {
        PG8_STAGE(PG8_SB(0, 0), cB, voffB); PG8_STAGE(PG8_SB(0, 1), cB + hstepB, voffB); PG8_STAGE(PG8_SA(0, 0), cA, voffA); PG8_STAGE(PG8_SA(0, 1), cA + hstepA, voffA);
        if (wr == 1) PG8_BAR;
        PG8_WAIT_V(2); PG8_BAR;
        PG8_STAGE(PG8_SB(1, 0), cB + kstep, voffB); PG8_STAGE(PG8_SA(1, 0), cA + kstep, voffA); PG8_STAGE(PG8_SB(1, 1), cB + hstepB + kstep, voffB);
        PG8_WAIT_V(6); PG8_BAR;
    } else {
        PG8_STAGE(PG8_SB(0, 0), cB, voffB); PG8_STAGE(PG8_SA(0, 0), cA, voffA); PG8_STAGE(PG8_SB(0, 1), cB + hstepB, voffB); PG8_STAGE(PG8_SA(0, 1), cA + hstepA, voffA);
        if (wr == 1) PG8_BAR;
        PG8_WAIT_V(4); PG8_BAR;
        PG8_STAGE(PG8_SB(1, 0), cB + kstep, voffB); PG8_STAGE(PG8_SA(1, 0), cA + kstep, voffA); PG8_STAGE(PG8_SB(1, 1), cB + hstepB + kstep, voffB);
        PG8_WAIT_V(6); PG8_BAR;
    }
    for (;;) {
        const bool has_next = S.next(ui + 1, nxt);
        const char* nA = has_next ? (const char*)g.A + (size_t)nxt.pm * tstepA + nxt.aoff : cA; const char* nB = has_next ? (const char*)g.Bt + (size_t)nxt.pn * tstepB : cB;
        for (int t = 0; t < nt; t += 2) {
            const bool last = (t == nt - 2);
            const char* a1 = cA + (size_t)(t + 1) * kstep;
            const char* a2 = last ? nA : cA + (size_t)(t + 2) * kstep; const char* b2 = last ? nB : cB + (size_t)(t + 2) * kstep;
            const char* a3 = a2 + kstep; const char* b3 = b2 + kstep;
            if (last && has_next) S.a_ready(nxt);
            if constexpr (SP2) {
            PG8_LDB(B0, 0, 0); PG8_LDB(B1, 0, 1); PG8_SCHED; PG8_LDA(At, 0, 0); PG8_STAGE(PG8_SA(1, 1), a1 + hstepA, voffA);
            PG8_WAIT_V(8); PG8_WAIT_L(0); PG8_BAR; PG8_MMA(0, 0, At, B0); PG8_MMA(0, 1, At, B1); PG8_BAR; PG8_SCHED;
            PG8_LDA(At, 0, 1); PG8_STAGE(PG8_SB(0, 0), b2, voffB); PG8_STAGE(PG8_SB(0, 1), b2 + hstepB, voffB); PG8_STAGE(PG8_SA(0, 0), a2, voffA);
            PG8_WAIT_V(8); PG8_WAIT_L(0); PG8_BAR; PG8_MMA(1, 0, At, B0); PG8_MMA(1, 1, At, B1); PG8_BAR; PG8_SCHED;
            PG8_LDB(B0, 1, 0); PG8_LDB(B1, 1, 1); PG8_SCHED; PG8_LDA(At, 1, 0); PG8_STAGE(PG8_SA(0, 1), a2 + hstepA, voffA);
            PG8_WAIT_V(8); PG8_WAIT_L(0); PG8_BAR; PG8_MMA(0, 0, At, B0); PG8_MMA(0, 1, At, B1); PG8_BAR; PG8_SCHED;
            PG8_LDA(At, 1, 1); PG8_STAGE(PG8_SB(1, 0), b3, voffB); PG8_STAGE(PG8_SB(1, 1), b3 + hstepB, voffB); PG8_STAGE(PG8_SA(1, 0), a3, voffA);
            PG8_WAIT_V(8); PG8_WAIT_L(0); PG8_BAR; PG8_MMA(1, 0, At, B0); PG8_MMA(1, 1, At, B1); PG8_BAR; PG8_SCHED;
            } else {
            PG8_LDB(B0, 0, 0); PG8_SCHED; PG8_LDA(At, 0, 0); PG8_STAGE(PG8_SA(1, 1), a1 + hstepA, voffA);
            PG8_WAIT_L(8); PG8_BAR; PG8_WAIT_L(0); PG8_MMA(0, 0, At, B0); PG8_BAR; PG8_SCHED;
            PG8_LDB(B1, 0, 1); PG8_STAGE(PG8_SB(0, 0), b2, voffB);
            PG8_BAR; PG8_WAIT_L(0); PG8_MMA(0, 1, At, B1); PG8_BAR;
            PG8_LDA(At, 0, 1); PG8_STAGE(PG8_SA(0, 0), a2, voffA);
            PG8_BAR; PG8_WAIT_L(0); PG8_MMA(1, 0, At, B0); PG8_BAR; PG8_SCHED;
            PG8_STAGE(PG8_SB(0, 1), b2 + hstepB, voffB);
            PG8_WAIT_V(6); PG8_BAR; PG8_MMA(1, 1, At, B1); PG8_BAR;
            PG8_LDB(B0, 1, 0); PG8_SCHED; PG8_LDA(At, 1, 0); PG8_STAGE(PG8_SA(0, 1), a2 + hstepA, voffA);
            PG8_WAIT_L(8); PG8_BAR; PG8_WAIT_L(0); PG8_MMA(0, 0, At, B0); PG8_BAR; PG8_SCHED;
            PG8_LDB(B1, 1, 1); PG8_STAGE(PG8_SB(1, 0), b3, voffB);
            PG8_BAR; PG8_WAIT_L(0); PG8_MMA(0, 1, At, B1); PG8_BAR;
            PG8_LDA(At, 1, 1); PG8_STAGE(PG8_SA(1, 0), a3, voffA);
            PG8_BAR; PG8_WAIT_L(0); PG8_MMA(1, 0, At, B0); PG8_BAR; PG8_SCHED;
            PG8_STAGE(PG8_SB(1, 1), b3 + hstepB, voffB);
            PG8_WAIT_V(6); PG8_BAR; PG8_MMA(1, 1, At, B1); PG8_BAR;
            }
        }
        if constexpr (ALIGN_EPI) { if (wr == 0) PG8_BAR; }
        if constexpr (!Epi::AFTER_DRAIN) { E(acc, cur, wr, wc, fr, fq); S.done(cur); }
        if (!has_next) break;
#pragma unroll
        for (int a = 0; a < 2; ++a)
#pragma unroll
            for (int b = 0; b < 2; ++b)
#pragma unroll
                for (int m = 0; m < 4; ++m)
#pragma unroll
                    for (int n = 0; n < 2; ++n) acc[a][b][m][n] = (f32x4){0.f, 0.f, 0.f, 0.f};
        cur = nxt; cA = nA; cB = nB; ++ui;
        if constexpr (ALIGN_EPI) { if (wr == 1) PG8_BAR; }
    }
    PG8_WAIT_V(0);
    if constexpr (!ALIGN_EPI) { if (wr == 0) PG8_BAR; }
    PG8_BAR;
    if constexpr (Epi::AFTER_DRAIN) { E.fused(acc, cur, wr, wc, fr, fq, lds, wid, lane); S.done(cur); }
#undef PG8_SA
#undef PG8_SB
#undef PG8_STAGE
#undef PG8_LDA
#undef PG8_LDB
#undef PG8_MMA
#undef PG8_WAIT_V
#undef PG8_WAIT_L
#undef PG8_BAR
#undef PG8_SCHED
}
}
namespace mk {
using pg8::bf16_t; using pg8::bf16x8; using pg8::f32x4; using pg8::u32x4; using pg8::f32x2;
typedef float f32x16 __attribute__((ext_vector_type(16)));
typedef unsigned u32x2 __attribute__((ext_vector_type(2)));
typedef short s16x4 __attribute__((ext_vector_type(4)));
typedef _Float16 f16x8 __attribute__((ext_vector_type(8)));
#define GAS __attribute__((address_space(1)))
#define LAS __attribute__((address_space(3)))
typedef GAS unsigned gu32;
#define RLX_AGENT __ATOMIC_RELAXED, __HIP_MEMORY_SCOPE_AGENT
#define LDS_WAIT() asm volatile("s_waitcnt lgkmcnt(0)" ::: "memory")
#define VM_WAIT() asm volatile("s_waitcnt vmcnt(0)" ::: "memory")

constexpr int T = 16384, D = 1024, S = 2048, NB = 8;
constexpr int NWAVES = 8, NTHR = 512;
constexpr float EPS = 1e-6f;
constexpr float LOG2E = 1.4426950408889634f;
constexpr float C2M = 0.10206207261596575f * LOG2E;
constexpr float C2S = 0.125f * LOG2E;

constexpr size_t MiB = (size_t)1 << 20;
constexpr size_t WS_CTL = 0, CTL_ZERO_BYTES = 1 * MiB;
constexpr size_t WS_WINE = 1 * MiB;
constexpr size_t WS_WOUTE = 5 * MiB;
constexpr size_t WS_WINO = 7 * MiB;
constexpr size_t WS_WUQ = 10 * MiB;
constexpr size_t WS_WUKV = 10 * MiB + 393216;
constexpr size_t WS_WOUTO = 11 * MiB;
constexpr size_t WS_ROUTER = 13 * MiB;
constexpr size_t WS_ROUTER16 = WS_ROUTER + 393216;
constexpr size_t WS_ROPE = 14 * MiB;
constexpr size_t WS_RS0 = 14 * MiB + 512 * 1024;
constexpr size_t WS_RSM = WS_RS0 + 64 * 1024;
constexpr size_t WS_SSQQ = 15 * MiB;
constexpr size_t WS_SSQKV = 15 * MiB + 256 * 1024;
constexpr size_t WS_WMOE = 16 * MiB;
constexpr size_t WS_XB = 64 * MiB;
constexpr size_t WS_MB = 96 * MiB;
constexpr size_t WS_Y = 128 * MiB;
constexpr size_t WS_PART = 128 * MiB;
constexpr size_t WS_Q = 128 * MiB;
constexpr size_t WS_KV = 152 * MiB;
constexpr size_t WS_P = 192 * MiB;
constexpr size_t WS_LSLOT = 232 * MiB;
constexpr size_t WS_LGW = 234 * MiB;
constexpr size_t WS_KPE = 236 * MiB;
constexpr size_t WS_LRS = 238 * MiB;
constexpr size_t WS_END = 240 * MiB;
constexpr size_t W1_EXP = 524288, W2_EXP = 262144;
constexpr size_t WMOE_LAYER = 24 * MiB, WMOE_W2 = 16 * MiB;
constexpr float WSCALE = 64.f, WDESCALE = 1.f / 64.f;

constexpr int CW_TMO = 0;
constexpr int CW_BAR = 4096;
constexpr int CW_CVT = 8192;
constexpr int CW_PCNT = 24576;
constexpr int CW_ECNT = 16384;

constexpr int LDS_BYTES = 160 * 1024;
constexpr int RING_BYTES = 131072;
constexpr int MISC_OFF = 159 * 1024;

__device__ __forceinline__ unsigned f2bf(float f) { unsigned u = __builtin_bit_cast(unsigned, f); return (u + 0x7fffu + ((u >> 16) & 1u)) >> 16; }
__device__ __forceinline__ float bf2f(unsigned h) { return __builtin_bit_cast(float, h << 16); }
__device__ __forceinline__ unsigned pk2(float lo, float hi) { return pg8::cvt_pk_bf16(lo, hi); }
__device__ __forceinline__ float wave_sum(float v) {
#pragma unroll
    for (int o = 1; o < 64; o <<= 1) v += __shfl_xor(v, o);
    return v;
}
__device__ __forceinline__ float fast_exp2(float x) { return __builtin_amdgcn_exp2f(x); }
__device__ __forceinline__ float fast_rcp(float x) { return __builtin_amdgcn_rcpf(x); }
__device__ __forceinline__ float sigmoid_f(float x) { return fast_rcp(1.f + fast_exp2(-x * LOG2E)); }
__device__ __forceinline__ float silu_f(float x) { return x * sigmoid_f(x); }
__device__ __forceinline__ float gelu_f(float x) { const float u = 0.7978845608028654f * (x + 0.044715f * x * x * x); return x * sigmoid_f(2.f * u); }
__device__ __forceinline__ f32x2 rcp2_(f32x2 d) { f32x2 r; r.x = fast_rcp(d.x); r.y = fast_rcp(d.y); return r; }
__device__ __forceinline__ f32x2 exp2_2_(f32x2 z) { f32x2 r; r.x = fast_exp2(z.x); r.y = fast_exp2(z.y); return r; }
constexpr float GC1 = -2.f * 0.7978845608028654f * LOG2E, GC2 = GC1 * 0.044715f;
__device__ __forceinline__ f32x2 gelu2_f(f32x2 x) { const f32x2 t = x * x; const f32x2 z = x * (t * GC2 + GC1); return x * rcp2_(exp2_2_(z) + 1.f); }
__device__ __forceinline__ f32x2 mul_sigmoid2_f(f32x2 a, f32x2 zn) { return a * rcp2_(exp2_2_(zn) + 1.f); }

#define XB_TMO      128
#define XB_XCNT(j)  (256  + 64 * (j))
#define XB_XSUB(j)  (1280 + 64 * (j))
#define XB_XGEN(j)  (2304 + 64 * (j))
#define XB_TOP      3328
#define XB_TOPGEN   3392
#define XCD_BAR_WORDS 3456
#define XB_SPIN_CAP (1u << 18)
__device__ __forceinline__ unsigned xb_ld(unsigned* p)              { return __hip_atomic_load(p, __ATOMIC_RELAXED, __HIP_MEMORY_SCOPE_AGENT); }
__device__ __forceinline__ unsigned xb_add(unsigned* p, unsigned v) { return __hip_atomic_fetch_add(p, v, __ATOMIC_RELAXED, __HIP_MEMORY_SCOPE_AGENT); }
__device__ __forceinline__ unsigned xb_xcc_id() { return (unsigned)__builtin_amdgcn_s_getreg((3 << 11) | 20) & 0xFu; }
#define XB_SPIN(cond, bar) do { unsigned _sp = 0; while (cond) { __builtin_amdgcn_s_sleep(1); \
    if ((++_sp & 255u) == 0u) { if (xb_ld(&(bar)[XB_TMO])) break; if (_sp > XB_SPIN_CAP) { atomicAdd(&(bar)[XB_TMO], 1u); break; } } } } while (0)
struct XcdBarrier { unsigned* bar; unsigned x; volatile LAS unsigned* st; };
__device__ __forceinline__ XcdBarrier xcd_barrier_post(unsigned* bar, volatile LAS unsigned* st) {
    XcdBarrier b; b.bar = bar; b.x = xb_xcc_id(); b.st = st;
    if (threadIdx.x == 0) (void)xb_add(&bar[XB_XCNT(b.x)], 1u);
    return b;
}
__device__ __forceinline__ void xcd_barrier_complete(unsigned* bar, unsigned x, unsigned& nloc, unsigned& nx) {
    const unsigned G = gridDim.x * gridDim.y * gridDim.z;
    unsigned sum, cnt, mine, sp = 0u;
    for (;;) {
        sum = 0u; cnt = 0u; mine = 0u;
#pragma unroll
        for (unsigned j = 0; j < 16; ++j) { const unsigned c = xb_ld(&bar[XB_XCNT(j)]); sum += c; cnt += (c > 0u) ? 1u : 0u; mine = (j == x) ? c : mine; }
        if (sum == G) break;
        __builtin_amdgcn_s_sleep(1);
        if ((++sp & 255u) == 0u) { if (xb_ld(&bar[XB_TMO])) break; if (sp > XB_SPIN_CAP) { atomicAdd(&bar[XB_TMO], 1u); break; } }
    }
    nloc = mine > 0u ? mine : 1u; nx = cnt > 0u ? cnt : 1u;
}
__device__ __forceinline__ void xcd_barrier(const XcdBarrier& b) {
    asm volatile("s_waitcnt vmcnt(0)" ::: "memory");
    __syncthreads();
    if (threadIdx.x == 0) {
        unsigned* bar = b.bar;
        __builtin_amdgcn_s_waitcnt(0);
        unsigned nloc = b.st[0], nx = b.st[1];
        if (nloc == 0u) { xcd_barrier_complete(bar, b.x, nloc, nx); b.st[0] = nloc; b.st[1] = nx; }
        const unsigned old = xb_add(&bar[XB_XSUB(b.x)], 1u);
        const unsigned gen = old / nloc;
        if (old + 1u == (gen + 1u) * nloc) {
            __builtin_amdgcn_fence(__ATOMIC_RELEASE, "agent");
            asm volatile("s_waitcnt vmcnt(0)" ::: "memory");
            const unsigned og = xb_add(&bar[XB_TOP], 1u);
            const unsigned tg = og / nx;
            if (og + 1u == (tg + 1u) * nx) xb_add(&bar[XB_TOPGEN], 1u);
            else XB_SPIN(xb_ld(&bar[XB_TOPGEN]) == tg, bar);
            xb_add(&bar[XB_XGEN(b.x)], 1u);
            __builtin_amdgcn_fence(__ATOMIC_ACQUIRE, "agent");
            asm volatile("s_waitcnt vmcnt(0)" ::: "memory");
        } else {
            XB_SPIN(xb_ld(&bar[XB_XGEN(b.x)]) == gen, bar);
            __builtin_amdgcn_fence(__ATOMIC_ACQUIRE, "agent");
            asm volatile("s_waitcnt vmcnt(0)" ::: "memory");
        }
    }
    __syncthreads();
}

__device__ __forceinline__ __amdgpu_buffer_rsrc_t uniform_rsrc(const void* p, unsigned bytes) {
    const unsigned long long a = (unsigned long long)p;
    const unsigned lo = __builtin_amdgcn_readfirstlane((unsigned)a), hi = __builtin_amdgcn_readfirstlane((unsigned)(a >> 32));
    return __builtin_amdgcn_make_buffer_rsrc((void*)(((unsigned long long)hi << 32) | lo), 0, bytes, 0x00020000);
}
__device__ __forceinline__ void st16_wt(__amdgpu_buffer_rsrc_t r, unsigned byte_off, u32x4 v) { __builtin_amdgcn_raw_buffer_store_b128(v, r, byte_off, 0, 0); }
__device__ __forceinline__ void st16_wt(__amdgpu_buffer_rsrc_t r, unsigned byte_off, f32x4 v) { __builtin_amdgcn_raw_buffer_store_b128(__builtin_bit_cast(u32x4, v), r, byte_off, 0, 0); }

struct Args { const float* in[28]; float* out; unsigned char* ws; int ph_lo, ph_hi, li, pad; };

struct Frame {
    LAS unsigned char* lds;
    int tid, lane, wave, vcu, G;
    const float* const* in;
    float* out; unsigned char* ws;
};
}
namespace mk {
__device__ __forceinline__ void p0_transpose_item(const float* W, int ldn, int k0, int src_n0, bf16_t* WT, int ldk, int dst_n0,
                                                  const float* gain, float scale, LAS float* scr, int lane) {
    if (src_n0 >= 0) {
#pragma unroll 8
        for (int i = 0; i < 32; ++i) { const int kk = 2 * i + (lane >> 5);
            float v = W[(size_t)(k0 + kk) * ldn + src_n0 + (lane & 31)] * scale; if (gain) v *= gain[k0 + kk];
            scr[kk * 33 + (lane & 31)] = v; }
    } else {
#pragma unroll 8
        for (int i = 0; i < 32; ++i) { const int kk = 2 * i + (lane >> 5); scr[kk * 33 + (lane & 31)] = 0.f; }
    }
    LDS_WAIT(); asm volatile("" ::: "memory");
    const int c = lane & 7;
#pragma unroll
    for (int j = 0; j < 4; ++j) { const int n = (lane >> 3) + 8 * j; const LAS float* s = scr + (8 * c) * 33 + n;
        u32x4 o; o.x = pk2(s[0 * 33], s[1 * 33]); o.y = pk2(s[2 * 33], s[3 * 33]); o.z = pk2(s[4 * 33], s[5 * 33]); o.w = pk2(s[6 * 33], s[7 * 33]);
        *(GAS u32x4*)(WT + (size_t)(dst_n0 + n) * ldk + k0 + 8 * c) = o; }
    LDS_WAIT(); asm volatile("" ::: "memory");
}
template <bool STAGE2>
__device__ __forceinline__ void moe_cvt_tile(const float* src, int ld, const float* gain16, bf16_t* dst0, size_t piece_stride  , LAS float* scr, int lane) {
#pragma unroll 4
    for (int i = 0; i < 16; ++i) { f32x4 v = *(const GAS f32x4*)(src + (size_t)i * ld + 4 * lane); if (gain16) v = v * gain16[i]; *(LAS f32x4*)(scr + i * 256 + 4 * lane) = v; }
    LDS_WAIT(); asm volatile("" ::: "memory");
    const int r = lane & 31, h = lane >> 5;
#pragma unroll
    for (int c = 0; c < 8; ++c) {
        float v[8];
#pragma unroll
        for (int j = 0; j < 8; ++j) { const int row = STAGE2 ? (8 * (j >> 2) + 4 * h + (j & 3)) : (8 * h + j); v[j] = scr[row * 256 + 32 * c + r]; }
        u32x4 o; o.x = pk2(v[0], v[1]); o.y = pk2(v[2], v[3]); o.z = pk2(v[4], v[5]); o.w = pk2(v[6], v[7]);
        *(GAS u32x4*)(dst0 + (size_t)c * piece_stride + (size_t)lane * 8) = o;
    }
    LDS_WAIT(); asm volatile("" ::: "memory");
}
constexpr int MOE_CVT_ITEMS = 6144;
struct CvtRegs { f32x4 v[16]; };
__device__ __forceinline__ void moe_cvt_load(const Frame& F, int layer, int it, CvtRegs& R) {
    const float* src; int ld;
    if (it < 4096) { const int gu = it & 1, r = it >> 1, e = r >> 6, ks = r & 63; src = (gu ? F.in[26] : F.in[25]) + ((size_t)(layer * 32 + e) * 1024 + 16 * ks) * 256; ld = 256; }
    else { const int r = it - 4096, e = r >> 6, kk = (r >> 2) & 15, dq = r & 3; src = F.in[27] + ((size_t)(layer * 32 + e) * 256 + 16 * kk) * 1024 + 256 * dq; ld = 1024; }
#pragma unroll
    for (int i = 0; i < 16; ++i) R.v[i] = __builtin_nontemporal_load((const GAS f32x4*)(src + (size_t)i * ld + 4 * F.lane));
}
__device__ __forceinline__ void moe_cvt_stage(const Frame& F, int layer, int it, const CvtRegs& R, LAS float* scr) {
    if (it < 4096) { const int ks = (it >> 1) & 63; const float* gain = F.in[2] + layer * 1024 + 16 * ks;
#pragma unroll
        for (int i = 0; i < 16; ++i) *(LAS f32x4*)(scr + i * 256 + 4 * F.lane) = R.v[i] * (gain[i] * WSCALE);
    } else {
#pragma unroll
        for (int i = 0; i < 16; ++i) *(LAS f32x4*)(scr + i * 256 + 4 * F.lane) = R.v[i] * WSCALE;
    }
    LDS_WAIT(); asm volatile("" ::: "memory");
}
__device__ __forceinline__ void moe_cvt_emit(const Frame& F, int layer, int it, LAS float* scr) {
    unsigned char* W1 = F.ws + WS_WMOE + (size_t)layer * WMOE_LAYER; unsigned char* W2 = W1 + WMOE_W2;
    const int rr = F.lane & 31, h = F.lane >> 5;
    const bool s2 = it >= 4096;
    unsigned char* base; size_t st_c2, st_dt;
    if (!s2) { const int gu = it & 1, r = it >> 1, e = r >> 6, ks = r & 63; base = W1 + (size_t)e * W1_EXP + (size_t)ks * 1024 + gu * 8; st_c2 = 2 * 65536; st_dt = 65536; }
    else { const int r = it - 4096, e = r >> 6, kk = (r >> 2) & 15, dq = r & 3; const int p = dq >> 1, w0 = (dq & 1) * 4;
        base = W2 + (size_t)e * W2_EXP + ((size_t)(p * 8 + w0) * 16 + kk) * 1024; st_c2 = 16 * 1024; st_dt = 8; }
#pragma unroll
    for (int c = 0; c < 8; ++c) {
        float v[8];
#pragma unroll
        for (int j = 0; j < 8; ++j) { const int row = s2 ? (8 * (j >> 2) + 4 * h + (j & 3)) : (8 * h + j); v[j] = scr[row * 256 + 32 * c + rr]; }
        int w0_ = __builtin_amdgcn_cvt_pk_fp8_f32(v[0], v[1], 0, false); w0_ = __builtin_amdgcn_cvt_pk_fp8_f32(v[2], v[3], w0_, true);
        int w1_ = __builtin_amdgcn_cvt_pk_fp8_f32(v[4], v[5], 0, false); w1_ = __builtin_amdgcn_cvt_pk_fp8_f32(v[6], v[7], w1_, true);
        u32x2 o; o.x = (unsigned)w0_; o.y = (unsigned)w1_;
        *(GAS u32x2*)(base + (size_t)(c >> 1) * st_c2 + (size_t)(c & 1) * st_dt + (size_t)F.lane * 16) = o;
    }
    LDS_WAIT(); asm volatile("" ::: "memory");
}
__device__ __forceinline__ void row_to_bf16_rs(const float* xrow, bf16_t* orow, float* rs, int lane) {
    const GAS f32x4* xr = (const GAS f32x4*)xrow + lane;
    f32x4 v[4]; float s = 0.f;
#pragma unroll
    for (int j = 0; j < 4; ++j) { v[j] = __builtin_nontemporal_load(xr + 64 * j); s += (v[j].x * v[j].x + v[j].y * v[j].y) + (v[j].z * v[j].z + v[j].w * v[j].w); }
    s = wave_sum(s);
    GAS u32x2* o8 = (GAS u32x2*)orow + lane;
#pragma unroll
    for (int j = 0; j < 4; ++j) { u32x2 w; w.x = pk2(v[j].x, v[j].y); w.y = pk2(v[j].z, v[j].w); o8[64 * j] = w; }
    if (lane == 0) *rs = 1.0f / sqrtf(s * (1.f / 1024.f) + EPS);
}

__device__ __forceinline__ void p0_t64(const float* W, int ldn, int k0, int s0, int s1, bf16_t* WT, int ldk, int dst_n0, int dk0, const float* gain, float sc0, float sc1, LAS float* scr, int lane) {
    const int half = (lane >> 3) & 1, src = half ? s1 : s0; const float sc = half ? sc1 : sc0;
    const int rr = lane >> 4, cc = (lane & 15) * 4;
    f32x4 v[16];
#pragma unroll
    for (int i = 0; i < 16; ++i) { const int kk = 4 * i + rr;
        v[i] = (src >= 0) ? __builtin_nontemporal_load((const GAS f32x4*)(W + (size_t)(k0 + kk) * ldn + src + (lane & 7) * 4)) : (f32x4){0.f, 0.f, 0.f, 0.f}; }
#pragma unroll
    for (int i = 0; i < 16; ++i) { const int kk = 4 * i + rr; const float g = (gain ? gain[k0 + kk] : 1.f) * sc; const f32x4 x = v[i] * g;
        LAS float* d = scr + kk * 65 + cc; d[0] = x.x; d[1] = x.y; d[2] = x.z; d[3] = x.w; }
    LDS_WAIT(); asm volatile("" ::: "memory");
    const int c = lane & 7;
#pragma unroll
    for (int j = 0; j < 8; ++j) { const int n = (lane >> 3) + 8 * j; const LAS float* s = scr + (8 * c) * 65 + n;
        u32x4 o; o.x = pk2(s[0 * 65], s[1 * 65]); o.y = pk2(s[2 * 65], s[3 * 65]); o.z = pk2(s[4 * 65], s[5 * 65]); o.w = pk2(s[6 * 65], s[7 * 65]);
        *(GAS u32x4*)(WT + (size_t)(dst_n0 + n) * ldk + dk0 + 8 * c) = o; }
    LDS_WAIT(); asm volatile("" ::: "memory");
}
__device__ __forceinline__ void p0_dense_item(const Frame& F, int it, LAS float* scr) {
    int r = it;
    if (r < 512) { const int kb = r >> 5, nb = r & 31; const int n = 64 * nb; int src;
        if (n < 1024) { const int j = n >> 8, c = n & 255; src = (c < 128) ? (128 * j + c) : (512 + 128 * j + (c - 128)); } else src = n;
        p0_t64(F.in[4], 2048, 64 * kb, src, src + 32, (bf16_t*)(F.ws + WS_WINE), 1024, n, 64 * kb, F.in[1], 1.f, 1.f, scr, F.lane); return; } r -= 512;
    if (r < 256) { const int kb = r >> 4, nb = r & 15;
        p0_t64(F.in[13], 1024, 64 * kb, 64 * nb, 64 * nb + 32, (bf16_t*)(F.ws + WS_WOUTE), 1024, 64 * nb, 64 * kb, nullptr, 1.f, 1.f, scr, F.lane); return; } r -= 256;
    if (r < 320) { const int kb = r / 20, nb = r % 20; const int n = 64 * nb; int s0, s1; float sc = 1.f;
        if (n < 384) { s0 = n; s1 = n + 32; } else if (n == 384) { s0 = 384; s1 = -1; } else if (n < 512) { s0 = -1; s1 = -1; }
        else if (n < 1024) { s0 = 416 + (n - 512); s1 = s0 + 32; sc = C2S; } else if (n < 1152) { s0 = 928 + (n - 1024); s1 = s0 + 32; } else { s0 = 1056 + (n - 1152); s1 = s0 + 32; }
        p0_t64(F.in[14], 1184, 64 * kb, s0, s1, (bf16_t*)(F.ws + WS_WINO), 1024, n, 64 * kb, F.in[1] + 1024, sc, sc, scr, F.lane); return; } r -= 320;
    if (r < 48) { const int kb = r / 12, nb = r % 12; const int n = 64 * nb; int s0, s1;
        if (n < 512) { s0 = 96 * (n >> 6); s1 = s0 + 32; } else { const int h = (n - 512) >> 5; s0 = 96 * h + 64; s1 = 96 * (h + 1) + 64; }
        p0_t64(F.in[16], 768, 64 * kb, s0, s1, (bf16_t*)(F.ws + WS_WUQ), 256, n, 64 * kb, F.in[15], C2M, C2M, scr, F.lane); return; } r -= 48;
    if (r < 64) { const int kb = r >> 4, nb = r & 15; const int n = 64 * nb; int s0;
        if (n < 512) s0 = 128 * (n >> 6); else s0 = 128 * ((n - 512) >> 6) + 64;
        if (kb >= 2) p0_t64(F.in[18], 1024, 0, -1, -1, (bf16_t*)(F.ws + WS_WUKV), 256, n, 64 * kb, nullptr, 1.f, 1.f, scr, F.lane);
        else p0_t64(F.in[18], 1024, 64 * kb, s0, s0 + 32, (bf16_t*)(F.ws + WS_WUKV), 256, n, 64 * kb, F.in[17], 1.f, 1.f, scr, F.lane);
        return; } r -= 64;
    { const int kb = r >> 4, nb = r & 15;
        p0_t64(F.in[20], 1024, 64 * kb, 64 * nb, 64 * nb + 32, (bf16_t*)(F.ws + WS_WOUTO), 1024, 64 * nb, 64 * kb, nullptr, 1.f, 1.f, scr, F.lane); }
}
constexpr int DENSE_ITEMS = 1456;

template <int PARTS = 15> __device__ __forceinline__ void phase_p0(const Frame& F) {
    LAS float* scr = (LAS float*)(F.lds + F.wave * 16896);
    const int gw = F.vcu * NWAVES + F.wave, NGW = F.G * NWAVES;
    if (PARTS & 1) { CvtRegs R; int it = gw; if (it < MOE_CVT_ITEMS) moe_cvt_load(F, 0, it, R);
      for (; it < MOE_CVT_ITEMS; it += NGW) { moe_cvt_stage(F, 0, it, R, scr); if (it + NGW < MOE_CVT_ITEMS) moe_cvt_load(F, 0, it + NGW, R); moe_cvt_emit(F, 0, it, scr); } }
    if (PARTS & 2) for (int it = gw; it < DENSE_ITEMS; it += NGW) p0_dense_item(F, it, scr);
    if (PARTS & 4) for (int m = gw; m < T; m += NGW) row_to_bf16_rs(F.in[0] + (size_t)m * D, (bf16_t*)(F.ws + WS_XB) + (size_t)m * D, (float*)(F.ws + WS_RS0) + m, F.lane);
    const int gt = gw * 64 + F.lane, NGT = NGW * 64;
    if (PARTS & 8) for (int idx = gt; idx < 2 * 49152; idx += NGT) {
        const int layer = idx / 49152, li = idx % 49152;
        const int j = li & 7, ln = (li >> 3) & 63, blk = li >> 9, ct = blk % 3, ks = (blk / 3) & 3, w = blk / 12;
        const int k = 128 * w + 32 * ks + 8 * (ln >> 4) + j, col = 16 * ct + (ln & 15);
        float v = 0.f;
        if (col < 4) v = F.in[21][((size_t)layer * 1024 + k) * 4 + col];
        else if (col < 36) v = F.in[23][(((size_t)layer * 4 + ((col - 4) >> 3)) * 1024 + k) * 8 + ((col - 4) & 7)];
        v *= F.in[2][layer * 1024 + k];
        const unsigned hi = f2bf(v); const unsigned lo = f2bf(v - bf2f(hi));
        bf16_t* R = (bf16_t*)(F.ws + WS_ROUTER);
        R[(size_t)(layer * 2 + 0) * 49152 + li] = (bf16_t)hi;
        R[(size_t)(layer * 2 + 1) * 49152 + li] = (bf16_t)lo;
        ((_Float16*)(F.ws + WS_ROUTER16))[(size_t)layer * 49152 + li] = (_Float16)v;
    }
    if (PARTS & 8) for (int idx = gt; idx < S * 16; idx += NGT) {
        const int pos = idx >> 4, j = idx & 15;
        const double inv = pow(10000.0, -(double)(2 * j) / 32.0), ang = (double)pos * inv;
        f32x2 cs; cs.x = (float)cos(ang); cs.y = (float)sin(ang);
        ((f32x2*)(F.ws + WS_ROPE))[idx] = cs;
    }
}
}
namespace mk {
using pg8::Unit;
__device__ __forceinline__ u32x4 pack8(const f32x4& a, const f32x4& b) { u32x4 w; w.x = pk2(a[0], a[1]); w.y = pk2(a[2], a[3]); w.z = pk2(b[0], b[1]); w.w = pk2(b[2], b[3]); return w; }

struct EpiE1 {
    static constexpr bool PERM = true, AFTER_DRAIN = false;
    bf16_t* ACT; const float* rs;
    __device__ __forceinline__ void operator()(const f32x4 (&acc)[2][2][4][2], const Unit& u, int wr, int wc, int fr, int fq) const {
        const int row0 = u.pm * 256 + wr * 64 + fr, cl = wc * 32 + 8 * fq;
        const __amdgpu_buffer_rsrc_t RA = uniform_rsrc(ACT, (unsigned)T * 1536u * 2u);
        float rsv[2][4];
#pragma unroll
        for (int ai = 0; ai < 2; ++ai)
#pragma unroll
            for (int m = 0; m < 4; ++m) rsv[ai][m] = rs[row0 + ai * 128 + m * 16];
#pragma unroll
        for (int ai = 0; ai < 2; ++ai)
#pragma unroll
            for (int m = 0; m < 4; ++m) {
                const int row = row0 + ai * 128 + m * 16; const float r = rsv[ai][m]; const unsigned rowb = (unsigned)row * 3072u;
                if (u.pn < 4) {
                    f32x4 o0, o1; const float rn = -r * LOG2E;
#pragma unroll
                    for (int n = 0; n < 2; ++n)
#pragma unroll
                        for (int i = 0; i < 4; i += 2) { const f32x2 a = {acc[ai][0][m][n][i], acc[ai][0][m][n][i + 1]}, g = {acc[ai][1][m][n][i], acc[ai][1][m][n][i + 1]};
                            const f32x2 v = mul_sigmoid2_f(a * r, g * rn); if (n == 0) { o0[i] = v.x; o0[i + 1] = v.y; } else { o1[i] = v.x; o1[i + 1] = v.y; } }
                    st16_wt(RA, rowb + (unsigned)(128 * u.pn + cl) * 2u, pack8(o0, o1));
                } else {
                    const int base = (u.pn < 6) ? (512 + (u.pn - 4) * 256) : (1024 + (u.pn - 6) * 256);
#pragma unroll
                    for (int bj = 0; bj < 2; ++bj) { f32x4 o0, o1;
#pragma unroll
                        for (int i = 0; i < 4; i += 2) { const f32x2 x0 = {acc[ai][bj][m][0][i], acc[ai][bj][m][0][i + 1]}, x1 = {acc[ai][bj][m][1][i], acc[ai][bj][m][1][i + 1]};
                            const f32x2 y0 = gelu2_f(x0 * r), y1 = gelu2_f(x1 * r); o0[i] = y0.x; o0[i + 1] = y0.y; o1[i] = y1.x; o1[i + 1] = y1.y; }
                        st16_wt(RA, rowb + (unsigned)(base + bj * 128 + cl) * 2u, pack8(o0, o1)); }
                }
            }
    }
};
struct EpiRes {
    static constexpr bool PERM = true, AFTER_DRAIN = false;
    const float* resid; float* out; bf16_t* xb;
    __device__ __forceinline__ void operator()(const f32x4 (&acc)[2][2][4][2], const Unit& u, int wr, int wc, int fr, int fq) const {
        const int row0 = u.pm * 256 + wr * 64 + fr, col0 = u.pn * 256 + wc * 32 + 8 * fq;
        const __amdgpu_buffer_rsrc_t RO = uniform_rsrc(out, (unsigned)T * 1024u * 4u), RX = uniform_rsrc(xb, (unsigned)T * 1024u * 2u);
#pragma unroll
        for (int ai = 0; ai < 2; ++ai) {
            f32x4 rv[4][2][2];
#pragma unroll
            for (int m = 0; m < 4; ++m) { const size_t off = (size_t)(row0 + ai * 128 + m * 16) * 1024 + col0;
#pragma unroll
                for (int bj = 0; bj < 2; ++bj) { rv[m][bj][0] = *(const f32x4*)(resid + off + bj * 128); rv[m][bj][1] = *(const f32x4*)(resid + off + bj * 128 + 4); } }
            asm volatile("" ::: "memory");
#pragma unroll
            for (int m = 0; m < 4; ++m) {
                const size_t off = (size_t)(row0 + ai * 128 + m * 16) * 1024 + col0;
#pragma unroll
                for (int bj = 0; bj < 2; ++bj) {
                    const f32x4 v0 = acc[ai][bj][m][0] + rv[m][bj][0], v1 = acc[ai][bj][m][1] + rv[m][bj][1];
                    const unsigned eo = (unsigned)(off + bj * 128);
                    st16_wt(RO, eo * 4u, v0); st16_wt(RO, eo * 4u + 16u, v1);
                    st16_wt(RX, eo * 2u, pack8(v0, v1));
                }
            }
            asm volatile("" ::: "memory");
        }
    }
};
__device__ __forceinline__ void router_select256(unsigned char* ws, const LAS float* bg, const LAS float* br, unsigned* gcnt, int tok0, int tid, int lane, int wave, LAS unsigned char* lds) {
    LAS float* lg = (LAS float*)lds;
    LAS float* rsl = (LAS float*)(lds + 49152);
    LAS int* sel = (LAS int*)(lds + 50176);
    LAS float* gwl = (LAS float*)(lds + 52224);
    LAS int* basel = (LAS int*)(lds + 54272);
    LAS int* cntw = (LAS int*)(lds + 54400);
    LAS int* pre = (LAS int*)(lds + 55424);
    if (tid < 256) {
        const float rs = rsl[tid]; const LAS float* L = lg + tid * 48;
        float gl[4];
#pragma unroll
        for (int j = 0; j < 4; ++j) gl[j] = L[j] * rs + bg[j];
        int gi = 0; float gm = gl[0];
#pragma unroll
        for (int j = 1; j < 4; ++j) if (gl[j] > gm) { gm = gl[j]; gi = j; }
        float den = 0.f;
#pragma unroll
        for (int j = 0; j < 4; ++j) den += __expf(gl[j] - gm);
        const float gp = 1.f / den;
        float el[8];
#pragma unroll
        for (int x = 0; x < 8; ++x) el[x] = L[4 + 8 * gi + x] * rs + br[gi * 8 + x];
        int i1 = 0; float v1 = el[0];
#pragma unroll
        for (int x = 1; x < 8; ++x) if (el[x] > v1) { v1 = el[x]; i1 = x; }
        int i2 = 0; float v2 = -3.0e38f;
#pragma unroll
        for (int x = 0; x < 8; ++x) if (x != i1 && el[x] > v2) { v2 = el[x]; i2 = x; }
        const float e2 = __expf(v2 - v1);
        sel[2 * tid] = gi * 8 + i1; sel[2 * tid + 1] = gi * 8 + i2;
        gwl[2 * tid] = gp / (1.f + e2); gwl[2 * tid + 1] = gp * e2 / (1.f + e2);
        ((float*)(ws + WS_RSM))[tok0 + tid] = rs;
    }
    __syncthreads();
    const int myexp = sel[tid]; unsigned long long mymask = 0ull;
#pragma unroll 4
    for (int x = 0; x < 32; ++x) { const unsigned long long m = __ballot(myexp == x); if (myexp == x) mymask = m; if (lane == 0) cntw[wave * 32 + x] = __popcll(m); }
    const int pos = __popcll(mymask & ((1ull << lane) - 1ull));
    __syncthreads();
    if (tid < 32) { int run = 0;
#pragma unroll
        for (int w = 0; w < 8; ++w) { pre[w * 32 + tid] = run; run += cntw[w * 32 + tid]; }
        basel[tid] = run ? (int)__hip_atomic_fetch_add(gcnt + tid * 64, (unsigned)run, __ATOMIC_RELAXED, __HIP_MEMORY_SCOPE_AGENT) : 0; }
    __syncthreads();
    const size_t dst = (size_t)myexp * T + basel[myexp] + pre[wave * 32 + myexp] + pos;
    ((int*)(ws + WS_LSLOT))[dst] = 2 * (tok0 + (tid >> 1)) + (tid & 1);
    ((float*)(ws + WS_LGW))[dst] = gwl[tid];
    ((float*)(ws + WS_LRS))[dst] = rsl[tid >> 1];
}
template <bool SELECT> struct EpiResR {
    static constexpr bool PERM = true, AFTER_DRAIN = true;
    bf16_t* xb; const _Float16* rw; float* part;
    unsigned char* ws; const float* bg; const float* br; unsigned* gcnt; unsigned* pcnt;
    __device__ __forceinline__ void operator()(const f32x4 (&acc)[2][2][4][2], const Unit& u, int wr, int wc, int fr, int fq) const {}
    __device__ __forceinline__ void fused(const f32x4 (&acc)[2][2][4][2], const Unit& u, int wr, int wc, int fr, int fq, LAS unsigned char* lds, int wid, int lane) const {
        const int tid = wid * 64 + lane;
        LAS float* pl = (LAS float*)lds;
        f16x8 B[2][3];
#pragma unroll
        for (int bj = 0; bj < 2; ++bj)
#pragma unroll
            for (int ct = 0; ct < 3; ++ct) B[bj][ct] = *(const GAS f16x8*)(rw + ((size_t)((8 * u.pn + 4 * bj + wc) * 3 + ct) * 64 + lane) * 8);
        const int row0 = u.pm * 256 + wr * 64 + fr, col0 = u.pn * 256 + wc * 32 + 8 * fq;
        const __amdgpu_buffer_rsrc_t RX = uniform_rsrc(xb, (unsigned)T * 1024u * 2u), RP = uniform_rsrc(part, 4u * (unsigned)T * 208u);
        LAS float* bgl = (LAS float*)(lds + 122880);
        if constexpr (SELECT) { if (tid < 4) bgl[tid] = bg[tid]; else if (tid >= 8 && tid < 40) bgl[tid] = br[tid - 8]; }
#pragma unroll
        for (int ai = 0; ai < 2; ++ai) {
            u32x4 rv[4][2];
#pragma unroll
            for (int m = 0; m < 4; ++m) { const unsigned off = (unsigned)((row0 + ai * 128 + m * 16) * 1024 + col0);
#pragma unroll
                for (int bj = 0; bj < 2; ++bj) rv[m][bj] = __builtin_amdgcn_raw_buffer_load_b128(RX, (off + bj * 128) * 2u, 0, 0); }
            asm volatile("" ::: "memory");
#pragma unroll
            for (int m = 0; m < 4; ++m) {
                const unsigned off = (unsigned)((row0 + ai * 128 + m * 16) * 1024 + col0);
                f32x4 lacc[3]; f32x2 ssq2 = {0.f, 0.f};
#pragma unroll
                for (int ct = 0; ct < 3; ++ct) lacc[ct] = (f32x4){0.f, 0.f, 0.f, 0.f};
#pragma unroll
                for (int bj = 0; bj < 2; ++bj) {
                    const u32x4 rw_ = rv[m][bj];
                    typedef _Float16 h2_t __attribute__((ext_vector_type(2)));
                    const unsigned rwa[4] = {rw_.x, rw_.y, rw_.z, rw_.w};
                    f32x4 v0, v1; u32x4 hiw, low;
#pragma unroll
                    for (int q = 0; q < 4; ++q) {
                        const f32x2 rr = {bf2f(rwa[q] & 0xffffu), __builtin_bit_cast(float, rwa[q] & 0xffff0000u)};
                        const f32x2 aa = (q < 2) ? (f32x2){acc[ai][bj][m][0][2 * q], acc[ai][bj][m][0][2 * q + 1]} : (f32x2){acc[ai][bj][m][1][2 * q - 4], acc[ai][bj][m][1][2 * q - 3]};
                        const f32x2 vv = aa + rr;
                        ssq2 = vv * vv + ssq2;
                        const h2_t hh = __builtin_bit_cast(h2_t, __builtin_amdgcn_cvt_pkrtz(vv.x, vv.y));
                        const f32x2 back = {(float)hh.x, (float)hh.y};
                        const f32x2 dd = vv - back;
                        hiw[q] = __builtin_bit_cast(unsigned, hh); low[q] = __builtin_bit_cast(unsigned, __builtin_amdgcn_cvt_pkrtz(dd.x, dd.y));
                        if (q < 2) { v0[2 * q] = vv.x; v0[2 * q + 1] = vv.y; } else { v1[2 * q - 4] = vv.x; v1[2 * q - 3] = vv.y; }
                    }
                    st16_wt(RX, (off + bj * 128) * 2u, pack8(v0, v1));
                    const f16x8 hi = __builtin_bit_cast(f16x8, hiw), lo = __builtin_bit_cast(f16x8, low);
#pragma unroll
                    for (int ct = 0; ct < 3; ++ct) {
                        lacc[ct] = __builtin_amdgcn_mfma_f32_16x16x32_f16(hi, B[bj][ct], lacc[ct], 0, 0, 0);
                        lacc[ct] = __builtin_amdgcn_mfma_f32_16x16x32_f16(lo, B[bj][ct], lacc[ct], 0, 0, 0);
                    }
                }
                LAS float* pr = pl + (wc * 128 + wr * 64 + m * 16 + 4 * fq) * 52 + fr;
#pragma unroll
                for (int ct = 0; ct < 3; ++ct)
#pragma unroll
                    for (int i = 0; i < 4; ++i) pr[i * 52 + 16 * ct] = lacc[ct][i];
                float ssq = ssq2.x + ssq2.y; ssq += __shfl_xor(ssq, 16); ssq += __shfl_xor(ssq, 32);
                if (fq == 0) pl[(wc * 128 + wr * 64 + m * 16 + fr) * 52 + 48] = ssq;
            }
            asm volatile("" ::: "memory");
            __syncthreads();
            const unsigned dsto = (unsigned)((u.pn * T + u.pm * 256 + ai * 128) * 208);
            for (int i = tid; i < 1664; i += NTHR) { const LAS f32x4* s = (const LAS f32x4*)pl + i;
                const f32x4 v = (s[0] + s[1664]) + (s[2 * 1664] + s[3 * 1664]);
                __builtin_amdgcn_raw_buffer_store_b128(__builtin_bit_cast(u32x4, v), RP, dsto + (unsigned)i * 16u, 0, SELECT ? 16 : 0); }
            if (ai == 0) __syncthreads();
        }
        if constexpr (SELECT) {
            asm volatile("s_waitcnt vmcnt(0)" ::: "memory");
            __syncthreads();
            volatile LAS int* flag = (volatile LAS int*)(lds + 56448);
            if (tid == 0) *flag = (__hip_atomic_fetch_add(pcnt + u.pm * 16, 1u, __ATOMIC_RELAXED, __HIP_MEMORY_SCOPE_AGENT) == 3u) ? 1 : 0;
            __syncthreads();
            if (*flag) {
                const int tok0 = u.pm * 256;
                LAS float* lg = (LAS float*)lds; LAS float* rsl = (LAS float*)(lds + 49152);
                u32x4 pv[7][4];
#pragma unroll
                for (int k = 0; k < 7; ++k) { const int idx = tid + NTHR * k, ic = idx < 3328 ? idx : 0;
#pragma unroll
                    for (int pn = 0; pn < 4; ++pn) pv[k][pn] = __builtin_amdgcn_raw_buffer_load_b128(RP, (unsigned)(pn * T * 208 + tok0 * 208 + ic * 16), 0, 16); }
#pragma unroll
                for (int k = 0; k < 7; ++k) { const int idx = tid + NTHR * k; const int t = idx / 13, j = idx - 13 * t;
                    f32x4 s = __builtin_bit_cast(f32x4, pv[k][0]);
#pragma unroll
                    for (int pn = 1; pn < 4; ++pn) s += __builtin_bit_cast(f32x4, pv[k][pn]);
                    if (idx < 3328) { if (j < 12) *(LAS f32x4*)(lg + t * 48 + 4 * j) = s; else rsl[t] = 1.0f / sqrtf(s[0] * (1.f / 1024.f) + EPS); } }
                __syncthreads();
                router_select256(ws, bgl, bgl + 8, gcnt, tok0, tid, lane, wid, lds);
            }
        }
    }
};
struct EpiO1 {
    static constexpr bool PERM = true, AFTER_DRAIN = false;
    bf16_t* P; const float* rs; float* ssqq; float* ssqkv; bf16_t* kpe; const f32x2* rope;
    __device__ __forceinline__ void operator()(const f32x4 (&acc)[2][2][4][2], const Unit& u, int wr, int wc, int fr, int fq) const {
        const int row0 = u.pm * 256 + wr * 64 + fr, cl = wc * 32 + 8 * fq;
        const __amdgpu_buffer_rsrc_t RP = uniform_rsrc(P, (unsigned)T * 1280u * 2u);
        float rsv[2][4];
#pragma unroll
        for (int ai = 0; ai < 2; ++ai)
#pragma unroll
            for (int m = 0; m < 4; ++m) rsv[ai][m] = rs[row0 + ai * 128 + m * 16];
#pragma unroll
        for (int ai = 0; ai < 2; ++ai)
#pragma unroll
            for (int m = 0; m < 4; ++m) {
                const int row = row0 + ai * 128 + m * 16; const float r = rsv[ai][m]; const unsigned rowb = ((unsigned)row * 1280u + (unsigned)(u.pn * 256 + cl)) * 2u;
                f32x4 v[2][2];
#pragma unroll
                for (int bj = 0; bj < 2; ++bj) { v[bj][0] = acc[ai][bj][m][0] * r; v[bj][1] = acc[ai][bj][m][1] * r; st16_wt(RP, rowb + bj * 256u, pack8(v[bj][0], v[bj][1])); }
                if (u.pn <= 1) {
                    float s = 0.f;
#pragma unroll
                    for (int i = 0; i < 4; ++i) { s += v[0][0][i] * v[0][0][i] + v[0][1][i] * v[0][1][i]; if (u.pn == 0) s += v[1][0][i] * v[1][0][i] + v[1][1][i] * v[1][1][i]; }
                    s += __shfl_xor(s, 16); s += __shfl_xor(s, 32);
                    if (fq == 0) (u.pn == 0 ? ssqq : ssqkv)[(size_t)row * 4 + wc] = s;
                }
                if (u.pn == 1 && wc == 0) {
                    const int pos = row & (S - 1); f32x4 o[2];
#pragma unroll
                    for (int n = 0; n < 2; ++n)
#pragma unroll
                        for (int i = 0; i < 4; ++i) { const float x = v[1][n][i], y = __shfl_xor(x, 32); const f32x2 cs = rope[pos * 16 + ((8 * fq + 4 * n + i) & 15)];
                            o[n][i] = (fq < 2) ? (x * cs.x - y * cs.y) : (x * cs.x + y * cs.y); }
                    *(u32x4*)(kpe + (size_t)row * 32 + 8 * fq) = pack8(o[0], o[1]);
                }
                asm volatile("" ::: "memory");
            }
    }
};
struct O2Order : pg8::StaticOrder {
    __device__ bool next(int i, Unit& u) const { const bool ok = pg8::StaticOrder::next(i, u); if (ok) u.aoff = (u.pn >= 3) ? 512 : 0; return ok; }
};
struct EpiO2 {
    static constexpr bool PERM = true, AFTER_DRAIN = false;
    bf16_t* Q; bf16_t* KV; const float* ssqq; const float* ssqkv;
    __device__ __forceinline__ void operator()(const f32x4 (&acc)[2][2][4][2], const Unit& u, int wr, int wc, int fr, int fq) const {
        const int row0 = u.pm * 256 + wr * 64 + fr, cl = wc * 32 + 8 * fq;
        const bool isq = u.pn < 3; const float* ssq = isq ? ssqq : ssqkv; const float inv_n = isq ? (1.f / 256.f) : (1.f / 128.f);
        bf16_t* O = isq ? (Q + u.pn * 256 + cl) : (KV + (u.pn - 3) * 256 + cl); const int ldo = isq ? 768 : 1024;
        f32x4 sqv[2][4];
#pragma unroll
        for (int ai = 0; ai < 2; ++ai)
#pragma unroll
            for (int m = 0; m < 4; ++m) sqv[ai][m] = *(const f32x4*)(ssq + (size_t)(row0 + ai * 128 + m * 16) * 4);
#pragma unroll
        for (int ai = 0; ai < 2; ++ai)
#pragma unroll
            for (int m = 0; m < 4; ++m) {
                const int row = row0 + ai * 128 + m * 16; const f32x4 sq = sqv[ai][m];
                const float r = __builtin_amdgcn_rsqf(((sq[0] + sq[1]) + (sq[2] + sq[3])) * inv_n + EPS);
                bf16_t* rowp = O + (size_t)row * ldo;
#pragma unroll
                for (int bj = 0; bj < 2; ++bj) *(u32x4*)(rowp + bj * 128) = pack8(acc[ai][bj][m][0] * r, acc[ai][bj][m][1] * r);
                asm volatile("" ::: "memory");
            }
    }
};
}
namespace mk {
struct ConvW { f32x2 w[31]; f32x2 bias, g, bt; };
__device__ __forceinline__ void e2_conv_load_w(const Frame& F, int grp, ConvW& W) {
    const int ch = grp * 128 + 2 * F.lane; const float* cw = F.in[5];
#pragma unroll
    for (int q = 0; q < 31; ++q) W.w[q] = *(const f32x2*)(cw + q * 512 + ch);
    W.bias = *(const f32x2*)(F.in[6] + ch); W.g = *(const f32x2*)(F.in[7] + ch); W.bt = *(const f32x2*)(F.in[8] + ch);
}
__device__ __forceinline__ void e2_conv_wave_unit(const Frame& F, int run, int grp, const bf16_t* ACT, bf16_t* MBo, const ConvW& W) {
    LAS bf16_t* tile = (LAS bf16_t*)(F.lds + F.wave * 16896);
    LAS float* scr = (LAS float*)(F.lds + F.wave * 16896 + 12288);
    const int t0 = run * 16, s0 = t0 & (S - 1);
#pragma unroll
    for (int i = 0; i < 12; ++i) { const int idx = F.lane + 64 * i, r = idx >> 4, c = idx & 15; const int sp = s0 + r - 15;
        if (r < 46) { u32x4 v = {0u, 0u, 0u, 0u};
            if (sp >= 0 && sp < S) v = *(const GAS u32x4*)(ACT + (size_t)(t0 + r - 15) * 1536 + grp * 128 + c * 8);
            *(LAS u32x4*)(tile + r * 128 + c * 8) = v; } }
    const int ch = grp * 128 + 2 * F.lane;
    const f32x2 bias = W.bias;
    f32x2 av[16];
#pragma unroll
    for (int k = 0; k < 16; ++k) av[k] = bias;
    LDS_WAIT(); asm volatile("" ::: "memory");
    const LAS unsigned* src = (const LAS unsigned*)(tile + 2 * F.lane);
#pragma unroll
    for (int i = 0; i < 46; ++i) { const unsigned x = src[i * 64]; const f32x2 xv = {bf2f(x & 0xffffu), bf2f(x >> 16)};
#pragma unroll
        for (int k = 0; k < 16; ++k) { const int q = i - k; if (q >= 0 && q <= 30) av[k] = xv * W.w[q] + av[k]; } }
    float a0[16], a1[16];
#pragma unroll
    for (int k = 0; k < 16; ++k) { a0[k] = av[k].x; a1[k] = av[k].y; }
    const f32x2 g = W.g, bt = W.bt;
    const bool b5 = (F.lane & 32) != 0, b4 = (F.lane & 16) != 0, b3 = (F.lane & 8) != 0, b2 = (F.lane & 4) != 0;
    const int tk = (b5 ? 8 : 0) + (b4 ? 4 : 0) + (b3 ? 2 : 0) + (b2 ? 1 : 0);
#define E2_BFLY(S, OUT) do { float v8_[8], v4_[4], v2_[2]; \
        _Pragma("unroll") for (int k = 0; k < 8; ++k) { const float kp = b5 ? S[k + 8] : S[k], sd = b5 ? S[k] : S[k + 8]; v8_[k] = kp + __shfl_xor(sd, 32); } \
        _Pragma("unroll") for (int k = 0; k < 4; ++k) { const float kp = b4 ? v8_[k + 4] : v8_[k], sd = b4 ? v8_[k] : v8_[k + 4]; v4_[k] = kp + __shfl_xor(sd, 16); } \
        _Pragma("unroll") for (int k = 0; k < 2; ++k) { const float kp = b3 ? v4_[k + 2] : v4_[k], sd = b3 ? v4_[k] : v4_[k + 2]; v2_[k] = kp + __shfl_xor(sd, 8); } \
        { const float kp = b2 ? v2_[1] : v2_[0], sd = b2 ? v2_[0] : v2_[1]; OUT = kp + __shfl_xor(sd, 4); } \
        OUT += __shfl_xor(OUT, 2); OUT += __shfl_xor(OUT, 1); } while (0)
    float st[16], tot;
#pragma unroll
    for (int k = 0; k < 16; ++k) st[k] = a0[k] + a1[k];
    E2_BFLY(st, tot);
    if ((F.lane & 3) == 0) scr[tk] = tot * (1.f / 128.f);
    LDS_WAIT(); asm volatile("" ::: "memory");
    float mu[16];
#pragma unroll
    for (int k4 = 0; k4 < 4; ++k4) { const f32x4 m4 = *(const LAS f32x4*)(scr + 4 * k4); mu[4 * k4] = m4.x; mu[4 * k4 + 1] = m4.y; mu[4 * k4 + 2] = m4.z; mu[4 * k4 + 3] = m4.w; }
#pragma unroll
    for (int k = 0; k < 16; ++k) { a0[k] -= mu[k]; a1[k] -= mu[k]; st[k] = a0[k] * a0[k] + a1[k] * a1[k]; }
    E2_BFLY(st, tot);
    if ((F.lane & 3) == 0) scr[16 + tk] = 1.0f / sqrtf(tot * (1.f / 128.f) + EPS);
    LDS_WAIT(); asm volatile("" ::: "memory");
#undef E2_BFLY
#pragma unroll
    for (int k4 = 0; k4 < 4; ++k4) { const f32x4 r4 = *(const LAS f32x4*)(scr + 16 + 4 * k4);
#pragma unroll
        for (int i = 0; i < 4; ++i) { const int k = 4 * k4 + i; const float rs = r4[i];
            const float y0 = silu_f(a0[k] * rs * g.x + bt.x), y1 = silu_f(a1[k] * rs * g.y + bt.y);
            *(GAS unsigned*)(MBo + (size_t)(t0 + k) * 1024 + ch) = pk2(y0, y1); } }
    LDS_WAIT(); asm volatile("" ::: "memory");
}
__device__ __forceinline__ void e2_sgu_unit(const Frame& F, int chunk, int h, const bf16_t* ACT, bf16_t* MBo, bool load_w) {
    constexpr int LD = 136, LDO = 132;
    LAS bf16_t* WSl = (LAS bf16_t*)F.lds;
    LAS bf16_t* VTl = (LAS bf16_t*)(F.lds + 34816);
    LAS float* OUTl = (LAS float*)(F.lds + 69632);
    const int t0 = chunk * 128;
    const float* wsp = F.in[11] + (size_t)h * 128 * 128;
    if (load_w) for (int idx = F.tid; idx < 4096; idx += NTHR) { const int r = idx >> 5, c4 = idx & 31; const f32x4 v = *(const GAS f32x4*)(wsp + r * 128 + 4 * c4);
        u32x2 w; w.x = pk2(v.x, v.y); w.y = pk2(v.z, v.w); *(LAS u32x2*)(WSl + r * LD + 4 * c4) = w; }
#pragma unroll
    for (int it = 0; it < 4; ++it) { const int idx = F.tid + NTHR * it, s = idx >> 4, c = idx & 15;
        const u32x4 raw = *(const GAS u32x4*)(ACT + (size_t)(t0 + s) * 1536 + 1024 + h * 128 + 8 * c);
        float x[8]; x[0] = bf2f(raw.x & 0xffffu); x[1] = bf2f(raw.x >> 16); x[2] = bf2f(raw.y & 0xffffu); x[3] = bf2f(raw.y >> 16);
        x[4] = bf2f(raw.z & 0xffffu); x[5] = bf2f(raw.z >> 16); x[6] = bf2f(raw.w & 0xffffu); x[7] = bf2f(raw.w >> 16);
        float sm = 0.f;
#pragma unroll
        for (int i = 0; i < 8; ++i) sm += x[i];
        sm += __shfl_xor(sm, 1); sm += __shfl_xor(sm, 2); sm += __shfl_xor(sm, 4); sm += __shfl_xor(sm, 8);
        const float mu = sm * (1.f / 128.f); float q = 0.f;
#pragma unroll
        for (int i = 0; i < 8; ++i) { x[i] -= mu; q += x[i] * x[i]; }
        q += __shfl_xor(q, 1); q += __shfl_xor(q, 2); q += __shfl_xor(q, 4); q += __shfl_xor(q, 8);
        const float rs = 1.0f / sqrtf(q * (1.f / 128.f) + EPS);
        const float* vg = F.in[9] + h * 128 + 8 * c; const float* vb = F.in[10] + h * 128 + 8 * c;
#pragma unroll
        for (int i = 0; i < 8; ++i) { const float y = x[i] * rs * vg[i] + vb[i]; VTl[(8 * c + i) * LD + s] = (bf16_t)f2bf(y); }
    }
    __syncthreads();
    const int wt = F.wave >> 1, wc = F.wave & 1, r32 = F.lane & 31, hi = F.lane >> 5;
    f32x16 acc[2]; acc[0] = f32x16{}; acc[1] = f32x16{};
#pragma unroll
    for (int ks = 0; ks < 8; ++ks) {
        const bf16x8 a = *(const LAS bf16x8*)(WSl + (32 * wt + r32) * LD + 16 * ks + 8 * hi);
#pragma unroll
        for (int ct = 0; ct < 2; ++ct) { const bf16x8 b = *(const LAS bf16x8*)(VTl + (64 * wc + 32 * ct + r32) * LD + 16 * ks + 8 * hi);
            acc[ct] = __builtin_amdgcn_mfma_f32_32x32x16_bf16(a, b, acc[ct], 0, 0, 0); }
    }
    const float* bsp = F.in[12] + h * 128;
#pragma unroll
    for (int ct = 0; ct < 2; ++ct)
#pragma unroll
        for (int r = 0; r < 16; ++r) { const int trow = 32 * wt + (r & 3) + 8 * (r >> 2) + 4 * hi; OUTl[trow * LDO + 64 * wc + 32 * ct + r32] = acc[ct][r] + bsp[trow]; }
    __syncthreads();
#pragma unroll
    for (int it = 0; it < 4; ++it) { const int idx = F.tid + NTHR * it, t = idx >> 4, c = idx & 15;
        const u32x4 raw = *(const GAS u32x4*)(ACT + (size_t)(t0 + t) * 1536 + 512 + h * 128 + 8 * c);
        const f32x4 s0 = *(const LAS f32x4*)(OUTl + t * LDO + 8 * c), s1 = *(const LAS f32x4*)(OUTl + t * LDO + 8 * c + 4);
        u32x4 o; o.x = pk2(bf2f(raw.x & 0xffffu) * s0.x, bf2f(raw.x >> 16) * s0.y); o.y = pk2(bf2f(raw.y & 0xffffu) * s0.z, bf2f(raw.y >> 16) * s0.w);
        o.z = pk2(bf2f(raw.z & 0xffffu) * s1.x, bf2f(raw.z >> 16) * s1.y); o.w = pk2(bf2f(raw.w & 0xffffu) * s1.z, bf2f(raw.w >> 16) * s1.w);
        *(GAS u32x4*)(MBo + (size_t)(t0 + t) * 1024 + 512 + h * 128 + 8 * c) = o; }
    __syncthreads();
}
__device__ __forceinline__ void phase_e2(const Frame& F) {
    const bf16_t* ACT = (const bf16_t*)F.out; bf16_t* MBo = (bf16_t*)(F.ws + WS_MB);
    { const int gw = F.vcu * NWAVES + F.wave, NGW = F.G * NWAVES;
      LAS float* cscr = (LAS float*)(F.lds + F.wave * 16896); CvtRegs R; int it = gw; bool staged = false;
      if (it < MOE_CVT_ITEMS) moe_cvt_load(F, 0, it, R);
      ConvW W; e2_conv_load_w(F, gw & 3, W);
      for (int u = gw; u < 4096 || it < MOE_CVT_ITEMS; u += NGW) {
          if (u < 4096) { if ((NGW & 3) != 0) e2_conv_load_w(F, u & 3, W); e2_conv_wave_unit(F, u >> 2, u & 3, ACT, MBo, W); }
          if (it < MOE_CVT_ITEMS) { moe_cvt_stage(F, 0, it, R, cscr); if (it + NGW < MOE_CVT_ITEMS) moe_cvt_load(F, 0, it + NGW, R); moe_cvt_emit(F, 0, it, cscr); it += NGW; }
      }
      (void)staged; }
    __syncthreads();
    for (int u = F.vcu; u < 512; u += F.G) e2_sgu_unit(F, u >> 2, u & 3, ACT, MBo, u == F.vcu || (F.G & 3) != 0);
}
template <bool FINAL> __device__ __forceinline__ void combine_rows(const Frame& F) {
    const int gw = F.vcu * NWAVES + F.wave, NGW = F.G * NWAVES;
    const bf16_t* Y = (const bf16_t*)(F.ws + WS_Y);
    for (int m = gw; m < T; m += NGW) {
        GAS u32x2* xr = (GAS u32x2*)((bf16_t*)(F.ws + WS_XB) + (size_t)m * D) + F.lane;
        const GAS u32x2* y0 = (const GAS u32x2*)(Y + (size_t)(2 * m) * D) + F.lane; const GAS u32x2* y1 = (const GAS u32x2*)(Y + (size_t)(2 * m + 1) * D) + F.lane;
        f32x4 v[4]; float s = 0.f;
#pragma unroll
        for (int j = 0; j < 4; ++j) { const u32x2 a = __builtin_nontemporal_load(y0 + 64 * j), b = __builtin_nontemporal_load(y1 + 64 * j);
            v[j].x = bf2f(a.x & 0xffffu) + bf2f(b.x & 0xffffu); v[j].y = bf2f(a.x >> 16) + bf2f(b.x >> 16);
            v[j].z = bf2f(a.y & 0xffffu) + bf2f(b.y & 0xffffu); v[j].w = bf2f(a.y >> 16) + bf2f(b.y >> 16);
            s += (v[j].x * v[j].x + v[j].y * v[j].y) + (v[j].z * v[j].z + v[j].w * v[j].w); }
        s = wave_sum(s);
        const float rs = 1.0f / sqrtf(s * (1.f / 1024.f) + EPS);
        if (FINAL) {
            GAS f32x4* orow = (GAS f32x4*)(F.out + (size_t)m * D) + F.lane;
            const GAS f32x4* g = (const GAS f32x4*)F.in[3] + F.lane;
#pragma unroll
            for (int j = 0; j < 4; ++j) { const f32x4 gg = g[64 * j]; __builtin_nontemporal_store(v[j] * rs * gg, orow + 64 * j); }
        } else {
#pragma unroll
            for (int j = 0; j < 4; ++j) { u32x2 w; w.x = pk2(v[j].x, v[j].y); w.y = pk2(v[j].z, v[j].w); xr[64 * j] = w; }
            if (F.lane == 0) ((float*)(F.ws + WS_RS0))[m] = rs;
        }
    }
}
}
namespace mk {
typedef float f32x4v __attribute__((ext_vector_type(4)));
template <bool FUSED = false> __device__ __forceinline__ void phase_router(const Frame& F, int layer) {
    LAS float* red = (LAS float*)F.lds;
    LAS float* ssqr = (LAS float*)(F.lds + 98304);
    LAS float* lg = (LAS float*)(F.lds + 100352);
    LAS float* rsl = (LAS float*)(F.lds + 112640);
    LAS int* sel = (LAS int*)(F.lds + 112896);
    LAS float* gwl = (LAS float*)(F.lds + 113408);
    LAS int* basel = (LAS int*)(F.lds + 113920);
    const bf16_t* RH = (const bf16_t*)(F.ws + WS_ROUTER) + (size_t)(layer * 2) * 49152 + (size_t)F.wave * 6144;
    const bf16_t* RL = RH + 49152;
    unsigned* gcnt = (unsigned*)(F.ws + WS_CTL) + CW_ECNT + layer * 32 * 64;
    const int r = F.lane & 15, q = F.lane >> 4;
    for (int unit = F.vcu; unit < T / 64; unit += F.G) {
        const int tok0 = unit * 64;
        if constexpr (FUSED) {
            const f32x4* PT = (const f32x4*)(F.ws + WS_PART);
            for (int idx = F.tid; idx < 64 * 13; idx += NTHR) { const int t = idx / 13, j = idx - 13 * t;
                f32x4 s = PT[(size_t)(tok0 + t) * 13 + j];
#pragma unroll
                for (int pn = 1; pn < 4; ++pn) s += PT[((size_t)pn * T + tok0 + t) * 13 + j];
                if (j < 12) *(LAS f32x4*)(lg + t * 48 + 4 * j) = s; else rsl[t] = 1.0f / sqrtf(s[0] * (1.f / 1024.f) + EPS); }
        } else {
        const float* X = F.out + (size_t)tok0 * D + 128 * F.wave + 8 * q;
        f32x4 acc[4][3]; float ssq[4];
#pragma unroll
        for (int tt = 0; tt < 4; ++tt) { ssq[tt] = 0.f;
#pragma unroll
            for (int ct = 0; ct < 3; ++ct) acc[tt][ct] = (f32x4){0.f, 0.f, 0.f, 0.f}; }
#pragma unroll 2
        for (int ks = 0; ks < 4; ++ks) {
            bf16x8 bh[3], bl[3];
#pragma unroll
            for (int ct = 0; ct < 3; ++ct) { bh[ct] = *(const GAS bf16x8*)(RH + ((ks * 3 + ct) * 64 + F.lane) * 8); bl[ct] = *(const GAS bf16x8*)(RL + ((ks * 3 + ct) * 64 + F.lane) * 8); }
#pragma unroll
            for (int tt = 0; tt < 4; ++tt) {
                const float* xp = X + (size_t)(16 * tt + r) * D + 32 * ks;
                const f32x4 x0 = *(const GAS f32x4*)xp, x1 = *(const GAS f32x4*)(xp + 4);
                float xv[8] = {x0.x, x0.y, x0.z, x0.w, x1.x, x1.y, x1.z, x1.w};
                unsigned hh[8], ll[8];
#pragma unroll
                for (int j = 0; j < 8; ++j) { ssq[tt] = fmaf(xv[j], xv[j], ssq[tt]); hh[j] = f2bf(xv[j]); ll[j] = f2bf(xv[j] - bf2f(hh[j])); }
                u32x4 ahw, alw;
                ahw.x = hh[0] | (hh[1] << 16); ahw.y = hh[2] | (hh[3] << 16); ahw.z = hh[4] | (hh[5] << 16); ahw.w = hh[6] | (hh[7] << 16);
                alw.x = ll[0] | (ll[1] << 16); alw.y = ll[2] | (ll[3] << 16); alw.z = ll[4] | (ll[5] << 16); alw.w = ll[6] | (ll[7] << 16);
                const bf16x8 ah = __builtin_bit_cast(bf16x8, ahw), al = __builtin_bit_cast(bf16x8, alw);
#pragma unroll
                for (int ct = 0; ct < 3; ++ct) {
                    acc[tt][ct] = __builtin_amdgcn_mfma_f32_16x16x32_bf16(ah, bh[ct], acc[tt][ct], 0, 0, 0);
                    acc[tt][ct] = __builtin_amdgcn_mfma_f32_16x16x32_bf16(al, bh[ct], acc[tt][ct], 0, 0, 0);
                    acc[tt][ct] = __builtin_amdgcn_mfma_f32_16x16x32_bf16(ah, bl[ct], acc[tt][ct], 0, 0, 0);
                }
            }
        }
#pragma unroll
        for (int tt = 0; tt < 4; ++tt) {
#pragma unroll
            for (int ct = 0; ct < 3; ++ct)
#pragma unroll
                for (int i = 0; i < 4; ++i) red[(F.wave * 64 + 16 * tt + 4 * q + i) * 48 + 16 * ct + r] = acc[tt][ct][i];
            float s = ssq[tt]; s += __shfl_xor(s, 16); s += __shfl_xor(s, 32);
            if (q == 0) ssqr[F.wave * 64 + 16 * tt + r] = s;
        }
        __syncthreads();
        for (int idx = F.tid; idx < 3072; idx += NTHR) { float s = 0.f;
#pragma unroll
            for (int w = 0; w < 8; ++w) s += red[w * 3072 + idx];
            lg[idx] = s; }
        if (F.tid < 64) { float s = 0.f;
#pragma unroll
            for (int w = 0; w < 8; ++w) s += ssqr[w * 64 + F.tid];
            rsl[F.tid] = 1.0f / sqrtf(s * (1.f / 1024.f) + EPS); }
        }
        __syncthreads();
        if (F.tid < 64) {
            const int t = tok0 + F.tid; const float rs = rsl[F.tid]; const LAS float* L = lg + F.tid * 48;
            const float* bg = F.in[22] + layer * 4; const float* br = F.in[24] + layer * 32;
            float gl[4];
#pragma unroll
            for (int j = 0; j < 4; ++j) gl[j] = L[j] * rs + bg[j];
            int gi = 0; float gm = gl[0];
#pragma unroll
            for (int j = 1; j < 4; ++j) if (gl[j] > gm) { gm = gl[j]; gi = j; }
            float den = 0.f;
#pragma unroll
            for (int j = 0; j < 4; ++j) den += __expf(gl[j] - gm);
            const float gp = 1.f / den;
            float el[8];
#pragma unroll
            for (int e = 0; e < 8; ++e) el[e] = L[4 + 8 * gi + e] * rs + br[gi * 8 + e];
            int i1 = 0; float v1 = el[0];
#pragma unroll
            for (int e = 1; e < 8; ++e) if (el[e] > v1) { v1 = el[e]; i1 = e; }
            int i2 = 0; float v2 = -3.0e38f;
#pragma unroll
            for (int e = 0; e < 8; ++e) if (e != i1 && el[e] > v2) { v2 = el[e]; i2 = e; }
            const float e2 = __expf(v2 - v1);
            sel[2 * F.tid] = gi * 8 + i1; sel[2 * F.tid + 1] = gi * 8 + i2;
            gwl[2 * F.tid] = gp / (1.f + e2); gwl[2 * F.tid + 1] = gp * e2 / (1.f + e2);
            ((float*)(F.ws + WS_RSM))[t] = rs;
        }
        __syncthreads();
        LAS int* cntw = basel + 32;
        int pos = 0, myexp = 0;
        if (F.tid < 128) { myexp = sel[F.tid]; unsigned long long mymask = 0ull;
#pragma unroll 4
            for (int e = 0; e < 32; ++e) { const unsigned long long m = __ballot(myexp == e); if (myexp == e) mymask = m; if (F.lane == 0) cntw[F.wave * 32 + e] = __popcll(m); }
            pos = __popcll(mymask & ((1ull << F.lane) - 1ull)); }
        __syncthreads();
        if (F.tid >= 128 && F.tid < 160) { const int e = F.tid - 128; const int c = cntw[e] + cntw[32 + e];
            basel[e] = c ? (int)__hip_atomic_fetch_add(gcnt + e * 64, (unsigned)c, __ATOMIC_RELAXED, __HIP_MEMORY_SCOPE_AGENT) : 0; }
        __syncthreads();
        if (F.tid < 128) { const size_t dst = (size_t)myexp * T + basel[myexp] + pos + (F.wave == 1 ? cntw[myexp] : 0);
            ((int*)(F.ws + WS_LSLOT))[dst] = 2 * (tok0 + (F.tid >> 1)) + (F.tid & 1);
            ((float*)(F.ws + WS_LGW))[dst] = gwl[F.tid]; }
        __syncthreads();
    }
}

#ifndef MK_PF1
#define MK_PF1 8
#endif
#ifndef MK_PF2
#define MK_PF2 8
#endif
__device__ __forceinline__ bf16x8 fp8x8_to_bf16(u32x2 w) {
    u32x4 o;
    o.x = __builtin_bit_cast(unsigned, __builtin_amdgcn_cvt_scalef32_pk_bf16_fp8(w.x, 1.0f, false)); o.y = __builtin_bit_cast(unsigned, __builtin_amdgcn_cvt_scalef32_pk_bf16_fp8(w.x, 1.0f, true));
    o.z = __builtin_bit_cast(unsigned, __builtin_amdgcn_cvt_scalef32_pk_bf16_fp8(w.y, 1.0f, false)); o.w = __builtin_bit_cast(unsigned, __builtin_amdgcn_cvt_scalef32_pk_bf16_fp8(w.y, 1.0f, true));
    return __builtin_bit_cast(bf16x8, o);
}
#define MOE_LDW(rsrc, soff) __builtin_amdgcn_raw_buffer_load_b128((rsrc), loff, (soff), 0)
template <int NT, int PRB = 0> __device__ __forceinline__ void moe_segment_t(const Frame& F, int layer, int e, int l0, int n) {
    constexpr bool P_NOMFMA = PRB == 2 || (PRB >= 16 && (PRB & 1)), P_WHIT = PRB == 3 || (PRB >= 16 && (PRB & 2)), P_NOLDS = PRB == 4 || (PRB >= 16 && (PRB & 4)),
                   P_NOCVT = PRB == 5 || (PRB >= 16 && (PRB & 8)), P_NOSTG = PRB == 6 || (PRB >= 32 && (PRB & 16));
    constexpr int PF = (NT <= 2) ? 8 : MK_PF1, PF2 = (NT <= 2) ? 8 : MK_PF2;
    constexpr int XRB = 34816;
    LAS unsigned char* XR = F.lds;
    LAS unsigned char* HID = F.lds + 2 * XRB;
    LAS int* s_slot = (LAS int*)(F.lds + 2 * XRB + 65536);
    LAS float* s_gw = (LAS float*)(s_slot + 128);
    LAS float* s_rs = s_gw + 128;
    const int r32 = F.lane & 31, hi = F.lane >> 5, w = F.wave;
    const __amdgpu_buffer_rsrc_t R1 = uniform_rsrc(F.ws + WS_WMOE + (size_t)layer * WMOE_LAYER + (size_t)e * W1_EXP + (size_t)w * 65536, 65536);
    const __amdgpu_buffer_rsrc_t R2 = uniform_rsrc(F.ws + WS_WMOE + (size_t)layer * WMOE_LAYER + WMOE_W2 + (size_t)e * W2_EXP + (size_t)w * 16384, 262144);
    const int loff = F.lane * 16;
    u32x4 wb[PF > PF2 ? PF : PF2];
#pragma unroll
    for (int s = 0; s < PF; ++s) wb[s] = MOE_LDW(R1, s * 1024);
    const int pr = F.tid >> 4, pc = F.tid & 15;
    const __amdgpu_buffer_rsrc_t RXB = uniform_rsrc(F.ws + WS_XB, (unsigned)T * 2048u);
    const int* LS = (const int*)(F.ws + WS_LSLOT) + (size_t)e * T + l0;
    unsigned xo[4];
#pragma unroll
    for (int j = 0; j < 4; ++j) { const int rj = pr + 32 * j; xo[j] = (unsigned)(LS[rj < n ? rj : 0] >> 1) * 2048u + (unsigned)pc * 16u; }
    __builtin_amdgcn_sched_barrier(0);
    const int xw = pr * 272 + pc * 16;
    u32x4 xs[4];
#pragma unroll
    for (int j = 0; j < 4; ++j) xs[j] = __builtin_amdgcn_raw_buffer_load_b128(RXB, xo[j], 0, 0);
    if (F.tid < 128) { const int tl = F.tid < n ? F.tid : 0; const size_t li = (size_t)e * T + l0 + tl;
        s_slot[F.tid] = F.tid < n ? LS[tl] : -1; s_gw[F.tid] = F.tid < n ? ((const float*)(F.ws + WS_LGW))[li] * WDESCALE : 0.f;
        s_rs[F.tid] = ((const float*)(F.ws + WS_LRS))[li] * WDESCALE; }
    __builtin_amdgcn_sched_barrier(0);
#pragma unroll
    for (int j = 0; j < 4; ++j) *(LAS u32x4*)(XR + xw + j * 8704) = xs[j];
    __syncthreads();
    f32x16 accg[NT], accu[NT];
#pragma unroll
    for (int i = 0; i < NT; ++i) { accg[i] = f32x16{}; accu[i] = f32x16{}; }
    bf16x8 xf[NT];
    for (int kc = 0; kc < (PRB == 8 ? 0 : 8); ++kc) {
        const LAS unsigned char* buf = XR + (kc & 1) * XRB + r32 * 272 + hi * 16;
        LAS unsigned char* nb = XR + ((kc + 1) & 1) * XRB + xw;
#pragma unroll
        for (int ks = 0; ks < 8; ++ks) {
            __builtin_amdgcn_sched_barrier(0);
#pragma unroll
            for (int i = 0; i < NT; ++i) if (!P_NOLDS || ks == 0) xf[i] = *(const LAS bf16x8*)(buf + 32 * i * 272 + 2 * ks * 16);
            if (kc < 7 && !P_NOSTG) {
                if (ks == 0) { const int so = (kc + 1) * 256;
                    xs[0] = __builtin_amdgcn_raw_buffer_load_b128(RXB, xo[0], so, 0); xs[1] = __builtin_amdgcn_raw_buffer_load_b128(RXB, xo[1], so, 0);
                    xs[2] = __builtin_amdgcn_raw_buffer_load_b128(RXB, xo[2], so, 0); xs[3] = __builtin_amdgcn_raw_buffer_load_b128(RXB, xo[3], so, 0); }
                if (ks == 7) { *(LAS u32x4*)(nb) = xs[0]; *(LAS u32x4*)(nb + 8704) = xs[1]; *(LAS u32x4*)(nb + 17408) = xs[2]; *(LAS u32x4*)(nb + 26112) = xs[3]; }
            }
            const u32x2 g8 = {wb[ks % PF].x, wb[ks % PF].y}, u8 = {wb[ks % PF].z, wb[ks % PF].w};
            if (ks < 8 - PF || kc < 7) { const int o = P_WHIT ? (ks & 3) * 1024 : (kc * 8 + ks + PF) * 1024;
                wb[ks % PF] = MOE_LDW(R1, o); }
            const bf16x8 wg = P_NOCVT ? __builtin_bit_cast(bf16x8, (u32x4){g8.x, g8.y, g8.x, g8.y}) : fp8x8_to_bf16(g8), wu = P_NOCVT ? __builtin_bit_cast(bf16x8, (u32x4){u8.x, u8.y, u8.x, u8.y}) : fp8x8_to_bf16(u8);
#pragma unroll
            for (int i = 0; i < NT; ++i) {
                if (P_NOMFMA) { asm volatile("" :: "v"(wg), "v"(wu), "v"(xf[i])); } else {
                accg[i] = __builtin_amdgcn_mfma_f32_32x32x16_bf16(wg, xf[i], accg[i], 0, 0, 0);
                accu[i] = __builtin_amdgcn_mfma_f32_32x32x16_bf16(wu, xf[i], accu[i], 0, 0, 0); }
            }
        }
        __builtin_amdgcn_sched_barrier(0);
        if (PRB != 7) __syncthreads();
    }
#pragma unroll
    for (int s = 0; s < PF2; ++s) wb[s] = MOE_LDW(R2, s * 1024);
#pragma unroll
    for (int i = 0; i < NT; ++i) {
        const float rs = s_rs[32 * i + r32], gw = s_gw[32 * i + r32];
#pragma unroll
        for (int s = 0; s < 2; ++s) { float hv[8];
#pragma unroll
            for (int j = 0; j < 8; j += 2) { const f32x2 g = {accg[i][8 * s + j], accg[i][8 * s + j + 1]}, u = {accu[i][8 * s + j], accu[i][8 * s + j + 1]};
                const f32x2 v = mul_sigmoid2_f((g * rs) * (u * (rs * gw)), g * (-rs * LOG2E)); hv[j] = v.x; hv[j + 1] = v.y; }
            u32x4 o; o.x = pk2(hv[0], hv[1]); o.y = pk2(hv[2], hv[3]); o.z = pk2(hv[4], hv[5]); o.w = pk2(hv[6], hv[7]);
            *(LAS u32x4*)(HID + (((2 * w + s) * 2 + hi) * 128 + 32 * i + r32) * 16) = o; }
    }
    __syncthreads();
    const __amdgpu_buffer_rsrc_t RY = uniform_rsrc(F.ws + WS_Y, 2u * (unsigned)T * 2048u);
    const LAS unsigned char* hb = HID + (hi * 128 + r32) * 16;
#pragma unroll 1
    for (int p = 0; p < 2; ++p) {
        f32x16 acc2[NT][2];
#pragma unroll
        for (int i = 0; i < NT; ++i) { acc2[i][0] = f32x16{}; acc2[i][1] = f32x16{}; }
        u32x4 xres[4];
        { const unsigned yoff0 = (unsigned)(1024 * p + 128 * w + 16 * (F.lane & 7));
#pragma unroll
          for (int k = 0; k < 4; ++k) { const int sl = s_slot[8 * k + (F.lane >> 3)];
              xres[k] = __builtin_amdgcn_raw_buffer_load_b128(RXB, (sl >= 0 && (sl & 1) == 0) ? (unsigned)(sl >> 1) * 2048u + yoff0 : 0xfffffff0u, 0, 0); } }
#pragma unroll
        for (int kk = 0; kk < (PRB == 8 ? 0 : 16); ++kk) {
            __builtin_amdgcn_sched_barrier(0);
#pragma unroll
            for (int i = 0; i < NT; ++i) if (!P_NOLDS || kk == 0) xf[i] = *(const LAS bf16x8*)(hb + (kk * 2 * 128 + 32 * i) * 16);
            const u32x2 g8 = {wb[kk % PF2].x, wb[kk % PF2].y}, u8 = {wb[kk % PF2].z, wb[kk % PF2].w};
            if (kk < 16 - PF2 || p < 1) { const int o = P_WHIT ? (kk & 3) * 1024 : (kk < 16 - PF2) ? (p * 131072 + (kk + PF2) * 1024) : ((p + 1) * 131072 + (kk + PF2 - 16) * 1024);
                wb[kk % PF2] = MOE_LDW(R2, o); }
            const bf16x8 a0 = P_NOCVT ? __builtin_bit_cast(bf16x8, (u32x4){g8.x, g8.y, g8.x, g8.y}) : fp8x8_to_bf16(g8), a1 = P_NOCVT ? __builtin_bit_cast(bf16x8, (u32x4){u8.x, u8.y, u8.x, u8.y}) : fp8x8_to_bf16(u8);
#pragma unroll
            for (int i = 0; i < NT; ++i) {
                if (P_NOMFMA) { asm volatile("" :: "v"(a0), "v"(a1), "v"(xf[i])); } else {
                acc2[i][0] = __builtin_amdgcn_mfma_f32_32x32x16_bf16(a0, xf[i], acc2[i][0], 0, 0, 0);
                acc2[i][1] = __builtin_amdgcn_mfma_f32_32x32x16_bf16(a1, xf[i], acc2[i][1], 0, 0, 0); }
            }
        }
        __builtin_amdgcn_sched_barrier(0);
#pragma unroll
        for (int i = 0; i < NT; ++i) {
            __builtin_amdgcn_sched_barrier(0);
            if (PRB != 0) { asm volatile("" :: "v"(acc2[i][0]), "v"(acc2[i][1])); } else {
                int ln_ = F.lane; asm volatile("" : "+v"(ln_));
                LAS unsigned char* ysc = F.lds + w * 8192;
                const unsigned yoff = (unsigned)(1024 * p + 128 * w + 16 * (ln_ & 7));
                const int wro = (ln_ & 31) * 144 + 32 * (ln_ >> 5), rdo = (ln_ >> 3) * 144 + (ln_ & 7) * 16;
                u32x4 xnxt[4];
                if (i + 1 < NT) {
#pragma unroll
                    for (int k = 0; k < 4; ++k) { const int sl = s_slot[32 * (i + 1) + 8 * k + (ln_ >> 3)];
                        xnxt[k] = __builtin_amdgcn_raw_buffer_load_b128(RXB, (sl >= 0 && (sl & 1) == 0) ? (unsigned)(sl >> 1) * 2048u + yoff : 0xfffffff0u, 0, 0); }
                }
#pragma unroll
                for (int dt = 0; dt < 2; ++dt)
#pragma unroll
                    for (int q2 = 0; q2 < 2; ++q2) {
                        const unsigned a0 = pk2(acc2[i][dt][4 * q2], acc2[i][dt][4 * q2 + 1]), a1 = pk2(acc2[i][dt][4 * q2 + 2], acc2[i][dt][4 * q2 + 3]);
                        const unsigned b0 = pk2(acc2[i][dt][4 * q2 + 8], acc2[i][dt][4 * q2 + 9]), b1 = pk2(acc2[i][dt][4 * q2 + 10], acc2[i][dt][4 * q2 + 11]);
                        const auto s0 = __builtin_amdgcn_permlane32_swap(a0, b0, false, false), s1 = __builtin_amdgcn_permlane32_swap(a1, b1, false, false);
                        const u32x4 o = {(unsigned)s0[0], (unsigned)s1[0], (unsigned)s0[1], (unsigned)s1[1]};
                        *(LAS u32x4*)(ysc + wro + (32 * dt + 8 * q2) * 2) = o; }
                LDS_WAIT(); asm volatile("" ::: "memory");
#pragma unroll
                for (int k = 0; k < 4; ++k) { const int sl = s_slot[32 * i + 8 * k + (ln_ >> 3)];
                    u32x4 v = *(const LAS u32x4*)(ysc + rdo + 8 * k * 144);
#pragma unroll
                    for (int d = 0; d < 4; ++d) { const f32x2 a_ = {bf2f(v[d] & 0xffffu), __builtin_bit_cast(float, v[d] & 0xffff0000u)}, b_ = {bf2f(xres[k][d] & 0xffffu), __builtin_bit_cast(float, xres[k][d] & 0xffff0000u)};
                        const f32x2 s_ = a_ + b_; v[d] = pk2(s_.x, s_.y); }
                    __builtin_amdgcn_raw_buffer_store_b128(v, RY, sl >= 0 ? (unsigned)sl * 2048u + yoff : 0xfffffff0u, 0, 0); }
                LDS_WAIT(); asm volatile("" ::: "memory");
                if (i + 1 < NT) {
#pragma unroll
                    for (int k = 0; k < 4; ++k) xres[k] = xnxt[k]; }
            }
        }
    }
    __syncthreads();
}
template <int PRB = 0> __device__ __forceinline__ void moe_segment(const Frame& F, int layer, int e, int l0, int n) {
    const int nt = (n + 31) >> 5;
    if (nt == 4) moe_segment_t<4, PRB>(F, layer, e, l0, n); else if (nt == 3) moe_segment_t<3, PRB>(F, layer, e, l0, n); else if (nt == 2) moe_segment_t<2, PRB>(F, layer, e, l0, n); else moe_segment_t<1, PRB>(F, layer, e, l0, n);
}
template <int PRB = 0> __device__ __forceinline__ int phase_moe(const Frame& F, int layer) {
    int nseg = 0;
    unsigned* gcnt = (unsigned*)(F.ws + WS_CTL) + CW_ECNT + layer * 32 * 64;
    const int mycnt = (int)__hip_atomic_load(gcnt + (F.lane & 31) * 64, __ATOMIC_RELAXED, __HIP_MEMORY_SCOPE_AGENT);
    for (int unit = F.vcu; unit < 256; unit += F.G) {
        const int v0 = 128 * unit, v1 = v0 + 128; int vb = 0;
        for (int e = 0; e < 32; ++e) {
            const int ne = __builtin_amdgcn_readlane(mycnt, e);
            const int lo = v0 > vb ? v0 : vb, hi_ = v1 < vb + ne ? v1 : vb + ne;
            if (lo < hi_) { moe_segment<PRB>(F, layer, e, lo - vb, hi_ - lo); ++nseg; }
            vb += ne;
        }
    }
    return nseg;
}
}
namespace mk {
__device__ __forceinline__ int crow(int r, int hi) { return (r & 3) + 8 * (r >> 2) + 4 * hi; }
__device__ __forceinline__ s16x4 vtr(const LAS unsigned char* p) {
    typedef short v4i16_t __attribute__((ext_vector_type(4)));
    return __builtin_bit_cast(s16x4, __builtin_amdgcn_ds_read_tr16_b64_v4i16((LAS v4i16_t*)p));
}
constexpr float ATT_THR = 8.f;

template <int MODE, int APROBE = 0> __device__ __forceinline__ void attn_unit(const Frame& F, int unit) {
    constexpr int NKC = MODE == 0 ? 12 : 8, ND0 = NKC / 2, KBYTES = NKC * 1024, BUF = KBYTES + 8192;
    const int lane = F.lane, w = F.wave, r32 = lane & 31, hi = lane >> 5;
    LAS unsigned char* lds = F.lds;
    constexpr int NBUF = 3;
    LAS float* wsf = (LAS float*)(lds + NBUF * BUF) + w * 64;
    LAS bf16_t* stg = (LAS bf16_t*)(lds + NBUF * BUF + 2048) + w * 2048;
    const bf16_t* Qb = (const bf16_t*)(F.ws + WS_Q); const bf16_t* KVb = (const bf16_t*)(F.ws + WS_KV); const bf16_t* KPE = (const bf16_t*)(F.ws + WS_KPE);
    const bf16_t* Pb = (const bf16_t*)(F.ws + WS_P); bf16_t* Ob = (bf16_t*)(F.ws + WS_MB);
    int b, h = 0, g = 0, hq = 0, tq0, j_lo, j_hi, kbase0, ocol, qpos0 = 0;
    if (MODE == 0) { b = unit >> 6; h = (unit >> 3) & 7; const int qb = unit & 7; tq0 = b * S + 256 * qb + 32 * w; j_lo = 0; j_hi = 32; kbase0 = b * S; ocol = h * 64; }
    else { b = unit >> 6; const int rem = unit & 63; g = rem >> 5; const int qblk = (rem >> 1) & 15, hp = rem & 1; hq = 4 * g + 2 * hp + (w >> 2);
        qpos0 = 128 * qblk + 32 * (w & 3); tq0 = b * S + qpos0; j_lo = (qblk == 0) ? 2 : 0; j_hi = (qblk == 15) ? 4 : 6; kbase0 = b * S + 128 * qblk - 128; ocol = 512 + hq * 64; }
    bf16x8 qr[ND0];
    if (MODE == 0) { const bf16_t* qrow = Qb + (size_t)(tq0 + r32) * 768;
#pragma unroll
        for (int d0 = 0; d0 < 4; ++d0) qr[d0] = *(const GAS bf16x8*)(qrow + h * 64 + 16 * d0 + 8 * hi);
#pragma unroll
        for (int d0 = 4; d0 < 6; ++d0) qr[d0] = *(const GAS bf16x8*)(qrow + 512 + h * 32 + 16 * (d0 - 4) + 8 * hi);
        {
            const f32x2* rp = (const f32x2*)(F.ws + WS_ROPE) + ((tq0 + r32) & (S - 1)) * 16 + 8 * hi;
            bf16x8 a4 = qr[4], a5 = qr[5];
#pragma unroll
            for (int j = 0; j < 8; ++j) { const f32x2 cs = rp[j]; const float x = bf2f((unsigned short)a4[j]), y = bf2f((unsigned short)a5[j]);
                a4[j] = (short)f2bf(x * cs.x - y * cs.y); a5[j] = (short)f2bf(y * cs.x + x * cs.y); }
            qr[4] = a4; qr[5] = a5; }
    } else { const bf16_t* qrow = Pb + (size_t)(tq0 + r32) * 1280 + 512 + hq * 64;
#pragma unroll
        for (int d0 = 0; d0 < ND0; ++d0) qr[d0] = *(const GAS bf16x8*)(qrow + 16 * d0 + 8 * hi);
    }
    const bf16_t *ksrc0, *ksrc1 = nullptr, *vsrc; size_t kstride, kstride1 = 0, vstride;
    const int vrow = 16 * (w & 3) + (lane >> 2), vcol = (w >> 2) * 32 + (lane & 3) * 8;
    if (MODE == 0) { ksrc0 = KVb + (size_t)(kbase0 + lane) * 1024 + h * 64 + w * 8; kstride = 64 * 1024;
        ksrc1 = KPE + (size_t)(kbase0 + lane) * 32 + (w & 3) * 8; kstride1 = 64 * 32;
        vsrc = KVb + (size_t)(kbase0 + vrow) * 1024 + 512 + h * 64 + vcol; vstride = 64 * 1024; }
    else { ksrc0 = Pb + (size_t)((long)kbase0 + lane) * 1280 + 1024 + g * 64 + w * 8; kstride = 64 * 1280;
        vsrc = Pb + (size_t)((long)kbase0 + vrow) * 1280 + 1152 + g * 64 + vcol; vstride = 64 * 1280; }
    const bool two_k = (MODE == 0) && (w < 4);
    u32x4 ks0s[2], ks1s[2] = {{0u, 0u, 0u, 0u}, {0u, 0u, 0u, 0u}}, vss[2];
#define ATT_LOAD(S, j) do { ks0s[S] = *(const GAS u32x4*)(ksrc0 + (size_t)(j) * kstride); if (MODE == 0) ks1s[S] = *(const GAS u32x4*)(ksrc1 + (size_t)(j) * kstride1); vss[S] = *(const GAS u32x4*)(vsrc + (size_t)(j) * vstride); } while (0)
#define ATT_WRITE(S, bufo) do { *(LAS u32x4*)(lds + (bufo) + w * 1024 + lane * 16) = ks0s[S]; if (MODE == 0) *(LAS u32x4*)(lds + (bufo) + (8 + (w & 3)) * 1024 + lane * 16) = ks1s[S]; \
        *(LAS u32x4*)(lds + (bufo) + KBYTES + w * 1024 + lane * 16) = vss[S]; } while (0)
    float m_run, l_run; f32x16 o[2]; o[0] = f32x16{}; o[1] = f32x16{};
    float slope2 = 0.f;
    if (MODE == 1) { m_run = F.in[19][hq] * LOG2E; l_run = (hi == 0) ? 1.f : 0.f; slope2 = exp2f(-(float)(hq + 1)) * LOG2E; }
    else { m_run = -1e30f; l_run = 0.f; }
#ifndef MK_ATT_STAGGER
#define MK_ATT_STAGGER 0
#endif
    const bool late = MK_ATT_STAGGER && (w >= 4);
    ATT_LOAD(0, j_lo); ATT_WRITE(0, 0); ATT_LOAD(1, j_lo + 1); __syncthreads();
    const int voff = KBYTES + ((lane >> 4) & 1) * 32 + (lane & 3) * 8 + (4 * hi + ((lane & 15) >> 2)) * 64;
    int bo_prev = 0, bo_cur = 0, bo_next = BUF;
    u32x4 pwp[4] = {{0u, 0u, 0u, 0u}, {0u, 0u, 0u, 0u}, {0u, 0u, 0u, 0u}, {0u, 0u, 0u, 0u}};
#define SB() __builtin_amdgcn_sched_barrier(0)
#define ATT_VRD(BO) do { const LAS unsigned char* vp_ = lds + (BO) + voff; \
        _Pragma("unroll") for (int i_ = 0; i_ < 8; ++i_) { vl[i_] = vtr(vp_ + (i_ >> 2) * 4096 + (i_ & 3) * 1024); vh[i_] = vtr(vp_ + (i_ >> 2) * 4096 + (i_ & 3) * 1024 + 512); } } while (0)
#define ATT_PVM(PW) do { _Pragma("unroll") for (int i_ = 0; i_ < 8; ++i_) { \
            const bf16x8 vf = (bf16x8){vl[i_][0], vl[i_][1], vl[i_][2], vl[i_][3], vh[i_][0], vh[i_][1], vh[i_][2], vh[i_][3]}; \
            o[i_ >> 2] = __builtin_amdgcn_mfma_f32_32x32x16_bf16(__builtin_bit_cast(bf16x8, PW[i_ & 3]), vf, o[i_ >> 2], 0, 0, 0); } } while (0)
    s16x4 vl[8], vh[8];
    for (int j2 = j_lo; j2 < j_hi; j2 += 2) {
#pragma unroll
    for (int par = 0; par < 2; ++par) { const int j = j2 + par;
        if (APROBE != 1) { const int jl = (j + 2 < j_hi) ? j + 2 : j_hi - 1; ATT_LOAD(par, jl); }
        if (late && j > j_lo) { ATT_VRD(bo_prev); SB(); ATT_PVM(pwp); SB(); }
        f32x16 p0 = f32x16{}, p1 = f32x16{};
        const LAS unsigned char* kb = lds + bo_cur + hi * 1024 + r32 * 16;
        {
            bf16x8 kf0[ND0], kf1[ND0];
#pragma unroll
            for (int d0 = 0; d0 < ND0; ++d0) { kf0[d0] = *(const LAS bf16x8*)(kb + d0 * 2048); kf1[d0] = *(const LAS bf16x8*)(kb + d0 * 2048 + 512); }
            SB();
#pragma unroll
            for (int d0 = 0; d0 < ND0; ++d0) {
                p0 = __builtin_amdgcn_mfma_f32_32x32x16_bf16(kf0[d0], qr[d0], p0, 0, 0, 0);
                p1 = __builtin_amdgcn_mfma_f32_32x32x16_bf16(kf1[d0], qr[d0], p1, 0, 0, 0);
            }
            SB();
        }
        if (!late) { ATT_VRD(bo_cur); SB(); }
        if (MODE == 1) {
            const int qp = qpos0 + r32, kp = 128 * ((unit >> 1) & 15) - 128 + 64 * j;
#pragma unroll
            for (int r = 0; r < 16; ++r) { const int k0 = kp + crow(r, hi); int d0_ = qp - k0; d0_ = d0_ < 0 ? -d0_ : d0_; int d1_ = qp - (k0 + 32); d1_ = d1_ < 0 ? -d1_ : d1_;
                p0[r] = (d0_ <= 128) ? p0[r] - slope2 * (float)d0_ : -1e30f; p1[r] = (d1_ <= 128) ? p1[r] - slope2 * (float)d1_ : -1e30f; }
        }
        float pmax = p0[0];
#pragma unroll
        for (int r = 1; r < 16; ++r) pmax = fmaxf(pmax, p0[r]);
#pragma unroll
        for (int r = 0; r < 16; ++r) pmax = fmaxf(pmax, p1[r]);
        pmax = fmaxf(pmax, __shfl_xor(pmax, 32));
        if (!__all(pmax - m_run <= ATT_THR)) {
            const float mn = fmaxf(m_run, pmax), alpha = fast_exp2(m_run - mn); m_run = mn; l_run *= alpha;
            if (hi == 0) wsf[r32] = alpha;
            LDS_WAIT(); asm volatile("" ::: "memory");
#pragma unroll
            for (int r = 0; r < 16; ++r) { const float a = wsf[crow(r, hi)]; o[0][r] *= a; o[1][r] *= a; }
        }
        float ps = 0.f;
#pragma unroll
        for (int r = 0; r < 16; ++r) { if (APROBE != 2) { p0[r] = fast_exp2(p0[r] - m_run); p1[r] = fast_exp2(p1[r] - m_run); ps += p0[r] + p1[r]; } }
        l_run += ps;
        u32x4 pw[4];
        pw[0] = (u32x4){pk2(p0[0], p0[1]), pk2(p0[2], p0[3]), pk2(p0[4], p0[5]), pk2(p0[6], p0[7])};
        pw[1] = (u32x4){pk2(p0[8], p0[9]), pk2(p0[10], p0[11]), pk2(p0[12], p0[13]), pk2(p0[14], p0[15])};
        pw[2] = (u32x4){pk2(p1[0], p1[1]), pk2(p1[2], p1[3]), pk2(p1[4], p1[5]), pk2(p1[6], p1[7])};
        pw[3] = (u32x4){pk2(p1[8], p1[9]), pk2(p1[10], p1[11]), pk2(p1[12], p1[13]), pk2(p1[14], p1[15])};
        SB();
        if (!late) ATT_PVM(pw);
        else { pwp[0] = pw[0]; pwp[1] = pw[1]; pwp[2] = pw[2]; pwp[3] = pw[3]; }
        if (APROBE != 1) { ATT_WRITE(par ^ 1, bo_next);
        __syncthreads(); }
        bo_prev = bo_cur; bo_cur = bo_next; bo_next = (bo_next == (NBUF - 1) * BUF) ? 0 : bo_next + BUF;
    } }
    if (late) { ATT_VRD(bo_prev); SB(); ATT_PVM(pwp); }
#undef ATT_VRD
#undef ATT_PVM
#undef SB
#undef ATT_LOAD
#undef ATT_WRITE
    const float lt = l_run + __shfl_xor(l_run, 32);
    if (hi == 0) wsf[32 + r32] = lt;
    LDS_WAIT(); asm volatile("" ::: "memory");
#pragma unroll
    for (int r = 0; r < 16; ++r) { const int orow = crow(r, hi); const float rl = fast_rcp(wsf[32 + orow]);
        stg[orow * 64 + r32] = (bf16_t)f2bf(o[0][r] * rl); stg[orow * 64 + 32 + r32] = (bf16_t)f2bf(o[1][r] * rl); }
    LDS_WAIT(); asm volatile("" ::: "memory");
    bf16_t* Ow = Ob + (size_t)tq0 * 1024 + ocol;
#pragma unroll
    for (int i = 0; i < 4; ++i) { const int row = i * 8 + (lane >> 3), ch = lane & 7; const u32x4 v = *(const LAS u32x4*)(stg + row * 64 + ch * 8); if (APROBE == 0) *(GAS u32x4*)(Ow + (size_t)row * 1024 + ch * 8) = v; else asm volatile("" :: "v"(v)); }
    __syncthreads();
}
__device__ __forceinline__ void mla_unit(const Frame& F, int unit) {
    constexpr int ND0 = 6, KBYTES = 12288, BUF = KBYTES + 8192, NBUF = 3, NTILE = 32;
    const int lane = F.lane, w = F.wave, r32 = lane & 31, hi = lane >> 5;
    LAS unsigned char* lds = F.lds;
    LAS float* wsf = (LAS float*)(lds + NBUF * BUF) + w * 64;
    LAS bf16_t* stg = (LAS bf16_t*)(lds + NBUF * BUF + 2048) + w * 2048;
    const bf16_t* Qb = (const bf16_t*)(F.ws + WS_Q); const bf16_t* KVb = (const bf16_t*)(F.ws + WS_KV); const bf16_t* KPE = (const bf16_t*)(F.ws + WS_KPE);
    bf16_t* Ob = (bf16_t*)(F.ws + WS_MB);
    const int b = unit >> 6, h = (unit >> 3) & 7, qb = unit & 7, tq0 = b * S + 256 * qb + 32 * w, kbase0 = b * S;
    bf16x8 qr[ND0];
    { const bf16_t* qrow = Qb + (size_t)(tq0 + r32) * 768;
#pragma unroll
      for (int d0 = 0; d0 < 4; ++d0) qr[d0] = *(const GAS bf16x8*)(qrow + h * 64 + 16 * d0 + 8 * hi);
#pragma unroll
      for (int d0 = 4; d0 < 6; ++d0) qr[d0] = *(const GAS bf16x8*)(qrow + 512 + h * 32 + 16 * (d0 - 4) + 8 * hi);
      const f32x2* rp = (const f32x2*)(F.ws + WS_ROPE) + ((tq0 + r32) & (S - 1)) * 16 + 8 * hi;
      bf16x8 a4 = qr[4], a5 = qr[5];
#pragma unroll
      for (int j = 0; j < 8; ++j) { const f32x2 cs = rp[j]; const float x = bf2f((unsigned short)a4[j]), y = bf2f((unsigned short)a5[j]);
          a4[j] = (short)f2bf(x * cs.x - y * cs.y); a5[j] = (short)f2bf(y * cs.x + x * cs.y); }
      qr[4] = a4; qr[5] = a5; }
    const int vrow = 16 * (w & 3) + (lane >> 2), vcol = (w >> 2) * 32 + (lane & 3) * 8;
    const bf16_t* ksrc0 = KVb + (size_t)(kbase0 + lane) * 1024 + h * 64 + w * 8;
    const bf16_t* ksrc1 = KPE + (size_t)(kbase0 + lane) * 32 + (w & 3) * 8;
    const bf16_t* vsrc = KVb + (size_t)(kbase0 + vrow) * 1024 + 512 + h * 64 + vcol;
    u32x4 ks0s[2], ks1s[2], vss[2];
#define M_LOAD(S_, t_) do { const int tt_ = (t_) < NTILE ? (t_) : NTILE - 1; ks0s[S_] = *(const GAS u32x4*)(ksrc0 + (size_t)tt_ * 65536); ks1s[S_] = *(const GAS u32x4*)(ksrc1 + (size_t)tt_ * 2048); vss[S_] = *(const GAS u32x4*)(vsrc + (size_t)tt_ * 65536); } while (0)
#define M_WRITE(S_, bo_) do { *(LAS u32x4*)(lds + (bo_) + w * 1024 + lane * 16) = ks0s[S_]; *(LAS u32x4*)(lds + (bo_) + (8 + (w & 3)) * 1024 + lane * 16) = ks1s[S_]; \
        *(LAS u32x4*)(lds + (bo_) + KBYTES + w * 1024 + lane * 16) = vss[S_]; } while (0)
    const int voff = KBYTES + ((lane >> 4) & 1) * 32 + (lane & 3) * 8 + (4 * hi + ((lane & 15) >> 2)) * 64;
    float m_run = -1e30f, l_run = 0.f; f32x16 o[2]; o[0] = f32x16{}; o[1] = f32x16{};
    f32x16 pA0, pA1, pB0, pB1; float alA = 1.f, alB = 1.f; u32x4 pw[4];
#define M_QKT(P0, P1, bo_) do { const LAS unsigned char* kb_ = lds + (bo_) + hi * 1024 + r32 * 16; P0 = f32x16{}; P1 = f32x16{}; \
        _Pragma("unroll") for (int d0 = 0; d0 < ND0; ++d0) { const bf16x8 b0_ = *(const LAS bf16x8*)(kb_ + d0 * 2048), b1_ = *(const LAS bf16x8*)(kb_ + d0 * 2048 + 512); \
            P0 = __builtin_amdgcn_mfma_f32_32x32x16_bf16(b0_, qr[d0], P0, 0, 0, 0); P1 = __builtin_amdgcn_mfma_f32_32x32x16_bf16(b1_, qr[d0], P1, 0, 0, 0); } } while (0)
#define M_PART(P0, P1, AL) do { float pm_ = P0[0]; \
        _Pragma("unroll") for (int r = 1; r < 16; ++r) pm_ = fmaxf(pm_, P0[r]); \
        _Pragma("unroll") for (int r = 0; r < 16; ++r) pm_ = fmaxf(pm_, P1[r]); \
        pm_ = fmaxf(pm_, __shfl_xor(pm_, 32)); \
        { const bool keep_ = __all(pm_ - m_run <= ATT_THR); const float mn_ = keep_ ? m_run : fmaxf(m_run, pm_); AL = fast_exp2(m_run - mn_); m_run = mn_; }     \
        { const f32x2 mm_ = {m_run, m_run}; \
        _Pragma("unroll") for (int r = 0; r < 16; r += 2) { f32x2 a_ = {P0[r], P0[r + 1]}, b_ = {P1[r], P1[r + 1]}; a_ -= mm_; b_ -= mm_;     \
            P0[r] = fast_exp2(a_.x); P0[r + 1] = fast_exp2(a_.y); P1[r] = b_.x; P1[r + 1] = b_.y; } } } while (0)
#define M_FIN(P0, P1, AL) do { f32x2 ps2_ = {0.f, 0.f}; \
        _Pragma("unroll") for (int r = 0; r < 16; r += 2) { P1[r] = fast_exp2(P1[r]); P1[r + 1] = fast_exp2(P1[r + 1]); ps2_ += (f32x2){P0[r], P0[r + 1]} + (f32x2){P1[r], P1[r + 1]}; } \
        const float ps_ = ps2_.x + ps2_.y; \
        l_run = l_run * AL + ps_; \
        pw[0] = (u32x4){pk2(P0[0], P0[1]), pk2(P0[2], P0[3]), pk2(P0[4], P0[5]), pk2(P0[6], P0[7])}; \
        pw[1] = (u32x4){pk2(P0[8], P0[9]), pk2(P0[10], P0[11]), pk2(P0[12], P0[13]), pk2(P0[14], P0[15])}; \
        pw[2] = (u32x4){pk2(P1[0], P1[1]), pk2(P1[2], P1[3]), pk2(P1[4], P1[5]), pk2(P1[6], P1[7])}; \
        pw[3] = (u32x4){pk2(P1[8], P1[9]), pk2(P1[10], P1[11]), pk2(P1[12], P1[13]), pk2(P1[14], P1[15])}; } while (0)
#define M_PV(bo_) do { const LAS unsigned char* vp_ = lds + (bo_) + voff; \
        _Pragma("unroll") for (int i_ = 0; i_ < 8; ++i_) { const s16x4 vl_ = vtr(vp_ + (i_ >> 2) * 4096 + (i_ & 3) * 1024), vh_ = vtr(vp_ + (i_ >> 2) * 4096 + (i_ & 3) * 1024 + 512); \
            const bf16x8 vf_ = (bf16x8){vl_[0], vl_[1], vl_[2], vl_[3], vh_[0], vh_[1], vh_[2], vh_[3]}; \
            o[i_ >> 2] = __builtin_amdgcn_mfma_f32_32x32x16_bf16(__builtin_bit_cast(bf16x8, pw[i_ & 3]), vf_, o[i_ >> 2], 0, 0, 0); } } while (0)
#define M_RESC(AL) do { if (__any(AL < 1.f)) { if (hi == 0) wsf[r32] = AL; LDS_WAIT(); asm volatile("" ::: "memory"); \
        _Pragma("unroll") for (int r = 0; r < 16; ++r) { const float a_ = wsf[crow(r, hi)]; o[0][r] *= a_; o[1][r] *= a_; } } } while (0)
    int bo_prev = 0, bo_cur = 0, bo_next = BUF;
#define M_ROT() do { bo_prev = bo_cur; bo_cur = bo_next; bo_next = (bo_next == (NBUF - 1) * BUF) ? 0 : bo_next + BUF; } while (0)
    M_LOAD(0, 0); M_WRITE(0, 0); M_LOAD(1, 1); __syncthreads();
    M_QKT(pA0, pA1, 0); M_PART(pA0, pA1, alA);
    M_LOAD(0, 2); M_WRITE(1, BUF); __syncthreads(); M_ROT();
#define M_STEP(PX0, PX1, ALX, PY0, PY1, ALY, PAR_, jt_) do { \
        __builtin_amdgcn_sched_barrier(0); \
        M_QKT(PX0, PX1, bo_cur); M_FIN(PY0, PY1, ALY); \
        _Pragma("unroll") for (int g_ = 0; g_ < 12; ++g_) { __builtin_amdgcn_sched_group_barrier(0x100, 1, 0); __builtin_amdgcn_sched_group_barrier(0x008, 1, 0); __builtin_amdgcn_sched_group_barrier(0x002, 6, 0); } \
        __builtin_amdgcn_sched_barrier(0); \
        M_LOAD(PAR_, (jt_) + 2); \
        M_PV(bo_prev); M_PART(PX0, PX1, ALX); \
        _Pragma("unroll") for (int g_ = 0; g_ < 8; ++g_) { __builtin_amdgcn_sched_group_barrier(0x100, 2, 1); __builtin_amdgcn_sched_group_barrier(0x008, 1, 1); __builtin_amdgcn_sched_group_barrier(0x002, 10, 1); } \
        __builtin_amdgcn_sched_barrier(0); \
        M_RESC(ALX); \
        M_WRITE((PAR_) ^ 1, bo_next); __syncthreads(); M_ROT(); } while (0)
    for (int j = 1; j < NTILE; j += 2) {
        M_STEP(pB0, pB1, alB, pA0, pA1, alA, 1, j);
        if (j + 1 < NTILE) M_STEP(pA0, pA1, alA, pB0, pB1, alB, 0, j + 1);
    }
    M_FIN(pB0, pB1, alB); M_PV(bo_prev);
    const float lt = l_run + __shfl_xor(l_run, 32);
    if (hi == 0) wsf[32 + r32] = lt;
    LDS_WAIT(); asm volatile("" ::: "memory");
#pragma unroll
    for (int r = 0; r < 16; ++r) { const int orow = crow(r, hi); const float rl = fast_rcp(wsf[32 + orow]);
        stg[orow * 64 + r32] = (bf16_t)f2bf(o[0][r] * rl); stg[orow * 64 + 32 + r32] = (bf16_t)f2bf(o[1][r] * rl); }
    LDS_WAIT(); asm volatile("" ::: "memory");
    bf16_t* Ow = Ob + (size_t)tq0 * 1024 + h * 64;
#pragma unroll
    for (int i = 0; i < 4; ++i) { const int row = i * 8 + (lane >> 3), ch = lane & 7; const u32x4 v = *(const LAS u32x4*)(stg + row * 64 + ch * 8); *(GAS u32x4*)(Ow + (size_t)row * 1024 + ch * 8) = v; }
    __syncthreads();
#undef M_LOAD
#undef M_WRITE
#undef M_QKT
#undef M_PART
#undef M_FIN
#undef M_PV
#undef M_RESC
#undef M_ROT
#undef M_STEP
}
__device__ __forceinline__ void swa_unit(const Frame& F, int unit) {
    constexpr int TB = 16384;
    const int lane = F.lane, w = F.wave, r32 = lane & 31, hi = lane >> 5;
    LAS unsigned char* lds = F.lds;
    LAS float* wsf = (LAS float*)(lds + 6 * TB) + w * 64;
    LAS bf16_t* stg = (LAS bf16_t*)(lds + 6 * TB + 2048) + w * 2048;
    const bf16_t* Pb = (const bf16_t*)(F.ws + WS_P); bf16_t* Ob = (bf16_t*)(F.ws + WS_MB);
    const int b = unit >> 5, g = (unit >> 4) & 1, qblk = unit & 15;
    const int j_lo = (qblk == 0) ? 2 : 0, j_hi = (qblk == 15) ? 4 : 6, nt = j_hi - j_lo;
    const long kbase = (long)b * S + 128 * qblk - 128 + 64 * j_lo;
    const int qpos0 = 128 * qblk + 32 * (w & 3), tq0 = b * S + qpos0;
    const int vrow = 16 * (w & 3) + (lane >> 2), vcol = (w >> 2) * 32 + (lane & 3) * 8;
    const bf16_t* ksrc = Pb + (size_t)(kbase + lane) * 1280 + 1024 + g * 64 + w * 8;
    const bf16_t* vsrc = Pb + (size_t)(kbase + vrow) * 1280 + 1152 + g * 64 + vcol;
    u32x4 kst[6], vst[6];
#pragma unroll
    for (int t = 0; t < 6; ++t) { const int tt = t < nt ? t : nt - 1;
        kst[t] = *(const GAS u32x4*)(ksrc + (size_t)tt * 64 * 1280); vst[t] = *(const GAS u32x4*)(vsrc + (size_t)tt * 64 * 1280); }
    bf16x8 qr[2][4];
#pragma unroll
    for (int ps = 0; ps < 2; ++ps) { const bf16_t* qrow = Pb + (size_t)(tq0 + r32) * 1280 + 512 + (4 * g + 2 * ps + (w >> 2)) * 64;
#pragma unroll
        for (int d0 = 0; d0 < 4; ++d0) qr[ps][d0] = *(const GAS bf16x8*)(qrow + 16 * d0 + 8 * hi); }
#pragma unroll
    for (int t = 0; t < 6; ++t) { *(LAS u32x4*)(lds + t * TB + w * 1024 + lane * 16) = kst[t]; *(LAS u32x4*)(lds + t * TB + 8192 + w * 1024 + lane * 16) = vst[t]; }
    __syncthreads();
    const int voff = 8192 + ((lane >> 4) & 1) * 32 + (lane & 3) * 8 + (4 * hi + ((lane & 15) >> 2)) * 64;
    const float qf = (float)(qpos0 + r32 - (128 * qblk - 128 + 64 * j_lo) - 4 * hi);
#pragma unroll
    for (int ps = 0; ps < 2; ++ps) {
        const int hq = 4 * g + 2 * ps + (w >> 2);
        float m_run = F.in[19][hq] * LOG2E, l_run = (hi == 0) ? 1.f : 0.f; const float slope2 = exp2f(-(float)(hq + 1)) * LOG2E;
        f32x16 o[2]; o[0] = f32x16{}; o[1] = f32x16{};
        for (int t = 0; t < nt; ++t) {
            const int q0 = qpos0 - (128 * qblk - 128 + 64 * j_lo), k0 = 64 * t;
            if (k0 + 63 < q0 - 128 || k0 > q0 + 31 + 128) continue;
            const bool inside = (k0 >= q0 - 97) && (k0 <= q0 + 65);
            const LAS unsigned char* kb = lds + t * TB + hi * 1024 + r32 * 16;
            f32x16 p0 = f32x16{}, p1 = f32x16{};
            { bf16x8 kf0[4], kf1[4];
#pragma unroll
              for (int d0 = 0; d0 < 4; ++d0) { kf0[d0] = *(const LAS bf16x8*)(kb + d0 * 2048); kf1[d0] = *(const LAS bf16x8*)(kb + d0 * 2048 + 512); }
#pragma unroll
              for (int d0 = 0; d0 < 4; ++d0) { p0 = __builtin_amdgcn_mfma_f32_32x32x16_bf16(kf0[d0], qr[ps][d0], p0, 0, 0, 0); p1 = __builtin_amdgcn_mfma_f32_32x32x16_bf16(kf1[d0], qr[ps][d0], p1, 0, 0, 0); } }
            s16x4 vl[8], vh[8];
            { const LAS unsigned char* vp_ = lds + t * TB + voff;
#pragma unroll
              for (int i_ = 0; i_ < 8; ++i_) { vl[i_] = vtr(vp_ + (i_ >> 2) * 4096 + (i_ & 3) * 1024); vh[i_] = vtr(vp_ + (i_ >> 2) * 4096 + (i_ & 3) * 1024 + 512); } }
            const float tq = qf - (float)k0;
            if (inside) {
#pragma unroll
                for (int r = 0; r < 16; ++r) { const float c = (float)((r & 3) + 8 * (r >> 2)); p0[r] = fmaf(-slope2, fabsf(tq - c), p0[r]); p1[r] = fmaf(-slope2, fabsf(tq - c - 32.f), p1[r]); }
            } else {
#pragma unroll
                for (int r = 0; r < 16; ++r) { const float c = (float)((r & 3) + 8 * (r >> 2)); const float d0_ = fabsf(tq - c), d1_ = fabsf(tq - c - 32.f);
                    p0[r] = (d0_ <= 128.f) ? fmaf(-slope2, d0_, p0[r]) : -1e30f; p1[r] = (d1_ <= 128.f) ? fmaf(-slope2, d1_, p1[r]) : -1e30f; }
            }
            float pmax = p0[0];
#pragma unroll
            for (int r = 1; r < 16; ++r) pmax = fmaxf(pmax, p0[r]);
#pragma unroll
            for (int r = 0; r < 16; ++r) pmax = fmaxf(pmax, p1[r]);
            pmax = fmaxf(pmax, __shfl_xor(pmax, 32));
            if (!__all(pmax - m_run <= ATT_THR)) {
                const float mn = fmaxf(m_run, pmax), alpha = fast_exp2(m_run - mn); m_run = mn; l_run *= alpha;
                if (hi == 0) wsf[r32] = alpha;
                LDS_WAIT(); asm volatile("" ::: "memory");
#pragma unroll
                for (int r = 0; r < 16; ++r) { const float a_ = wsf[crow(r, hi)]; o[0][r] *= a_; o[1][r] *= a_; }
            }
            f32x2 ps2 = {0.f, 0.f}; const f32x2 mm = {m_run, m_run};
#pragma unroll
            for (int r = 0; r < 16; r += 2) { const f32x2 a_ = (f32x2){p0[r], p0[r + 1]} - mm, b_ = (f32x2){p1[r], p1[r + 1]} - mm;
                p0[r] = fast_exp2(a_.x); p0[r + 1] = fast_exp2(a_.y); p1[r] = fast_exp2(b_.x); p1[r + 1] = fast_exp2(b_.y);
                ps2 += (f32x2){p0[r], p0[r + 1]} + (f32x2){p1[r], p1[r + 1]}; }
            l_run += ps2.x + ps2.y;
            u32x4 pw[4];
            pw[0] = (u32x4){pk2(p0[0], p0[1]), pk2(p0[2], p0[3]), pk2(p0[4], p0[5]), pk2(p0[6], p0[7])};
            pw[1] = (u32x4){pk2(p0[8], p0[9]), pk2(p0[10], p0[11]), pk2(p0[12], p0[13]), pk2(p0[14], p0[15])};
            pw[2] = (u32x4){pk2(p1[0], p1[1]), pk2(p1[2], p1[3]), pk2(p1[4], p1[5]), pk2(p1[6], p1[7])};
            pw[3] = (u32x4){pk2(p1[8], p1[9]), pk2(p1[10], p1[11]), pk2(p1[12], p1[13]), pk2(p1[14], p1[15])};
#pragma unroll
            for (int i_ = 0; i_ < 8; ++i_) { const bf16x8 vf = (bf16x8){vl[i_][0], vl[i_][1], vl[i_][2], vl[i_][3], vh[i_][0], vh[i_][1], vh[i_][2], vh[i_][3]};
                o[i_ >> 2] = __builtin_amdgcn_mfma_f32_32x32x16_bf16(__builtin_bit_cast(bf16x8, pw[i_ & 3]), vf, o[i_ >> 2], 0, 0, 0); }
        }
        const float lt = l_run + __shfl_xor(l_run, 32);
        if (hi == 0) wsf[32 + r32] = lt;
        LDS_WAIT(); asm volatile("" ::: "memory");
#pragma unroll
        for (int r = 0; r < 16; ++r) { const int orow = crow(r, hi); const float rl = fast_rcp(wsf[32 + orow]);
            stg[orow * 64 + r32] = (bf16_t)f2bf(o[0][r] * rl); stg[orow * 64 + 32 + r32] = (bf16_t)f2bf(o[1][r] * rl); }
        LDS_WAIT(); asm volatile("" ::: "memory");
        bf16_t* Ow = Ob + (size_t)tq0 * 1024 + 512 + hq * 64;
#pragma unroll
        for (int i = 0; i < 4; ++i) { const int row = i * 8 + (lane >> 3), ch = lane & 7; const u32x4 v = *(const LAS u32x4*)(stg + row * 64 + ch * 8); *(GAS u32x4*)(Ow + (size_t)row * 1024 + ch * 8) = v; }
        LDS_WAIT(); asm volatile("" ::: "memory");
    }
    __syncthreads();
}
template <int PROBE = 0> __device__ __forceinline__ void phase_attn(const Frame& F) {
#ifdef MK_MLA_OLD
    if (PROBE != 2) for (int u = F.vcu; u < 512; u += F.G) attn_unit<0, (PROBE >= 10 ? PROBE - 10 : 0)>(F, u);
    if (PROBE >= 10) return;
#else
    if (PROBE != 2) for (int u = F.vcu; u < 512; u += F.G) mla_unit(F, u);
#endif
    if (PROBE != 1) for (int u = F.vcu; u < 256; u += F.G) swa_unit(F, u);
}
}
namespace mk {
constexpr int N_PHASES = 14;
__global__ void __launch_bounds__(NTHR, 2) fwd_mega(Args args) {
    extern __shared__ __attribute__((aligned(16))) unsigned char lds_raw[];
    Frame F;
    F.lds = (LAS unsigned char*)lds_raw;
    F.tid = threadIdx.x; F.lane = F.tid & 63; F.wave = __builtin_amdgcn_readfirstlane(F.tid >> 6);
    F.G = gridDim.x; { const int bx = blockIdx.x; F.vcu = (F.G % 8 == 0) ? (bx % 8) * (F.G / 8) + bx / 8 : bx; }
    F.in = args.in; F.out = args.out; F.ws = args.ws;
    volatile LAS unsigned* MISC = (volatile LAS unsigned*)(F.lds + MISC_OFF);
    if (F.tid < 64) MISC[F.tid] = 0u;
    __syncthreads();
    unsigned* ctl = (unsigned*)(F.ws + WS_CTL);
    const int lo = args.ph_lo, hi = args.ph_hi;
    XcdBarrier bar; bar.bar = ctl + CW_BAR + args.li * XCD_BAR_WORDS; bar.x = 0; bar.st = nullptr;
    if (hi - lo > 1) bar = xcd_barrier_post(ctl + CW_BAR + args.li * XCD_BAR_WORDS, MISC + 8);
#ifndef MK_PHASE_MASK
#define MK_PHASE_MASK 0x3fff
#endif
#define IN(k) (((MK_PHASE_MASK >> (k)) & 1) && lo <= (k) && (k) < hi)
#ifndef MK_DUP_MASK
#define MK_DUP_MASK 0
#endif
#define REP(k) for (int rep_ = 0; rep_ <= ((MK_DUP_MASK >> (k)) & 1); ++rep_)
#define FRESH() do { int t_ = threadIdx.x; asm volatile("" : "+v"(t_)); F.tid = t_; F.lane = t_ & 63; F.wave = __builtin_amdgcn_readfirstlane(t_ >> 6); } while (0)
#ifdef MK_STRETCH_K
#define STRETCH_BEGIN(k) unsigned long long st0_ = 0; if ((k) == MK_STRETCH_K) st0_ = __builtin_amdgcn_s_memrealtime();
#define STRETCH_END(k) if ((k) == MK_STRETCH_K) { const unsigned long long d_ = __builtin_amdgcn_s_memrealtime() - st0_; const unsigned long long t1_ = __builtin_amdgcn_s_memrealtime(); while (__builtin_amdgcn_s_memrealtime() - t1_ < 3 * d_) __builtin_amdgcn_s_sleep(4); }
#else
#define STRETCH_BEGIN(k)
#define STRETCH_END(k)
#endif
#if defined(MK_STRETCH_K) && defined(MK_STRETCH_SEG)
#define STRETCH_END5(k) if ((k) == MK_STRETCH_K && ((MK_STRETCH_SEG == 1) ? (nseg_ == 1) : (nseg_ >= 2))) { const unsigned long long d_ = __builtin_amdgcn_s_memrealtime() - st0_; const unsigned long long t1_ = __builtin_amdgcn_s_memrealtime(); while (__builtin_amdgcn_s_memrealtime() - t1_ < 3 * d_) __builtin_amdgcn_s_sleep(4); }
#else
#define STRETCH_END5(k) STRETCH_END(k)
#endif
#define SEAM(k) do { if (IN(k) && IN((k) + 1)) xcd_barrier(bar); } while (0)
#ifdef MK_ROUTER_PHASE
    constexpr bool RSEL = false;
#define SEAM_R(k) SEAM(k)
#else
    constexpr bool RSEL = true;
#define SEAM_R(k) do { if (IN(k) && IN((k) + 2)) xcd_barrier(bar); } while (0)
#endif
    bf16_t* XB = (bf16_t*)(F.ws + WS_XB); bf16_t* MBp = (bf16_t*)(F.ws + WS_MB); bf16_t* Pp = (bf16_t*)(F.ws + WS_P);
    float* RS0 = (float*)(F.ws + WS_RS0);
    const f32x2* rope = (const f32x2*)(F.ws + WS_ROPE);
    const int bid = (int)blockIdx.x;

    if (IN(0)) REP(0) { FRESH(); STRETCH_BEGIN(0)
#ifdef MK_P0_PROBE
        if (rep_ > 0) phase_p0<MK_P0_PROBE>(F); else
#endif
        phase_p0<14>(F); STRETCH_END(0) } SEAM(0);
    if (IN(1)) REP(1) { FRESH(); STRETCH_BEGIN(1) pg8::Gemm g{XB, (const bf16_t*)(F.ws + WS_WINE), T, 2048, 1024, 1024, 1024}; pg8::StaticOrder So; So.init(T, 2048, F.G, bid);
        EpiE1 E{(bf16_t*)F.out, RS0}; pg8::gemm_phase<EpiE1, pg8::StaticOrder, true, true>(F.lds, g, So, E); STRETCH_END(1) } SEAM(1);
#ifdef MK_XBAR
    for (int xb_ = 0; xb_ < MK_XBAR; ++xb_) xcd_barrier(bar);
#endif
    if (IN(2)) REP(2) { FRESH(); STRETCH_BEGIN(2) phase_e2(F); STRETCH_END(2) } SEAM(2);
    if (IN(3)) REP(3) { FRESH(); STRETCH_BEGIN(3) pg8::Gemm g{MBp, (const bf16_t*)(F.ws + WS_WOUTE), T, 1024, 1024, 1024, 1024}; pg8::StaticOrder So; So.init(T, 1024, F.G, bid);
        EpiResR<RSEL> E{XB, (const _Float16*)(F.ws + WS_ROUTER16), (float*)(F.ws + WS_PART), F.ws, F.in[22], F.in[24], ctl + CW_ECNT, ctl + CW_PCNT}; pg8::gemm_phase<EpiResR<RSEL>, pg8::StaticOrder, true, true>(F.lds, g, So, E); STRETCH_END(3) } SEAM_R(3);
#ifdef MK_ROUTER_PHASE
    if (IN(4)) REP(4) { FRESH(); STRETCH_BEGIN(4) phase_router<true>(F, 0); STRETCH_END(4) } SEAM(4);
#endif
    if (IN(5)) REP(5) { FRESH(); STRETCH_BEGIN(5)
#ifdef MK_MOE_PROBE
        if (rep_ > 0) { phase_moe<MK_MOE_PROBE>(F, 0); } else
#endif
        { const int nseg_ = phase_moe<0>(F, 0); (void)nseg_; STRETCH_END5(5) } } SEAM(5);
    if (IN(6)) REP(6) { FRESH(); STRETCH_BEGIN(6) combine_rows<false>(F);
 STRETCH_END(6) } SEAM(6);
    if (IN(7)) REP(7) { FRESH(); STRETCH_BEGIN(7) pg8::Gemm g{XB, (const bf16_t*)(F.ws + WS_WINO), T, 1280, 1024, 1024, 1024}; pg8::StaticOrder So; So.init(T, 1280, F.G, bid);
        EpiO1 E{Pp, RS0, (float*)(F.ws + WS_SSQQ), (float*)(F.ws + WS_SSQKV), (bf16_t*)(F.ws + WS_KPE), rope};
        pg8::gemm_phase<EpiO1, pg8::StaticOrder, true, true>(F.lds, g, So, E);
        if (rep_ == 0 && (F.G != 256 || bid >= 64)) { LAS float* scr = (LAS float*)(F.lds + F.wave * 16384); CvtRegs R;
            const int nw = (F.G == 256) ? 192 * NWAVES : F.G * NWAVES, gw = ((F.G == 256) ? (bid - 64) : bid) * NWAVES + F.wave;
            int it = gw; if (it < MOE_CVT_ITEMS) moe_cvt_load(F, 1, it, R);
            for (; it < MOE_CVT_ITEMS; it += nw) { moe_cvt_stage(F, 1, it, R, scr); if (it + nw < MOE_CVT_ITEMS) moe_cvt_load(F, 1, it + nw, R); moe_cvt_emit(F, 1, it, scr); } } STRETCH_END(7) } SEAM(7);
    if (IN(8)) REP(8) { FRESH(); STRETCH_BEGIN(8) pg8::Gemm g{Pp, (const bf16_t*)(F.ws + WS_WUQ), T, 1792, 256, 1280, 256}; O2Order So; So.init(T, 1792, F.G, bid);
        EpiO2 E{(bf16_t*)(F.ws + WS_Q), (bf16_t*)(F.ws + WS_KV), (const float*)(F.ws + WS_SSQQ), (const float*)(F.ws + WS_SSQKV)};
        pg8::gemm_phase<EpiO2, O2Order, true, true>(F.lds, g, So, E);
    STRETCH_END(8) } SEAM(8);
    if (IN(9)) REP(9) { FRESH(); STRETCH_BEGIN(9)
#ifdef MK_ATT_PROBE
        if (rep_ > 0) phase_attn<MK_ATT_PROBE>(F); else
#endif
        phase_attn<0>(F); STRETCH_END(9) } SEAM(9);
    if (IN(10)) REP(10) { FRESH(); STRETCH_BEGIN(10) pg8::Gemm g{MBp, (const bf16_t*)(F.ws + WS_WOUTO), T, 1024, 1024, 1024, 1024}; pg8::StaticOrder So; So.init(T, 1024, F.G, bid);
        EpiResR<RSEL> E{XB, (const _Float16*)(F.ws + WS_ROUTER16) + 49152, (float*)(F.ws + WS_PART), F.ws, F.in[22] + 4, F.in[24] + 32, ctl + CW_ECNT + 32 * 64, ctl + CW_PCNT + 64 * 16}; pg8::gemm_phase<EpiResR<RSEL>, pg8::StaticOrder, true, true>(F.lds, g, So, E); STRETCH_END(10) } SEAM_R(10);
#ifdef MK_ROUTER_PHASE
    if (IN(11)) REP(11) { FRESH(); STRETCH_BEGIN(11) phase_router<true>(F, 1); STRETCH_END(11) } SEAM(11);
#endif
    if (IN(12)) REP(12) { FRESH(); STRETCH_BEGIN(12) phase_moe<0>(F, 1); STRETCH_END(12) } SEAM(12);
#ifdef MK_XCC_CHECK
    if (xb_xcc_id() != ((unsigned)blockIdx.x & 7u) && threadIdx.x == 0) atomicAdd(ctl + CW_TMO + 5, 1u);
#endif
    if (IN(13)) REP(13) { FRESH(); STRETCH_BEGIN(13) combine_rows<true>(F); STRETCH_END(13) }
#ifdef MK_XCC_CHECK
    { xcd_barrier(bar); const unsigned bad = __hip_atomic_load(ctl + CW_TMO + 5, __ATOMIC_RELAXED, __HIP_MEMORY_SCOPE_AGENT);
      if (bad) { for (int i = blockIdx.x * NTHR + threadIdx.x; i < T * D; i += gridDim.x * NTHR) F.out[i] *= (bad >= 128u ? 3.f : 2.f); } }
#endif
#undef IN
#undef SEAM
}

static int g_grid = 0;
static bool setup() {
    if (g_grid) return g_grid > 0;
    int dev = 0, cus = 0;
    if (hipGetDevice(&dev) != hipSuccess || hipDeviceGetAttribute(&cus, hipDeviceAttributeMultiprocessorCount, dev) != hipSuccess) { g_grid = -1; return false; }
    if (hipFuncSetAttribute((const void*)fwd_mega, hipFuncAttributeMaxDynamicSharedMemorySize, LDS_BYTES) != hipSuccess) { fprintf(stderr, "hipFuncSetAttribute failed\n"); g_grid = -1; return false; }
    int per_cu = 0;
    if (hipOccupancyMaxActiveBlocksPerMultiprocessor(&per_cu, (const void*)fwd_mega, NTHR, LDS_BYTES) != hipSuccess || per_cu < 1) { fprintf(stderr, "occupancy query: %d\n", per_cu); }
    (void)hipGetLastError();
    if (cus != 256) { fprintf(stderr, "fwd_mega is laid out for 256 CUs (one E3 / O4 tile per workgroup), found %d\n", cus); g_grid = -1; return false; }
    g_grid = cus;
    return true;
}
static void launch_range(void* const* d_in, float* out, unsigned char* ws, int lo, int hi, hipStream_t st, int li = 0) {
    Args a{};
    for (int i = 0; i < 28; ++i) a.in[i] = (const float*)d_in[i];
    a.out = out; a.ws = ws; a.ph_lo = lo; a.ph_hi = hi; a.li = li;
    hipLaunchKernelGGL(fwd_mega, dim3(g_grid), dim3(NTHR), LDS_BYTES, st, a);
}
}
extern "C" void kernel_launch(void* const* d_in, const int* in_sizes, int n_in, void* d_out, int out_size, void* d_ws, size_t ws_size, hipStream_t stream) {
    if (n_in != 28 || out_size != mk::T * mk::D || ws_size < mk::WS_END) { fprintf(stderr, "kernel_launch: unexpected shapes n_in %d out %d ws %zu\n", n_in, out_size, ws_size); return; }
    if (!mk::setup()) return;
    if (hipMemsetAsync((unsigned char*)d_ws + mk::WS_CTL, 0, mk::CTL_ZERO_BYTES, stream) != hipSuccess) { fprintf(stderr, "kernel_launch: memset failed\n"); return; }
#ifdef MK_SPLIT_K
    mk::launch_range(d_in, (float*)d_out, (unsigned char*)d_ws, 0, MK_SPLIT_K + 1, stream, 0);
#ifndef MK_SPLIT_NOREP
    mk::launch_range(d_in, (float*)d_out, (unsigned char*)d_ws, MK_SPLIT_K, MK_SPLIT_K + 1, stream);
#endif
    mk::launch_range(d_in, (float*)d_out, (unsigned char*)d_ws, MK_SPLIT_K + 1, mk::N_PHASES, stream, 1);
#else
    mk::launch_range(d_in, (float*)d_out, (unsigned char*)d_ws, 0, mk::N_PHASES, stream);
#endif
}
```

```cpp
#define MK_PF1 8
#define MK_PF2 8
#include <hip/hip_runtime.h>
#include <hip/hip_bf16.h>
#include <cstdio>
#include <cstdint>
namespace pg8 {
#define PG8_LAS __attribute__((address_space(3)))
typedef unsigned short bf16_t;
typedef short bf16x8 __attribute__((ext_vector_type(8)));
typedef float f32x4 __attribute__((ext_vector_type(4)));
typedef unsigned u32x4 __attribute__((ext_vector_type(4)));
constexpr int BM = 256, BK = 64, HALF = 128, HTB = HALF * BK * 2  , STAGE_BYTES = 8 * HTB, NXCD = 8, WGM = 8;

__host__ __device__ __forceinline__ int lds_byte(int r, int c) { const int st = (r >> 4) * 2 + (c >> 5), rr = r & 15, cc = c & 31, ob = rr * 64 + cc * 2; return st * 1024 + (ob ^ (((ob >> 9) & 1) << 5)); }
__host__ __device__ __forceinline__ void stage_rc(int b, int& R, int& C) { const int st = b / 1024, sb = b % 1024, swz = sb ^ (((sb >> 9) & 1) << 5); R = (st >> 1) * 16 + swz / 64; C = (st & 1) * 32 + (swz % 64) / 2; }
__host__ __device__ __forceinline__ int perm32(int rho) { const int n = rho >> 4, i = rho & 15; return 8 * (i >> 2) + 4 * n + (i & 3); }

struct Unit { int pm, pn, aoff; };
struct Gemm { const bf16_t* A; const bf16_t* Bt; int M, N, K, lda, ldb; };

struct StaticOrder {
    int nM, nN, nwg, G, c;
    __host__ __device__ void init(int M, int N, int G_, int c_) { nM = M / BM; nN = N / BM; nwg = nM * nN; G = G_; c = c_; }
    __host__ __device__ bool next(int i, Unit& u) const {
        const long L = (long)i * G + c; if (L >= nwg) return false;
        int wgid = (int)L; { const int q = nwg / NXCD, r = nwg % NXCD, xcd = wgid % NXCD, off = wgid / NXCD; wgid = (xcd < r ? xcd * (q + 1) : r * (q + 1) + (xcd - r) * q) + off; }
        const int nig = WGM * nN, gid = wgid / nig, fm = gid * WGM, gsz = (nM - fm) < WGM ? (nM - fm) : WGM;
        u.pm = fm + ((wgid % nig) % gsz); u.pn = (wgid % nig) / gsz; u.aoff = 0; return true;
    }
    __device__ __forceinline__ void a_ready(const Unit&) const {}
    __device__ __forceinline__ void done(const Unit&) const {}
};

__device__ __forceinline__ unsigned cvt_pk_bf16(float lo, float hi) { unsigned r; asm volatile("v_cvt_pk_bf16_f32 %0, %1, %2" : "=v"(r) : "v"(lo), "v"(hi)); return r; }
typedef float f32x2 __attribute__((ext_vector_type(2)));
template <class Epi, class Sched, bool ALIGN_EPI = false, bool SP2 = false>
__device__ __forceinline__ void gemm_phase(PG8_LAS unsigned char* lds, const Gemm g, const Sched& S, const Epi& E) {
    int tid_ = threadIdx.x; asm volatile("" : "+v"(tid_));
    const int tid = tid_, wid = __builtin_amdgcn_readfirstlane(tid >> 6), lane = tid & 63, wr = wid >> 2, wc = wid & 3, fr = lane & 15, fq = lane >> 4;
    const int K = g.K, nt = K / BK;
    unsigned voffA[2], voffB[2];
#pragma unroll
    for (int i = 0; i < 2; ++i) { int R, C; stage_rc(tid * 16 + i * 8192, R, C); const int Rb = Epi::PERM ? ((R & ~31) + perm32(R & 31)) : R;
        voffA[i] = (unsigned)(R * g.lda + C) * 2u; voffB[i] = (unsigned)(Rb * g.ldb + C) * 2u; }
    const size_t kstep = (size_t)(BK * 2);
    const size_t hstepA = (size_t)HALF * g.lda * 2, hstepB = (size_t)HALF * g.ldb * 2;
    const size_t tstepA = 2 * hstepA, tstepB = 2 * hstepB;
    const unsigned ldsw = (unsigned)wid * 1024u;
    const int aoff = lds_byte(wr * 64 + fr, fq * 8), boff = lds_byte(wc * 32 + fr, fq * 8);
#define PG8_SA(b, h) (((b) * 2 + (h)) * HTB)
#define PG8_SB(b, h) ((4 + (b) * 2 + (h)) * HTB)
#define PG8_STAGE(bufoff, gbase, voff) do { _Pragma("unroll") for (int _i = 0; _i < 2; ++_i) \
        __builtin_amdgcn_global_load_lds((const unsigned*)((const char*)(gbase) + (voff)[_i]), (PG8_LAS unsigned*)(lds + (bufoff) + ldsw + _i * 8192), 16, 0, 0); } while (0)
#define PG8_LDA(dst, b, h) do { _Pragma("unroll") for (int m = 0; m < 4; ++m) _Pragma("unroll") for (int k = 0; k < 2; ++k) dst[m][k] = *(const PG8_LAS bf16x8*)(lds + PG8_SA(b, h) + aoff + m * 2048 + k * 1024); } while (0)
#define PG8_LDB(dst, b, h) do { _Pragma("unroll") for (int n = 0; n < 2; ++n) _Pragma("unroll") for (int k = 0; k < 2; ++k) dst[n][k] = *(const PG8_LAS bf16x8*)(lds + PG8_SB(b, h) + boff + n * 2048 + k * 1024); } while (0)
#define PG8_MMA(ai, bj, At, Bt) do { __builtin_amdgcn_s_setprio(1); _Pragma("unroll") for (int m = 0; m < 4; ++m) _Pragma("unroll") for (int n = 0; n < 2; ++n) _Pragma("unroll") for (int k = 0; k < 2; ++k) \
        acc[ai][bj][m][n] = __builtin_amdgcn_mfma_f32_16x16x32_bf16(Bt[n][k], At[m][k], acc[ai][bj][m][n], 0, 0, 0); __builtin_amdgcn_s_setprio(0); } while (0)
#define PG8_WAIT_V(n) asm volatile("s_waitcnt vmcnt(" #n ")" ::: "memory")
#define PG8_WAIT_L(n) asm volatile("s_waitcnt lgkmcnt(" #n ")" ::: "memory")
#define PG8_BAR __builtin_amdgcn_s_barrier()
#define PG8_SCHED __builtin_amdgcn_sched_barrier(0)
    Unit cur, nxt; int ui = 0;
    if (!S.next(0, cur)) return;
    f32x4 acc[2][2][4][2];
#pragma unroll
    for (int a = 0; a < 2; ++a)
#pragma unroll
        for (int b = 0; b < 2; ++b)
#pragma unroll
            for (int m = 0; m < 4; ++m)
#pragma unroll
                for (int n = 0; n < 2; ++n) acc[a][b][m][n] = (f32x4){0.f, 0.f, 0.f, 0.f};
    bf16x8 At[4][2], B0[2][2], B1[2][2];
    const char* cA = (const char*)g.A + (size_t)cur.pm * tstepA + cur.aoff; const char* cB = (const char*)g.Bt + (size_t)cur.pn * tstepB;
    S.a_ready(cur);
    if constexpr (SP2) {
        PG8_STAGE(PG8_SB(0, 0), cB, voffB); PG8_STAGE(PG8_SB(0, 1), cB + hstepB, voffB); PG8_STAGE(PG8_SA(0, 0), cA, voffA); PG8_STAGE(PG8_SA(0, 1), cA + hstepA, voffA);
        if (wr == 1) PG8_BAR;
        PG8_WAIT_V(2); PG8_BAR;
        PG8_STAGE(PG8_SB(1, 0), cB + kstep, voffB); PG8_STAGE(PG8_SA(1, 0), cA + kstep, voffA); PG8_STAGE(PG8_SB(1, 1), cB + hstepB + kstep, voffB);
        PG8_WAIT_V(6); PG8_BAR;
    } else {
        PG8_STAGE(PG8_SB(0, 0), cB, voffB); PG8_STAGE(PG8_SA(0, 0), cA, voffA); PG8_STAGE(PG8_SB(0, 1), cB + hstepB, voffB); PG8_STAGE(PG8_SA(0, 1), cA + hstepA, voffA);
        if (wr == 1) PG8_BAR;
        PG8_WAIT_V(4); PG8_BAR;
        PG8_STAGE(PG8_SB(1, 0), cB + kstep, voffB); PG8_STAGE(PG8_SA(1, 0), cA + kstep, voffA); PG8_STAGE(PG8_SB(1, 1), cB + hstepB + kstep, voffB);
        PG8_WAIT_V(6); PG8_BAR;
    }
    for (;;) {
        const bool has_next = S.next(ui + 1, nxt);
        const char* nA = has_next ? (const char*)g.A + (size_t)nxt.pm * tstepA + nxt.aoff : cA; const char* nB = has_next ? (const char*)g.Bt + (size_t)nxt.pn * tstepB : cB;
        for (int t = 0; t < nt; t += 2) {
            const bool last = (t == nt - 2);
            const char* a1 = cA + (size_t)(t + 1) * kstep;
            const char* a2 = last ? nA : cA + (size_t)(t + 2) * kstep; const char* b2 = last ? nB : cB + (size_t)(t + 2) * kstep;
            const char* a3 = a2 + kstep; const char* b3 = b2 + kstep;
            if (last && has_next) S.a_ready(nxt);
            if constexpr (SP2) {
            PG8_LDB(B0, 0, 0); PG8_LDB(B1, 0, 1); PG8_SCHED; PG8_LDA(At, 0, 0); PG8_STAGE(PG8_SA(1, 1), a1 + hstepA, voffA);
            PG8_WAIT_V(8); PG8_WAIT_L(0); PG8_BAR; PG8_MMA(0, 0, At, B0); PG8_MMA(0, 1, At, B1); PG8_BAR; PG8_SCHED;
            PG8_LDA(At, 0, 1); PG8_STAGE(PG8_SB(0, 0), b2, voffB); PG8_STAGE(PG8_SB(0, 1), b2 + hstepB, voffB); PG8_STAGE(PG8_SA(0, 0), a2, voffA);
            PG8_WAIT_V(8); PG8_WAIT_L(0); PG8_BAR; PG8_MMA(1, 0, At, B0); PG8_MMA(1, 1, At, B1); PG8_BAR; PG8_SCHED;
            PG8_LDB(B0, 1, 0); PG8_LDB(B1, 1, 1); PG8_SCHED; PG8_LDA(At, 1, 0); PG8_STAGE(PG8_SA(0, 1), a2 + hstepA, voffA);
            PG8_WAIT_V(8); PG8_WAIT_L(0); PG8_BAR; PG8_MMA(0, 0, At, B0); PG8_MMA(0, 1, At, B1); PG8_BAR; PG8_SCHED;
            PG8_LDA(At, 1, 1); PG8_STAGE(PG8_SB(1, 0), b3, voffB); PG8_STAGE(PG8_SB(1, 1), b3 + hstepB, voffB); PG8_STAGE(PG8_SA(1, 0), a3, voffA);
            PG8_WAIT_V(8); PG8_WAIT_L(0); PG8_BAR; PG8_MMA(1, 0, At, B0); PG8_MMA(1, 1, At, B1); PG8_BAR; PG8_SCHED;
            } else {
            PG8_LDB(B0, 0, 0); PG8_SCHED; PG8_LDA(At, 0, 0); PG8_STAGE(PG8_SA(1, 1), a1 + hstepA, voffA);
            PG8_WAIT_L(8); PG8_BAR; PG8_WAIT_L(0); PG8_MMA(0, 0, At, B0); PG8_BAR; PG8_SCHED;
            PG8_LDB(B1, 0, 1); PG8_STAGE(PG8_SB(0, 0), b2, voffB);
            PG8_BAR; PG8_WAIT_L(0); PG8_MMA(0, 1, At, B1); PG8_BAR;
            PG8_LDA(At, 0, 1); PG8_STAGE(PG8_SA(0, 0), a2, voffA);
            PG8_BAR; PG8_WAIT_L(0); PG8_MMA(1, 0, At, B0); PG8_BAR; PG8_SCHED;
            PG8_STAGE(PG8_SB(0, 1), b2 + hstepB, voffB);
            PG8_WAIT_V(6); PG8_BAR; PG8_MMA(1, 1, At, B1); PG8_BAR;
            PG8_LDB(B0, 1, 0); PG8_SCHED; PG8_LDA(At, 1, 0); PG8_STAGE(PG8_SA(0, 1), a2 + hstepA, voffA);
            PG8_WAIT_L(8); PG8_BAR; PG8_WAIT_L(0); PG8_MMA(0, 0, At, B0); PG8_BAR; PG8_SCHED;
            PG8_LDB(B1, 1, 1); PG8_STAGE(PG8_SB(1, 0), b3, voffB);
            PG8_BAR; PG8_WAIT_L(0); PG8_MMA(0, 1, At, B1); PG8_BAR;
            PG8_LDA(At, 1, 1); PG8_STAGE(PG8_SA(1, 0), a3, voffA);
            PG8_BAR; PG8_WAIT_L(0); PG8_MMA(1, 0, At, B0); PG8_BAR; PG8_SCHED;
            PG8_STAGE(PG8_SB(1, 1), b3 + hstepB, voffB);
            PG8_WAIT_V(6); PG8_BAR; PG8_MMA(1, 1, At, B1); PG8_BAR;
            }
        }
        if constexpr (ALIGN_EPI) { if (wr == 0) PG8_BAR; }
        if constexpr (!Epi::AFTER_DRAIN) { E(acc, cur, wr, wc, fr, fq); S.done(cur); }
        if (!has_next) break;
#pragma unroll
        for (int a = 0; a < 2; ++a)
#pragma unroll
            for (int b = 0; b < 2; ++b)
#pragma unroll
                for (int m = 0; m < 4; ++m)
#pragma unroll
                    for (int n = 0; n < 2; ++n) acc[a][b][m][n] = (f32x4){0.f, 0.f, 0.f, 0.f};
        cur = nxt; cA = nA; cB = nB; ++ui;
        if constexpr (ALIGN_EPI) { if (wr == 1) PG8_BAR; }
    }
    PG8_WAIT_V(0);
    if constexpr (!ALIGN_EPI) { if (wr == 0) PG8_BAR; }
    PG8_BAR;
    if constexpr (Epi::AFTER_DRAIN) { E.fused(acc, cur, wr, wc, fr, fq, lds, wid, lane); S.done(cur); }
#undef PG8_SA
#undef PG8_SB
#undef PG8_STAGE
#undef PG8_LDA
#undef PG8_LDB
#undef PG8_MMA
#undef PG8_WAIT_V
#undef PG8_WAIT_L
#undef PG8_BAR
#undef PG8_SCHED
}
}
namespace mk {
using pg8::bf16_t; using pg8::bf16x8; using pg8::f32x4; using pg8::u32x4; using pg8::f32x2;
typedef float f32x16 __attribute__((ext_vector_type(16)));
typedef unsigned u32x2 __attribute__((ext_vector_type(2)));
typedef short s16x4 __attribute__((ext_vector_type(4)));
typedef _Float16 f16x8 __attribute__((ext_vector_type(8)));
#define GAS __attribute__((address_space(1)))
#define LAS __attribute__((address_space(3)))
typedef GAS unsigned gu32;
#define RLX_AGENT __ATOMIC_RELAXED, __HIP_MEMORY_SCOPE_AGENT
#define LDS_WAIT() asm volatile("s_waitcnt lgkmcnt(0)" ::: "memory")
#define VM_WAIT() asm volatile("s_waitcnt vmcnt(0)" ::: "memory")

constexpr int T = 16384, D = 1024, S = 2048, NB = 8;
constexpr int NWAVES = 8, NTHR = 512;
constexpr float EPS = 1e-6f;
constexpr float LOG2E = 1.4426950408889634f;
constexpr float C2M = 0.10206207261596575f * LOG2E;
constexpr float C2S = 0.125f * LOG2E;

constexpr size_t MiB = (size_t)1 << 20;
constexpr size_t WS_CTL = 0, CTL_ZERO_BYTES = 1 * MiB;
constexpr size_t WS_WINE = 1 * MiB;
constexpr size_t WS_WOUTE = 5 * MiB;
constexpr size_t WS_WINO = 7 * MiB;
constexpr size_t WS_WUQ = 10 * MiB;
constexpr size_t WS_WUKV = 10 * MiB + 393216;
constexpr size_t WS_WOUTO = 11 * MiB;
constexpr size_t WS_ROUTER = 13 * MiB;
constexpr size_t WS_ROUTER16 = WS_ROUTER + 393216;
constexpr size_t WS_ROPE = 14 * MiB;
constexpr size_t WS_RS0 = 14 * MiB + 512 * 1024;
constexpr size_t WS_RSM = WS_RS0 + 64 * 1024;
constexpr size_t WS_SSQQ = 15 * MiB;
constexpr size_t WS_SSQKV = 15 * MiB + 256 * 1024;
constexpr size_t WS_WMOE = 16 * MiB;
constexpr size_t WS_XB = 64 * MiB;
constexpr size_t WS_MB = 96 * MiB;
constexpr size_t WS_Y = 128 * MiB;
constexpr size_t WS_PART = 128 * MiB;
constexpr size_t WS_Q = 128 * MiB;
constexpr size_t WS_KV = 152 * MiB;
constexpr size_t WS_P = 192 * MiB;
constexpr size_t WS_LSLOT = 232 * MiB;
constexpr size_t WS_LGW = 234 * MiB;
constexpr size_t WS_KPE = 236 * MiB;
constexpr size_t WS_LRS = 238 * MiB;
constexpr size_t WS_END = 240 * MiB;
constexpr size_t W1_EXP = 524288, W2_EXP = 262144;
constexpr size_t WMOE_LAYER = 24 * MiB, WMOE_W2 = 16 * MiB;
constexpr float WSCALE = 64.f, WDESCALE = 1.f / 64.f;

constexpr int CW_TMO = 0;
constexpr int CW_BAR = 4096;
constexpr int CW_CVT = 8192;
constexpr int CW_PCNT = 24576;
constexpr int CW_ECNT = 16384;

constexpr int LDS_BYTES = 160 * 1024;
constexpr int RING_BYTES = 131072;
constexpr int MISC_OFF = 159 * 1024;

__device__ __forceinline__ unsigned f2bf(float f) { unsigned u = __builtin_bit_cast(unsigned, f); return (u + 0x7fffu + ((u >> 16) & 1u)) >> 16; }
__device__ __forceinline__ float bf2f(unsigned h) { return __builtin_bit_cast(float, h << 16); }
__device__ __forceinline__ unsigned pk2(float lo, float hi) { return pg8::cvt_pk_bf16(lo, hi); }
__device__ __forceinline__ float wave_sum(float v) {
#pragma unroll
    for (int o = 1; o < 64; o <<= 1) v += __shfl_xor(v, o);
    return v;
}
__device__ __forceinline__ float fast_exp2(float x) { return __builtin_amdgcn_exp2f(x); }
__device__ __forceinline__ float fast_rcp(float x) { return __builtin_amdgcn_rcpf(x); }
__device__ __forceinline__ float sigmoid_f(float x) { return fast_rcp(1.f + fast_exp2(-x * LOG2E)); }
__device__ __forceinline__ float silu_f(float x) { return x * sigmoid_f(x); }
__device__ __forceinline__ float gelu_f(float x) { const float u = 0.7978845608028654f * (x + 0.044715f * x * x * x); return x * sigmoid_f(2.f * u); }
__device__ __forceinline__ f32x2 rcp2_(f32x2 d) { f32x2 r; r.x = fast_rcp(d.x); r.y = fast_rcp(d.y); return r; }
__device__ __forceinline__ f32x2 exp2_2_(f32x2 z) { f32x2 r; r.x = fast_exp2(z.x); r.y = fast_exp2(z.y); return r; }
constexpr float GC1 = -2.f * 0.7978845608028654f * LOG2E, GC2 = GC1 * 0.044715f;
__device__ __forceinline__ f32x2 gelu2_f(f32x2 x) { const f32x2 t = x * x; const f32x2 z = x * (t * GC2 + GC1); return x * rcp2_(exp2_2_(z) + 1.f); }
__device__ __forceinline__ f32x2 mul_sigmoid2_f(f32x2 a, f32x2 zn) { return a * rcp2_(exp2_2_(zn) + 1.f); }

#define XB_TMO      128
#define XB_XCNT(j)  (256  + 64 * (j))
#define XB_XSUB(j)  (1280 + 64 * (j))
#define XB_XGEN(j)  (2304 + 64 * (j))
#define XB_TOP      3328
#define XB_TOPGEN   3392
#define XCD_BAR_WORDS 3456
#define XB_SPIN_CAP (1u << 18)
__device__ __forceinline__ unsigned xb_ld(unsigned* p)              { return __hip_atomic_load(p, __ATOMIC_RELAXED, __HIP_MEMORY_SCOPE_AGENT); }
__device__ __forceinline__ unsigned xb_add(unsigned* p, unsigned v) { return __hip_atomic_fetch_add(p, v, __ATOMIC_RELAXED, __HIP_MEMORY_SCOPE_AGENT); }
__device__ __forceinline__ unsigned xb_xcc_id() { return (unsigned)__builtin_amdgcn_s_getreg((3 << 11) | 20) & 0xFu; }
#define XB_SPIN(cond, bar) do { unsigned _sp = 0; while (cond) { __builtin_amdgcn_s_sleep(1); \
    if ((++_sp & 255u) == 0u) { if (xb_ld(&(bar)[XB_TMO])) break; if (_sp > XB_SPIN_CAP) { atomicAdd(&(bar)[XB_TMO], 1u); break; } } } } while (0)
struct XcdBarrier { unsigned* bar; unsigned x; volatile LAS unsigned* st; };
__device__ __forceinline__ XcdBarrier xcd_barrier_post(unsigned* bar, volatile LAS unsigned* st) {
    XcdBarrier b; b.bar = bar; b.x = xb_xcc_id(); b.st = st;
    if (threadIdx.x == 0) (void)xb_add(&bar[XB_XCNT(b.x)], 1u);
    return b;
}
__device__ __forceinline__ void xcd_barrier_complete(unsigned* bar, unsigned x, unsigned& nloc, unsigned& nx) {
    const unsigned G = gridDim.x * gridDim.y * gridDim.z;
    unsigned sum, cnt, mine, sp = 0u;
    for (;;) {
        sum = 0u; cnt = 0u; mine = 0u;
#pragma unroll
        for (unsigned j = 0; j < 16; ++j) { const unsigned c = xb_ld(&bar[XB_XCNT(j)]); sum += c; cnt += (c > 0u) ? 1u : 0u; mine = (j == x) ? c : mine; }
        if (sum == G) break;
        __builtin_amdgcn_s_sleep(1);
        if ((++sp & 255u) == 0u) { if (xb_ld(&bar[XB_TMO])) break; if (sp > XB_SPIN_CAP) { atomicAdd(&bar[XB_TMO], 1u); break; } }
    }
    nloc = mine > 0u ? mine : 1u; nx = cnt > 0u ? cnt : 1u;
}
__device__ __forceinline__ void xcd_barrier(const XcdBarrier& b) {
    asm volatile("s_waitcnt vmcnt(0)" ::: "memory");
    __syncthreads();
    if (threadIdx.x == 0) {
        unsigned* bar = b.bar;
        __builtin_amdgcn_s_waitcnt(0);
        unsigned nloc = b.st[0], nx = b.st[1];
        if (nloc == 0u) { xcd_barrier_complete(bar, b.x, nloc, nx); b.st[0] = nloc; b.st[1] = nx; }
        const unsigned old = xb_add(&bar[XB_XSUB(b.x)], 1u);
        const unsigned gen = old / nloc;
        if (old + 1u == (gen + 1u) * nloc) {
            __builtin_amdgcn_fence(__ATOMIC_RELEASE, "agent");
            asm volatile("s_waitcnt vmcnt(0)" ::: "memory");
            const unsigned og = xb_add(&bar[XB_TOP], 1u);
            const unsigned tg = og / nx;
            if (og + 1u == (tg + 1u) * nx) xb_add(&bar[XB_TOPGEN], 1u);
            else XB_SPIN(xb_ld(&bar[XB_TOPGEN]) == tg, bar);
            xb_add(&bar[XB_XGEN(b.x)], 1u);
            __builtin_amdgcn_fence(__ATOMIC_ACQUIRE, "agent");
            asm volatile("s_waitcnt vmcnt(0)" ::: "memory");
        } else {
            XB_SPIN(xb_ld(&bar[XB_XGEN(b.x)]) == gen, bar);
            __builtin_amdgcn_fence(__ATOMIC_ACQUIRE, "agent");
            asm volatile("s_waitcnt vmcnt(0)" ::: "memory");
        }
    }
    __syncthreads();
}

__device__ __forceinline__ __amdgpu_buffer_rsrc_t uniform_rsrc(const void* p, unsigned bytes) {
    const unsigned long long a = (unsigned long long)p;
    const unsigned lo = __builtin_amdgcn_readfirstlane((unsigned)a), hi = __builtin_amdgcn_readfirstlane((unsigned)(a >> 32));
    return __builtin_amdgcn_make_buffer_rsrc((void*)(((unsigned long long)hi << 32) | lo), 0, bytes, 0x00020000);
}
__device__ __forceinline__ void st16_wt(__amdgpu_buffer_rsrc_t r, unsigned byte_off, u32x4 v) { __builtin_amdgcn_raw_buffer_store_b128(v, r, byte_off, 0, 0); }
__device__ __forceinline__ void st16_wt(__amdgpu_buffer_rsrc_t r, unsigned byte_off, f32x4 v) { __builtin_amdgcn_raw_buffer_store_b128(__builtin_bit_cast(u32x4, v), r, byte_off, 0, 0); }

struct Args { const float* in[28]; float* out; unsigned char* ws; int ph_lo, ph_hi, li, pad; };

struct Frame {
    LAS unsigned char* lds;
    int tid, lane, wave, vcu, G;
    const float* const* in;
    float* out; unsigned char* ws;
};
}
namespace mk {
__device__ __forceinline__ void p0_transpose_item(const float* W, int ldn, int k0, int src_n0, bf16_t* WT, int ldk, int dst_n0,
                                                  const float* gain, float scale, LAS float* scr, int lane) {
    if (src_n0 >= 0) {
#pragma unroll 8
        for (int i = 0; i < 32; ++i) { const int kk = 2 * i + (lane >> 5);
            float v = W[(size_t)(k0 + kk) * ldn + src_n0 + (lane & 31)] * scale; if (gain) v *= gain[k0 + kk];
            scr[kk * 33 + (lane & 31)] = v; }
    } else {
#pragma unroll 8
        for (int i = 0; i < 32; ++i) { const int kk = 2 * i + (lane >> 5); scr[kk * 33 + (lane & 31)] = 0.f; }
    }
    LDS_WAIT(); asm volatile("" ::: "memory");
    const int c = lane & 7;
#pragma unroll
    for (int j = 0; j < 4; ++j) { const int n = (lane >> 3) + 8 * j; const LAS float* s = scr + (8 * c) * 33 + n;
        u32x4 o; o.x = pk2(s[0 * 33], s[1 * 33]); o.y = pk2(s[2 * 33], s[3 * 33]); o.z = pk2(s[4 * 33], s[5 * 33]); o.w = pk2(s[6 * 33], s[7 * 33]);
        *(GAS u32x4*)(WT + (size_t)(dst_n0 + n) * ldk + k0 + 8 * c) = o; }
    LDS_WAIT(); asm volatile("" ::: "memory");
}
template <bool STAGE2>
__device__ __forceinline__ void moe_cvt_tile(const float* src, int ld, const float* gain16, bf16_t* dst0, size_t piece_stride  , LAS float* scr, int lane) {
#pragma unroll 4
    for (int i = 0; i < 16; ++i) { f32x4 v = *(const GAS f32x4*)(src + (size_t)i * ld + 4 * lane); if (gain16) v = v * gain16[i]; *(LAS f32x4*)(scr + i * 256 + 4 * lane) = v; }
    LDS_WAIT(); asm volatile("" ::: "memory");
    const int r = lane & 31, h = lane >> 5;
#pragma unroll
    for (int c = 0; c < 8; ++c) {
        float v[8];
#pragma unroll
        for (int j = 0; j < 8; ++j) { const int row = STAGE2 ? (8 * (j >> 2) + 4 * h + (j & 3)) : (8 * h + j); v[j] = scr[row * 256 + 32 * c + r]; }
        u32x4 o; o.x = pk2(v[0], v[1]); o.y = pk2(v[2], v[3]); o.z = pk2(v[4], v[5]); o.w = pk2(v[6], v[7]);
        *(GAS u32x4*)(dst0 + (size_t)c * piece_stride + (size_t)lane * 8) = o;
    }
    LDS_WAIT(); asm volatile("" ::: "memory");
}
constexpr int MOE_CVT_ITEMS = 6144;
struct CvtRegs { f32x4 v[16]; };
__device__ __forceinline__ void moe_cvt_load(const Frame& F, int layer, int it, CvtRegs& R) {
    const float* src; int ld;
    if (it < 4096) { const int gu = it & 1, r = it >> 1, e = r >> 6, ks = r & 63; src = (gu ? F.in[26] : F.in[25]) + ((size_t)(layer * 32 + e) * 1024 + 16 * ks) * 256; ld = 256; }
    else { const int r = it - 4096, e = r >> 6, kk = (r >> 2) & 15, dq = r & 3; src = F.in[27] + ((size_t)(layer * 32 + e) * 256 + 16 * kk) * 1024 + 256 * dq; ld = 1024; }
#pragma unroll
    for (int i = 0; i < 16; ++i) R.v[i] = __builtin_nontemporal_load((const GAS f32x4*)(src + (size_t)i * ld + 4 * F.lane));
}
__device__ __forceinline__ void moe_cvt_stage(const Frame& F, int layer, int it, const CvtRegs& R, LAS float* scr) {
    if (it < 4096) { const int ks = (it >> 1) & 63; const float* gain = F.in[2] + layer * 1024 + 16 * ks;
#pragma unroll
        for (int i = 0; i < 16; ++i) *(LAS f32x4*)(scr + i * 256 + 4 * F.lane) = R.v[i] * (gain[i] * WSCALE);
    } else {
#pragma unroll
        for (int i = 0; i < 16; ++i) *(LAS f32x4*)(scr + i * 256 + 4 * F.lane) = R.v[i] * WSCALE;
    }
    LDS_WAIT(); asm volatile("" ::: "memory");
}
__device__ __forceinline__ void moe_cvt_emit(const Frame& F, int layer, int it, LAS float* scr) {
    unsigned char* W1 = F.ws + WS_WMOE + (size_t)layer * WMOE_LAYER; unsigned char* W2 = W1 + WMOE_W2;
    const int rr = F.lane & 31, h = F.lane >> 5;
    const bool s2 = it >= 4096;
    unsigned char* base; size_t st_c2, st_dt;
    if (!s2) { const int gu = it & 1, r = it >> 1, e = r >> 6, ks = r & 63; base = W1 + (size_t)e * W1_EXP + (size_t)ks * 1024 + gu * 8; st_c2 = 2 * 65536; st_dt = 65536; }
    else { const int r = it - 4096, e = r >> 6, kk = (r >> 2) & 15, dq = r & 3; const int p = dq >> 1, w0 = (dq & 1) * 4;
        base = W2 + (size_t)e * W2_EXP + ((size_t)(p * 8 + w0) * 16 + kk) * 1024; st_c2 = 16 * 1024; st_dt = 8; }
#pragma unroll
    for (int c = 0; c < 8; ++c) {
        float v[8];
#pragma unroll
        for (int j = 0; j < 8; ++j) { const int row = s2 ? (8 * (j >> 2) + 4 * h + (j & 3)) : (8 * h + j); v[j] = scr[row * 256 + 32 * c + rr]; }
        int w0_ = __builtin_amdgcn_cvt_pk_fp8_f32(v[0], v[1], 0, false); w0_ = __builtin_amdgcn_cvt_pk_fp8_f32(v[2], v[3], w0_, true);
        int w1_ = __builtin_amdgcn_cvt_pk_fp8_f32(v[4], v[5], 0, false); w1_ = __builtin_amdgcn_cvt_pk_fp8_f32(v[6], v[7], w1_, true);
        u32x2 o; o.x = (unsigned)w0_; o.y = (unsigned)w1_;
        *(GAS u32x2*)(base + (size_t)(c >> 1) * st_c2 + (size_t)(c & 1) * st_dt + (size_t)F.lane * 16) = o;
    }
    LDS_WAIT(); asm volatile("" ::: "memory");
}
__device__ __forceinline__ void row_to_bf16_rs(const float* xrow, bf16_t* orow, float* rs, int lane) {
    const GAS f32x4* xr = (const GAS f32x4*)xrow + lane;
    f32x4 v[4]; float s = 0.f;
#pragma unroll
    for (int j = 0; j < 4; ++j) { v[j] = __builtin_nontemporal_load(xr + 64 * j); s += (v[j].x * v[j].x + v[j].y * v[j].y) + (v[j].z * v[j].z + v[j].w * v[j].w); }
    s = wave_sum(s);
    GAS u32x2* o8 = (GAS u32x2*)orow + lane;
#pragma unroll
    for (int j = 0; j < 4; ++j) { u32x2 w; w.x = pk2(v[j].x, v[j].y); w.y = pk2(v[j].z, v[j].w); o8[64 * j] = w; }
    if (lane == 0) *rs = 1.0f / sqrtf(s * (1.f / 1024.f) + EPS);
}

__device__ __forceinline__ void p0_t64(const float* W, int ldn, int k0, int s0, int s1, bf16_t* WT, int ldk, int dst_n0, int dk0, const float* gain, float sc0, float sc1, LAS float* scr, int lane) {
    const int half = (lane >> 3) & 1, src = half ? s1 : s0; const float sc = half ? sc1 : sc0;
    const int rr = lane >> 4, cc = (lane & 15) * 4;
    f32x4 v[16];
#pragma unroll
    for (int i = 0; i < 16; ++i) { const int kk = 4 * i + rr;
        v[i] = (src >= 0) ? __builtin_nontemporal_load((const GAS f32x4*)(W + (size_t)(k0 + kk) * ldn + src + (lane & 7) * 4)) : (f32x4){0.f, 0.f, 0.f, 0.f}; }
#pragma unroll
    for (int i = 0; i < 16; ++i) { const int kk = 4 * i + rr; const float g = (gain ? gain[k0 + kk] : 1.f) * sc; const f32x4 x = v[i] * g;
        LAS float* d = scr + kk * 65 + cc; d[0] = x.x; d[1] = x.y; d[2] = x.z; d[3] = x.w; }
    LDS_WAIT(); asm volatile("" ::: "memory");
    const int c = lane & 7;
#pragma unroll
    for (int j = 0; j < 8; ++j) { const int n = (lane >> 3) + 8 * j; const LAS float* s = scr + (8 * c) * 65 + n;
        u32x4 o; o.x = pk2(s[0 * 65], s[1 * 65]); o.y = pk2(s[2 * 65], s[3 * 65]); o.z = pk2(s[4 * 65], s[5 * 65]); o.w = pk2(s[6 * 65], s[7 * 65]);
        *(GAS u32x4*)(WT + (size_t)(dst_n0 + n) * ldk + dk0 + 8 * c) = o; }
    LDS_WAIT(); asm volatile("" ::: "memory");
}
__device__ __forceinline__ void p0_dense_item(const Frame& F, int it, LAS float* scr) {
    int r = it;
    if (r < 512) { const int kb = r >> 5, nb = r & 31; const int n = 64 * nb; int src;
        if (n < 1024) { const int j = n >> 8, c = n & 255; src = (c < 128) ? (128 * j + c) : (512 + 128 * j + (c - 128)); } else src = n;
        p0_t64(F.in[4], 2048, 64 * kb, src, src + 32, (bf16_t*)(F.ws + WS_WINE), 1024, n, 64 * kb, F.in[1], 1.f, 1.f, scr, F.lane); return; } r -= 512;
    if (r < 256) { const int kb = r >> 4, nb = r & 15;
        p0_t64(F.in[13], 1024, 64 * kb, 64 * nb, 64 * nb + 32, (bf16_t*)(F.ws + WS_WOUTE), 1024, 64 * nb, 64 * kb, nullptr, 1.f, 1.f, scr, F.lane); return; } r -= 256;
    if (r < 320) { const int kb = r / 20, nb = r % 20; const int n = 64 * nb; int s0, s1; float sc = 1.f;
        if (n < 384) { s0 = n; s1 = n + 32; } else if (n == 384) { s0 = 384; s1 = -1; } else if (n < 512) { s0 = -1; s1 = -1; }
        else if (n < 1024) { s0 = 416 + (n - 512); s1 = s0 + 32; sc = C2S; } else if (n < 1152) { s0 = 928 + (n - 1024); s1 = s0 + 32; } else { s0 = 1056 + (n - 1152); s1 = s0 + 32; }
        p0_t64(F.in[14], 1184, 64 * kb, s0, s1, (bf16_t*)(F.ws + WS_WINO), 1024, n, 64 * kb, F.in[1] + 1024, sc, sc, scr, F.lane); return; } r -= 320;
    if (r < 48) { const int kb = r / 12, nb = r % 12; const int n = 64 * nb; int s0, s1;
        if (n < 512) { s0 = 96 * (n >> 6); s1 = s0 + 32; } else { const int h = (n - 512) >> 5; s0 = 96 * h + 64; s1 = 96 * (h + 1) + 64; }
        p0_t64(F.in[16], 768, 64 * kb, s0, s1, (bf16_t*)(F.ws + WS_WUQ), 256, n, 64 * kb, F.in[15], C2M, C2M, scr, F.lane); return; } r -= 48;
    if (r < 64) { const int kb = r >> 4, nb = r & 15; const int n = 64 * nb; int s0;
        if (n < 512) s0 = 128 * (n >> 6); else s0 = 128 * ((n - 512) >> 6) + 64;
        if (kb >= 2) p0_t64(F.in[18], 1024, 0, -1, -1, (bf16_t*)(F.ws + WS_WUKV), 256, n, 64 * kb, nullptr, 1.f, 1.f, scr, F.lane);
        else p0_t64(F.in[18], 1024, 64 * kb, s0, s0 + 32, (bf16_t*)(F.ws + WS_WUKV), 256, n, 64 * kb, F.in[17], 1.f, 1.f, scr, F.lane);
        return; } r -= 64;
    { const int kb = r >> 4, nb = r & 15;
        p0_t64(F.in[20], 1024, 64 * kb, 64 * nb, 64 * nb + 32, (bf16_t*)(F.ws + WS_WOUTO), 1024, 64 * nb, 64 * kb, nullptr, 1.f, 1.f, scr, F.lane); }
}
constexpr int DENSE_ITEMS = 1456;

template <int PARTS = 15> __device__ __forceinline__ void phase_p0(const Frame& F) {
    LAS float* scr = (LAS float*)(F.lds + F.wave * 16896);
    const int gw = F.vcu * NWAVES + F.wave, NGW = F.G * NWAVES;
    if (PARTS & 1) { CvtRegs R; int it = gw; if (it < MOE_CVT_ITEMS) moe_cvt_load(F, 0, it, R);
      for (; it < MOE_CVT_ITEMS; it += NGW) { moe_cvt_stage(F, 0, it, R, scr); if (it + NGW < MOE_CVT_ITEMS) moe_cvt_load(F, 0, it + NGW, R); moe_cvt_emit(F, 0, it, scr); } }
    if (PARTS & 2) for (int it = gw; it < DENSE_ITEMS; it += NGW) p0_dense_item(F, it, scr);
    if (PARTS & 4) for (int m = gw; m < T; m += NGW) row_to_bf16_rs(F.in[0] + (size_t)m * D, (bf16_t*)(F.ws + WS_XB) + (size_t)m * D, (float*)(F.ws + WS_RS0) + m, F.lane);
    const int gt = gw * 64 + F.lane, NGT = NGW * 64;
    if (PARTS & 8) for (int idx = gt; idx < 2 * 49152; idx += NGT) {
        const int layer = idx / 49152, li = idx % 49152;
        const int j = li & 7, ln = (li >> 3) & 63, blk = li >> 9, ct = blk % 3, ks = (blk / 3) & 3, w = blk / 12;
        const int k = 128 * w + 32 * ks + 8 * (ln >> 4) + j, col = 16 * ct + (ln & 15);
        float v = 0.f;
        if (col < 4) v = F.in[21][((size_t)layer * 1024 + k) * 4 + col];
        else if (col < 36) v = F.in[23][(((size_t)layer * 4 + ((col - 4) >> 3)) * 1024 + k) * 8 + ((col - 4) & 7)];
        v *= F.in[2][layer * 1024 + k];
        const unsigned hi = f2bf(v); const unsigned lo = f2bf(v - bf2f(hi));
        bf16_t* R = (bf16_t*)(F.ws + WS_ROUTER);
        R[(size_t)(layer * 2 + 0) * 49152 + li] = (bf16_t)hi;
        R[(size_t)(layer * 2 + 1) * 49152 + li] = (bf16_t)lo;
        ((_Float16*)(F.ws + WS_ROUTER16))[(size_t)layer * 49152 + li] = (_Float16)v;
    }
    if (PARTS & 8) for (int idx = gt; idx < S * 16; idx += NGT) {
        const int pos = idx >> 4, j = idx & 15;
        const double inv = pow(10000.0, -(double)(2 * j) / 32.0), ang = (double)pos * inv;
        f32x2 cs; cs.x = (float)cos(ang); cs.y = (float)sin(ang);
        ((f32x2*)(F.ws + WS_ROPE))[idx] = cs;
    }
}
}
namespace mk {
using pg8::Unit;
__device__ __forceinline__ u32x4 pack8(const f32x4& a, const f32x4& b) { u32x4 w; w.x = pk2(a[0], a[1]); w.y = pk2(a[2], a[3]); w.z = pk2(b[0], b[1]); w.w = pk2(b[2], b[3]); return w; }

struct EpiE1 {
    static constexpr bool PERM = true, AFTER_DRAIN = false;
    bf16_t* ACT; const float* rs;
    __device__ __forceinline__ void operator()(const f32x4 (&acc)[2][2][4][2], const Unit& u, int wr, int wc, int fr, int fq) const {
        const int row0 = u.pm * 256 + wr * 64 + fr, cl = wc * 32 + 8 * fq;
        const __amdgpu_buffer_rsrc_t RA = uniform_rsrc(ACT, (unsigned)T * 1536u * 2u);
        float rsv[2][4];
#pragma unroll
        for (int ai = 0; ai < 2; ++ai)
#pragma unroll
            for (int m = 0; m < 4; ++m) rsv[ai][m] = rs[row0 + ai * 128 + m * 16];
#pragma unroll
        for (int ai = 0; ai < 2; ++ai)
#pragma unroll
            for (int m = 0; m < 4; ++m) {
                const int row = row0 + ai * 128 + m * 16; const float r = rsv[ai][m]; const unsigned rowb = (unsigned)row * 3072u;
                if (u.pn < 4) {
                    f32x4 o0, o1; const float rn = -r * LOG2E;
#pragma unroll
                    for (int n = 0; n < 2; ++n)
#pragma unroll
                        for (int i = 0; i < 4; i += 2) { const f32x2 a = {acc[ai][0][m][n][i], acc[ai][0][m][n][i + 1]}, g = {acc[ai][1][m][n][i], acc[ai][1][m][n][i + 1]};
                            const f32x2 v = mul_sigmoid2_f(a * r, g * rn); if (n == 0) { o0[i] = v.x; o0[i + 1] = v.y; } else { o1[i] = v.x; o1[i + 1] = v.y; } }
                    st16_wt(RA, rowb + (unsigned)(128 * u.pn + cl) * 2u, pack8(o0, o1));
                } else {
                    const int base = (u.pn < 6) ? (512 + (u.pn - 4) * 256) : (1024 + (u.pn - 6) * 256);
#pragma unroll
                    for (int bj = 0; bj < 2; ++bj) { f32x4 o0, o1;
#pragma unroll
                        for (int i = 0; i < 4; i += 2) { const f32x2 x0 = {acc[ai][bj][m][0][i], acc[ai][bj][m][0][i + 1]}, x1 = {acc[ai][bj][m][1][i], acc[ai][bj][m][1][i + 1]};
                            const f32x2 y0 = gelu2_f(x0 * r), y1 = gelu2_f(x1 * r); o0[i] = y0.x; o0[i + 1] = y0.y; o1[i] = y1.x; o1[i + 1] = y1.y; }
                        st16_wt(RA, rowb + (unsigned)(base + bj * 128 + cl) * 2u, pack8(o0, o1)); }
                }
            }
    }
};
struct EpiRes {
    static constexpr bool PERM = true, AFTER_DRAIN = false;
    const float* resid; float* out; bf16_t* xb;
    __device__ __forceinline__ void operator()(const f32x4 (&acc)[2][2][4][2], const Unit& u, int wr, int wc, int fr, int fq) const {
        const int row0 = u.pm * 256 + wr * 64 + fr, col0 = u.pn * 256 + wc * 32 + 8 * fq;
        const __amdgpu_buffer_rsrc_t RO = uniform_rsrc(out, (unsigned)T * 1024u * 4u), RX = uniform_rsrc(xb, (unsigned)T * 1024u * 2u);
#pragma unroll
        for (int ai = 0; ai < 2; ++ai) {
            f32x4 rv[4][2][2];
#pragma unroll
            for (int m = 0; m < 4; ++m) { const size_t off = (size_t)(row0 + ai * 128 + m * 16) * 1024 + col0;
#pragma unroll
                for (int bj = 0; bj < 2; ++bj) { rv[m][bj][0] = *(const f32x4*)(resid + off + bj * 128); rv[m][bj][1] = *(const f32x4*)(resid + off + bj * 128 + 4); } }
            asm volatile("" ::: "memory");
#pragma unroll
            for (int m = 0; m < 4; ++m) {
                const size_t off = (size_t)(row0 + ai * 128 + m * 16) * 1024 + col0;
#pragma unroll
                for (int bj = 0; bj < 2; ++bj) {
                    const f32x4 v0 = acc[ai][bj][m][0] + rv[m][bj][0], v1 = acc[ai][bj][m][1] + rv[m][bj][1];
                    const unsigned eo = (unsigned)(off + bj * 128);
                    st16_wt(RO, eo * 4u, v0); st16_wt(RO, eo * 4u + 16u, v1);
                    st16_wt(RX, eo * 2u, pack8(v0, v1));
                }
            }
            asm volatile("" ::: "memory");
        }
    }
};
__device__ __forceinline__ void router_select256(unsigned char* ws, const LAS float* bg, const LAS float* br, unsigned* gcnt, int tok0, int tid, int lane, int wave, LAS unsigned char* lds) {
    LAS float* lg = (LAS float*)lds;
    LAS float* rsl = (LAS float*)(lds + 49152);
    LAS int* sel = (LAS int*)(lds + 50176);
    LAS float* gwl = (LAS float*)(lds + 52224);
    LAS int* basel = (LAS int*)(lds + 54272);
    LAS int* cntw = (LAS int*)(lds + 54400);
    LAS int* pre = (LAS int*)(lds + 55424);
    if (tid < 256) {
        const float rs = rsl[tid]; const LAS float* L = lg + tid * 48;
        float gl[4];
#pragma unroll
        for (int j = 0; j < 4; ++j) gl[j] = L[j] * rs + bg[j];
        int gi = 0; float gm = gl[0];
#pragma unroll
        for (int j = 1; j < 4; ++j) if (gl[j] > gm) { gm = gl[j]; gi = j; }
        float den = 0.f;
#pragma unroll
        for (int j = 0; j < 4; ++j) den += __expf(gl[j] - gm);
        const float gp = 1.f / den;
        float el[8];
#pragma unroll
        for (int x = 0; x < 8; ++x) el[x] = L[4 + 8 * gi + x] * rs + br[gi * 8 + x];
        int i1 = 0; float v1 = el[0];
#pragma unroll
        for (int x = 1; x < 8; ++x) if (el[x] > v1) { v1 = el[x]; i1 = x; }
        int i2 = 0; float v2 = -3.0e38f;
#pragma unroll
        for (int x = 0; x < 8; ++x) if (x != i1 && el[x] > v2) { v2 = el[x]; i2 = x; }
        const float e2 = __expf(v2 - v1);
        sel[2 * tid] = gi * 8 + i1; sel[2 * tid + 1] = gi * 8 + i2;
        gwl[2 * tid] = gp / (1.f + e2); gwl[2 * tid + 1] = gp * e2 / (1.f + e2);
        ((float*)(ws + WS_RSM))[tok0 + tid] = rs;
    }
    __syncthreads();
    const int myexp = sel[tid]; unsigned long long mymask = 0ull;
#pragma unroll 4
    for (int x = 0; x < 32; ++x) { const unsigned long long m = __ballot(myexp == x); if (myexp == x) mymask = m; if (lane == 0) cntw[wave * 32 + x] = __popcll(m); }
    const int pos = __popcll(mymask & ((1ull << lane) - 1ull));
    __syncthreads();
    if (tid < 32) { int run = 0;
#pragma unroll
        for (int w = 0; w < 8; ++w) { pre[w * 32 + tid] = run; run += cntw[w * 32 + tid]; }
        basel[tid] = run ? (int)__hip_atomic_fetch_add(gcnt + tid * 64, (unsigned)run, __ATOMIC_RELAXED, __HIP_MEMORY_SCOPE_AGENT) : 0; }
    __syncthreads();
    const size_t dst = (size_t)myexp * T + basel[myexp] + pre[wave * 32 + myexp] + pos;
    ((int*)(ws + WS_LSLOT))[dst] = 2 * (tok0 + (tid >> 1)) + (tid & 1);
    ((float*)(ws + WS_LGW))[dst] = gwl[tid];
    ((float*)(ws + WS_LRS))[dst] = rsl[tid >> 1];
}
template <bool SELECT> struct EpiResR {
    static constexpr bool PERM = true, AFTER_DRAIN = true;
    bf16_t* xb; const _Float16* rw; float* part;
    unsigned char* ws; const float* bg; const float* br; unsigned* gcnt; unsigned* pcnt;
    __device__ __forceinline__ void operator()(const f32x4 (&acc)[2][2][4][2], const Unit& u, int wr, int wc, int fr, int fq) const {}
    __device__ __forceinline__ void fused(const f32x4 (&acc)[2][2][4][2], const Unit& u, int wr, int wc, int fr, int fq, LAS unsigned char* lds, int wid, int lane) const {
        const int tid = wid * 64 + lane;
        LAS float* pl = (LAS float*)lds;
        f16x8 B[2][3];
#pragma unroll
        for (int bj = 0; bj < 2; ++bj)
#pragma unroll
            for (int ct = 0; ct < 3; ++ct) B[bj][ct] = *(const GAS f16x8*)(rw + ((size_t)((8 * u.pn + 4 * bj + wc) * 3 + ct) * 64 + lane) * 8);
        const int row0 = u.pm * 256 + wr * 64 + fr, col0 = u.pn * 256 + wc * 32 + 8 * fq;
        const __amdgpu_buffer_rsrc_t RX = uniform_rsrc(xb, (unsigned)T * 1024u * 2u), RP = uniform_rsrc(part, 4u * (unsigned)T * 208u);
        LAS float* bgl = (LAS float*)(lds + 122880);
        if constexpr (SELECT) { if (tid < 4) bgl[tid] = bg[tid]; else if (tid >= 8 && tid < 40) bgl[tid] = br[tid - 8]; }
#pragma unroll
        for (int ai = 0; ai < 2; ++ai) {
            u32x4 rv[4][2];
#pragma unroll
            for (int m = 0; m < 4; ++m) { const unsigned off = (unsigned)((row0 + ai * 128 + m * 16) * 1024 + col0);
#pragma unroll
                for (int bj = 0; bj < 2; ++bj) rv[m][bj] = __builtin_amdgcn_raw_buffer_load_b128(RX, (off + bj * 128) * 2u, 0, 0); }
            asm volatile("" ::: "memory");
#pragma unroll
            for (int m = 0; m < 4; ++m) {
                const unsigned off = (unsigned)((row0 + ai * 128 + m * 16) * 1024 + col0);
                f32x4 lacc[3]; f32x2 ssq2 = {0.f, 0.f};
#pragma unroll
                for (int ct = 0; ct < 3; ++ct) lacc[ct] = (f32x4){0.f, 0.f, 0.f, 0.f};
#pragma unroll
                for (int bj = 0; bj < 2; ++bj) {
                    const u32x4 rw_ = rv[m][bj];
                    typedef _Float16 h2_t __attribute__((ext_vector_type(2)));
                    const unsigned rwa[4] = {rw_.x, rw_.y, rw_.z, rw_.w};
                    f32x4 v0, v1; u32x4 hiw, low;
#pragma unroll
                    for (int q = 0; q < 4; ++q) {
                        const f32x2 rr = {bf2f(rwa[q] & 0xffffu), __builtin_bit_cast(float, rwa[q] & 0xffff0000u)};
                        const f32x2 aa = (q < 2) ? (f32x2){acc[ai][bj][m][0][2 * q], acc[ai][bj][m][0][2 * q + 1]} : (f32x2){acc[ai][bj][m][1][2 * q - 4], acc[ai][bj][m][1][2 * q - 3]};
                        const f32x2 vv = aa + rr;
                        ssq2 = vv * vv + ssq2;
                        const h2_t hh = __builtin_bit_cast(h2_t, __builtin_amdgcn_cvt_pkrtz(vv.x, vv.y));
                        const f32x2 back = {(float)hh.x, (float)hh.y};
                        const f32x2 dd = vv - back;
                        hiw[q] = __builtin_bit_cast(unsigned, hh); low[q] = __builtin_bit_cast(unsigned, __builtin_amdgcn_cvt_pkrtz(dd.x, dd.y));
                        if (q < 2) { v0[2 * q] = vv.x; v0[2 * q + 1] = vv.y; } else { v1[2 * q - 4] = vv.x; v1[2 * q - 3] = vv.y; }
                    }
                    st16_wt(RX, (off + bj * 128) * 2u, pack8(v0, v1));
                    const f16x8 hi = __builtin_bit_cast(f16x8, hiw), lo = __builtin_bit_cast(f16x8, low);
#pragma unroll
                    for (int ct = 0; ct < 3; ++ct) {
                        lacc[ct] = __builtin_amdgcn_mfma_f32_16x16x32_f16(hi, B[bj][ct], lacc[ct], 0, 0, 0);
                        lacc[ct] = __builtin_amdgcn_mfma_f32_16x16x32_f16(lo, B[bj][ct], lacc[ct], 0, 0, 0);
                    }
                }
                LAS float* pr = pl + (wc * 128 + wr * 64 + m * 16 + 4 * fq) * 52 + fr;
#pragma unroll
                for (int ct = 0; ct < 3; ++ct)
#pragma unroll
                    for (int i = 0; i < 4; ++i) pr[i * 52 + 16 * ct] = lacc[ct][i];
                float ssq = ssq2.x + ssq2.y; ssq += __shfl_xor(ssq, 16); ssq += __shfl_xor(ssq, 32);
                if (fq == 0) pl[(wc * 128 + wr * 64 + m * 16 + fr) * 52 + 48] = ssq;
            }
            asm volatile("" ::: "memory");
            __syncthreads();
            const unsigned dsto = (unsigned)((u.pn * T + u.pm * 256 + ai * 128) * 208);
            for (int i = tid; i < 1664; i += NTHR) { const LAS f32x4* s = (const LAS f32x4*)pl + i;
                const f32x4 v = (s[0] + s[1664]) + (s[2 * 1664] + s[3 * 1664]);
                __builtin_amdgcn_raw_buffer_store_b128(__builtin_bit_cast(u32x4, v), RP, dsto + (unsigned)i * 16u, 0, SELECT ? 16 : 0); }
            if (ai == 0) __syncthreads();
        }
        if constexpr (SELECT) {
            asm volatile("s_waitcnt vmcnt(0)" ::: "memory");
            __syncthreads();
            volatile LAS int* flag = (volatile LAS int*)(lds + 56448);
            if (tid == 0) *flag = (__hip_atomic_fetch_add(pcnt + u.pm * 16, 1u, __ATOMIC_RELAXED, __HIP_MEMORY_SCOPE_AGENT) == 3u) ? 1 : 0;
            __syncthreads();
            if (*flag) {
                const int tok0 = u.pm * 256;
                LAS float* lg = (LAS float*)lds; LAS float* rsl = (LAS float*)(lds + 49152);
                u32x4 pv[7][4];
#pragma unroll
                for (int k = 0; k < 7; ++k) { const int idx = tid + NTHR * k, ic = idx < 3328 ? idx : 0;
#pragma unroll
                    for (int pn = 0; pn < 4; ++pn) pv[k][pn] = __builtin_amdgcn_raw_buffer_load_b128(RP, (unsigned)(pn * T * 208 + tok0 * 208 + ic * 16), 0, 16); }
#pragma unroll
                for (int k = 0; k < 7; ++k) { const int idx = tid + NTHR * k; const int t = idx / 13, j = idx - 13 * t;
                    f32x4 s = __builtin_bit_cast(f32x4, pv[k][0]);
#pragma unroll
                    for (int pn = 1; pn < 4; ++pn) s += __builtin_bit_cast(f32x4, pv[k][pn]);
                    if (idx < 3328) { if (j < 12) *(LAS f32x4*)(lg + t * 48 + 4 * j) = s; else rsl[t] = 1.0f / sqrtf(s[0] * (1.f / 1024.f) + EPS); } }
                __syncthreads();
                router_select256(ws, bgl, bgl + 8, gcnt, tok0, tid, lane, wid, lds);
            }
        }
    }
};
struct EpiO1 {
    static constexpr bool PERM = true, AFTER_DRAIN = false;
    bf16_t* P; const float* rs; float* ssqq; float* ssqkv; bf16_t* kpe; const f32x2* rope;
    __device__ __forceinline__ void operator()(const f32x4 (&acc)[2][2][4][2], const Unit& u, int wr, int wc, int fr, int fq) const {
        const int row0 = u.pm * 256 + wr * 64 + fr, cl = wc * 32 + 8 * fq;
        const __amdgpu_buffer_rsrc_t RP = uniform_rsrc(P, (unsigned)T * 1280u * 2u);
        float rsv[2][4];
#pragma unroll
        for (int ai = 0; ai < 2; ++ai)
#pragma unroll
            for (int m = 0; m < 4; ++m) rsv[ai][m] = rs[row0 + ai * 128 + m * 16];
#pragma unroll
        for (int ai = 0; ai < 2; ++ai)
#pragma unroll
            for (int m = 0; m < 4; ++m) {
                const int row = row0 + ai * 128 + m * 16; const float r = rsv[ai][m]; const unsigned rowb = ((unsigned)row * 1280u + (unsigned)(u.pn * 256 + cl)) * 2u;
                f32x4 v[2][2];
#pragma unroll
                for (int bj = 0; bj < 2; ++bj) { v[bj][0] = acc[ai][bj][m][0] * r; v[bj][1] = acc[ai][bj][m][1] * r; st16_wt(RP, rowb + bj * 256u, pack8(v[bj][0], v[bj][1])); }
                if (u.pn <= 1) {
                    float s = 0.f;
#pragma unroll
                    for (int i = 0; i < 4; ++i) { s += v[0][0][i] * v[0][0][i] + v[0][1][i] * v[0][1][i]; if (u.pn == 0) s += v[1][0][i] * v[1][0][i] + v[1][1][i] * v[1][1][i]; }
                    s += __shfl_xor(s, 16); s += __shfl_xor(s, 32);
                    if (fq == 0) (u.pn == 0 ? ssqq : ssqkv)[(size_t)row * 4 + wc] = s;
                }
                if (u.pn == 1 && wc == 0) {
                    const int pos = row & (S - 1); f32x4 o[2];
#pragma unroll
                    for (int n = 0; n < 2; ++n)
#pragma unroll
                        for (int i = 0; i < 4; ++i) { const float x = v[1][n][i], y = __shfl_xor(x, 32); const f32x2 cs = rope[pos * 16 + ((8 * fq + 4 * n + i) & 15)];
                            o[n][i] = (fq < 2) ? (x * cs.x - y * cs.y) : (x * cs.x + y * cs.y); }
                    *(u32x4*)(kpe + (size_t)row * 32 + 8 * fq) = pack8(o[0], o[1]);
                }
                asm volatile("" ::: "memory");
            }
    }
};
struct O2Order : pg8::StaticOrder {
    __device__ bool next(int i, Unit& u) const { const bool ok = pg8::StaticOrder::next(i, u); if (ok) u.aoff = (u.pn >= 3) ? 512 : 0; return ok; }
};
struct O1mOrder {
    int x, idx, nun;
    __device__ void init(int bid) { x = bid & 7; idx = bid >> 3; int n = ((idx >> 3) == 2) ? 2 : 1; asm volatile("" : "+s"(n)); nun = n; }
    __device__ bool next(int i, Unit& u) const {
        if (i >= nun) return false;
        const int t = idx + 16 * i; u.pm = 8 * x + (t & 7); u.pn = t >> 3; u.aoff = 0; return true;
    }
    __device__ __forceinline__ void a_ready(const Unit&) const {}
    __device__ __forceinline__ void done(const Unit&) const {}
};
struct O2mOrder {
    int x, idx, nun;
    __device__ void init(int bid) { x = bid & 7; idx = bid >> 3; int n = (idx < 16) ? 3 + (idx >> 3) : 0; asm volatile("" : "+s"(n)); nun = n; }
    __device__ bool next(int i, Unit& u) const {
        if (i >= nun) return false;
        const int kv = idx >> 3; u.pm = 8 * x + (idx & 7); u.pn = 3 * kv + i; u.aoff = 512 * kv; return true;
    }
    __device__ __forceinline__ void a_ready(const Unit&) const {}
    __device__ __forceinline__ void done(const Unit&) const {}
};
struct EpiO2 {
    static constexpr bool PERM = true, AFTER_DRAIN = false;
    bf16_t* Q; bf16_t* KV; const float* ssqq; const float* ssqkv;
    __device__ __forceinline__ void operator()(const f32x4 (&acc)[2][2][4][2], const Unit& u, int wr, int wc, int fr, int fq) const {
        const int row0 = u.pm * 256 + wr * 64 + fr, cl = wc * 32 + 8 * fq;
        const bool isq = u.pn < 3; const float* ssq = isq ? ssqq : ssqkv; const float inv_n = isq ? (1.f / 256.f) : (1.f / 128.f);
        bf16_t* O = isq ? (Q + u.pn * 256 + cl) : (KV + (u.pn - 3) * 256 + cl); const int ldo = isq ? 768 : 1024;
        f32x4 sqv[2][4];
#pragma unroll
        for (int ai = 0; ai < 2; ++ai)
#pragma unroll
            for (int m = 0; m < 4; ++m) sqv[ai][m] = *(const f32x4*)(ssq + (size_t)(row0 + ai * 128 + m * 16) * 4);
#pragma unroll
        for (int ai = 0; ai < 2; ++ai)
#pragma unroll
            for (int m = 0; m < 4; ++m) {
                const int row = row0 + ai * 128 + m * 16; const f32x4 sq = sqv[ai][m];
                const float r = __builtin_amdgcn_rsqf(((sq[0] + sq[1]) + (sq[2] + sq[3])) * inv_n + EPS);
                bf16_t* rowp = O + (size_t)row * ldo;
#pragma unroll
                for (int bj = 0; bj < 2; ++bj) *(u32x4*)(rowp + bj * 128) = pack8(acc[ai][bj][m][0] * r, acc[ai][bj][m][1] * r);
                asm volatile("" ::: "memory");
            }
    }
};
}
namespace mk {
struct ConvW { f32x2 w[31]; f32x2 bias, g, bt; };
__device__ __forceinline__ void e2_conv_load_w(const Frame& F, int grp, ConvW& W) {
    const int ch = grp * 128 + 2 * F.lane; const float* cw = F.in[5];
#pragma unroll
    for (int q = 0; q < 31; ++q) W.w[q] = *(const f32x2*)(cw + q * 512 + ch);
    W.bias = *(const f32x2*)(F.in[6] + ch); W.g = *(const f32x2*)(F.in[7] + ch); W.bt = *(const f32x2*)(F.in[8] + ch);
}
__device__ __forceinline__ void e2_conv_wave_unit(const Frame& F, int run, int grp, const bf16_t* ACT, bf16_t* MBo, const ConvW& W) {
    LAS bf16_t* tile = (LAS bf16_t*)(F.lds + F.wave * 16896);
    LAS float* scr = (LAS float*)(F.lds + F.wave * 16896 + 12288);
    const int t0 = run * 16, s0 = t0 & (S - 1);
#pragma unroll
    for (int i = 0; i < 12; ++i) { const int idx = F.lane + 64 * i, r = idx >> 4, c = idx & 15; const int sp = s0 + r - 15;
        if (r < 46) { u32x4 v = {0u, 0u, 0u, 0u};
            if (sp >= 0 && sp < S) v = *(const GAS u32x4*)(ACT + (size_t)(t0 + r - 15) * 1536 + grp * 128 + c * 8);
            *(LAS u32x4*)(tile + r * 128 + c * 8) = v; } }
    const int ch = grp * 128 + 2 * F.lane;
    const f32x2 bias = W.bias;
    f32x2 av[16];
#pragma unroll
    for (int k = 0; k < 16; ++k) av[k] = bias;
    LDS_WAIT(); asm volatile("" ::: "memory");
    const LAS unsigned* src = (const LAS unsigned*)(tile + 2 * F.lane);
#pragma unroll
    for (int i = 0; i < 46; ++i) { const unsigned x = src[i * 64]; const f32x2 xv = {bf2f(x & 0xffffu), bf2f(x >> 16)};
#pragma unroll
        for (int k = 0; k < 16; ++k) { const int q = i - k; if (q >= 0 && q <= 30) av[k] = xv * W.w[q] + av[k]; } }
    float a0[16], a1[16];
#pragma unroll
    for (int k = 0; k < 16; ++k) { a0[k] = av[k].x; a1[k] = av[k].y; }
    const f32x2 g = W.g, bt = W.bt;
    const bool b5 = (F.lane & 32) != 0, b4 = (F.lane & 16) != 0, b3 = (F.lane & 8) != 0, b2 = (F.lane & 4) != 0;
    const int tk = (b5 ? 8 : 0) + (b4 ? 4 : 0) + (b3 ? 2 : 0) + (b2 ? 1 : 0);
#define E2_BFLY(S, OUT) do { float v8_[8], v4_[4], v2_[2]; \
        _Pragma("unroll") for (int k = 0; k < 8; ++k) { const float kp = b5 ? S[k + 8] : S[k], sd = b5 ? S[k] : S[k + 8]; v8_[k] = kp + __shfl_xor(sd, 32); } \
        _Pragma("unroll") for (int k = 0; k < 4; ++k) { const float kp = b4 ? v8_[k + 4] : v8_[k], sd = b4 ? v8_[k] : v8_[k + 4]; v4_[k] = kp + __shfl_xor(sd, 16); } \
        _Pragma("unroll") for (int k = 0; k < 2; ++k) { const float kp = b3 ? v4_[k + 2] : v4_[k], sd = b3 ? v4_[k] : v4_[k + 2]; v2_[k] = kp + __shfl_xor(sd, 8); } \
        { const float kp = b2 ? v2_[1] : v2_[0], sd = b2 ? v2_[0] : v2_[1]; OUT = kp + __shfl_xor(sd, 4); } \
        OUT += __shfl_xor(OUT, 2); OUT += __shfl_xor(OUT, 1); } while (0)
    float st[16], tot;
#pragma unroll
    for (int k = 0; k < 16; ++k) st[k] = a0[k] + a1[k];
    E2_BFLY(st, tot);
    if ((F.lane & 3) == 0) scr[tk] = tot * (1.f / 128.f);
    LDS_WAIT(); asm volatile("" ::: "memory");
    float mu[16];
#pragma unroll
    for (int k4 = 0; k4 < 4; ++k4) { const f32x4 m4 = *(const LAS f32x4*)(scr + 4 * k4); mu[4 * k4] = m4.x; mu[4 * k4 + 1] = m4.y; mu[4 * k4 + 2] = m4.z; mu[4 * k4 + 3] = m4.w; }
#pragma unroll
    for (int k = 0; k < 16; ++k) { a0[k] -= mu[k]; a1[k] -= mu[k]; st[k] = a0[k] * a0[k] + a1[k] * a1[k]; }
    E2_BFLY(st, tot);
    if ((F.lane & 3) == 0) scr[16 + tk] = 1.0f / sqrtf(tot * (1.f / 128.f) + EPS);
    LDS_WAIT(); asm volatile("" ::: "memory");
#undef E2_BFLY
#pragma unroll
    for (int k4 = 0; k4 < 4; ++k4) { const f32x4 r4 = *(const LAS f32x4*)(scr + 16 + 4 * k4);
#pragma unroll
        for (int i = 0; i < 4; ++i) { const int k = 4 * k4 + i; const float rs = r4[i];
            const float y0 = silu_f(a0[k] * rs * g.x + bt.x), y1 = silu_f(a1[k] * rs * g.y + bt.y);
            *(GAS unsigned*)(MBo + (size_t)(t0 + k) * 1024 + ch) = pk2(y0, y1); } }
    LDS_WAIT(); asm volatile("" ::: "memory");
}
__device__ __forceinline__ void e2_sgu_unit(const Frame& F, int chunk, int h, const bf16_t* ACT, bf16_t* MBo, bool load_w) {
    constexpr int LD = 136, LDO = 132;
    LAS bf16_t* WSl = (LAS bf16_t*)F.lds;
    LAS bf16_t* VTl = (LAS bf16_t*)(F.lds + 34816);
    LAS float* OUTl = (LAS float*)(F.lds + 69632);
    const int t0 = chunk * 128;
    const float* wsp = F.in[11] + (size_t)h * 128 * 128;
    if (load_w) for (int idx = F.tid; idx < 4096; idx += NTHR) { const int r = idx >> 5, c4 = idx & 31; const f32x4 v = *(const GAS f32x4*)(wsp + r * 128 + 4 * c4);
        u32x2 w; w.x = pk2(v.x, v.y); w.y = pk2(v.z, v.w); *(LAS u32x2*)(WSl + r * LD + 4 * c4) = w; }
#pragma unroll
    for (int it = 0; it < 4; ++it) { const int idx = F.tid + NTHR * it, s = idx >> 4, c = idx & 15;
        const u32x4 raw = *(const GAS u32x4*)(ACT + (size_t)(t0 + s) * 1536 + 1024 + h * 128 + 8 * c);
        float x[8]; x[0] = bf2f(raw.x & 0xffffu); x[1] = bf2f(raw.x >> 16); x[2] = bf2f(raw.y & 0xffffu); x[3] = bf2f(raw.y >> 16);
        x[4] = bf2f(raw.z & 0xffffu); x[5] = bf2f(raw.z >> 16); x[6] = bf2f(raw.w & 0xffffu); x[7] = bf2f(raw.w >> 16);
        float sm = 0.f;
#pragma unroll
        for (int i = 0; i < 8; ++i) sm += x[i];
        sm += __shfl_xor(sm, 1); sm += __shfl_xor(sm, 2); sm += __shfl_xor(sm, 4); sm += __shfl_xor(sm, 8);
        const float mu = sm * (1.f / 128.f); float q = 0.f;
#pragma unroll
        for (int i = 0; i < 8; ++i) { x[i] -= mu; q += x[i] * x[i]; }
        q += __shfl_xor(q, 1); q += __shfl_xor(q, 2); q += __shfl_xor(q, 4); q += __shfl_xor(q, 8);
        const float rs = 1.0f / sqrtf(q * (1.f / 128.f) + EPS);
        const float* vg = F.in[9] + h * 128 + 8 * c; const float* vb = F.in[10] + h * 128 + 8 * c;
#pragma unroll
        for (int i = 0; i < 8; ++i) { const float y = x[i] * rs * vg[i] + vb[i]; VTl[(8 * c + i) * LD + s] = (bf16_t)f2bf(y); }
    }
    __syncthreads();
    const int wt = F.wave >> 1, wc = F.wave & 1, r32 = F.lane & 31, hi = F.lane >> 5;
    f32x16 acc[2]; acc[0] = f32x16{}; acc[1] = f32x16{};
#pragma unroll
    for (int ks = 0; ks < 8; ++ks) {
        const bf16x8 a = *(const LAS bf16x8*)(WSl + (32 * wt + r32) * LD + 16 * ks + 8 * hi);
#pragma unroll
        for (int ct = 0; ct < 2; ++ct) { const bf16x8 b = *(const LAS bf16x8*)(VTl + (64 * wc + 32 * ct + r32) * LD + 16 * ks + 8 * hi);
            acc[ct] = __builtin_amdgcn_mfma_f32_32x32x16_bf16(a, b, acc[ct], 0, 0, 0); }
    }
    const float* bsp = F.in[12] + h * 128;
#pragma unroll
    for (int ct = 0; ct < 2; ++ct)
#pragma unroll
        for (int r = 0; r < 16; ++r) { const int trow = 32 * wt + (r & 3) + 8 * (r >> 2) + 4 * hi; OUTl[trow * LDO + 64 * wc + 32 * ct + r32] = acc[ct][r] + bsp[trow]; }
    __syncthreads();
#pragma unroll
    for (int it = 0; it < 4; ++it) { const int idx = F.tid + NTHR * it, t = idx >> 4, c = idx & 15;
        const u32x4 raw = *(const GAS u32x4*)(ACT + (size_t)(t0 + t) * 1536 + 512 + h * 128 + 8 * c);
        const f32x4 s0 = *(const LAS f32x4*)(OUTl + t * LDO + 8 * c), s1 = *(const LAS f32x4*)(OUTl + t * LDO + 8 * c + 4);
        u32x4 o; o.x = pk2(bf2f(raw.x & 0xffffu) * s0.x, bf2f(raw.x >> 16) * s0.y); o.y = pk2(bf2f(raw.y & 0xffffu) * s0.z, bf2f(raw.y >> 16) * s0.w);
        o.z = pk2(bf2f(raw.z & 0xffffu) * s1.x, bf2f(raw.z >> 16) * s1.y); o.w = pk2(bf2f(raw.w & 0xffffu) * s1.z, bf2f(raw.w >> 16) * s1.w);
        *(GAS u32x4*)(MBo + (size_t)(t0 + t) * 1024 + 512 + h * 128 + 8 * c) = o; }
    __syncthreads();
}
__device__ __forceinline__ void phase_e2(const Frame& F) {
    const bf16_t* ACT = (const bf16_t*)F.out; bf16_t* MBo = (bf16_t*)(F.ws + WS_MB);
    { const int gw = F.vcu * NWAVES + F.wave, NGW = F.G * NWAVES;
      LAS float* cscr = (LAS float*)(F.lds + F.wave * 16896); CvtRegs R; int it = gw; bool staged = false;
      if (it < MOE_CVT_ITEMS) moe_cvt_load(F, 0, it, R);
      ConvW W; e2_conv_load_w(F, gw & 3, W);
      for (int u = gw; u < 4096 || it < MOE_CVT_ITEMS; u += NGW) {
          if (u < 4096) { if ((NGW & 3) != 0) e2_conv_load_w(F, u & 3, W); e2_conv_wave_unit(F, u >> 2, u & 3, ACT, MBo, W); }
          if (it < MOE_CVT_ITEMS) { moe_cvt_stage(F, 0, it, R, cscr); if (it + NGW < MOE_CVT_ITEMS) moe_cvt_load(F, 0, it + NGW, R); moe_cvt_emit(F, 0, it, cscr); it += NGW; }
      }
      (void)staged; }
    __syncthreads();
    for (int u = F.vcu; u < 512; u += F.G) e2_sgu_unit(F, u >> 2, u & 3, ACT, MBo, u == F.vcu || (F.G & 3) != 0);
}
template <bool FINAL> __device__ __forceinline__ void combine_rows(const Frame& F) {
    const int gw = F.vcu * NWAVES + F.wave, NGW = F.G * NWAVES;
    const bf16_t* Y = (const bf16_t*)(F.ws + WS_Y);
    for (int m = gw; m < T; m += NGW) {
        GAS u32x2* xr = (GAS u32x2*)((bf16_t*)(F.ws + WS_XB) + (size_t)m * D) + F.lane;
        const GAS u32x2* y0 = (const GAS u32x2*)(Y + (size_t)(2 * m) * D) + F.lane; const GAS u32x2* y1 = (const GAS u32x2*)(Y + (size_t)(2 * m + 1) * D) + F.lane;
        f32x4 v[4]; float s = 0.f;
#pragma unroll
        for (int j = 0; j < 4; ++j) { const u32x2 x = xr[64 * j], a = __builtin_nontemporal_load(y0 + 64 * j), b = __builtin_nontemporal_load(y1 + 64 * j);
            v[j].x = bf2f(x.x & 0xffffu) + (bf2f(a.x & 0xffffu) + bf2f(b.x & 0xffffu)); v[j].y = bf2f(x.x >> 16) + (bf2f(a.x >> 16) + bf2f(b.x >> 16));
            v[j].z = bf2f(x.y & 0xffffu) + (bf2f(a.y & 0xffffu) + bf2f(b.y & 0xffffu)); v[j].w = bf2f(x.y >> 16) + (bf2f(a.y >> 16) + bf2f(b.y >> 16));
            s += (v[j].x * v[j].x + v[j].y * v[j].y) + (v[j].z * v[j].z + v[j].w * v[j].w); }
        s = wave_sum(s);
        const float rs = 1.0f / sqrtf(s * (1.f / 1024.f) + EPS);
        if (FINAL) {
            GAS f32x4* orow = (GAS f32x4*)(F.out + (size_t)m * D) + F.lane;
            const GAS f32x4* g = (const GAS f32x4*)F.in[3] + F.lane;
#pragma unroll
            for (int j = 0; j < 4; ++j) { const f32x4 gg = g[64 * j]; __builtin_nontemporal_store(v[j] * rs * gg, orow + 64 * j); }
        } else {
#pragma unroll
            for (int j = 0; j < 4; ++j) { u32x2 w; w.x = pk2(v[j].x, v[j].y); w.y = pk2(v[j].z, v[j].w); xr[64 * j] = w; }
            if (F.lane == 0) ((float*)(F.ws + WS_RS0))[m] = rs;
        }
    }
}
}
namespace mk {
typedef float f32x4v __attribute__((ext_vector_type(4)));
template <bool FUSED = false> __device__ __forceinline__ void phase_router(const Frame& F, int layer) {
    LAS float* red = (LAS float*)F.lds;
    LAS float* ssqr = (LAS float*)(F.lds + 98304);
    LAS float* lg = (LAS float*)(F.lds + 100352);
    LAS float* rsl = (LAS float*)(F.lds + 112640);
    LAS int* sel = (LAS int*)(F.lds + 112896);
    LAS float* gwl = (LAS float*)(F.lds + 113408);
    LAS int* basel = (LAS int*)(F.lds + 113920);
    const bf16_t* RH = (const bf16_t*)(F.ws + WS_ROUTER) + (size_t)(layer * 2) * 49152 + (size_t)F.wave * 6144;
    const bf16_t* RL = RH + 49152;
    unsigned* gcnt = (unsigned*)(F.ws + WS_CTL) + CW_ECNT + layer * 32 * 64;
    const int r = F.lane & 15, q = F.lane >> 4;
    for (int unit = F.vcu; unit < T / 64; unit += F.G) {
        const int tok0 = unit * 64;
        if constexpr (FUSED) {
            const f32x4* PT = (const f32x4*)(F.ws + WS_PART);
            for (int idx = F.tid; idx < 64 * 13; idx += NTHR) { const int t = idx / 13, j = idx - 13 * t;
                f32x4 s = PT[(size_t)(tok0 + t) * 13 + j];
#pragma unroll
                for (int pn = 1; pn < 4; ++pn) s += PT[((size_t)pn * T + tok0 + t) * 13 + j];
                if (j < 12) *(LAS f32x4*)(lg + t * 48 + 4 * j) = s; else rsl[t] = 1.0f / sqrtf(s[0] * (1.f / 1024.f) + EPS); }
        } else {
        const float* X = F.out + (size_t)tok0 * D + 128 * F.wave + 8 * q;
        f32x4 acc[4][3]; float ssq[4];
#pragma unroll
        for (int tt = 0; tt < 4; ++tt) { ssq[tt] = 0.f;
#pragma unroll
            for (int ct = 0; ct < 3; ++ct) acc[tt][ct] = (f32x4){0.f, 0.f, 0.f, 0.f}; }
#pragma unroll 2
        for (int ks = 0; ks < 4; ++ks) {
            bf16x8 bh[3], bl[3];
#pragma unroll
            for (int ct = 0; ct < 3; ++ct) { bh[ct] = *(const GAS bf16x8*)(RH + ((ks * 3 + ct) * 64 + F.lane) * 8); bl[ct] = *(const GAS bf16x8*)(RL + ((ks * 3 + ct) * 64 + F.lane) * 8); }
#pragma unroll
            for (int tt = 0; tt < 4; ++tt) {
                const float* xp = X + (size_t)(16 * tt + r) * D + 32 * ks;
                const f32x4 x0 = *(const GAS f32x4*)xp, x1 = *(const GAS f32x4*)(xp + 4);
                float xv[8] = {x0.x, x0.y, x0.z, x0.w, x1.x, x1.y, x1.z, x1.w};
                unsigned hh[8], ll[8];
#pragma unroll
                for (int j = 0; j < 8; ++j) { ssq[tt] = fmaf(xv[j], xv[j], ssq[tt]); hh[j] = f2bf(xv[j]); ll[j] = f2bf(xv[j] - bf2f(hh[j])); }
                u32x4 ahw, alw;
                ahw.x = hh[0] | (hh[1] << 16); ahw.y = hh[2] | (hh[3] << 16); ahw.z = hh[4] | (hh[5] << 16); ahw.w = hh[6] | (hh[7] << 16);
                alw.x = ll[0] | (ll[1] << 16); alw.y = ll[2] | (ll[3] << 16); alw.z = ll[4] | (ll[5] << 16); alw.w = ll[6] | (ll[7] << 16);
                const bf16x8 ah = __builtin_bit_cast(bf16x8, ahw), al = __builtin_bit_cast(bf16x8, alw);
#pragma unroll
                for (int ct = 0; ct < 3; ++ct) {
                    acc[tt][ct] = __builtin_amdgcn_mfma_f32_16x16x32_bf16(ah, bh[ct], acc[tt][ct], 0, 0, 0);
                    acc[tt][ct] = __builtin_amdgcn_mfma_f32_16x16x32_bf16(al, bh[ct], acc[tt][ct], 0, 0, 0);
                    acc[tt][ct] = __builtin_amdgcn_mfma_f32_16x16x32_bf16(ah, bl[ct], acc[tt][ct], 0, 0, 0);
                }
            }
        }
#pragma unroll
        for (int tt = 0; tt < 4; ++tt) {
#pragma unroll
            for (int ct = 0; ct < 3; ++ct)
#pragma unroll
                for (int i = 0; i < 4; ++i) red[(F.wave * 64 + 16 * tt + 4 * q + i) * 48 + 16 * ct + r] = acc[tt][ct][i];
            float s = ssq[tt]; s += __shfl_xor(s, 16); s += __shfl_xor(s, 32);
            if (q == 0) ssqr[F.wave * 64 + 16 * tt + r] = s;
        }
        __syncthreads();
        for (int idx = F.tid; idx < 3072; idx += NTHR) { float s = 0.f;
#pragma unroll
            for (int w = 0; w < 8; ++w) s += red[w * 3072 + idx];
            lg[idx] = s; }
        if (F.tid < 64) { float s = 0.f;
#pragma unroll
            for (int w = 0; w < 8; ++w) s += ssqr[w * 64 + F.tid];
            rsl[F.tid] = 1.0f / sqrtf(s * (1.f / 1024.f) + EPS); }
        }
        __syncthreads();
        if (F.tid < 64) {
            const int t = tok0 + F.tid; const float rs = rsl[F.tid]; const LAS float* L = lg + F.tid * 48;
            const float* bg = F.in[22] + layer * 4; const float* br = F.in[24] + layer * 32;
            float gl[4];
#pragma unroll
            for (int j = 0; j < 4; ++j) gl[j] = L[j] * rs + bg[j];
            int gi = 0; float gm = gl[0];
#pragma unroll
            for (int j = 1; j < 4; ++j) if (gl[j] > gm) { gm = gl[j]; gi = j; }
            float den = 0.f;
#pragma unroll
            for (int j = 0; j < 4; ++j) den += __expf(gl[j] - gm);
            const float gp = 1.f / den;
            float el[8];
#pragma unroll
            for (int e = 0; e < 8; ++e) el[e] = L[4 + 8 * gi + e] * rs + br[gi * 8 + e];
            int i1 = 0; float v1 = el[0];
#pragma unroll
            for (int e = 1; e < 8; ++e) if (el[e] > v1) { v1 = el[e]; i1 = e; }
            int i2 = 0; float v2 = -3.0e38f;
#pragma unroll
            for (int e = 0; e < 8; ++e) if (e != i1 && el[e] > v2) { v2 = el[e]; i2 = e; }
            const float e2 = __expf(v2 - v1);
            sel[2 * F.tid] = gi * 8 + i1; sel[2 * F.tid + 1] = gi * 8 + i2;
            gwl[2 * F.tid] = gp / (1.f + e2); gwl[2 * F.tid + 1] = gp * e2 / (1.f + e2);
            ((float*)(F.ws + WS_RSM))[t] = rs;
        }
        __syncthreads();
        LAS int* cntw = basel + 32;
        int pos = 0, myexp = 0;
        if (F.tid < 128) { myexp = sel[F.tid]; unsigned long long mymask = 0ull;
#pragma unroll 4
            for (int e = 0; e < 32; ++e) { const unsigned long long m = __ballot(myexp == e); if (myexp == e) mymask = m; if (F.lane == 0) cntw[F.wave * 32 + e] = __popcll(m); }
            pos = __popcll(mymask & ((1ull << F.lane) - 1ull)); }
        __syncthreads();
        if (F.tid >= 128 && F.tid < 160) { const int e = F.tid - 128; const int c = cntw[e] + cntw[32 + e];
            basel[e] = c ? (int)__hip_atomic_fetch_add(gcnt + e * 64, (unsigned)c, __ATOMIC_RELAXED, __HIP_MEMORY_SCOPE_AGENT) : 0; }
        __syncthreads();
        if (F.tid < 128) { const size_t dst = (size_t)myexp * T + basel[myexp] + pos + (F.wave == 1 ? cntw[myexp] : 0);
            ((int*)(F.ws + WS_LSLOT))[dst] = 2 * (tok0 + (F.tid >> 1)) + (F.tid & 1);
            ((float*)(F.ws + WS_LGW))[dst] = gwl[F.tid]; }
        __syncthreads();
    }
}

#ifndef MK_PF1
#define MK_PF1 8
#endif
#ifndef MK_PF2
#define MK_PF2 8
#endif
__device__ __forceinline__ bf16x8 fp8x8_to_bf16(u32x2 w) {
    u32x4 o;
    o.x = __builtin_bit_cast(unsigned, __builtin_amdgcn_cvt_scalef32_pk_bf16_fp8(w.x, 1.0f, false)); o.y = __builtin_bit_cast(unsigned, __builtin_amdgcn_cvt_scalef32_pk_bf16_fp8(w.x, 1.0f, true));
    o.z = __builtin_bit_cast(unsigned, __builtin_amdgcn_cvt_scalef32_pk_bf16_fp8(w.y, 1.0f, false)); o.w = __builtin_bit_cast(unsigned, __builtin_amdgcn_cvt_scalef32_pk_bf16_fp8(w.y, 1.0f, true));
    return __builtin_bit_cast(bf16x8, o);
}
#define MOE_LDW(rsrc, soff) __builtin_amdgcn_raw_buffer_load_b128((rsrc), loff, (soff), 0)
template <int NT, int PRB = 0> __device__ __forceinline__ void moe_segment_t(const Frame& F, int layer, int e, int l0, int n) {
    constexpr bool P_NOMFMA = PRB == 2 || (PRB >= 16 && (PRB & 1)), P_WHIT = PRB == 3 || (PRB >= 16 && (PRB & 2)), P_NOLDS = PRB == 4 || (PRB >= 16 && (PRB & 4)),
                   P_NOCVT = PRB == 5 || (PRB >= 16 && (PRB & 8)), P_NOSTG = PRB == 6 || (PRB >= 32 && (PRB & 16));
    constexpr int PF = (NT <= 2) ? 8 : MK_PF1, PF2 = (NT <= 2) ? 8 : MK_PF2;
    constexpr int XRB = 34816;
    LAS unsigned char* XR = F.lds;
    LAS unsigned char* HID = F.lds + 2 * XRB;
    LAS int* s_slot = (LAS int*)(F.lds + 2 * XRB + 65536);
    LAS float* s_gw = (LAS float*)(s_slot + 128);
    LAS float* s_rs = s_gw + 128;
    const int r32 = F.lane & 31, hi = F.lane >> 5, w = F.wave;
    const __amdgpu_buffer_rsrc_t R1 = uniform_rsrc(F.ws + WS_WMOE + (size_t)layer * WMOE_LAYER + (size_t)e * W1_EXP + (size_t)w * 65536, 65536);
    const __amdgpu_buffer_rsrc_t R2 = uniform_rsrc(F.ws + WS_WMOE + (size_t)layer * WMOE_LAYER + WMOE_W2 + (size_t)e * W2_EXP + (size_t)w * 16384, 262144);
    const int loff = F.lane * 16;
    u32x4 wb[PF > PF2 ? PF : PF2];
#pragma unroll
    for (int s = 0; s < PF; ++s) wb[s] = MOE_LDW(R1, s * 1024);
    const int pr = F.tid >> 4, pc = F.tid & 15;
    const __amdgpu_buffer_rsrc_t RXB = uniform_rsrc(F.ws + WS_XB, (unsigned)T * 2048u);
    const int* LS = (const int*)(F.ws + WS_LSLOT) + (size_t)e * T + l0;
    unsigned xo[4];
#pragma unroll
    for (int j = 0; j < 4; ++j) { const int rj = pr + 32 * j; xo[j] = (unsigned)(LS[rj < n ? rj : 0] >> 1) * 2048u + (unsigned)pc * 16u; }
    __builtin_amdgcn_sched_barrier(0);
    const int xw = pr * 272 + pc * 16;
    u32x4 xs[4];
#pragma unroll
    for (int j = 0; j < 4; ++j) xs[j] = __builtin_amdgcn_raw_buffer_load_b128(RXB, xo[j], 0, 0);
    if (F.tid < 128) { const int tl = F.tid < n ? F.tid : 0; const size_t li = (size_t)e * T + l0 + tl;
        s_slot[F.tid] = F.tid < n ? LS[tl] : -1; s_gw[F.tid] = F.tid < n ? ((const float*)(F.ws + WS_LGW))[li] * WDESCALE : 0.f;
        s_rs[F.tid] = ((const float*)(F.ws + WS_LRS))[li] * WDESCALE; }
    __builtin_amdgcn_sched_barrier(0);
#pragma unroll
    for (int j = 0; j < 4; ++j) *(LAS u32x4*)(XR + xw + j * 8704) = xs[j];
    __syncthreads();
    f32x16 accg[NT], accu[NT];
#pragma unroll
    for (int i = 0; i < NT; ++i) { accg[i] = f32x16{}; accu[i] = f32x16{}; }
    bf16x8 xf[NT];
    for (int kc = 0; kc < (PRB == 8 ? 0 : 8); ++kc) {
        const LAS unsigned char* buf = XR + (kc & 1) * XRB + r32 * 272 + hi * 16;
        LAS unsigned char* nb = XR + ((kc + 1) & 1) * XRB + xw;
#pragma unroll
        for (int ks = 0; ks < 8; ++ks) {
            __builtin_amdgcn_sched_barrier(0);
#pragma unroll
            for (int i = 0; i < NT; ++i) if (!P_NOLDS || ks == 0) xf[i] = *(const LAS bf16x8*)(buf + 32 * i * 272 + 2 * ks * 16);
            if (kc < 7 && !P_NOSTG) {
                if (ks == 0) { const int so = (kc + 1) * 256;
                    xs[0] = __builtin_amdgcn_raw_buffer_load_b128(RXB, xo[0], so, 0); xs[1] = __builtin_amdgcn_raw_buffer_load_b128(RXB, xo[1], so, 0);
                    xs[2] = __builtin_amdgcn_raw_buffer_load_b128(RXB, xo[2], so, 0); xs[3] = __builtin_amdgcn_raw_buffer_load_b128(RXB, xo[3], so, 0); }
                if (ks == 7) { *(LAS u32x4*)(nb) = xs[0]; *(LAS u32x4*)(nb + 8704) = xs[1]; *(LAS u32x4*)(nb + 17408) = xs[2]; *(LAS u32x4*)(nb + 26112) = xs[3]; }
            }
            const u32x2 g8 = {wb[ks % PF].x, wb[ks % PF].y}, u8 = {wb[ks % PF].z, wb[ks % PF].w};
            if (ks < 8 - PF || kc < 7) { const int o = P_WHIT ? (ks & 3) * 1024 : (kc * 8 + ks + PF) * 1024;
                wb[ks % PF] = MOE_LDW(R1, o); }
            const bf16x8 wg = P_NOCVT ? __builtin_bit_cast(bf16x8, (u32x4){g8.x, g8.y, g8.x, g8.y}) : fp8x8_to_bf16(g8), wu = P_NOCVT ? __builtin_bit_cast(bf16x8, (u32x4){u8.x, u8.y, u8.x, u8.y}) : fp8x8_to_bf16(u8);
#pragma unroll
            for (int i = 0; i < NT; ++i) {
                if (P_NOMFMA) { asm volatile("" :: "v"(wg), "v"(wu), "v"(xf[i])); } else {
                accg[i] = __builtin_amdgcn_mfma_f32_32x32x16_bf16(wg, xf[i], accg[i], 0, 0, 0);
                accu[i] = __builtin_amdgcn_mfma_f32_32x32x16_bf16(wu, xf[i], accu[i], 0, 0, 0); }
            }
        }
        __builtin_amdgcn_sched_barrier(0);
        if (PRB != 7) __syncthreads();
    }
#pragma unroll
    for (int s = 0; s < PF2; ++s) wb[s] = MOE_LDW(R2, s * 1024);
#pragma unroll
    for (int i = 0; i < NT; ++i) {
        const float rs = s_rs[32 * i + r32], gw = s_gw[32 * i + r32];
#pragma unroll
        for (int s = 0; s < 2; ++s) { float hv[8];
#pragma unroll
            for (int j = 0; j < 8; j += 2) { const f32x2 g = {accg[i][8 * s + j], accg[i][8 * s + j + 1]}, u = {accu[i][8 * s + j], accu[i][8 * s + j + 1]};
                const f32x2 v = mul_sigmoid2_f((g * rs) * (u * (rs * gw)), g * (-rs * LOG2E)); hv[j] = v.x; hv[j + 1] = v.y; }
            u32x4 o; o.x = pk2(hv[0], hv[1]); o.y = pk2(hv[2], hv[3]); o.z = pk2(hv[4], hv[5]); o.w = pk2(hv[6], hv[7]);
            *(LAS u32x4*)(HID + (((2 * w + s) * 2 + hi) * 128 + 32 * i + r32) * 16) = o; }
    }
    __syncthreads();
    const __amdgpu_buffer_rsrc_t RY = uniform_rsrc(F.ws + WS_Y, 2u * (unsigned)T * 2048u);
    const LAS unsigned char* hb = HID + (hi * 128 + r32) * 16;
#pragma unroll 1
    for (int p = 0; p < 2; ++p) {
        f32x16 acc2[NT][2];
#pragma unroll
        for (int i = 0; i < NT; ++i) { acc2[i][0] = f32x16{}; acc2[i][1] = f32x16{}; }
#pragma unroll
        for (int kk = 0; kk < (PRB == 8 ? 0 : 16); ++kk) {
            __builtin_amdgcn_sched_barrier(0);
#pragma unroll
            for (int i = 0; i < NT; ++i) if (!P_NOLDS || kk == 0) xf[i] = *(const LAS bf16x8*)(hb + (kk * 2 * 128 + 32 * i) * 16);
            const u32x2 g8 = {wb[kk % PF2].x, wb[kk % PF2].y}, u8 = {wb[kk % PF2].z, wb[kk % PF2].w};
            if (kk < 16 - PF2 || p < 1) { const int o = P_WHIT ? (kk & 3) * 1024 : (kk < 16 - PF2) ? (p * 131072 + (kk + PF2) * 1024) : ((p + 1) * 131072 + (kk + PF2 - 16) * 1024);
                wb[kk % PF2] = MOE_LDW(R2, o); }
            const bf16x8 a0 = P_NOCVT ? __builtin_bit_cast(bf16x8, (u32x4){g8.x, g8.y, g8.x, g8.y}) : fp8x8_to_bf16(g8), a1 = P_NOCVT ? __builtin_bit_cast(bf16x8, (u32x4){u8.x, u8.y, u8.x, u8.y}) : fp8x8_to_bf16(u8);
#pragma unroll
            for (int i = 0; i < NT; ++i) {
                if (P_NOMFMA) { asm volatile("" :: "v"(a0), "v"(a1), "v"(xf[i])); } else {
                acc2[i][0] = __builtin_amdgcn_mfma_f32_32x32x16_bf16(a0, xf[i], acc2[i][0], 0, 0, 0);
                acc2[i][1] = __builtin_amdgcn_mfma_f32_32x32x16_bf16(a1, xf[i], acc2[i][1], 0, 0, 0); }
            }
        }
        __builtin_amdgcn_sched_barrier(0);
#pragma unroll
        for (int i = 0; i < NT; ++i) {
            __builtin_amdgcn_sched_barrier(0);
            if (PRB != 0) { asm volatile("" :: "v"(acc2[i][0]), "v"(acc2[i][1])); } else {
                int ln_ = F.lane; asm volatile("" : "+v"(ln_));
                LAS unsigned char* ysc = F.lds + w * 8192;
                const unsigned yoff = (unsigned)(1024 * p + 128 * w + 16 * (ln_ & 7));
                const int wro = (ln_ & 31) * 144 + 32 * (ln_ >> 5), rdo = (ln_ >> 3) * 144 + (ln_ & 7) * 16;
#pragma unroll
                for (int dt = 0; dt < 2; ++dt)
#pragma unroll
                    for (int q2 = 0; q2 < 2; ++q2) {
                        const unsigned a0 = pk2(acc2[i][dt][4 * q2], acc2[i][dt][4 * q2 + 1]), a1 = pk2(acc2[i][dt][4 * q2 + 2], acc2[i][dt][4 * q2 + 3]);
                        const unsigned b0 = pk2(acc2[i][dt][4 * q2 + 8], acc2[i][dt][4 * q2 + 9]), b1 = pk2(acc2[i][dt][4 * q2 + 10], acc2[i][dt][4 * q2 + 11]);
                        const auto s0 = __builtin_amdgcn_permlane32_swap(a0, b0, false, false), s1 = __builtin_amdgcn_permlane32_swap(a1, b1, false, false);
                        const u32x4 o = {(unsigned)s0[0], (unsigned)s1[0], (unsigned)s0[1], (unsigned)s1[1]};
                        *(LAS u32x4*)(ysc + wro + (32 * dt + 8 * q2) * 2) = o; }
                LDS_WAIT(); asm volatile("" ::: "memory");
#pragma unroll
                for (int k = 0; k < 4; ++k) { const int sl = s_slot[32 * i + 8 * k + (ln_ >> 3)];
                    const u32x4 v = *(const LAS u32x4*)(ysc + rdo + 8 * k * 144);
                    __builtin_amdgcn_raw_buffer_store_b128(v, RY, sl >= 0 ? (unsigned)sl * 2048u + yoff : 0xfffffff0u, 0, 0); }
                LDS_WAIT(); asm volatile("" ::: "memory");
            }
        }
    }
    __syncthreads();
}
template <int PRB = 0> __device__ __forceinline__ void moe_segment(const Frame& F, int layer, int e, int l0, int n) {
    const int nt = (n + 31) >> 5;
    if (nt == 4) moe_segment_t<4, PRB>(F, layer, e, l0, n); else if (nt == 3) moe_segment_t<3, PRB>(F, layer, e, l0, n); else if (nt == 2) moe_segment_t<2, PRB>(F, layer, e, l0, n); else moe_segment_t<1, PRB>(F, layer, e, l0, n);
}
template <int PRB = 0> __device__ __forceinline__ int phase_moe(const Frame& F, int layer) {
    int nseg = 0;
    unsigned* gcnt = (unsigned*)(F.ws + WS_CTL) + CW_ECNT + layer * 32 * 64;
    const int mycnt = (int)__hip_atomic_load(gcnt + (F.lane & 31) * 64, __ATOMIC_RELAXED, __HIP_MEMORY_SCOPE_AGENT);
    for (int unit = F.vcu; unit < 256; unit += F.G) {
        const int v0 = 128 * unit, v1 = v0 + 128; int vb = 0;
        for (int e = 0; e < 32; ++e) {
            const int ne = __builtin_amdgcn_readlane(mycnt, e);
            const int lo = v0 > vb ? v0 : vb, hi_ = v1 < vb + ne ? v1 : vb + ne;
            if (lo < hi_) { moe_segment<PRB>(F, layer, e, lo - vb, hi_ - lo); ++nseg; }
            vb += ne;
        }
    }
    return nseg;
}
}
namespace mk {
__device__ __forceinline__ int crow(int r, int hi) { return (r & 3) + 8 * (r >> 2) + 4 * hi; }
__device__ __forceinline__ s16x4 vtr(const LAS unsigned char* p) {
    typedef short v4i16_t __attribute__((ext_vector_type(4)));
    return __builtin_bit_cast(s16x4, __builtin_amdgcn_ds_read_tr16_b64_v4i16((LAS v4i16_t*)p));
}
constexpr float ATT_THR = 8.f;

template <int MODE, int APROBE = 0> __device__ __forceinline__ void attn_unit(const Frame& F, int unit) {
    constexpr int NKC = MODE == 0 ? 12 : 8, ND0 = NKC / 2, KBYTES = NKC * 1024, BUF = KBYTES + 8192;
    const int lane = F.lane, w = F.wave, r32 = lane & 31, hi = lane >> 5;
    LAS unsigned char* lds = F.lds;
    constexpr int NBUF = 3;
    LAS float* wsf = (LAS float*)(lds + NBUF * BUF) + w * 64;
    LAS bf16_t* stg = (LAS bf16_t*)(lds + NBUF * BUF + 2048) + w * 2048;
    const bf16_t* Qb = (const bf16_t*)(F.ws + WS_Q); const bf16_t* KVb = (const bf16_t*)(F.ws + WS_KV); const bf16_t* KPE = (const bf16_t*)(F.ws + WS_KPE);
    const bf16_t* Pb = (const bf16_t*)(F.ws + WS_P); bf16_t* Ob = (bf16_t*)(F.ws + WS_MB);
    int b, h = 0, g = 0, hq = 0, tq0, j_lo, j_hi, kbase0, ocol, qpos0 = 0;
    if (MODE == 0) { b = unit >> 6; h = (unit >> 3) & 7; const int qb = unit & 7; tq0 = b * S + 256 * qb + 32 * w; j_lo = 0; j_hi = 32; kbase0 = b * S; ocol = h * 64; }
    else { b = unit >> 6; const int rem = unit & 63; g = rem >> 5; const int qblk = (rem >> 1) & 15, hp = rem & 1; hq = 4 * g + 2 * hp + (w >> 2);
        qpos0 = 128 * qblk + 32 * (w & 3); tq0 = b * S + qpos0; j_lo = (qblk == 0) ? 2 : 0; j_hi = (qblk == 15) ? 4 : 6; kbase0 = b * S + 128 * qblk - 128; ocol = 512 + hq * 64; }
    bf16x8 qr[ND0];
    if (MODE == 0) { const bf16_t* qrow = Qb + (size_t)(tq0 + r32) * 768;
#pragma unroll
        for (int d0 = 0; d0 < 4; ++d0) qr[d0] = *(const GAS bf16x8*)(qrow + h * 64 + 16 * d0 + 8 * hi);
#pragma unroll
        for (int d0 = 4; d0 < 6; ++d0) qr[d0] = *(const GAS bf16x8*)(qrow + 512 + h * 32 + 16 * (d0 - 4) + 8 * hi);
        {
            const f32x2* rp = (const f32x2*)(F.ws + WS_ROPE) + ((tq0 + r32) & (S - 1)) * 16 + 8 * hi;
            bf16x8 a4 = qr[4], a5 = qr[5];
#pragma unroll
            for (int j = 0; j < 8; ++j) { const f32x2 cs = rp[j]; const float x = bf2f((unsigned short)a4[j]), y = bf2f((unsigned short)a5[j]);
                a4[j] = (short)f2bf(x * cs.x - y * cs.y); a5[j] = (short)f2bf(y * cs.x + x * cs.y); }
            qr[4] = a4; qr[5] = a5; }
    } else { const bf16_t* qrow = Pb + (size_t)(tq0 + r32) * 1280 + 512 + hq * 64;
#pragma unroll
        for (int d0 = 0; d0 < ND0; ++d0) qr[d0] = *(const GAS bf16x8*)(qrow + 16 * d0 + 8 * hi);
    }
    const bf16_t *ksrc0, *ksrc1 = nullptr, *vsrc; size_t kstride, kstride1 = 0, vstride;
    const int vrow = 16 * (w & 3) + (lane >> 2), vcol = (w >> 2) * 32 + (lane & 3) * 8;
    if (MODE == 0) { ksrc0 = KVb + (size_t)(kbase0 + lane) * 1024 + h * 64 + w * 8; kstride = 64 * 1024;
        ksrc1 = KPE + (size_t)(kbase0 + lane) * 32 + (w & 3) * 8; kstride1 = 64 * 32;
        vsrc = KVb + (size_t)(kbase0 + vrow) * 1024 + 512 + h * 64 + vcol; vstride = 64 * 1024; }
    else { ksrc0 = Pb + (size_t)((long)kbase0 + lane) * 1280 + 1024 + g * 64 + w * 8; kstride = 64 * 1280;
        vsrc = Pb + (size_t)((long)kbase0 + vrow) * 1280 + 1152 + g * 64 + vcol; vstride = 64 * 1280; }
    const bool two_k = (MODE == 0) && (w < 4);
    u32x4 ks0s[2], ks1s[2] = {{0u, 0u, 0u, 0u}, {0u, 0u, 0u, 0u}}, vss[2];
#define ATT_LOAD(S, j) do { ks0s[S] = *(const GAS u32x4*)(ksrc0 + (size_t)(j) * kstride); if (MODE == 0) ks1s[S] = *(const GAS u32x4*)(ksrc1 + (size_t)(j) * kstride1); vss[S] = *(const GAS u32x4*)(vsrc + (size_t)(j) * vstride); } while (0)
#define ATT_WRITE(S, bufo) do { *(LAS u32x4*)(lds + (bufo) + w * 1024 + lane * 16) = ks0s[S]; if (MODE == 0) *(LAS u32x4*)(lds + (bufo) + (8 + (w & 3)) * 1024 + lane * 16) = ks1s[S]; \
        *(LAS u32x4*)(lds + (bufo) + KBYTES + w * 1024 + lane * 16) = vss[S]; } while (0)
    float m_run, l_run; f32x16 o[2]; o[0] = f32x16{}; o[1] = f32x16{};
    float slope2 = 0.f;
    if (MODE == 1) { m_run = F.in[19][hq] * LOG2E; l_run = (hi == 0) ? 1.f : 0.f; slope2 = exp2f(-(float)(hq + 1)) * LOG2E; }
    else { m_run = -1e30f; l_run = 0.f; }
#ifndef MK_ATT_STAGGER
#define MK_ATT_STAGGER 0
#endif
    const bool late = MK_ATT_STAGGER && (w >= 4);
    ATT_LOAD(0, j_lo); ATT_WRITE(0, 0); ATT_LOAD(1, j_lo + 1); __syncthreads();
    const int voff = KBYTES + ((lane >> 4) & 1) * 32 + (lane & 3) * 8 + (4 * hi + ((lane & 15) >> 2)) * 64;
    int bo_prev = 0, bo_cur = 0, bo_next = BUF;
    u32x4 pwp[4] = {{0u, 0u, 0u, 0u}, {0u, 0u, 0u, 0u}, {0u, 0u, 0u, 0u}, {0u, 0u, 0u, 0u}};
#define SB() __builtin_amdgcn_sched_barrier(0)
#define ATT_VRD(BO) do { const LAS unsigned char* vp_ = lds + (BO) + voff; \
        _Pragma("unroll") for (int i_ = 0; i_ < 8; ++i_) { vl[i_] = vtr(vp_ + (i_ >> 2) * 4096 + (i_ & 3) * 1024); vh[i_] = vtr(vp_ + (i_ >> 2) * 4096 + (i_ & 3) * 1024 + 512); } } while (0)
#define ATT_PVM(PW) do { _Pragma("unroll") for (int i_ = 0; i_ < 8; ++i_) { \
            const bf16x8 vf = (bf16x8){vl[i_][0], vl[i_][1], vl[i_][2], vl[i_][3], vh[i_][0], vh[i_][1], vh[i_][2], vh[i_][3]}; \
            o[i_ >> 2] = __builtin_amdgcn_mfma_f32_32x32x16_bf16(__builtin_bit_cast(bf16x8, PW[i_ & 3]), vf, o[i_ >> 2], 0, 0, 0); } } while (0)
    s16x4 vl[8], vh[8];
    for (int j2 = j_lo; j2 < j_hi; j2 += 2) {
#pragma unroll
    for (int par = 0; par < 2; ++par) { const int j = j2 + par;
        if (APROBE != 1) { const int jl = (j + 2 < j_hi) ? j + 2 : j_hi - 1; ATT_LOAD(par, jl); }
        if (late && j > j_lo) { ATT_VRD(bo_prev); SB(); ATT_PVM(pwp); SB(); }
        f32x16 p0 = f32x16{}, p1 = f32x16{};
        const LAS unsigned char* kb = lds + bo_cur + hi * 1024 + r32 * 16;
        {
            bf16x8 kf0[ND0], kf1[ND0];
#pragma unroll
            for (int d0 = 0; d0 < ND0; ++d0) { kf0[d0] = *(const LAS bf16x8*)(kb + d0 * 2048); kf1[d0] = *(const LAS bf16x8*)(kb + d0 * 2048 + 512); }
            SB();
#pragma unroll
            for (int d0 = 0; d0 < ND0; ++d0) {
                p0 = __builtin_amdgcn_mfma_f32_32x32x16_bf16(kf0[d0], qr[d0], p0, 0, 0, 0);
                p1 = __builtin_amdgcn_mfma_f32_32x32x16_bf16(kf1[d0], qr[d0], p1, 0, 0, 0);
            }
            SB();
        }
        if (!late) { ATT_VRD(bo_cur); SB(); }
        if (MODE == 1) {
            const int qp = qpos0 + r32, kp = 128 * ((unit >> 1) & 15) - 128 + 64 * j;
#pragma unroll
            for (int r = 0; r < 16; ++r) { const int k0 = kp + crow(r, hi); int d0_ = qp - k0; d0_ = d0_ < 0 ? -d0_ : d0_; int d1_ = qp - (k0 + 32); d1_ = d1_ < 0 ? -d1_ : d1_;
                p0[r] = (d0_ <= 128) ? p0[r] - slope2 * (float)d0_ : -1e30f; p1[r] = (d1_ <= 128) ? p1[r] - slope2 * (float)d1_ : -1e30f; }
        }
        float pmax = p0[0];
#pragma unroll
        for (int r = 1; r < 16; ++r) pmax = fmaxf(pmax, p0[r]);
#pragma unroll
        for (int r = 0; r < 16; ++r) pmax = fmaxf(pmax, p1[r]);
        pmax = fmaxf(pmax, __shfl_xor(pmax, 32));
        if (!__all(pmax - m_run <= ATT_THR)) {
            const float mn = fmaxf(m_run, pmax), alpha = fast_exp2(m_run - mn); m_run = mn; l_run *= alpha;
            if (hi == 0) wsf[r32] = alpha;
            LDS_WAIT(); asm volatile("" ::: "memory");
#pragma unroll
            for (int r = 0; r < 16; ++r) { const float a = wsf[crow(r, hi)]; o[0][r] *= a; o[1][r] *= a; }
        }
        float ps = 0.f;
#pragma unroll
        for (int r = 0; r < 16; ++r) { if (APROBE != 2) { p0[r] = fast_exp2(p0[r] - m_run); p1[r] = fast_exp2(p1[r] - m_run); ps += p0[r] + p1[r]; } }
        l_run += ps;
        u32x4 pw[4];
        pw[0] = (u32x4){pk2(p0[0], p0[1]), pk2(p0[2], p0[3]), pk2(p0[4], p0[5]), pk2(p0[6], p0[7])};
        pw[1] = (u32x4){pk2(p0[8], p0[9]), pk2(p0[10], p0[11]), pk2(p0[12], p0[13]), pk2(p0[14], p0[15])};
        pw[2] = (u32x4){pk2(p1[0], p1[1]), pk2(p1[2], p1[3]), pk2(p1[4], p1[5]), pk2(p1[6], p1[7])};
        pw[3] = (u32x4){pk2(p1[8], p1[9]), pk2(p1[10], p1[11]), pk2(p1[12], p1[13]), pk2(p1[14], p1[15])};
        SB();
        if (!late) ATT_PVM(pw);
        else { pwp[0] = pw[0]; pwp[1] = pw[1]; pwp[2] = pw[2]; pwp[3] = pw[3]; }
        if (APROBE != 1) { ATT_WRITE(par ^ 1, bo_next);
        __syncthreads(); }
        bo_prev = bo_cur; bo_cur = bo_next; bo_next = (bo_next == (NBUF - 1) * BUF) ? 0 : bo_next + BUF;
    } }
    if (late) { ATT_VRD(bo_prev); SB(); ATT_PVM(pwp); }
#undef ATT_VRD
#undef ATT_PVM
#undef SB
#undef ATT_LOAD
#undef ATT_WRITE
    const float lt = l_run + __shfl_xor(l_run, 32);
    if (hi == 0) wsf[32 + r32] = lt;
    LDS_WAIT(); asm volatile("" ::: "memory");
#pragma unroll
    for (int r = 0; r < 16; ++r) { const int orow = crow(r, hi); const float rl = fast_rcp(wsf[32 + orow]);
        stg[orow * 64 + r32] = (bf16_t)f2bf(o[0][r] * rl); stg[orow * 64 + 32 + r32] = (bf16_t)f2bf(o[1][r] * rl); }
    LDS_WAIT(); asm volatile("" ::: "memory");
    bf16_t* Ow = Ob + (size_t)tq0 * 1024 + ocol;
#pragma unroll
    for (int i = 0; i < 4; ++i) { const int row = i * 8 + (lane >> 3), ch = lane & 7; const u32x4 v = *(const LAS u32x4*)(stg + row * 64 + ch * 8); if (APROBE == 0) *(GAS u32x4*)(Ow + (size_t)row * 1024 + ch * 8) = v; else asm volatile("" :: "v"(v)); }
    __syncthreads();
}
__device__ __forceinline__ void mla_unit(const Frame& F, int unit) {
    constexpr int ND0 = 6, KBYTES = 12288, BUF = KBYTES + 8192, NBUF = 3, NTILE = 32;
    const int lane = F.lane, w = F.wave, r32 = lane & 31, hi = lane >> 5;
    LAS unsigned char* lds = F.lds;
    LAS float* wsf = (LAS float*)(lds + NBUF * BUF) + w * 64;
    LAS bf16_t* stg = (LAS bf16_t*)(lds + NBUF * BUF + 2048) + w * 2048;
    const bf16_t* Qb = (const bf16_t*)(F.ws + WS_Q); const bf16_t* KVb = (const bf16_t*)(F.ws + WS_KV); const bf16_t* KPE = (const bf16_t*)(F.ws + WS_KPE);
    bf16_t* Ob = (bf16_t*)(F.ws + WS_MB);
    const int b = unit >> 6, h = (unit >> 3) & 7, qb = unit & 7, tq0 = b * S + 256 * qb + 32 * w, kbase0 = b * S;
    bf16x8 qr[ND0];
    { const bf16_t* qrow = Qb + (size_t)(tq0 + r32) * 768;
#pragma unroll
      for (int d0 = 0; d0 < 4; ++d0) qr[d0] = *(const GAS bf16x8*)(qrow + h * 64 + 16 * d0 + 8 * hi);
#pragma unroll
      for (int d0 = 4; d0 < 6; ++d0) qr[d0] = *(const GAS bf16x8*)(qrow + 512 + h * 32 + 16 * (d0 - 4) + 8 * hi);
      const f32x2* rp = (const f32x2*)(F.ws + WS_ROPE) + ((tq0 + r32) & (S - 1)) * 16 + 8 * hi;
      bf16x8 a4 = qr[4], a5 = qr[5];
#pragma unroll
      for (int j = 0; j < 8; ++j) { const f32x2 cs = rp[j]; const float x = bf2f((unsigned short)a4[j]), y = bf2f((unsigned short)a5[j]);
          a4[j] = (short)f2bf(x * cs.x - y * cs.y); a5[j] = (short)f2bf(y * cs.x + x * cs.y); }
      qr[4] = a4; qr[5] = a5; }
    const int vrow = 16 * (w & 3) + (lane >> 2), vcol = (w >> 2) * 32 + (lane & 3) * 8;
    const bf16_t* ksrc0 = KVb + (size_t)(kbase0 + lane) * 1024 + h * 64 + w * 8;
    const bf16_t* ksrc1 = KPE + (size_t)(kbase0 + lane) * 32 + (w & 3) * 8;
    const bf16_t* vsrc = KVb + (size_t)(kbase0 + vrow) * 1024 + 512 + h * 64 + vcol;
    u32x4 ks0s[2], ks1s[2], vss[2];
#define M_LOAD(S_, t_) do { const int tt_ = (t_) < NTILE ? (t_) : NTILE - 1; ks0s[S_] = *(const GAS u32x4*)(ksrc0 + (size_t)tt_ * 65536); ks1s[S_] = *(const GAS u32x4*)(ksrc1 + (size_t)tt_ * 2048); vss[S_] = *(const GAS u32x4*)(vsrc + (size_t)tt_ * 65536); } while (0)
#define M_WRITE(S_, bo_) do { *(LAS u32x4*)(lds + (bo_) + w * 1024 + lane * 16) = ks0s[S_]; *(LAS u32x4*)(lds + (bo_) + (8 + (w & 3)) * 1024 + lane * 16) = ks1s[S_]; \
        *(LAS u32x4*)(lds + (bo_) + KBYTES + w * 1024 + lane * 16) = vss[S_]; } while (0)
    const int voff = KBYTES + ((lane >> 4) & 1) * 32 + (lane & 3) * 8 + (4 * hi + ((lane & 15) >> 2)) * 64;
    float m_run = -1e30f, l_run = 0.f; f32x16 o[2]; o[0] = f32x16{}; o[1] = f32x16{};
    f32x16 pA0, pA1, pB0, pB1; float alA = 1.f, alB = 1.f; u32x4 pw[4];
#define M_QKT(P0, P1, bo_) do { const LAS unsigned char* kb_ = lds + (bo_) + hi * 1024 + r32 * 16; P0 = f32x16{}; P1 = f32x16{}; \
        _Pragma("unroll") for (int d0 = 0; d0 < ND0; ++d0) { const bf16x8 b0_ = *(const LAS bf16x8*)(kb_ + d0 * 2048), b1_ = *(const LAS bf16x8*)(kb_ + d0 * 2048 + 512); \
            P0 = __builtin_amdgcn_mfma_f32_32x32x16_bf16(b0_, qr[d0], P0, 0, 0, 0); P1 = __builtin_amdgcn_mfma_f32_32x32x16_bf16(b1_, qr[d0], P1, 0, 0, 0); } } while (0)
#define M_PART(P0, P1, AL) do { float pm_ = P0[0]; \
        _Pragma("unroll") for (int r = 1; r < 16; ++r) pm_ = fmaxf(pm_, P0[r]); \
        _Pragma("unroll") for (int r = 0; r < 16; ++r) pm_ = fmaxf(pm_, P1[r]); \
        pm_ = fmaxf(pm_, __shfl_xor(pm_, 32)); \
        { const bool keep_ = __all(pm_ - m_run <= ATT_THR); const float mn_ = keep_ ? m_run : fmaxf(m_run, pm_); AL = fast_exp2(m_run - mn_); m_run = mn_; }     \
        { const f32x2 mm_ = {m_run, m_run}; \
        _Pragma("unroll") for (int r = 0; r < 16; r += 2) { f32x2 a_ = {P0[r], P0[r + 1]}, b_ = {P1[r], P1[r + 1]}; a_ -= mm_; b_ -= mm_;     \
            P0[r] = fast_exp2(a_.x); P0[r + 1] = fast_exp2(a_.y); P1[r] = b_.x; P1[r + 1] = b_.y; } } } while (0)
#define M_FIN(P0, P1, AL) do { f32x2 ps2_ = {0.f, 0.f}; \
        _Pragma("unroll") for (int r = 0; r < 16; r += 2) { P1[r] = fast_exp2(P1[r]); P1[r + 1] = fast_exp2(P1[r + 1]); ps2_ += (f32x2){P0[r], P0[r + 1]} + (f32x2){P1[r], P1[r + 1]}; } \
        const float ps_ = ps2_.x + ps2_.y; \
        l_run = l_run * AL + ps_; \
        pw[0] = (u32x4){pk2(P0[0], P0[1]), pk2(P0[2], P0[3]), pk2(P0[4], P0[5]), pk2(P0[6], P0[7])}; \
        pw[1] = (u32x4){pk2(P0[8], P0[9]), pk2(P0[10], P0[11]), pk2(P0[12], P0[13]), pk2(P0[14], P0[15])}; \
        pw[2] = (u32x4){pk2(P1[0], P1[1]), pk2(P1[2], P1[3]), pk2(P1[4], P1[5]), pk2(P1[6], P1[7])}; \
        pw[3] = (u32x4){pk2(P1[8], P1[9]), pk2(P1[10], P1[11]), pk2(P1[12], P1[13]), pk2(P1[14], P1[15])}; } while (0)
#define M_PV(bo_) do { const LAS unsigned char* vp_ = lds + (bo_) + voff; \
        _Pragma("unroll") for (int i_ = 0; i_ < 8; ++i_) { const s16x4 vl_ = vtr(vp_ + (i_ >> 2) * 4096 + (i_ & 3) * 1024), vh_ = vtr(vp_ + (i_ >> 2) * 4096 + (i_ & 3) * 1024 + 512); \
            const bf16x8 vf_ = (bf16x8){vl_[0], vl_[1], vl_[2], vl_[3], vh_[0], vh_[1], vh_[2], vh_[3]}; \
            o[i_ >> 2] = __builtin_amdgcn_mfma_f32_32x32x16_bf16(__builtin_bit_cast(bf16x8, pw[i_ & 3]), vf_, o[i_ >> 2], 0, 0, 0); } } while (0)
#define M_RESC(AL) do { if (__any(AL < 1.f)) { if (hi == 0) wsf[r32] = AL; LDS_WAIT(); asm volatile("" ::: "memory"); \
        _Pragma("unroll") for (int r = 0; r < 16; ++r) { const float a_ = wsf[crow(r, hi)]; o[0][r] *= a_; o[1][r] *= a_; } } } while (0)
    int bo_prev = 0, bo_cur = 0, bo_next = BUF;
#define M_ROT() do { bo_prev = bo_cur; bo_cur = bo_next; bo_next = (bo_next == (NBUF - 1) * BUF) ? 0 : bo_next + BUF; } while (0)
    M_LOAD(0, 0); M_WRITE(0, 0); M_LOAD(1, 1); __syncthreads();
    M_QKT(pA0, pA1, 0); M_PART(pA0, pA1, alA);
    M_LOAD(0, 2); M_WRITE(1, BUF); __syncthreads(); M_ROT();
#define M_STEP(PX0, PX1, ALX, PY0, PY1, ALY, PAR_, jt_) do { \
        __builtin_amdgcn_sched_barrier(0); \
        M_QKT(PX0, PX1, bo_cur); M_FIN(PY0, PY1, ALY); \
        _Pragma("unroll") for (int g_ = 0; g_ < 12; ++g_) { __builtin_amdgcn_sched_group_barrier(0x100, 1, 0); __builtin_amdgcn_sched_group_barrier(0x008, 1, 0); __builtin_amdgcn_sched_group_barrier(0x002, 6, 0); } \
        __builtin_amdgcn_sched_barrier(0); \
        M_LOAD(PAR_, (jt_) + 2); \
        M_PV(bo_prev); M_PART(PX0, PX1, ALX); \
        _Pragma("unroll") for (int g_ = 0; g_ < 8; ++g_) { __builtin_amdgcn_sched_group_barrier(0x100, 2, 1); __builtin_amdgcn_sched_group_barrier(0x008, 1, 1); __builtin_amdgcn_sched_group_barrier(0x002, 10, 1); } \
        __builtin_amdgcn_sched_barrier(0); \
        M_RESC(ALX); \
        M_WRITE((PAR_) ^ 1, bo_next); __syncthreads(); M_ROT(); } while (0)
    for (int j = 1; j < NTILE; j += 2) {
        M_STEP(pB0, pB1, alB, pA0, pA1, alA, 1, j);
        if (j + 1 < NTILE) M_STEP(pA0, pA1, alA, pB0, pB1, alB, 0, j + 1);
    }
    M_FIN(pB0, pB1, alB); M_PV(bo_prev);
    const float lt = l_run + __shfl_xor(l_run, 32);
    if (hi == 0) wsf[32 + r32] = lt;
    LDS_WAIT(); asm volatile("" ::: "memory");
#pragma unroll
    for (int r = 0; r < 16; ++r) { const int orow = crow(r, hi); const float rl = fast_rcp(wsf[32 + orow]);
        stg[orow * 64 + r32] = (bf16_t)f2bf(o[0][r] * rl); stg[orow * 64 + 32 + r32] = (bf16_t)f2bf(o[1][r] * rl); }
    LDS_WAIT(); asm volatile("" ::: "memory");
    bf16_t* Ow = Ob + (size_t)tq0 * 1024 + h * 64;
#pragma unroll
    for (int i = 0; i < 4; ++i) { const int row = i * 8 + (lane >> 3), ch = lane & 7; const u32x4 v = *(const LAS u32x4*)(stg + row * 64 + ch * 8); *(GAS u32x4*)(Ow + (size_t)row * 1024 + ch * 8) = v; }
    __syncthreads();
#undef M_LOAD
#undef M_WRITE
#undef M_QKT
#undef M_PART
#undef M_FIN
#undef M_PV
#undef M_RESC
#undef M_ROT
#undef M_STEP
}
__device__ __forceinline__ void swa_unit(const Frame& F, int unit) {
    constexpr int TB = 16384;
    const int lane = F.lane, w = F.wave, r32 = lane & 31, hi = lane >> 5;
    LAS unsigned char* lds = F.lds;
    LAS float* wsf = (LAS float*)(lds + 6 * TB) + w * 64;
    LAS bf16_t* stg = (LAS bf16_t*)(lds + 6 * TB + 2048) + w * 2048;
    const bf16_t* Pb = (const bf16_t*)(F.ws + WS_P); bf16_t* Ob = (bf16_t*)(F.ws + WS_MB);
    const int b = unit >> 5, g = (unit >> 4) & 1, qblk = unit & 15;
    const int j_lo = (qblk == 0) ? 2 : 0, j_hi = (qblk == 15) ? 4 : 6, nt = j_hi - j_lo;
    const long kbase = (long)b * S + 128 * qblk - 128 + 64 * j_lo;
    const int qpos0 = 128 * qblk + 32 * (w & 3), tq0 = b * S + qpos0;
    const int vrow = 16 * (w & 3) + (lane >> 2), vcol = (w >> 2) * 32 + (lane & 3) * 8;
    const bf16_t* ksrc = Pb + (size_t)(kbase + lane) * 1280 + 1024 + g * 64 + w * 8;
    const bf16_t* vsrc = Pb + (size_t)(kbase + vrow) * 1280 + 1152 + g * 64 + vcol;
    u32x4 kst[6], vst[6];
#pragma unroll
    for (int t = 0; t < 6; ++t) { const int tt = t < nt ? t : nt - 1;
        kst[t] = *(const GAS u32x4*)(ksrc + (size_t)tt * 64 * 1280); vst[t] = *(const GAS u32x4*)(vsrc + (size_t)tt * 64 * 1280); }
    bf16x8 qr[2][4];
#pragma unroll
    for (int ps = 0; ps < 2; ++ps) { const bf16_t* qrow = Pb + (size_t)(tq0 + r32) * 1280 + 512 + (4 * g + 2 * ps + (w >> 2)) * 64;
#pragma unroll
        for (int d0 = 0; d0 < 4; ++d0) qr[ps][d0] = *(const GAS bf16x8*)(qrow + 16 * d0 + 8 * hi); }
#pragma unroll
    for (int t = 0; t < 6; ++t) { *(LAS u32x4*)(lds + t * TB + w * 1024 + lane * 16) = kst[t]; *(LAS u32x4*)(lds + t * TB + 8192 + w * 1024 + lane * 16) = vst[t]; }
    __syncthreads();
    const int voff = 8192 + ((lane >> 4) & 1) * 32 + (lane & 3) * 8 + (4 * hi + ((lane & 15) >> 2)) * 64;
    const float qf = (float)(qpos0 + r32 - (128 * qblk - 128 + 64 * j_lo) - 4 * hi);
#pragma unroll
    for (int ps = 0; ps < 2; ++ps) {
        const int hq = 4 * g + 2 * ps + (w >> 2);
        float m_run = F.in[19][hq] * LOG2E, l_run = (hi == 0) ? 1.f : 0.f; const float slope2 = exp2f(-(float)(hq + 1)) * LOG2E;
        f32x16 o[2]; o[0] = f32x16{}; o[1] = f32x16{};
        for (int t = 0; t < nt; ++t) {
            const int q0 = qpos0 - (128 * qblk - 128 + 64 * j_lo), k0 = 64 * t;
            if (k0 + 63 < q0 - 128 || k0 > q0 + 31 + 128) continue;
            const bool inside = (k0 >= q0 - 97) && (k0 <= q0 + 65);
            const LAS unsigned char* kb = lds + t * TB + hi * 1024 + r32 * 16;
            f32x16 p0 = f32x16{}, p1 = f32x16{};
            { bf16x8 kf0[4], kf1[4];
#pragma unroll
              for (int d0 = 0; d0 < 4; ++d0) { kf0[d0] = *(const LAS bf16x8*)(kb + d0 * 2048); kf1[d0] = *(const LAS bf16x8*)(kb + d0 * 2048 + 512); }
#pragma unroll
              for (int d0 = 0; d0 < 4; ++d0) { p0 = __builtin_amdgcn_mfma_f32_32x32x16_bf16(kf0[d0], qr[ps][d0], p0, 0, 0, 0); p1 = __builtin_amdgcn_mfma_f32_32x32x16_bf16(kf1[d0], qr[ps][d0], p1, 0, 0, 0); } }
            s16x4 vl[8], vh[8];
            { const LAS unsigned char* vp_ = lds + t * TB + voff;
#pragma unroll
              for (int i_ = 0; i_ < 8; ++i_) { vl[i_] = vtr(vp_ + (i_ >> 2) * 4096 + (i_ & 3) * 1024); vh[i_] = vtr(vp_ + (i_ >> 2) * 4096 + (i_ & 3) * 1024 + 512); } }
            const float tq = qf - (float)k0;
            if (inside) {
#pragma unroll
                for (int r = 0; r < 16; ++r) { const float c = (float)((r & 3) + 8 * (r >> 2)); p0[r] = fmaf(-slope2, fabsf(tq - c), p0[r]); p1[r] = fmaf(-slope2, fabsf(tq - c - 32.f), p1[r]); }
            } else {
#pragma unroll
                for (int r = 0; r < 16; ++r) { const float c = (float)((r & 3) + 8 * (r >> 2)); const float d0_ = fabsf(tq - c), d1_ = fabsf(tq - c - 32.f);
                    p0[r] = (d0_ <= 128.f) ? fmaf(-slope2, d0_, p0[r]) : -1e30f; p1[r] = (d1_ <= 128.f) ? fmaf(-slope2, d1_, p1[r]) : -1e30f; }
            }
            float pmax = p0[0];
#pragma unroll
            for (int r = 1; r < 16; ++r) pmax = fmaxf(pmax, p0[r]);
#pragma unroll
            for (int r = 0; r < 16; ++r) pmax = fmaxf(pmax, p1[r]);
            pmax = fmaxf(pmax, __shfl_xor(pmax, 32));
            if (!__all(pmax - m_run <= ATT_THR)) {
                const float mn = fmaxf(m_run, pmax), alpha = fast_exp2(m_run - mn); m_run = mn; l_run *= alpha;
                if (hi == 0) wsf[r32] = alpha;
                LDS_WAIT(); asm volatile("" ::: "memory");
#pragma unroll
                for (int r = 0; r < 16; ++r) { const float a_ = wsf[crow(r, hi)]; o[0][r] *= a_; o[1][r] *= a_; }
            }
            f32x2 ps2 = {0.f, 0.f}; const f32x2 mm = {m_run, m_run};
#pragma unroll
            for (int r = 0; r < 16; r += 2) { const f32x2 a_ = (f32x2){p0[r], p0[r + 1]} - mm, b_ = (f32x2){p1[r], p1[r + 1]} - mm;
                p0[r] = fast_exp2(a_.x); p0[r + 1] = fast_exp2(a_.y); p1[r] = fast_exp2(b_.x); p1[r + 1] = fast_exp2(b_.y);
                ps2 += (f32x2){p0[r], p0[r + 1]} + (f32x2){p1[r], p1[r + 1]}; }
            l_run += ps2.x + ps2.y;
            u32x4 pw[4];
            pw[0] = (u32x4){pk2(p0[0], p0[1]), pk2(p0[2], p0[3]), pk2(p0[4], p0[5]), pk2(p0[6], p0[7])};
            pw[1] = (u32x4){pk2(p0[8], p0[9]), pk2(p0[10], p0[11]), pk2(p0[12], p0[13]), pk2(p0[14], p0[15])};
            pw[2] = (u32x4){pk2(p1[0], p1[1]), pk2(p1[2], p1[3]), pk2(p1[4], p1[5]), pk2(p1[6], p1[7])};
            pw[3] = (u32x4){pk2(p1[8], p1[9]), pk2(p1[10], p1[11]), pk2(p1[12], p1[13]), pk2(p1[14], p1[15])};
#pragma unroll
            for (int i_ = 0; i_ < 8; ++i_) { const bf16x8 vf = (bf16x8){vl[i_][0], vl[i_][1], vl[i_][2], vl[i_][3], vh[i_][0], vh[i_][1], vh[i_][2], vh[i_][3]};
                o[i_ >> 2] = __builtin_amdgcn_mfma_f32_32x32x16_bf16(__builtin_bit_cast(bf16x8, pw[i_ & 3]), vf, o[i_ >> 2], 0, 0, 0); }
        }
        const float lt = l_run + __shfl_xor(l_run, 32);
        if (hi == 0) wsf[32 + r32] = lt;
        LDS_WAIT(); asm volatile("" ::: "memory");
#pragma unroll
        for (int r = 0; r < 16; ++r) { const int orow = crow(r, hi); const float rl = fast_rcp(wsf[32 + orow]);
            stg[orow * 64 + r32] = (bf16_t)f2bf(o[0][r] * rl); stg[orow * 64 + 32 + r32] = (bf16_t)f2bf(o[1][r] * rl); }
        LDS_WAIT(); asm volatile("" ::: "memory");
        bf16_t* Ow = Ob + (size_t)tq0 * 1024 + 512 + hq * 64;
#pragma unroll
        for (int i = 0; i < 4; ++i) { const int row = i * 8 + (lane >> 3), ch = lane & 7; const u32x4 v = *(const LAS u32x4*)(stg + row * 64 + ch * 8); *(GAS u32x4*)(Ow + (size_t)row * 1024 + ch * 8) = v; }
        LDS_WAIT(); asm volatile("" ::: "memory");
    }
    __syncthreads();
}
template <int PROBE = 0> __device__ __forceinline__ void phase_attn(const Frame& F) {
#ifdef MK_MLA_OLD
    if (PROBE != 2) for (int u = F.vcu; u < 512; u += F.G) attn_unit<0, (PROBE >= 10 ? PROBE - 10 : 0)>(F, u);
    if (PROBE >= 10) return;
#else
    if (PROBE != 2) for (int u = F.vcu; u < 512; u += F.G) mla_unit(F, u);
#endif
    if (PROBE != 1) for (int u = F.vcu; u < 256; u += F.G) swa_unit(F, u);
}
}
namespace mk {
constexpr int N_PHASES = 14;
__global__ void __launch_bounds__(NTHR, 2) fwd_mega(Args args) {
    extern __shared__ __attribute__((aligned(16))) unsigned char lds_raw[];
    Frame F;
    F.lds = (LAS unsigned char*)lds_raw;
    F.tid = threadIdx.x; F.lane = F.tid & 63; F.wave = __builtin_amdgcn_readfirstlane(F.tid >> 6);
    F.G = gridDim.x; { const int bx = blockIdx.x; F.vcu = (F.G % 8 == 0) ? (bx % 8) * (F.G / 8) + bx / 8 : bx; }
    F.in = args.in; F.out = args.out; F.ws = args.ws;
    volatile LAS unsigned* MISC = (volatile LAS unsigned*)(F.lds + MISC_OFF);
    if (F.tid < 64) MISC[F.tid] = 0u;
    __syncthreads();
    unsigned* ctl = (unsigned*)(F.ws + WS_CTL);
    const int lo = args.ph_lo, hi = args.ph_hi;
    XcdBarrier bar; bar.bar = ctl + CW_BAR + args.li * XCD_BAR_WORDS; bar.x = 0; bar.st = nullptr;
    if (hi - lo > 1) bar = xcd_barrier_post(ctl + CW_BAR + args.li * XCD_BAR_WORDS, MISC + 8);
#ifndef MK_PHASE_MASK
#define MK_PHASE_MASK 0x3fff
#endif
#define IN(k) (((MK_PHASE_MASK >> (k)) & 1) && lo <= (k) && (k) < hi)
#ifndef MK_DUP_MASK
#define MK_DUP_MASK 0
#endif
#define REP(k) for (int rep_ = 0; rep_ <= ((MK_DUP_MASK >> (k)) & 1); ++rep_)
#define FRESH() do { int t_ = threadIdx.x; asm volatile("" : "+v"(t_)); F.tid = t_; F.lane = t_ & 63; F.wave = __builtin_amdgcn_readfirstlane(t_ >> 6); } while (0)
#ifdef MK_STRETCH_K
#define STRETCH_BEGIN(k) unsigned long long st0_ = 0; if ((k) == MK_STRETCH_K) st0_ = __builtin_amdgcn_s_memrealtime();
#define STRETCH_END(k) if ((k) == MK_STRETCH_K) { const unsigned long long d_ = __builtin_amdgcn_s_memrealtime() - st0_; const unsigned long long t1_ = __builtin_amdgcn_s_memrealtime(); while (__builtin_amdgcn_s_memrealtime() - t1_ < 3 * d_) __builtin_amdgcn_s_sleep(4); }
#else
#define STRETCH_BEGIN(k)
#define STRETCH_END(k)
#endif
#if defined(MK_STRETCH_K) && defined(MK_STRETCH_SEG)
#define STRETCH_END5(k) if ((k) == MK_STRETCH_K && ((MK_STRETCH_SEG == 1) ? (nseg_ == 1) : (nseg_ >= 2))) { const unsigned long long d_ = __builtin_amdgcn_s_memrealtime() - st0_; const unsigned long long t1_ = __builtin_amdgcn_s_memrealtime(); while (__builtin_amdgcn_s_memrealtime() - t1_ < 3 * d_) __builtin_amdgcn_s_sleep(4); }
#else
#define STRETCH_END5(k) STRETCH_END(k)
#endif
#define SEAM(k) do { if (IN(k) && IN((k) + 1)) xcd_barrier(bar); } while (0)
#ifdef MK_ROUTER_PHASE
    constexpr bool RSEL = false;
#define SEAM_R(k) SEAM(k)
#else
    constexpr bool RSEL = true;
#define SEAM_R(k) do { if (IN(k) && IN((k) + 2)) xcd_barrier(bar); } while (0)
#endif
    bf16_t* XB = (bf16_t*)(F.ws + WS_XB); bf16_t* MBp = (bf16_t*)(F.ws + WS_MB); bf16_t* Pp = (bf16_t*)(F.ws + WS_P);
    float* RS0 = (float*)(F.ws + WS_RS0);
    const f32x2* rope = (const f32x2*)(F.ws + WS_ROPE);
    const int bid = (int)blockIdx.x;

    if (IN(0)) REP(0) { FRESH(); STRETCH_BEGIN(0)
#ifdef MK_P0_PROBE
        if (rep_ > 0) phase_p0<MK_P0_PROBE>(F); else
#endif
        phase_p0<14>(F); STRETCH_END(0) } SEAM(0);
    if (IN(1)) REP(1) { FRESH(); STRETCH_BEGIN(1) pg8::Gemm g{XB, (const bf16_t*)(F.ws + WS_WINE), T, 2048, 1024, 1024, 1024}; pg8::StaticOrder So; So.init(T, 2048, F.G, bid);
        EpiE1 E{(bf16_t*)F.out, RS0}; pg8::gemm_phase<EpiE1, pg8::StaticOrder, true, true>(F.lds, g, So, E); STRETCH_END(1) } SEAM(1);
#ifdef MK_XBAR
    for (int xb_ = 0; xb_ < MK_XBAR; ++xb_) xcd_barrier(bar);
#endif
    if (IN(2)) REP(2) { FRESH(); STRETCH_BEGIN(2) phase_e2(F); STRETCH_END(2) } SEAM(2);
    if (IN(3)) REP(3) { FRESH(); STRETCH_BEGIN(3) pg8::Gemm g{MBp, (const bf16_t*)(F.ws + WS_WOUTE), T, 1024, 1024, 1024, 1024}; pg8::StaticOrder So; So.init(T, 1024, F.G, bid);
        EpiResR<RSEL> E{XB, (const _Float16*)(F.ws + WS_ROUTER16), (float*)(F.ws + WS_PART), F.ws, F.in[22], F.in[24], ctl + CW_ECNT, ctl + CW_PCNT}; pg8::gemm_phase<EpiResR<RSEL>, pg8::StaticOrder, true, true>(F.lds, g, So, E); STRETCH_END(3) } SEAM_R(3);
#ifdef MK_ROUTER_PHASE
    if (IN(4)) REP(4) { FRESH(); STRETCH_BEGIN(4) phase_router<true>(F, 0); STRETCH_END(4) } SEAM(4);
#endif
    if (IN(5)) REP(5) { FRESH(); STRETCH_BEGIN(5)
#ifdef MK_MOE_PROBE
        if (rep_ > 0) { phase_moe<MK_MOE_PROBE>(F, 0); } else
#endif
        { const int nseg_ = phase_moe<0>(F, 0); (void)nseg_; STRETCH_END5(5) } } SEAM(5);
    if (IN(6)) REP(6) { FRESH(); STRETCH_BEGIN(6) combine_rows<false>(F);
 STRETCH_END(6) } SEAM(6);
#ifndef MK_O12_OFF
    if (IN(7)) REP(7) { FRESH(); STRETCH_BEGIN(7) pg8::Gemm g{XB, (const bf16_t*)(F.ws + WS_WINO), T, 1280, 1024, 1024, 1024}; O1mOrder So; So.init(bid);
        EpiO1 E{Pp, RS0, (float*)(F.ws + WS_SSQQ), (float*)(F.ws + WS_SSQKV), (bf16_t*)(F.ws + WS_KPE), rope};
        pg8::gemm_phase<EpiO1, O1mOrder, true, true>(F.lds, g, So, E);
        if (rep_ == 0 && (bid >> 3) >= 24) { LAS float* scr = (LAS float*)(F.lds + F.wave * 16384); CvtRegs R;
            const int nw = 64 * NWAVES, gw = ((bid & 7) * 8 + ((bid >> 3) - 24)) * NWAVES + F.wave;
            int it = gw; if (it < MOE_CVT_ITEMS) moe_cvt_load(F, 1, it, R);
            for (; it < MOE_CVT_ITEMS; it += nw) { moe_cvt_stage(F, 1, it, R, scr); if (it + nw < MOE_CVT_ITEMS) moe_cvt_load(F, 1, it + nw, R); moe_cvt_emit(F, 1, it, scr); } }
        STRETCH_END(7) }
    if (IN(7) && IN(8)) { asm volatile("s_waitcnt vmcnt(0)" ::: "memory"); __syncthreads(); }
    if (IN(8)) REP(8) { FRESH(); STRETCH_BEGIN(8) pg8::Gemm g{Pp, (const bf16_t*)(F.ws + WS_WUQ), T, 1792, 256, 1280, 256}; O2mOrder So; So.init(bid);
        EpiO2 E{(bf16_t*)(F.ws + WS_Q), (bf16_t*)(F.ws + WS_KV), (const float*)(F.ws + WS_SSQQ), (const float*)(F.ws + WS_SSQKV)};
        pg8::gemm_phase<EpiO2, O2mOrder, true, true>(F.lds, g, So, E);
    STRETCH_END(8) } SEAM(8);
#else
    if (IN(7)) REP(7) { FRESH(); STRETCH_BEGIN(7) pg8::Gemm g{XB, (const bf16_t*)(F.ws + WS_WINO), T, 1280, 1024, 1024, 1024}; pg8::StaticOrder So; So.init(T, 1280, F.G, bid);
        EpiO1 E{Pp, RS0, (float*)(F.ws + WS_SSQQ), (float*)(F.ws + WS_SSQKV), (bf16_t*)(F.ws + WS_KPE), rope};
        pg8::gemm_phase<EpiO1, pg8::StaticOrder, true, true>(F.lds, g, So, E);
        if (rep_ == 0 && (F.G != 256 || bid >= 64)) { LAS float* scr = (LAS float*)(F.lds + F.wave * 16384); CvtRegs R;
            const int nw = (F.G == 256) ? 192 * NWAVES : F.G * NWAVES, gw = ((F.G == 256) ? (bid - 64) : bid) * NWAVES + F.wave;
            int it = gw; if (it < MOE_CVT_ITEMS) moe_cvt_load(F, 1, it, R);
            for (; it < MOE_CVT_ITEMS; it += nw) { moe_cvt_stage(F, 1, it, R, scr); if (it + nw < MOE_CVT_ITEMS) moe_cvt_load(F, 1, it + nw, R); moe_cvt_emit(F, 1, it, scr); } } STRETCH_END(7) } SEAM(7);
    if (IN(8)) REP(8) { FRESH(); STRETCH_BEGIN(8) pg8::Gemm g{Pp, (const bf16_t*)(F.ws + WS_WUQ), T, 1792, 256, 1280, 256}; O2Order So; So.init(T, 1792, F.G, bid);
        EpiO2 E{(bf16_t*)(F.ws + WS_Q), (bf16_t*)(F.ws + WS_KV), (const float*)(F.ws + WS_SSQQ), (const float*)(F.ws + WS_SSQKV)};
        pg8::gemm_phase<EpiO2, O2Order, true, true>(F.lds, g, So, E);
    STRETCH_END(8) } SEAM(8);
#endif
    if (IN(9)) REP(9) { FRESH(); STRETCH_BEGIN(9)
#ifdef MK_ATT_PROBE
        if (rep_ > 0) phase_attn<MK_ATT_PROBE>(F); else
#endif
        phase_attn<0>(F); STRETCH_END(9) } SEAM(9);
    if (IN(10)) REP(10) { FRESH(); STRETCH_BEGIN(10) pg8::Gemm g{MBp, (const bf16_t*)(F.ws + WS_WOUTO), T, 1024, 1024, 1024, 1024}; pg8::StaticOrder So; So.init(T, 1024, F.G, bid);
        EpiResR<RSEL> E{XB, (const _Float16*)(F.ws + WS_ROUTER16) + 49152, (float*)(F.ws + WS_PART), F.ws, F.in[22] + 4, F.in[24] + 32, ctl + CW_ECNT + 32 * 64, ctl + CW_PCNT + 64 * 16}; pg8::gemm_phase<EpiResR<RSEL>, pg8::StaticOrder, true, true>(F.lds, g, So, E); STRETCH_END(10) } SEAM_R(10);
#ifdef MK_ROUTER_PHASE
    if (IN(11)) REP(11) { FRESH(); STRETCH_BEGIN(11) phase_router<true>(F, 1); STRETCH_END(11) } SEAM(11);
#endif
    if (IN(12)) REP(12) { FRESH(); STRETCH_BEGIN(12) phase_moe<0>(F, 1); STRETCH_END(12) } SEAM(12);
#ifdef MK_XCC_CHECK
    if (xb_xcc_id() != ((unsigned)blockIdx.x & 7u) && threadIdx.x == 0) atomicAdd(ctl + CW_TMO + 5, 1u);
#endif
    if (IN(13)) REP(13) { FRESH(); STRETCH_BEGIN(13) combine_rows<true>(F); STRETCH_END(13) }
#ifdef MK_XCC_CHECK
    { xcd_barrier(bar); const unsigned bad = __hip_atomic_load(ctl + CW_TMO + 5, __ATOMIC_RELAXED, __HIP_MEMORY_SCOPE_AGENT);
      if (bad) { for (int i = blockIdx.x * NTHR + threadIdx.x; i < T * D; i += gridDim.x * NTHR) F.out[i] *= (bad >= 128u ? 3.f : 2.f); } }
#endif
#undef IN
#undef SEAM
}

static int g_grid = 0;
static bool setup() {
    if (g_grid) return g_grid > 0;
    int dev = 0, cus = 0;
    if (hipGetDevice(&dev) != hipSuccess || hipDeviceGetAttribute(&cus, hipDeviceAttributeMultiprocessorCount, dev) != hipSuccess) { g_grid = -1; return false; }
    if (hipFuncSetAttribute((const void*)fwd_mega, hipFuncAttributeMaxDynamicSharedMemorySize, LDS_BYTES) != hipSuccess) { fprintf(stderr, "hipFuncSetAttribute failed\n"); g_grid = -1; return false; }
    int per_cu = 0;
    if (hipOccupancyMaxActiveBlocksPerMultiprocessor(&per_cu, (const void*)fwd_mega, NTHR, LDS_BYTES) != hipSuccess || per_cu < 1) { fprintf(stderr, "occupancy query: %d\n", per_cu); }
    (void)hipGetLastError();
    if (cus != 256) { fprintf(stderr, "fwd_mega is laid out for 256 CUs (one E3 / O4 tile per workgroup), found %d\n", cus); g_grid = -1; return false; }
    g_grid = cus;
    return true;
}
static void launch_range(void* const* d_in, float* out, unsigned char* ws, int lo, int hi, hipStream_t st, int li = 0) {
    Args a{};
    for (int i = 0; i < 28; ++i) a.in[i] = (const float*)d_in[i];
    a.out = out; a.ws = ws; a.ph_lo = lo; a.ph_hi = hi; a.li = li;
    hipLaunchKernelGGL(fwd_mega, dim3(g_grid), dim3(NTHR), LDS_BYTES, st, a);
}
}
extern "C" void kernel_launch(void* const* d_in, const int* in_sizes, int n_in, void* d_out, int out_size, void* d_ws, size_t ws_size, hipStream_t stream) {
    if (n_in != 28 || out_size != mk::T * mk::D || ws_size < mk::WS_END) { fprintf(stderr, "kernel_launch: unexpected shapes n_in %d out %d ws %zu\n", n_in, out_size, ws_size); return; }
    if (!mk::setup()) return;
    if (hipMemsetAsync((unsigned char*)d_ws + mk::WS_CTL, 0, mk::CTL_ZERO_BYTES, stream) != hipSuccess) { fprintf(stderr, "kernel_launch: memset failed\n"); return; }
#ifdef MK_SPLIT_K
    mk::launch_range(d_in, (float*)d_out, (unsigned char*)d_ws, 0, MK_SPLIT_K + 1, stream, 0);
#ifndef MK_SPLIT_NOREP
    mk::launch_range(d_in, (float*)d_out, (unsigned char*)d_ws, MK_SPLIT_K, MK_SPLIT_K + 1, stream);
#endif
    mk::launch_range(d_in, (float*)d_out, (unsigned char*)d_ws, MK_SPLIT_K + 1, mk::N_PHASES, stream, 1);
#else
    mk::launch_range(d_in, (float*)d_out, (unsigned char*)d_ws, 0, mk::N_PHASES, stream);
#endif
}
```

```cpp
#define MK_PF1 4
#define MK_PF2 8
#include <hip/hip_runtime.h>
#include <hip/hip_bf16.h>
#include <cstdio>
#include <cstdint>
namespace pg8 {
#define PG8_LAS __attribute__((address_space(3)))
typedef unsigned short bf16_t;
typedef short bf16x8 __attribute__((ext_vector_type(8)));
typedef float f32x4 __attribute__((ext_vector_type(4)));
typedef unsigned u32x4 __attribute__((ext_vector_type(4)));
constexpr int BM = 256, BK = 64, HALF = 128, HTB = HALF * BK * 2  , STAGE_BYTES = 8 * HTB, NXCD = 8, WGM = 8;

__host__ __device__ __forceinline__ int lds_byte(int r, int c) { const int st = (r >> 4) * 2 + (c >> 5), rr = r & 15, cc = c & 31, ob = rr * 64 + cc * 2; return st * 1024 + (ob ^ (((ob >> 9) & 1) << 5)); }
__host__ __device__ __forceinline__ void stage_rc(int b, int& R, int& C) { const int st = b / 1024, sb = b % 1024, swz = sb ^ (((sb >> 9) & 1) << 5); R = (st >> 1) * 16 + swz / 64; C = (st & 1) * 32 + (swz % 64) / 2; }
__host__ __device__ __forceinline__ int perm32(int rho) { const int n = rho >> 4, i = rho & 15; return 8 * (i >> 2) + 4 * n + (i & 3); }

struct Unit { int pm, pn, aoff; };
struct Gemm { const bf16_t* A; const bf16_t* Bt; int M, N, K, lda, ldb; };

struct StaticOrder {
    int nM, nN, nwg, G, c;
    __host__ __device__ void init(int M, int N, int G_, int c_) { nM = M / BM; nN = N / BM; nwg = nM * nN; G = G_; c = c_; }
    __host__ __device__ bool next(int i, Unit& u) const {
        const long L = (long)i * G + c; if (L >= nwg) return false;
        int wgid = (int)L; { const int q = nwg / NXCD, r = nwg % NXCD, xcd = wgid % NXCD, off = wgid / NXCD; wgid = (xcd < r ? xcd * (q + 1) : r * (q + 1) + (xcd - r) * q) + off; }
        const int nig = WGM * nN, gid = wgid / nig, fm = gid * WGM, gsz = (nM - fm) < WGM ? (nM - fm) : WGM;
        u.pm = fm + ((wgid % nig) % gsz); u.pn = (wgid % nig) / gsz; u.aoff = 0; return true;
    }
    __device__ __forceinline__ void a_ready(const Unit&) const {}
    __device__ __forceinline__ void done(const Unit&) const {}
};

__device__ __forceinline__ unsigned cvt_pk_bf16(float lo, float hi) { unsigned r; asm volatile("v_cvt_pk_bf16_f32 %0, %1, %2" : "=v"(r) : "v"(lo), "v"(hi)); return r; }
typedef float f32x2 __attribute__((ext_vector_type(2)));
template <class Epi, class Sched, bool ALIGN_EPI = false, bool SP2 = false>
__device__ __forceinline__ void gemm_phase(PG8_LAS unsigned char* lds, const Gemm g, const Sched& S, const Epi& E) {
    int tid_ = threadIdx.x; asm volatile("" : "+v"(tid_));
    const int tid = tid_, wid = __builtin_amdgcn_readfirstlane(tid >> 6), lane = tid & 63, wr = wid >> 2, wc = wid & 3, fr = lane & 15, fq = lane >> 4;
    const int K = g.K, nt = K / BK;
    unsigned voffA[2], voffB[2];
#pragma unroll
    for (int i = 0; i < 2; ++i) { int R, C; stage_rc(tid * 16 + i * 8192, R, C); const int Rb = Epi::PERM ? ((R & ~31) + perm32(R & 31)) : R;
        voffA[i] = (unsigned)(R * g.lda + C) * 2u; voffB[i] = (unsigned)(Rb * g.ldb + C) * 2u; }
    const size_t kstep = (size_t)(BK * 2);
    const size_t hstepA = (size_t)HALF * g.lda * 2, hstepB = (size_t)HALF * g.ldb * 2;
    const size_t tstepA = 2 * hstepA, tstepB = 2 * hstepB;
    const unsigned ldsw = (unsigned)wid * 1024u;
    const int aoff = lds_byte(wr * 64 + fr, fq * 8), boff = lds_byte(wc * 32 + fr, fq * 8);
#define PG8_SA(b, h) (((b) * 2 + (h)) * HTB)
#define PG8_SB(b, h) ((4 + (b) * 2 + (h)) * HTB)
#define PG8_STAGE(bufoff, gbase, voff) do { _Pragma("unroll") for (int _i = 0; _i < 2; ++_i) \
        __builtin_amdgcn_global_load_lds((const unsigned*)((const char*)(gbase) + (voff)[_i]), (PG8_LAS unsigned*)(lds + (bufoff) + ldsw + _i * 8192), 16, 0, 0); } while (0)
#define PG8_LDA(dst, b, h) do { _Pragma("unroll") for (int m = 0; m < 4; ++m) _Pragma("unroll") for (int k = 0; k < 2; ++k) dst[m][k] = *(const PG8_LAS bf16x8*)(lds + PG8_SA(b, h) + aoff + m * 2048 + k * 1024); } while (0)
#define PG8_LDB(dst, b, h) do { _Pragma("unroll") for (int n = 0; n < 2; ++n) _Pragma("unroll") for (int k = 0; k < 2; ++k) dst[n][k] = *(const PG8_LAS bf16x8*)(lds + PG8_SB(b, h) + boff + n * 2048 + k * 1024); } while (0)
#define PG8_MMA(ai, bj, At, Bt) do { __builtin_amdgcn_s_setprio(1); _Pragma("unroll") for (int m = 0; m < 4; ++m) _Pragma("unroll") for (int n = 0; n < 2; ++n) _Pragma("unroll") for (int k = 0; k < 2; ++k) \
        acc[ai][bj][m][n] = __builtin_amdgcn_mfma_f32_16x16x32_bf16(Bt[n][k], At[m][k], acc[ai][bj][m][n], 0, 0, 0); __builtin_amdgcn_s_setprio(0); } while (0)
#define PG8_WAIT_V(n) asm volatile("s_waitcnt vmcnt(" #n ")" ::: "memory")
#define PG8_WAIT_L(n) asm volatile("s_waitcnt lgkmcnt(" #n ")" ::: "memory")
#define PG8_BAR __builtin_amdgcn_s_barrier()
#define PG8_SCHED __builtin_amdgcn_sched_barrier(0)
    Unit cur, nxt; int ui = 0;
    if (!S.next(0, cur)) return;
    f32x4 acc[2][2][4][2];
#pragma unroll
    for (int a = 0; a < 2; ++a)
#pragma unroll
        for (int b = 0; b < 2; ++b)
#pragma unroll
            for (int m = 0; m < 4; ++m)
#pragma unroll
                for (int n = 0; n < 2; ++n) acc[a][b][m][n] = (f32x4){0.f, 0.f, 0.f, 0.f};
    bf16x8 At[4][2], B0[2][2], B1[2][2];
    const char* cA = (const char*)g.A + (size_t)cur.pm * tstepA + cur.aoff; const char* cB = (const char*)g.Bt + (size_t)cur.pn * tstepB;
    S.a_ready(cur);
    if constexpr (SP2) {
        PG8_STAGE(PG8_SB(0, 0), cB, voffB); PG8_STAGE(PG8_SB(0, 1), cB + hstepB, voffB); PG8_STAGE(PG8_SA(0, 0), cA, voffA); PG8_STAGE(PG8_SA(0, 1), cA + hstepA, voffA);
        if (wr == 1) PG8_BAR;
        PG8_WAIT_V(2); PG8_BAR;
        PG8_STAGE(PG8_SB(1, 0), cB + kstep, voffB); PG8_STAGE(PG8_SA(1, 0), cA + kstep, voffA); PG8_STAGE(PG8_SB(1, 1), cB + hstepB + kstep, voffB);
        PG8_WAIT_V(6); PG8_BAR;
    } else {
        PG8_STAGE(PG8_SB(0, 0), cB, voffB); PG8_STAGE(PG8_SA(0, 0), cA, voffA); PG8_STAGE(PG8_SB(0, 1), cB + hstepB, voffB); PG8_STAGE(PG8_SA(0, 1), cA + hstepA, voffA);
        if (wr == 1) PG8_BAR;
        PG8_WAIT_V(4); PG8_BAR;
        PG8_STAGE(PG8_SB(1, 0), cB + kstep, voffB); PG8_STAGE(PG8_SA(1, 0), cA + kstep, voffA); PG8_STAGE(PG8_SB(1, 1), cB + hstepB + kstep, voffB);
        PG8_WAIT_V(6); PG8_BAR;
    }
    for (;;) {
        const bool has_next = S.next(ui + 1, nxt);
        const char* nA = has_next ? (const char*)g.A + (size_t)nxt.pm * tstepA + nxt.aoff : cA; const char* nB = has_next ? (const char*)g.Bt + (size_t)nxt.pn * tstepB : cB;
        for (int t = 0; t < nt; t += 2) {
            const bool last = (t == nt - 2);
            const char* a1 = cA + (size_t)(t + 1) * kstep;
            const char* a2 = last ? nA : cA + (size_t)(t + 2) * kstep; const char* b2 = last ? nB : cB + (size_t)(t + 2) * kstep;
            const char* a3 = a2 + kstep; const char* b3 = b2 + kstep;
            if (last && has_next) S.a_ready(nxt);
            if constexpr (SP2) {
            PG8_LDB(B0, 0, 0); PG8_LDB(B1, 0, 1); PG8_SCHED; PG8_LDA(At, 0, 0); PG8_STAGE(PG8_SA(1, 1), a1 + hstepA, voffA);
            PG8_WAIT_V(8); PG8_WAIT_L(0); PG8_BAR; PG8_MMA(0, 0, At, B0); PG8_MMA(0, 1, At, B1); PG8_BAR; PG8_SCHED;
            PG8_LDA(At, 0, 1); PG8_STAGE(PG8_SB(0, 0), b2, voffB); PG8_STAGE(PG8_SB(0, 1), b2 + hstepB, voffB); PG8_STAGE(PG8_SA(0, 0), a2, voffA);
            PG8_WAIT_V(8); PG8_WAIT_L(0); PG8_BAR; PG8_MMA(1, 0, At, B0); PG8_MMA(1, 1, At, B1); PG8_BAR; PG8_SCHED;
            PG8_LDB(B0, 1, 0); PG8_LDB(B1, 1, 1); PG8_SCHED; PG8_LDA(At, 1, 0); PG8_STAGE(PG8_SA(0, 1), a2 + hstepA, voffA);
            PG8_WAIT_V(8); PG8_WAIT_L(0); PG8_BAR; PG8_MMA(0, 0, At, B0); PG8_MMA(0, 1, At, B1); PG8_BAR; PG8_SCHED;
            PG8_LDA(At, 1, 1); PG8_STAGE(PG8_SB(1, 0), b3, voffB); PG8_STAGE(PG8_SB(1, 1), b3 + hstepB, voffB); PG8_STAGE(PG8_SA(1, 0), a3, voffA);
            PG8_WAIT_V(8); PG8_WAIT_L(0); PG8_BAR; PG8_MMA(1, 0, At, B0); PG8_MMA(1, 1, At, B1); PG8_BAR; PG8_SCHED;
            } else {
            PG8_LDB(B0, 0, 0); PG8_SCHED; PG8_LDA(At, 0, 0); PG8_STAGE(PG8_SA(1, 1), a1 + hstepA, voffA);
            PG8_WAIT_L(8); PG8_BAR; PG8_WAIT_L(0); PG8_MMA(0, 0, At, B0); PG8_BAR; PG8_SCHED;
            PG8_LDB(B1, 0, 1); PG8_STAGE(PG8_SB(0, 0), b2, voffB);
            PG8_BAR; PG8_WAIT_L(0); PG8_MMA(0, 1, At, B1); PG8_BAR;
            PG8_LDA(At, 0, 1); PG8_STAGE(PG8_SA(0, 0), a2, voffA);
            PG8_BAR; PG8_WAIT_L(0); PG8_MMA(1, 0, At, B0); PG8_BAR; PG8_SCHED;
            PG8_STAGE(PG8_SB(0, 1), b2 + hstepB, voffB);
            PG8_WAIT_V(6); PG8_BAR; PG8_MMA(1, 1, At, B1); PG8_BAR;
            PG8_LDB(B0, 1, 0); PG8_SCHED; PG8_LDA(At, 1, 0); PG8_STAGE(PG8_SA(0, 1), a2 + hstepA, voffA);
            PG8_WAIT_L(8); PG8_BAR; PG8_WAIT_L(0); PG8_MMA(0, 0, At, B0); PG8_BAR; PG8_SCHED;
            PG8_LDB(B1, 1, 1); PG8_STAGE(PG8_SB(1, 0), b3, voffB);
            PG8_BAR; PG8_WAIT_L(0); PG8_MMA(0, 1, At, B1); PG8_BAR;
            PG8_LDA(At, 1, 1); PG8_STAGE(PG8_SA(1, 0), a3, voffA);
            PG8_BAR; PG8_WAIT_L(0); PG8_MMA(1, 0, At, B0); PG8_BAR; PG8_SCHED;
            PG8_STAGE(PG8_SB(1, 1), b3 + hstepB, voffB);
            PG8_WAIT_V(6); PG8_BAR; PG8_MMA(1, 1, At, B1); PG8_BAR;
            }
        }
        if constexpr (ALIGN_EPI) { if (wr == 0) PG8_BAR; }
        if constexpr (!Epi::AFTER_DRAIN) { E(acc, cur, wr, wc, fr, fq); S.done(cur); }
        if (!has_next) break;
#pragma unroll
        for (int a = 0; a < 2; ++a)
#pragma unroll
            for (int b = 0; b < 2; ++b)
#pragma unroll
                for (int m = 0; m < 4; ++m)
#pragma unroll
                    for (int n = 0; n < 2; ++n) acc[a][b][m][n] = (f32x4){0.f, 0.f, 0.f, 0.f};
        cur = nxt; cA = nA; cB = nB; ++ui;
        if constexpr (ALIGN_EPI) { if (wr == 1) PG8_BAR; }
    }
    PG8_WAIT_V(0);
    if constexpr (!ALIGN_EPI) { if (wr == 0) PG8_BAR; }
    PG8_BAR;
    if constexpr (Epi::AFTER_DRAIN) { E.fused(acc, cur, wr, wc, fr, fq, lds, wid, lane); S.done(cur); }
#undef PG8_SA
#undef PG8_SB
#undef PG8_STAGE
#undef PG8_LDA
#undef PG8_LDB
#undef PG8_MMA
#undef PG8_WAIT_V
#undef PG8_WAIT_L
#undef PG8_BAR
#undef PG8_SCHED
}
}
namespace mk {
using pg8::bf16_t; using pg8::bf16x8; using pg8::f32x4; using pg8::u32x4; using pg8::f32x2;
typedef float f32x16 __attribute__((ext_vector_type(16)));
typedef unsigned u32x2 __attribute__((ext_vector_type(2)));
typedef short s16x4 __attribute__((ext_vector_type(4)));
typedef _Float16 f16x8 __attribute__((ext_vector_type(8)));
#define GAS __attribute__((address_space(1)))
#define LAS __attribute__((address_space(3)))
typedef GAS unsigned gu32;
#define RLX_AGENT __ATOMIC_RELAXED, __HIP_MEMORY_SCOPE_AGENT
#define LDS_WAIT() asm volatile("s_waitcnt lgkmcnt(0)" ::: "memory")
#define VM_WAIT() asm volatile("s_waitcnt vmcnt(0)" ::: "memory")

constexpr int T = 16384, D = 1024, S = 2048, NB = 8;
constexpr int NWAVES = 8, NTHR = 512;
constexpr float EPS = 1e-6f;
constexpr float LOG2E = 1.4426950408889634f;
constexpr float C2M = 0.10206207261596575f * LOG2E;
constexpr float C2S = 0.125f * LOG2E;

constexpr size_t MiB = (size_t)1 << 20;
constexpr size_t WS_CTL = 0, CTL_ZERO_BYTES = 512 * 1024;
constexpr size_t WS_WINE = 1 * MiB;
constexpr size_t WS_WOUTE = 5 * MiB;
constexpr size_t WS_WINO = 7 * MiB;
constexpr size_t WS_WUQ = 10 * MiB;
constexpr size_t WS_WUKV = 10 * MiB + 393216;
constexpr size_t WS_WOUTO = 11 * MiB;
constexpr size_t WS_ROUTER = 13 * MiB;
constexpr size_t WS_ROUTER16 = WS_ROUTER + 393216;
constexpr size_t WS_ROPE = 14 * MiB;
constexpr size_t WS_RS0 = 14 * MiB + 512 * 1024;
constexpr size_t WS_RSM = WS_RS0 + 64 * 1024;
constexpr size_t WS_SSQQ = 15 * MiB;
constexpr size_t WS_SSQKV = 15 * MiB + 256 * 1024;
constexpr size_t WS_WMOE = 16 * MiB;
constexpr size_t WS_XB = 64 * MiB;
constexpr size_t WS_MB = 96 * MiB;
constexpr size_t WS_Y = 128 * MiB;
constexpr size_t WS_PART = 128 * MiB;
constexpr size_t WS_Q = 128 * MiB;
constexpr size_t WS_KV = 152 * MiB;
constexpr size_t WS_P = 192 * MiB;
constexpr size_t WS_LSLOT = 232 * MiB;
constexpr size_t WS_LGW = 234 * MiB;
constexpr size_t WS_KPE = 236 * MiB;
constexpr size_t WS_LRS = 238 * MiB;
constexpr size_t WS_END = 240 * MiB;
constexpr size_t W1_EXP = 524288, W2_EXP = 262144;
constexpr size_t WMOE_LAYER = 24 * MiB, WMOE_W2 = 16 * MiB;
constexpr float WSCALE = 64.f, WDESCALE = 1.f / 64.f;

constexpr int CW_TMO = 0;
constexpr int CW_BAR = 4096;
constexpr int CW_CVT = 8192;
constexpr int CW_PCNT = 24576;
constexpr int CW_ROWQ = 28672;
constexpr int CW_READY = 32768;
constexpr int CW_ECNT = 16384;

constexpr int LDS_BYTES = 160 * 1024;
constexpr int RING_BYTES = 131072;
constexpr int MISC_OFF = 159 * 1024;

__device__ __forceinline__ unsigned f2bf(float f) { unsigned u = __builtin_bit_cast(unsigned, f); return (u + 0x7fffu + ((u >> 16) & 1u)) >> 16; }
__device__ __forceinline__ float bf2f(unsigned h) { return __builtin_bit_cast(float, h << 16); }
__device__ __forceinline__ unsigned pk2(float lo, float hi) { return pg8::cvt_pk_bf16(lo, hi); }
__device__ __forceinline__ float row16_sum(float v) {
    v += __builtin_bit_cast(float, __builtin_amdgcn_update_dpp(0, __builtin_bit_cast(int, v), 0xB1, 0xF, 0xF, true));
    v += __builtin_bit_cast(float, __builtin_amdgcn_update_dpp(0, __builtin_bit_cast(int, v), 0x4E, 0xF, 0xF, true));
    v += __builtin_bit_cast(float, __builtin_amdgcn_update_dpp(0, __builtin_bit_cast(int, v), 0x141, 0xF, 0xF, true));
    v += __builtin_bit_cast(float, __builtin_amdgcn_update_dpp(0, __builtin_bit_cast(int, v), 0x140, 0xF, 0xF, true));
    return v;
}
__device__ __forceinline__ float xsum16(float v) { const unsigned u = __builtin_bit_cast(unsigned, v); const auto rr = __builtin_amdgcn_permlane16_swap(u, u, false, false); return __builtin_bit_cast(float, (unsigned)rr[0]) + __builtin_bit_cast(float, (unsigned)rr[1]); }
__device__ __forceinline__ float xsum32(float v) { const unsigned u = __builtin_bit_cast(unsigned, v); const auto rr = __builtin_amdgcn_permlane32_swap(u, u, false, false); return __builtin_bit_cast(float, (unsigned)rr[0]) + __builtin_bit_cast(float, (unsigned)rr[1]); }
__device__ __forceinline__ float wave_sum(float v) { return xsum32(xsum16(row16_sum(v))); }
__device__ __forceinline__ float fast_exp2(float x) { return __builtin_amdgcn_exp2f(x); }
__device__ __forceinline__ float fast_rcp(float x) { return __builtin_amdgcn_rcpf(x); }
__device__ __forceinline__ float sigmoid_f(float x) { return fast_rcp(1.f + fast_exp2(-x * LOG2E)); }
__device__ __forceinline__ float silu_f(float x) { return x * sigmoid_f(x); }
__device__ __forceinline__ float gelu_f(float x) { const float u = 0.7978845608028654f * (x + 0.044715f * x * x * x); return x * sigmoid_f(2.f * u); }
__device__ __forceinline__ f32x2 rcp2_(f32x2 d) { f32x2 r; r.x = fast_rcp(d.x); r.y = fast_rcp(d.y); return r; }
__device__ __forceinline__ f32x2 exp2_2_(f32x2 z) { f32x2 r; r.x = fast_exp2(z.x); r.y = fast_exp2(z.y); return r; }
constexpr float GC1 = -2.f * 0.7978845608028654f * LOG2E, GC2 = GC1 * 0.044715f;
__device__ __forceinline__ f32x2 gelu2_f(f32x2 x) { const f32x2 t = x * x; const f32x2 z = x * (t * GC2 + GC1); return x * rcp2_(exp2_2_(z) + 1.f); }
__device__ __forceinline__ f32x2 mul_sigmoid2_f(f32x2 a, f32x2 zn) { return a * rcp2_(exp2_2_(zn) + 1.f); }

#define XB_TMO      128
#define XB_XCNT(j)  (256  + 64 * (j))
#define XB_XSUB(j)  (1280 + 64 * (j))
#define XB_XGEN(j)  (2304 + 64 * (j))
#define XB_TOP      3328
#define XB_TOPGEN   3392
#define XCD_BAR_WORDS 3456
#define XB_SPIN_CAP (1u << 18)
__device__ __forceinline__ unsigned xb_ld(unsigned* p)              { return __hip_atomic_load(p, __ATOMIC_RELAXED, __HIP_MEMORY_SCOPE_AGENT); }
__device__ __forceinline__ unsigned xb_add(unsigned* p, unsigned v) { return __hip_atomic_fetch_add(p, v, __ATOMIC_RELAXED, __HIP_MEMORY_SCOPE_AGENT); }
__device__ __forceinline__ unsigned xb_xcc_id() { return (unsigned)__builtin_amdgcn_s_getreg((3 << 11) | 20) & 0xFu; }
#define XB_SPIN(cond, bar) do { unsigned _sp = 0; while (cond) { __builtin_amdgcn_s_sleep(1); \
    if ((++_sp & 255u) == 0u) { if (xb_ld(&(bar)[XB_TMO])) break; if (_sp > XB_SPIN_CAP) { atomicAdd(&(bar)[XB_TMO], 1u); break; } } } } while (0)
struct XcdBarrier { unsigned* bar; unsigned x; volatile LAS unsigned* st; };
__device__ __forceinline__ XcdBarrier xcd_barrier_post(unsigned* bar, volatile LAS unsigned* st) {
    XcdBarrier b; b.bar = bar; b.x = xb_xcc_id(); b.st = st;
    if (threadIdx.x == 0) (void)xb_add(&bar[XB_XCNT(b.x)], 1u);
    return b;
}
__device__ __forceinline__ void xcd_barrier_complete(unsigned* bar, unsigned x, unsigned& nloc, unsigned& nx) {
    const unsigned G = gridDim.x * gridDim.y * gridDim.z;
    unsigned sum, cnt, mine, sp = 0u;
    for (;;) {
        sum = 0u; cnt = 0u; mine = 0u;
#pragma unroll
        for (unsigned j = 0; j < 16; ++j) { const unsigned c = xb_ld(&bar[XB_XCNT(j)]); sum += c; cnt += (c > 0u) ? 1u : 0u; mine = (j == x) ? c : mine; }
        if (sum == G) break;
        __builtin_amdgcn_s_sleep(1);
        if ((++sp & 255u) == 0u) { if (xb_ld(&bar[XB_TMO])) break; if (sp > XB_SPIN_CAP) { atomicAdd(&bar[XB_TMO], 1u); break; } }
    }
    nloc = mine > 0u ? mine : 1u; nx = cnt > 0u ? cnt : 1u;
}
__device__ __forceinline__ void xcd_barrier(const XcdBarrier& b) {
    asm volatile("s_waitcnt vmcnt(0)" ::: "memory");
    __syncthreads();
    if (threadIdx.x == 0) {
        unsigned* bar = b.bar;
        __builtin_amdgcn_s_waitcnt(0);
        unsigned nloc = b.st[0], nx = b.st[1];
        if (nloc == 0u) { xcd_barrier_complete(bar, b.x, nloc, nx); b.st[0] = nloc; b.st[1] = nx; }
        const unsigned old = xb_add(&bar[XB_XSUB(b.x)], 1u);
        const unsigned gen = old / nloc;
        if (old + 1u == (gen + 1u) * nloc) {
            __builtin_amdgcn_fence(__ATOMIC_RELEASE, "agent");
            asm volatile("s_waitcnt vmcnt(0)" ::: "memory");
            const unsigned og = xb_add(&bar[XB_TOP], 1u);
            const unsigned tg = og / nx;
            if (og + 1u == (tg + 1u) * nx) xb_add(&bar[XB_TOPGEN], 1u);
            else XB_SPIN(xb_ld(&bar[XB_TOPGEN]) == tg, bar);
            xb_add(&bar[XB_XGEN(b.x)], 1u);
            __builtin_amdgcn_fence(__ATOMIC_ACQUIRE, "agent");
            asm volatile("s_waitcnt vmcnt(0)" ::: "memory");
        } else {
            XB_SPIN(xb_ld(&bar[XB_XGEN(b.x)]) == gen, bar);
            __builtin_amdgcn_fence(__ATOMIC_ACQUIRE, "agent");
            asm volatile("s_waitcnt vmcnt(0)" ::: "memory");
        }
    }
    __syncthreads();
}

__device__ __forceinline__ __amdgpu_buffer_rsrc_t uniform_rsrc(const void* p, unsigned bytes) {
    const unsigned long long a = (unsigned long long)p;
    const unsigned lo = __builtin_amdgcn_readfirstlane((unsigned)a), hi = __builtin_amdgcn_readfirstlane((unsigned)(a >> 32));
    return __builtin_amdgcn_make_buffer_rsrc((void*)(((unsigned long long)hi << 32) | lo), 0, bytes, 0x00020000);
}
__device__ __forceinline__ void st16_wt(__amdgpu_buffer_rsrc_t r, unsigned byte_off, u32x4 v) { __builtin_amdgcn_raw_buffer_store_b128(v, r, byte_off, 0, 0); }
__device__ __forceinline__ void st16_wt(__amdgpu_buffer_rsrc_t r, unsigned byte_off, f32x4 v) { __builtin_amdgcn_raw_buffer_store_b128(__builtin_bit_cast(u32x4, v), r, byte_off, 0, 0); }

struct Args { const float* in[28]; float* out; unsigned char* ws; int ph_lo, ph_hi, li, pad; };

struct Frame {
    LAS unsigned char* lds;
    int tid, lane, wave, vcu, G;
    const float* const* in;
    float* out; unsigned char* ws;
};
}
namespace mk {
__device__ __forceinline__ void p0_transpose_item(const float* W, int ldn, int k0, int src_n0, bf16_t* WT, int ldk, int dst_n0,
                                                  const float* gain, float scale, LAS float* scr, int lane) {
    if (src_n0 >= 0) {
#pragma unroll 8
        for (int i = 0; i < 32; ++i) { const int kk = 2 * i + (lane >> 5);
            float v = W[(size_t)(k0 + kk) * ldn + src_n0 + (lane & 31)] * scale; if (gain) v *= gain[k0 + kk];
            scr[kk * 33 + (lane & 31)] = v; }
    } else {
#pragma unroll 8
        for (int i = 0; i < 32; ++i) { const int kk = 2 * i + (lane >> 5); scr[kk * 33 + (lane & 31)] = 0.f; }
    }
    LDS_WAIT(); asm volatile("" ::: "memory");
    const int c = lane & 7;
#pragma unroll
    for (int j = 0; j < 4; ++j) { const int n = (lane >> 3) + 8 * j; const LAS float* s = scr + (8 * c) * 33 + n;
        u32x4 o; o.x = pk2(s[0 * 33], s[1 * 33]); o.y = pk2(s[2 * 33], s[3 * 33]); o.z = pk2(s[4 * 33], s[5 * 33]); o.w = pk2(s[6 * 33], s[7 * 33]);
        *(GAS u32x4*)(WT + (size_t)(dst_n0 + n) * ldk + k0 + 8 * c) = o; }
    LDS_WAIT(); asm volatile("" ::: "memory");
}
template <bool STAGE2>
__device__ __forceinline__ void moe_cvt_tile(const float* src, int ld, const float* gain16, bf16_t* dst0, size_t piece_stride  , LAS float* scr, int lane) {
#pragma unroll 4
    for (int i = 0; i < 16; ++i) { f32x4 v = *(const GAS f32x4*)(src + (size_t)i * ld + 4 * lane); if (gain16) v = v * gain16[i]; *(LAS f32x4*)(scr + i * 256 + 4 * lane) = v; }
    LDS_WAIT(); asm volatile("" ::: "memory");
    const int r = lane & 31, h = lane >> 5;
#pragma unroll
    for (int c = 0; c < 8; ++c) {
        float v[8];
#pragma unroll
        for (int j = 0; j < 8; ++j) { const int row = STAGE2 ? (8 * (j >> 2) + 4 * h + (j & 3)) : (8 * h + j); v[j] = scr[row * 256 + 32 * c + r]; }
        u32x4 o; o.x = pk2(v[0], v[1]); o.y = pk2(v[2], v[3]); o.z = pk2(v[4], v[5]); o.w = pk2(v[6], v[7]);
        *(GAS u32x4*)(dst0 + (size_t)c * piece_stride + (size_t)lane * 8) = o;
    }
    LDS_WAIT(); asm volatile("" ::: "memory");
}
constexpr int MOE_CVT_ITEMS = 6144;
struct CvtRegs { f32x4 v[16]; };
__device__ __forceinline__ void moe_cvt_load(const Frame& F, int layer, int it, CvtRegs& R) {
    const float* src; int ld;
    if (it < 4096) { const int gu = it & 1, r = it >> 1, e = r >> 6, ks = r & 63; src = (gu ? F.in[26] : F.in[25]) + ((size_t)(layer * 32 + e) * 1024 + 16 * ks) * 256; ld = 256; }
    else { const int r = it - 4096, e = r >> 6, kk = (r >> 2) & 15, dq = r & 3; src = F.in[27] + ((size_t)(layer * 32 + e) * 256 + 16 * kk) * 1024 + 256 * dq; ld = 1024; }
#pragma unroll
    for (int i = 0; i < 16; ++i) R.v[i] = __builtin_nontemporal_load((const GAS f32x4*)(src + (size_t)i * ld + 4 * F.lane));
}
__device__ __forceinline__ void moe_cvt_stage(const Frame& F, int layer, int it, const CvtRegs& R, LAS float* scr) {
    if (it < 4096) { const int ks = (it >> 1) & 63; const float* gain = F.in[2] + layer * 1024 + 16 * ks;
#pragma unroll
        for (int i = 0; i < 16; ++i) *(LAS f32x4*)(scr + i * 256 + 4 * F.lane) = R.v[i] * (gain[i] * WSCALE);
    } else {
#pragma unroll
        for (int i = 0; i < 16; ++i) *(LAS f32x4*)(scr + i * 256 + 4 * F.lane) = R.v[i] * WSCALE;
    }
    LDS_WAIT(); asm volatile("" ::: "memory");
}
__device__ __forceinline__ void moe_cvt_emit(const Frame& F, int layer, int it, LAS float* scr) {
    unsigned char* W1 = F.ws + WS_WMOE + (size_t)layer * WMOE_LAYER; unsigned char* W2 = W1 + WMOE_W2;
    const int rr = F.lane & 31, h = F.lane >> 5;
    const bool s2 = it >= 4096;
    unsigned char* base; size_t st_c2, st_dt;
    if (!s2) { const int gu = it & 1, r = it >> 1, e = r >> 6, ks = r & 63; base = W1 + (size_t)e * W1_EXP + (size_t)ks * 1024 + gu * 8; st_c2 = 2 * 65536; st_dt = 65536; }
    else { const int r = it - 4096, e = r >> 6, kk = (r >> 2) & 15, dq = r & 3; const int p = dq >> 1, w0 = (dq & 1) * 4;
        base = W2 + (size_t)e * W2_EXP + ((size_t)(p * 8 + w0) * 16 + kk) * 1024; st_c2 = 16 * 1024; st_dt = 8; }
#pragma unroll
    for (int c = 0; c < 8; ++c) {
        float v[8];
#pragma unroll
        for (int j = 0; j < 8; ++j) { const int row = s2 ? (8 * (j >> 2) + 4 * h + (j & 3)) : (8 * h + j); v[j] = scr[row * 256 + 32 * c + rr]; }
        int w0_ = __builtin_amdgcn_cvt_pk_fp8_f32(v[0], v[1], 0, false); w0_ = __builtin_amdgcn_cvt_pk_fp8_f32(v[2], v[3], w0_, true);
        int w1_ = __builtin_amdgcn_cvt_pk_fp8_f32(v[4], v[5], 0, false); w1_ = __builtin_amdgcn_cvt_pk_fp8_f32(v[6], v[7], w1_, true);
        u32x2 o; o.x = (unsigned)w0_; o.y = (unsigned)w1_;
        *(GAS u32x2*)(base + (size_t)(c >> 1) * st_c2 + (size_t)(c & 1) * st_dt + (size_t)F.lane * 16) = o;
    }
    LDS_WAIT(); asm volatile("" ::: "memory");
}
__device__ __forceinline__ void row_to_bf16_rs(const float* xrow, bf16_t* orow, float* rs, int lane) {
    const GAS f32x4* xr = (const GAS f32x4*)xrow + lane;
    f32x4 v[4]; float s = 0.f;
#pragma unroll
    for (int j = 0; j < 4; ++j) { v[j] = __builtin_nontemporal_load(xr + 64 * j); s += (v[j].x * v[j].x + v[j].y * v[j].y) + (v[j].z * v[j].z + v[j].w * v[j].w); }
    s = wave_sum(s);
    GAS u32x2* o8 = (GAS u32x2*)orow + lane;
#pragma unroll
    for (int j = 0; j < 4; ++j) { u32x2 w; w.x = pk2(v[j].x, v[j].y); w.y = pk2(v[j].z, v[j].w); o8[64 * j] = w; }
    if (lane == 0) *rs = 1.0f / sqrtf(s * (1.f / 1024.f) + EPS);
}

__device__ __forceinline__ void p0_t64(const float* W, int ldn, int k0, int s0, int s1, bf16_t* WT, int ldk, int dst_n0, int dk0, const float* gain, float sc0, float sc1, LAS float* scr, int lane) {
    const int half = (lane >> 3) & 1, src = half ? s1 : s0; const float sc = half ? sc1 : sc0;
    const int rr = lane >> 4, cc = (lane & 15) * 4;
    f32x4 v[16];
#pragma unroll
    for (int i = 0; i < 16; ++i) { const int kk = 4 * i + rr;
        v[i] = (src >= 0) ? __builtin_nontemporal_load((const GAS f32x4*)(W + (size_t)(k0 + kk) * ldn + src + (lane & 7) * 4)) : (f32x4){0.f, 0.f, 0.f, 0.f}; }
#pragma unroll
    for (int i = 0; i < 16; ++i) { const int kk = 4 * i + rr; const float g = (gain ? gain[k0 + kk] : 1.f) * sc; const f32x4 x = v[i] * g;
        LAS float* d = scr + kk * 65 + cc; d[0] = x.x; d[1] = x.y; d[2] = x.z; d[3] = x.w; }
    LDS_WAIT(); asm volatile("" ::: "memory");
    const int c = lane & 7;
#pragma unroll
    for (int j = 0; j < 8; ++j) { const int n = (lane >> 3) + 8 * j; const LAS float* s = scr + (8 * c) * 65 + n;
        u32x4 o; o.x = pk2(s[0 * 65], s[1 * 65]); o.y = pk2(s[2 * 65], s[3 * 65]); o.z = pk2(s[4 * 65], s[5 * 65]); o.w = pk2(s[6 * 65], s[7 * 65]);
        *(GAS u32x4*)(WT + (size_t)(dst_n0 + n) * ldk + dk0 + 8 * c) = o; }
    LDS_WAIT(); asm volatile("" ::: "memory");
}
__device__ __forceinline__ void p0_dense_item(const Frame& F, int it, LAS float* scr) {
    int r = it;
    if (r < 512) { const int kb = r >> 5, nb = r & 31; const int n = 64 * nb; int src;
        if (n < 1024) { const int j = n >> 8, c = n & 255; src = (c < 128) ? (128 * j + c) : (512 + 128 * j + (c - 128)); } else src = n;
        p0_t64(F.in[4], 2048, 64 * kb, src, src + 32, (bf16_t*)(F.ws + WS_WINE), 1024, n, 64 * kb, F.in[1], 1.f, 1.f, scr, F.lane); return; } r -= 512;
    if (r < 256) { const int kb = r >> 4, nb = r & 15;
        p0_t64(F.in[13], 1024, 64 * kb, 64 * nb, 64 * nb + 32, (bf16_t*)(F.ws + WS_WOUTE), 1024, 64 * nb, 64 * kb, nullptr, 1.f, 1.f, scr, F.lane); return; } r -= 256;
    if (r < 320) { const int kb = r / 20, nb = r % 20; const int n = 64 * nb; int s0, s1; float sc = 1.f;
        if (n < 384) { s0 = n; s1 = n + 32; } else if (n == 384) { s0 = 384; s1 = -1; } else if (n < 512) { s0 = -1; s1 = -1; }
        else if (n < 1024) { s0 = 416 + (n - 512); s1 = s0 + 32; sc = C2S; } else if (n < 1152) { s0 = 928 + (n - 1024); s1 = s0 + 32; } else { s0 = 1056 + (n - 1152); s1 = s0 + 32; }
        p0_t64(F.in[14], 1184, 64 * kb, s0, s1, (bf16_t*)(F.ws + WS_WINO), 1024, n, 64 * kb, F.in[1] + 1024, sc, sc, scr, F.lane); return; } r -= 320;
    if (r < 48) { const int kb = r / 12, nb = r % 12; const int n = 64 * nb; int s0, s1;
        if (n < 512) { s0 = 96 * (n >> 6); s1 = s0 + 32; } else { const int h = (n - 512) >> 5; s0 = 96 * h + 64; s1 = 96 * (h + 1) + 64; }
        p0_t64(F.in[16], 768, 64 * kb, s0, s1, (bf16_t*)(F.ws + WS_WUQ), 256, n, 64 * kb, F.in[15], C2M, C2M, scr, F.lane); return; } r -= 48;
    if (r < 64) { const int kb = r >> 4, nb = r & 15; const int n = 64 * nb; int s0;
        if (n < 512) s0 = 128 * (n >> 6); else s0 = 128 * ((n - 512) >> 6) + 64;
        if (kb >= 2) p0_t64(F.in[18], 1024, 0, -1, -1, (bf16_t*)(F.ws + WS_WUKV), 256, n, 64 * kb, nullptr, 1.f, 1.f, scr, F.lane);
        else p0_t64(F.in[18], 1024, 64 * kb, s0, s0 + 32, (bf16_t*)(F.ws + WS_WUKV), 256, n, 64 * kb, F.in[17], 1.f, 1.f, scr, F.lane);
        return; } r -= 64;
    { const int kb = r >> 4, nb = r & 15;
        p0_t64(F.in[20], 1024, 64 * kb, 64 * nb, 64 * nb + 32, (bf16_t*)(F.ws + WS_WOUTO), 1024, 64 * nb, 64 * kb, nullptr, 1.f, 1.f, scr, F.lane); }
}
constexpr int DENSE_ITEMS = 1456;

template <int PARTS = 15> __device__ __forceinline__ void phase_p0(const Frame& F) {
    LAS float* scr = (LAS float*)(F.lds + F.wave * 16896);
    const int gw = F.vcu * NWAVES + F.wave, NGW = F.G * NWAVES;
    if (PARTS & 1) { CvtRegs R; int it = gw; if (it < MOE_CVT_ITEMS) moe_cvt_load(F, 0, it, R);
      for (; it < MOE_CVT_ITEMS; it += NGW) { moe_cvt_stage(F, 0, it, R, scr); if (it + NGW < MOE_CVT_ITEMS) moe_cvt_load(F, 0, it + NGW, R); moe_cvt_emit(F, 0, it, scr); } }
    if (PARTS & 2) for (int it = gw; it < DENSE_ITEMS; it += NGW) p0_dense_item(F, it, scr);
    if (PARTS & 4) for (int m = gw; m < T; m += NGW) row_to_bf16_rs(F.in[0] + (size_t)m * D, (bf16_t*)(F.ws + WS_XB) + (size_t)m * D, (float*)(F.ws + WS_RS0) + m, F.lane);
    const int gt = gw * 64 + F.lane, NGT = NGW * 64;
    if (PARTS & 8) for (int idx = gt; idx < 2 * 49152; idx += NGT) {
        const int layer = idx / 49152, li = idx % 49152;
        const int j = li & 7, ln = (li >> 3) & 63, blk = li >> 9, ct = blk % 3, ks = (blk / 3) & 3, w = blk / 12;
        const int k = 128 * w + 32 * ks + 8 * (ln >> 4) + j, col = 16 * ct + (ln & 15);
        float v = 0.f;
        if (col < 4) v = F.in[21][((size_t)layer * 1024 + k) * 4 + col];
        else if (col < 36) v = F.in[23][(((size_t)layer * 4 + ((col - 4) >> 3)) * 1024 + k) * 8 + ((col - 4) & 7)];
        v *= F.in[2][layer * 1024 + k];
        const unsigned hi = f2bf(v); const unsigned lo = f2bf(v - bf2f(hi));
        bf16_t* R = (bf16_t*)(F.ws + WS_ROUTER);
        R[(size_t)(layer * 2 + 0) * 49152 + li] = (bf16_t)hi;
        R[(size_t)(layer * 2 + 1) * 49152 + li] = (bf16_t)lo;
        ((_Float16*)(F.ws + WS_ROUTER16))[(size_t)layer * 49152 + li] = (_Float16)v;
    }
    if (PARTS & 8) for (int idx = gt; idx < S * 16; idx += NGT) {
        const int pos = idx >> 4, j = idx & 15;
        const double inv = pow(10000.0, -(double)(2 * j) / 32.0), ang = (double)pos * inv;
        f32x2 cs; cs.x = (float)cos(ang); cs.y = (float)sin(ang);
        ((f32x2*)(F.ws + WS_ROPE))[idx] = cs;
    }
}
}
namespace mk {
using pg8::Unit;
__device__ __forceinline__ u32x4 pack8(const f32x4& a, const f32x4& b) { u32x4 w; w.x = pk2(a[0], a[1]); w.y = pk2(a[2], a[3]); w.z = pk2(b[0], b[1]); w.w = pk2(b[2], b[3]); return w; }

struct EpiE1 {
    static constexpr bool PERM = true, AFTER_DRAIN = false;
    bf16_t* ACT; const float* rs;
    __device__ __forceinline__ void operator()(const f32x4 (&acc)[2][2][4][2], const Unit& u, int wr, int wc, int fr, int fq) const {
        const int row0 = u.pm * 256 + wr * 64 + fr, cl = wc * 32 + 8 * fq;
        const __amdgpu_buffer_rsrc_t RA = uniform_rsrc(ACT, (unsigned)T * 1536u * 2u);
        float rsv[2][4];
#pragma unroll
        for (int ai = 0; ai < 2; ++ai)
#pragma unroll
            for (int m = 0; m < 4; ++m) rsv[ai][m] = rs[row0 + ai * 128 + m * 16];
#pragma unroll
        for (int ai = 0; ai < 2; ++ai)
#pragma unroll
            for (int m = 0; m < 4; ++m) {
                const int row = row0 + ai * 128 + m * 16; const float r = rsv[ai][m]; const unsigned rowb = (unsigned)row * 3072u;
                if (u.pn < 4) {
                    f32x4 o0, o1; const float rn = -r * LOG2E;
#pragma unroll
                    for (int n = 0; n < 2; ++n)
#pragma unroll
                        for (int i = 0; i < 4; i += 2) { const f32x2 a = {acc[ai][0][m][n][i], acc[ai][0][m][n][i + 1]}, g = {acc[ai][1][m][n][i], acc[ai][1][m][n][i + 1]};
                            const f32x2 v = mul_sigmoid2_f(a * r, g * rn); if (n == 0) { o0[i] = v.x; o0[i + 1] = v.y; } else { o1[i] = v.x; o1[i + 1] = v.y; } }
                    st16_wt(RA, rowb + (unsigned)(128 * u.pn + cl) * 2u, pack8(o0, o1));
                } else {
                    const int base = (u.pn < 6) ? (512 + (u.pn - 4) * 256) : (1024 + (u.pn - 6) * 256);
#pragma unroll
                    for (int bj = 0; bj < 2; ++bj) { f32x4 o0, o1;
#pragma unroll
                        for (int i = 0; i < 4; i += 2) { const f32x2 x0 = {acc[ai][bj][m][0][i], acc[ai][bj][m][0][i + 1]}, x1 = {acc[ai][bj][m][1][i], acc[ai][bj][m][1][i + 1]};
                            const f32x2 y0 = gelu2_f(x0 * r), y1 = gelu2_f(x1 * r); o0[i] = y0.x; o0[i + 1] = y0.y; o1[i] = y1.x; o1[i + 1] = y1.y; }
                        st16_wt(RA, rowb + (unsigned)(base + bj * 128 + cl) * 2u, pack8(o0, o1)); }
                }
            }
    }
};
struct EpiRes {
    static constexpr bool PERM = true, AFTER_DRAIN = false;
    const float* resid; float* out; bf16_t* xb;
    __device__ __forceinline__ void operator()(const f32x4 (&acc)[2][2][4][2], const Unit& u, int wr, int wc, int fr, int fq) const {
        const int row0 = u.pm * 256 + wr * 64 + fr, col0 = u.pn * 256 + wc * 32 + 8 * fq;
        const __amdgpu_buffer_rsrc_t RO = uniform_rsrc(out, (unsigned)T * 1024u * 4u), RX = uniform_rsrc(xb, (unsigned)T * 1024u * 2u);
#pragma unroll
        for (int ai = 0; ai < 2; ++ai) {
            f32x4 rv[4][2][2];
#pragma unroll
            for (int m = 0; m < 4; ++m) { const size_t off = (size_t)(row0 + ai * 128 + m * 16) * 1024 + col0;
#pragma unroll
                for (int bj = 0; bj < 2; ++bj) { rv[m][bj][0] = *(const f32x4*)(resid + off + bj * 128); rv[m][bj][1] = *(const f32x4*)(resid + off + bj * 128 + 4); } }
            asm volatile("" ::: "memory");
#pragma unroll
            for (int m = 0; m < 4; ++m) {
                const size_t off = (size_t)(row0 + ai * 128 + m * 16) * 1024 + col0;
#pragma unroll
                for (int bj = 0; bj < 2; ++bj) {
                    const f32x4 v0 = acc[ai][bj][m][0] + rv[m][bj][0], v1 = acc[ai][bj][m][1] + rv[m][bj][1];
                    const unsigned eo = (unsigned)(off + bj * 128);
                    st16_wt(RO, eo * 4u, v0); st16_wt(RO, eo * 4u + 16u, v1);
                    st16_wt(RX, eo * 2u, pack8(v0, v1));
                }
            }
            asm volatile("" ::: "memory");
        }
    }
};
__device__ __forceinline__ void router_select256(unsigned char* ws, const LAS float* bg, const LAS float* br, unsigned* gcnt, int tok0, int tid, int lane, int wave, LAS unsigned char* lds) {
    LAS float* lg = (LAS float*)lds;
    LAS float* rsl = (LAS float*)(lds + 51200);
    LAS int* sel = (LAS int*)(lds + 52224);
    LAS float* gwl = (LAS float*)(lds + 54272);
    LAS int* basel = (LAS int*)(lds + 56320);
    LAS int* cntw = (LAS int*)(lds + 56448);
    LAS int* pre = (LAS int*)(lds + 57472);
    if (tid < 256) {
        const float rs = rsl[tid]; const LAS float* L = lg + tid * 49;
        float gl[4];
#pragma unroll
        for (int j = 0; j < 4; ++j) gl[j] = L[j] * rs + bg[j];
        int gi = 0; float gm = gl[0];
#pragma unroll
        for (int j = 1; j < 4; ++j) if (gl[j] > gm) { gm = gl[j]; gi = j; }
        float den = 0.f;
#pragma unroll
        for (int j = 0; j < 4; ++j) den += __expf(gl[j] - gm);
        const float gp = 1.f / den;
        float el[8];
#pragma unroll
        for (int x = 0; x < 8; ++x) el[x] = L[4 + 8 * gi + x] * rs + br[gi * 8 + x];
        int i1 = 0; float v1 = el[0];
#pragma unroll
        for (int x = 1; x < 8; ++x) if (el[x] > v1) { v1 = el[x]; i1 = x; }
        int i2 = 0; float v2 = -3.0e38f;
#pragma unroll
        for (int x = 0; x < 8; ++x) if (x != i1 && el[x] > v2) { v2 = el[x]; i2 = x; }
        const float e2 = __expf(v2 - v1);
        sel[2 * tid] = gi * 8 + i1; sel[2 * tid + 1] = gi * 8 + i2;
        gwl[2 * tid] = gp / (1.f + e2); gwl[2 * tid + 1] = gp * e2 / (1.f + e2);
        ((float*)(ws + WS_RSM))[tok0 + tid] = rs;
    }
    __syncthreads();
    const int myexp = sel[tid]; unsigned long long mymask = 0ull;
#pragma unroll 4
    for (int x = 0; x < 32; ++x) { const unsigned long long m = __ballot(myexp == x); if (myexp == x) mymask = m; if (lane == 0) cntw[wave * 32 + x] = __popcll(m); }
    const int pos = __popcll(mymask & ((1ull << lane) - 1ull));
    __syncthreads();
    if (tid < 32) { int run = 0;
#pragma unroll
        for (int w = 0; w < 8; ++w) { pre[w * 32 + tid] = run; run += cntw[w * 32 + tid]; }
        basel[tid] = run ? (int)__hip_atomic_fetch_add(gcnt + tid * 64, (unsigned)run, __ATOMIC_RELAXED, __HIP_MEMORY_SCOPE_AGENT) : 0; }
    __syncthreads();
    const size_t dst = (size_t)myexp * T + basel[myexp] + pre[wave * 32 + myexp] + pos;
    ((int*)(ws + WS_LSLOT))[dst] = 2 * (tok0 + (tid >> 1)) + (tid & 1);
    ((float*)(ws + WS_LGW))[dst] = gwl[tid];
    ((float*)(ws + WS_LRS))[dst] = rsl[tid >> 1];
}
template <bool SELECT> struct EpiResR {
    static constexpr bool PERM = true, AFTER_DRAIN = true;
    bf16_t* xb; const _Float16* rw; float* part;
    unsigned char* ws; const float* bg; const float* br; unsigned* gcnt; unsigned* pcnt;
    __device__ __forceinline__ void operator()(const f32x4 (&acc)[2][2][4][2], const Unit& u, int wr, int wc, int fr, int fq) const {}
    __device__ __forceinline__ void fused(const f32x4 (&acc)[2][2][4][2], const Unit& u, int wr, int wc, int fr, int fq, LAS unsigned char* lds, int wid, int lane) const {
        const int tid = wid * 64 + lane;
        LAS float* pl = (LAS float*)lds;
        f16x8 B[2][3];
#pragma unroll
        for (int bj = 0; bj < 2; ++bj)
#pragma unroll
            for (int ct = 0; ct < 3; ++ct) B[bj][ct] = *(const GAS f16x8*)(rw + ((size_t)((8 * u.pn + 4 * bj + wc) * 3 + ct) * 64 + lane) * 8);
        const int row0 = u.pm * 256 + wr * 64 + fr, col0 = u.pn * 256 + wc * 32 + 8 * fq;
        const __amdgpu_buffer_rsrc_t RX = uniform_rsrc(xb, (unsigned)T * 1024u * 2u), RP = uniform_rsrc(part, 4u * (unsigned)T * 208u);
        LAS float* bgl = (LAS float*)(lds + 122880);
        if constexpr (SELECT) { if (tid < 4) bgl[tid] = bg[tid]; else if (tid >= 8 && tid < 40) bgl[tid] = br[tid - 8]; }
#pragma unroll
        for (int ai = 0; ai < 2; ++ai) {
            u32x4 rv[4][2];
#pragma unroll
            for (int m = 0; m < 4; ++m) { const unsigned off = (unsigned)((row0 + ai * 128 + m * 16) * 1024 + col0);
#pragma unroll
                for (int bj = 0; bj < 2; ++bj) rv[m][bj] = __builtin_amdgcn_raw_buffer_load_b128(RX, (off + bj * 128) * 2u, 0, 0); }
            asm volatile("" ::: "memory");
#pragma unroll
            for (int m = 0; m < 4; ++m) {
                const unsigned off = (unsigned)((row0 + ai * 128 + m * 16) * 1024 + col0);
                f32x4 lacc[3]; f32x2 ssq2 = {0.f, 0.f};
#pragma unroll
                for (int ct = 0; ct < 3; ++ct) lacc[ct] = (f32x4){0.f, 0.f, 0.f, 0.f};
#pragma unroll
                for (int bj = 0; bj < 2; ++bj) {
                    const u32x4 rw_ = rv[m][bj];
                    typedef _Float16 h2_t __attribute__((ext_vector_type(2)));
                    const unsigned rwa[4] = {rw_.x, rw_.y, rw_.z, rw_.w};
                    f32x4 v0, v1; u32x4 hiw, low;
#pragma unroll
                    for (int q = 0; q < 4; ++q) {
                        const f32x2 rr = {bf2f(rwa[q] & 0xffffu), __builtin_bit_cast(float, rwa[q] & 0xffff0000u)};
                        const f32x2 aa = (q < 2) ? (f32x2){acc[ai][bj][m][0][2 * q], acc[ai][bj][m][0][2 * q + 1]} : (f32x2){acc[ai][bj][m][1][2 * q - 4], acc[ai][bj][m][1][2 * q - 3]};
                        const f32x2 vv = aa + rr;
                        ssq2 = vv * vv + ssq2;
                        const h2_t hh = __builtin_bit_cast(h2_t, __builtin_amdgcn_cvt_pkrtz(vv.x, vv.y));
                        const f32x2 back = {(float)hh.x, (float)hh.y};
                        const f32x2 dd = vv - back;
                        hiw[q] = __builtin_bit_cast(unsigned, hh); low[q] = __builtin_bit_cast(unsigned, __builtin_amdgcn_cvt_pkrtz(dd.x, dd.y));
                        if (q < 2) { v0[2 * q] = vv.x; v0[2 * q + 1] = vv.y; } else { v1[2 * q - 4] = vv.x; v1[2 * q - 3] = vv.y; }
                    }
                    st16_wt(RX, (off + bj * 128) * 2u, pack8(v0, v1));
                    const f16x8 hi = __builtin_bit_cast(f16x8, hiw), lo = __builtin_bit_cast(f16x8, low);
#pragma unroll
                    for (int ct = 0; ct < 3; ++ct) {
                        lacc[ct] = __builtin_amdgcn_mfma_f32_16x16x32_f16(hi, B[bj][ct], lacc[ct], 0, 0, 0);
                        lacc[ct] = __builtin_amdgcn_mfma_f32_16x16x32_f16(lo, B[bj][ct], lacc[ct], 0, 0, 0);
                    }
                }
                LAS float* pr = pl + (wc * 128 + wr * 64 + m * 16 + 4 * fq) * 52 + fr;
#pragma unroll
                for (int ct = 0; ct < 3; ++ct)
#pragma unroll
                    for (int i = 0; i < 4; ++i) pr[i * 52 + 16 * ct] = lacc[ct][i];
                float ssq = xsum32(xsum16(ssq2.x + ssq2.y));
                if (fq == 0) pl[(wc * 128 + wr * 64 + m * 16 + fr) * 52 + 48] = ssq;
            }
            asm volatile("" ::: "memory");
            __syncthreads();
            const unsigned dsto = (unsigned)((u.pn * T + u.pm * 256 + ai * 128) * 208);
            for (int i = tid; i < 1664; i += NTHR) { const LAS f32x4* s = (const LAS f32x4*)pl + i;
                const f32x4 v = (s[0] + s[1664]) + (s[2 * 1664] + s[3 * 1664]);
                __builtin_amdgcn_raw_buffer_store_b128(__builtin_bit_cast(u32x4, v), RP, dsto + (unsigned)i * 16u, 0, SELECT ? 16 : 0); }
            if (ai == 0) __syncthreads();
        }
        if constexpr (SELECT) {
            asm volatile("s_waitcnt vmcnt(0)" ::: "memory");
            __syncthreads();
            volatile LAS int* flag = (volatile LAS int*)(lds + 58496);
            if (tid == 0) *flag = (__hip_atomic_fetch_add(pcnt + u.pm * 16, 1u, __ATOMIC_RELAXED, __HIP_MEMORY_SCOPE_AGENT) == 3u) ? 1 : 0;
            __syncthreads();
            if (*flag) {
                const int tok0 = u.pm * 256;
                LAS float* lg = (LAS float*)lds; LAS float* rsl = (LAS float*)(lds + 51200);
                u32x4 pv[7][4];
#pragma unroll
                for (int k = 0; k < 7; ++k) { const int idx = tid + NTHR * k, ic = idx < 3328 ? idx : 0;
#pragma unroll
                    for (int pn = 0; pn < 4; ++pn) pv[k][pn] = __builtin_amdgcn_raw_buffer_load_b128(RP, (unsigned)(pn * T * 208 + tok0 * 208 + ic * 16), 0, 16); }
#pragma unroll
                for (int k = 0; k < 7; ++k) { const int idx = tid + NTHR * k; const int t = idx / 13, j = idx - 13 * t;
                    f32x4 s = __builtin_bit_cast(f32x4, pv[k][0]);
#pragma unroll
                    for (int pn = 1; pn < 4; ++pn) s += __builtin_bit_cast(f32x4, pv[k][pn]);
                    if (idx < 3328) { if (j < 12) { LAS float* lp_ = lg + t * 49 + 4 * j; lp_[0] = s[0]; lp_[1] = s[1]; lp_[2] = s[2]; lp_[3] = s[3]; } else rsl[t] = 1.0f / sqrtf(s[0] * (1.f / 1024.f) + EPS); } }
                __syncthreads();
                router_select256(ws, bgl, bgl + 8, gcnt, tok0, tid, lane, wid, lds);
            }
        }
    }
};
struct EpiO1 {
    static constexpr bool PERM = true, AFTER_DRAIN = false;
    bf16_t* P; const float* rs; float* ssqq; float* ssqkv; bf16_t* kpe; const f32x2* rope;
    __device__ __forceinline__ void operator()(const f32x4 (&acc)[2][2][4][2], const Unit& u, int wr, int wc, int fr, int fq) const {
        const int row0 = u.pm * 256 + wr * 64 + fr, cl = wc * 32 + 8 * fq;
        const __amdgpu_buffer_rsrc_t RP = uniform_rsrc(P, (unsigned)T * 1280u * 2u);
        float rsv[2][4];
#pragma unroll
        for (int ai = 0; ai < 2; ++ai)
#pragma unroll
            for (int m = 0; m < 4; ++m) rsv[ai][m] = rs[row0 + ai * 128 + m * 16];
#pragma unroll
        for (int ai = 0; ai < 2; ++ai)
#pragma unroll
            for (int m = 0; m < 4; ++m) {
                const int row = row0 + ai * 128 + m * 16; const float r = rsv[ai][m]; const unsigned rowb = ((unsigned)row * 1280u + (unsigned)(u.pn * 256 + cl)) * 2u;
                f32x4 v[2][2];
#pragma unroll
                for (int bj = 0; bj < 2; ++bj) { v[bj][0] = acc[ai][bj][m][0] * r; v[bj][1] = acc[ai][bj][m][1] * r; st16_wt(RP, rowb + bj * 256u, pack8(v[bj][0], v[bj][1])); }
                if (u.pn <= 1) {
                    float s = 0.f;
#pragma unroll
                    for (int i = 0; i < 4; ++i) { s += v[0][0][i] * v[0][0][i] + v[0][1][i] * v[0][1][i]; if (u.pn == 0) s += v[1][0][i] * v[1][0][i] + v[1][1][i] * v[1][1][i]; }
                    s = xsum32(xsum16(s));
                    if (fq == 0) (u.pn == 0 ? ssqq : ssqkv)[(size_t)row * 4 + wc] = s;
                }
                if (u.pn == 1 && wc == 0) {
                    const int pos = row & (S - 1); f32x4 o[2];
#pragma unroll
                    for (int n = 0; n < 2; ++n)
#pragma unroll
                        for (int i = 0; i < 4; ++i) { const float x = v[1][n][i]; const auto sw_ = __builtin_amdgcn_permlane32_swap(__builtin_bit_cast(unsigned, x), __builtin_bit_cast(unsigned, x), false, false); const float y = __builtin_bit_cast(float, (unsigned)((fq >= 2) ? sw_[0] : sw_[1]));        const f32x2 cs = rope[pos * 16 + ((8 * fq + 4 * n + i) & 15)];
                            o[n][i] = (fq < 2) ? (x * cs.x - y * cs.y) : (x * cs.x + y * cs.y); }
                    *(u32x4*)(kpe + (size_t)row * 32 + 8 * fq) = pack8(o[0], o[1]);
                }
                asm volatile("" ::: "memory");
            }
    }
};
struct O2Order : pg8::StaticOrder {
    __device__ bool next(int i, Unit& u) const { const bool ok = pg8::StaticOrder::next(i, u); if (ok) u.aoff = (u.pn >= 3) ? 512 : 0; return ok; }
};
struct O1mOrder {
    int x, idx, nun;
    __device__ void init(int bid) { x = bid & 7; idx = bid >> 3; int n = ((idx >> 3) == 2) ? 2 : 1; asm volatile("" : "+s"(n)); nun = n; }
    __device__ bool next(int i, Unit& u) const {
        if (i >= nun) return false;
        const int t = idx + 16 * i; u.pm = 8 * x + (t & 7); u.pn = t >> 3; u.aoff = 0; return true;
    }
    __device__ __forceinline__ void a_ready(const Unit&) const {}
    __device__ __forceinline__ void done(const Unit&) const {}
};
struct O2mOrder {
    int x, idx, nun;
    __device__ void init(int bid) { x = bid & 7; idx = bid >> 3; int n = (idx < 16) ? 3 + (idx >> 3) : 0; asm volatile("" : "+s"(n)); nun = n; }
    __device__ bool next(int i, Unit& u) const {
        if (i >= nun) return false;
        const int kv = idx >> 3; u.pm = 8 * x + (idx & 7); u.pn = 3 * kv + i; u.aoff = 512 * kv; return true;
    }
    __device__ __forceinline__ void a_ready(const Unit&) const {}
    __device__ __forceinline__ void done(const Unit&) const {}
};
struct EpiO2 {
    static constexpr bool PERM = true, AFTER_DRAIN = false;
    bf16_t* Q; bf16_t* KV; const float* ssqq; const float* ssqkv;
    __device__ __forceinline__ void operator()(const f32x4 (&acc)[2][2][4][2], const Unit& u, int wr, int wc, int fr, int fq) const {
        const int row0 = u.pm * 256 + wr * 64 + fr, cl = wc * 32 + 8 * fq;
        const bool isq = u.pn < 3; const float* ssq = isq ? ssqq : ssqkv; const float inv_n = isq ? (1.f / 256.f) : (1.f / 128.f);
        bf16_t* O = isq ? (Q + u.pn * 256 + cl) : (KV + (u.pn - 3) * 256 + cl); const int ldo = isq ? 768 : 1024;
        f32x4 sqv[2][4];
#pragma unroll
        for (int ai = 0; ai < 2; ++ai)
#pragma unroll
            for (int m = 0; m < 4; ++m) sqv[ai][m] = *(const f32x4*)(ssq + (size_t)(row0 + ai * 128 + m * 16) * 4);
#pragma unroll
        for (int ai = 0; ai < 2; ++ai)
#pragma unroll
            for (int m = 0; m < 4; ++m) {
                const int row = row0 + ai * 128 + m * 16; const f32x4 sq = sqv[ai][m];
                const float r = __builtin_amdgcn_rsqf(((sq[0] + sq[1]) + (sq[2] + sq[3])) * inv_n + EPS);
                bf16_t* rowp = O + (size_t)row * ldo;
#pragma unroll
                for (int bj = 0; bj < 2; ++bj) *(u32x4*)(rowp + bj * 128) = pack8(acc[ai][bj][m][0] * r, acc[ai][bj][m][1] * r);
                asm volatile("" ::: "memory");
            }
    }
};
}
namespace mk {
struct ConvW { f32x2 w[31]; f32x2 bias, g, bt; };
__device__ __forceinline__ void e2_conv_load_w(const Frame& F, int grp, ConvW& W) {
    const int ch = grp * 128 + 2 * F.lane; const float* cw = F.in[5];
#pragma unroll
    for (int q = 0; q < 31; ++q) W.w[q] = *(const f32x2*)(cw + q * 512 + ch);
    W.bias = *(const f32x2*)(F.in[6] + ch); W.g = *(const f32x2*)(F.in[7] + ch); W.bt = *(const f32x2*)(F.in[8] + ch);
}
__device__ __forceinline__ void e2_conv_wave_unit(const Frame& F, int run, int grp, const bf16_t* ACT, bf16_t* MBo, const ConvW& W) {
    LAS bf16_t* tile = (LAS bf16_t*)(F.lds + F.wave * 16896);
    LAS float* scr = (LAS float*)(F.lds + F.wave * 16896 + 12288);
    const int t0 = run * 16, s0 = t0 & (S - 1);
#pragma unroll
    for (int i = 0; i < 12; ++i) { const int idx = F.lane + 64 * i, r = idx >> 4, c = idx & 15; const int sp = s0 + r - 15;
        if (r < 46) { u32x4 v = {0u, 0u, 0u, 0u};
            if (sp >= 0 && sp < S) v = *(const GAS u32x4*)(ACT + (size_t)(t0 + r - 15) * 1536 + grp * 128 + c * 8);
            *(LAS u32x4*)(tile + r * 128 + c * 8) = v; } }
    const int ch = grp * 128 + 2 * F.lane;
    const f32x2 bias = W.bias;
    f32x2 av[16];
#pragma unroll
    for (int k = 0; k < 16; ++k) av[k] = bias;
    LDS_WAIT(); asm volatile("" ::: "memory");
    const LAS unsigned* src = (const LAS unsigned*)(tile + 2 * F.lane);
#pragma unroll
    for (int i = 0; i < 46; ++i) { const unsigned x = src[i * 64]; const f32x2 xv = {bf2f(x & 0xffffu), bf2f(x >> 16)};
#pragma unroll
        for (int k = 0; k < 16; ++k) { const int q = i - k; if (q >= 0 && q <= 30) av[k] = xv * W.w[q] + av[k]; } }
    float a0[16], a1[16];
#pragma unroll
    for (int k = 0; k < 16; ++k) { a0[k] = av[k].x; a1[k] = av[k].y; }
    const f32x2 g = W.g, bt = W.bt;
    const bool b5 = (F.lane & 32) != 0, b4 = (F.lane & 16) != 0, b3 = (F.lane & 8) != 0, b2 = (F.lane & 4) != 0;
    const int tk = (b5 ? 8 : 0) + (b4 ? 4 : 0) + (b3 ? 2 : 0) + (b2 ? 1 : 0);
#define E2_BFLY(S, OUT) do { float v8_[8], v4_[4], v2_[2]; \
          \
        _Pragma("unroll") for (int k = 0; k < 8; ++k) { const auto r_ = __builtin_amdgcn_permlane32_swap(__builtin_bit_cast(unsigned, S[k]), __builtin_bit_cast(unsigned, S[k + 8]), false, false); \
            v8_[k] = __builtin_bit_cast(float, (unsigned)r_[0]) + __builtin_bit_cast(float, (unsigned)r_[1]); } \
        _Pragma("unroll") for (int k = 0; k < 4; ++k) { const auto r_ = __builtin_amdgcn_permlane16_swap(__builtin_bit_cast(unsigned, v8_[k]), __builtin_bit_cast(unsigned, v8_[k + 4]), false, false); \
            v4_[k] = __builtin_bit_cast(float, (unsigned)r_[0]) + __builtin_bit_cast(float, (unsigned)r_[1]); } \
        _Pragma("unroll") for (int k = 0; k < 2; ++k) { const float kp = b3 ? v4_[k + 2] : v4_[k], sd = b3 ? v4_[k] : v4_[k + 2]; v2_[k] = kp + __shfl_xor(sd, 8); } \
        { const float kp = b2 ? v2_[1] : v2_[0], sd = b2 ? v2_[0] : v2_[1]; OUT = kp + __shfl_xor(sd, 4); } \
        OUT += __shfl_xor(OUT, 2); OUT += __shfl_xor(OUT, 1); } while (0)
    float st[16], tot;
#pragma unroll
    for (int k = 0; k < 16; ++k) st[k] = a0[k] + a1[k];
    E2_BFLY(st, tot);
    if ((F.lane & 3) == 0) scr[tk] = tot * (1.f / 128.f);
    LDS_WAIT(); asm volatile("" ::: "memory");
    float mu[16];
#pragma unroll
    for (int k4 = 0; k4 < 4; ++k4) { const f32x4 m4 = *(const LAS f32x4*)(scr + 4 * k4); mu[4 * k4] = m4.x; mu[4 * k4 + 1] = m4.y; mu[4 * k4 + 2] = m4.z; mu[4 * k4 + 3] = m4.w; }
#pragma unroll
    for (int k = 0; k < 16; ++k) { a0[k] -= mu[k]; a1[k] -= mu[k]; st[k] = a0[k] * a0[k] + a1[k] * a1[k]; }
    E2_BFLY(st, tot);
    if ((F.lane & 3) == 0) scr[16 + tk] = 1.0f / sqrtf(tot * (1.f / 128.f) + EPS);
    LDS_WAIT(); asm volatile("" ::: "memory");
#undef E2_BFLY
#pragma unroll
    for (int k4 = 0; k4 < 4; ++k4) { const f32x4 r4 = *(const LAS f32x4*)(scr + 16 + 4 * k4);
#pragma unroll
        for (int i = 0; i < 4; ++i) { const int k = 4 * k4 + i; const float rs = r4[i];
            const float y0 = silu_f(a0[k] * rs * g.x + bt.x), y1 = silu_f(a1[k] * rs * g.y + bt.y);
            *(GAS unsigned*)(MBo + (size_t)(t0 + k) * 1024 + ch) = pk2(y0, y1); } }
    LDS_WAIT(); asm volatile("" ::: "memory");
}
__device__ __forceinline__ void e2_sgu_unit(const Frame& F, int chunk, int h, const bf16_t* ACT, bf16_t* MBo, bool load_w) {
    constexpr int LD = 136, LDO = 132;
    LAS bf16_t* WSl = (LAS bf16_t*)F.lds;
    LAS bf16_t* VTl = (LAS bf16_t*)(F.lds + 34816);
    LAS float* OUTl = (LAS float*)(F.lds + 69632);
    const int t0 = chunk * 128;
    const float* wsp = F.in[11] + (size_t)h * 128 * 128;
    if (load_w) for (int idx = F.tid; idx < 4096; idx += NTHR) { const int r = idx >> 5, c4 = idx & 31; const f32x4 v = *(const GAS f32x4*)(wsp + r * 128 + 4 * c4);
        u32x2 w; w.x = pk2(v.x, v.y); w.y = pk2(v.z, v.w); *(LAS u32x2*)(WSl + r * LD + 4 * c4) = w; }
#pragma unroll
    for (int it = 0; it < 4; ++it) { const int idx = F.tid + NTHR * it, s = idx >> 4, c = idx & 15;
        const u32x4 raw = *(const GAS u32x4*)(ACT + (size_t)(t0 + s) * 1536 + 1024 + h * 128 + 8 * c);
        float x[8]; x[0] = bf2f(raw.x & 0xffffu); x[1] = bf2f(raw.x >> 16); x[2] = bf2f(raw.y & 0xffffu); x[3] = bf2f(raw.y >> 16);
        x[4] = bf2f(raw.z & 0xffffu); x[5] = bf2f(raw.z >> 16); x[6] = bf2f(raw.w & 0xffffu); x[7] = bf2f(raw.w >> 16);
        float sm = 0.f;
#pragma unroll
        for (int i = 0; i < 8; ++i) sm += x[i];
        sm = row16_sum(sm);
        const float mu = sm * (1.f / 128.f); float q = 0.f;
#pragma unroll
        for (int i = 0; i < 8; ++i) { x[i] -= mu; q += x[i] * x[i]; }
        q = row16_sum(q);
        const float rs = 1.0f / sqrtf(q * (1.f / 128.f) + EPS);
        const float* vg = F.in[9] + h * 128 + 8 * c; const float* vb = F.in[10] + h * 128 + 8 * c;
#pragma unroll
        for (int i = 0; i < 8; ++i) { const float y = x[i] * rs * vg[i] + vb[i]; VTl[(8 * c + i) * LD + ((((s >> 3) ^ c) & 15) << 3) + (s & 7)] = (bf16_t)f2bf(y); }
    }
    u32x4 graw[4];
#pragma unroll
    for (int it = 0; it < 4; ++it) { const int idx = F.tid + NTHR * it, t = idx >> 4, cc = idx & 15; graw[it] = *(const GAS u32x4*)(ACT + (size_t)(t0 + t) * 1536 + 512 + h * 128 + 8 * cc); }
    __syncthreads();
    const int wt = F.wave >> 1, wc = F.wave & 1, r32 = F.lane & 31, hi = F.lane >> 5;
    f32x16 acc[2]; acc[0] = f32x16{}; acc[1] = f32x16{};
    float bspv[16];
    { const float* bsp = F.in[12] + h * 128;
#pragma unroll
      for (int r = 0; r < 16; ++r) bspv[r] = bsp[32 * wt + (r & 3) + 8 * (r >> 2) + 4 * hi]; }
#pragma unroll
    for (int ks = 0; ks < 8; ++ks) {
        const bf16x8 a = *(const LAS bf16x8*)(WSl + (32 * wt + r32) * LD + 16 * ks + 8 * hi);
#pragma unroll
        for (int ct = 0; ct < 2; ++ct) { const int vrow_ = 64 * wc + 32 * ct + r32; const bf16x8 b = *(const LAS bf16x8*)(VTl + vrow_ * LD + ((((2 * ks + hi) ^ (vrow_ >> 3)) & 15) << 3));
            acc[ct] = __builtin_amdgcn_mfma_f32_32x32x16_bf16(a, b, acc[ct], 0, 0, 0); }
    }
#pragma unroll
    for (int ct = 0; ct < 2; ++ct)
#pragma unroll
        for (int r = 0; r < 16; ++r) { const int trow = 32 * wt + (r & 3) + 8 * (r >> 2) + 4 * hi; OUTl[trow * LDO + 64 * wc + 32 * ct + r32] = acc[ct][r] + bspv[r]; }
    __syncthreads();
#pragma unroll
    for (int it = 0; it < 4; ++it) { const int idx = F.tid + NTHR * it, t = idx >> 4, c = idx & 15;
        const u32x4 raw = graw[it];
        const f32x4 s0 = *(const LAS f32x4*)(OUTl + t * LDO + 8 * c), s1 = *(const LAS f32x4*)(OUTl + t * LDO + 8 * c + 4);
        u32x4 o; o.x = pk2(bf2f(raw.x & 0xffffu) * s0.x, bf2f(raw.x >> 16) * s0.y); o.y = pk2(bf2f(raw.y & 0xffffu) * s0.z, bf2f(raw.y >> 16) * s0.w);
        o.z = pk2(bf2f(raw.z & 0xffffu) * s1.x, bf2f(raw.z >> 16) * s1.y); o.w = pk2(bf2f(raw.w & 0xffffu) * s1.z, bf2f(raw.w >> 16) * s1.w);
        *(GAS u32x4*)(MBo + (size_t)(t0 + t) * 1024 + 512 + h * 128 + 8 * c) = o; }
    __syncthreads();
}
__device__ __forceinline__ void phase_e2(const Frame& F) {
    const bf16_t* ACT = (const bf16_t*)F.out; bf16_t* MBo = (bf16_t*)(F.ws + WS_MB);
    { const int gw = F.vcu * NWAVES + F.wave, NGW = F.G * NWAVES;
      LAS float* cscr = (LAS float*)(F.lds + F.wave * 16896); CvtRegs R; int it = gw; bool staged = false;
      if (it < MOE_CVT_ITEMS) moe_cvt_load(F, 0, it, R);
      ConvW W; e2_conv_load_w(F, gw & 3, W);
      for (int u = gw; u < 4096 || it < MOE_CVT_ITEMS; u += NGW) {
          if (u < 4096) { if ((NGW & 3) != 0) e2_conv_load_w(F, u & 3, W); e2_conv_wave_unit(F, u >> 2, u & 3, ACT, MBo, W); }
          if (it < MOE_CVT_ITEMS) { moe_cvt_stage(F, 0, it, R, cscr); if (it + NGW < MOE_CVT_ITEMS) moe_cvt_load(F, 0, it + NGW, R); moe_cvt_emit(F, 0, it, cscr); it += NGW; }
      }
      (void)staged; }
    __syncthreads();
    for (int u = F.vcu; u < 512; u += F.G) e2_sgu_unit(F, u >> 2, u & 3, ACT, MBo, u == F.vcu || (F.G & 3) != 0);
}
struct CRow { u32x4 x[2], a[2], b[2]; };
__device__ __forceinline__ void crow_load(const Frame& F, __amdgpu_buffer_rsrc_t RY, int m, CRow& R) {
    const GAS u32x4* xr = (const GAS u32x4*)((const bf16_t*)(F.ws + WS_XB) + (size_t)m * D) + F.lane;
    const unsigned yo = (unsigned)(2 * m) * 2048u + (unsigned)F.lane * 16u;
#pragma unroll
    for (int j = 0; j < 2; ++j) { R.x[j] = xr[64 * j]; R.a[j] = __builtin_amdgcn_raw_buffer_load_b128(RY, yo + 1024u * j, 0, 16); R.b[j] = __builtin_amdgcn_raw_buffer_load_b128(RY, yo + 2048u + 1024u * j, 0, 16); }
}
template <bool FINAL> __device__ __forceinline__ void crow_finish(const Frame& F, int m, const CRow& R) {
    f32x2 v[2][4]; f32x2 s2 = {0.f, 0.f};
#pragma unroll
    for (int j = 0; j < 2; ++j)
#pragma unroll
        for (int d = 0; d < 4; ++d) { const unsigned x = R.x[j][d], a = R.a[j][d], b = R.b[j][d];
            const f32x2 xx = {bf2f(x & 0xffffu), __builtin_bit_cast(float, x & 0xffff0000u)}, aa = {bf2f(a & 0xffffu), __builtin_bit_cast(float, a & 0xffff0000u)}, bb = {bf2f(b & 0xffffu), __builtin_bit_cast(float, b & 0xffff0000u)};
            v[j][d] = xx + (aa + bb); s2 = v[j][d] * v[j][d] + s2; }
    const float s = wave_sum(s2.x + s2.y);
    const float rs = 1.0f / sqrtf(s * (1.f / 1024.f) + EPS);
    if (FINAL) {
        GAS f32x4* orow = (GAS f32x4*)(F.out + (size_t)m * D) + 2 * F.lane;
        const GAS f32x4* g = (const GAS f32x4*)F.in[3] + 2 * F.lane;
#pragma unroll
        for (int j = 0; j < 2; ++j) { const f32x4 g0 = g[128 * j], g1 = g[128 * j + 1];
            const f32x4 o0 = {v[j][0].x, v[j][0].y, v[j][1].x, v[j][1].y}, o1 = {v[j][2].x, v[j][2].y, v[j][3].x, v[j][3].y};
            __builtin_nontemporal_store(o0 * rs * g0, orow + 128 * j); __builtin_nontemporal_store(o1 * rs * g1, orow + 128 * j + 1); }
    } else {
        GAS u32x4* xr = (GAS u32x4*)((bf16_t*)(F.ws + WS_XB) + (size_t)m * D) + F.lane;
#pragma unroll
        for (int j = 0; j < 2; ++j) { u32x4 w; w.x = pk2(v[j][0].x, v[j][0].y); w.y = pk2(v[j][1].x, v[j][1].y); w.z = pk2(v[j][2].x, v[j][2].y); w.w = pk2(v[j][3].x, v[j][3].y); xr[64 * j] = w; }
        if (F.lane == 0) ((float*)(F.ws + WS_RS0))[m] = rs;
    }
}
template <bool FINAL> __device__ __forceinline__ void combine_rows(const Frame& F) {
    constexpr int layer = FINAL ? 1 : 0;
    unsigned* ctl = (unsigned*)(F.ws + WS_CTL);
    const unsigned* rdy = ctl + CW_READY + layer * 32768;
    const __amdgpu_buffer_rsrc_t RY = uniform_rsrc(F.ws + WS_Y, 2u * (unsigned)T * 2048u);
    const int base = (F.vcu * NWAVES + F.wave) * 8;
    if (base >= T) return;
    unsigned pend = 0xffu, spins = 0;
    while (pend) {
        const unsigned fl = (F.lane < 16) ? __hip_atomic_load(rdy + 2 * base + F.lane, __ATOMIC_RELAXED, __HIP_MEMORY_SCOPE_AGENT) : 0u;
        const unsigned long long bm = __ballot(fl != 0u);
        unsigned rdm = 0;
#pragma unroll
        for (int k = 0; k < 8; ++k) rdm |= (((unsigned)(bm >> (2 * k)) & 3u) == 3u) ? (1u << k) : 0u;
        if (spins >= (1u << 16)) rdm = 0xffu;
        const unsigned go = pend & rdm;
        if (!go) { __builtin_amdgcn_s_sleep(8); ++spins; continue; }
        pend &= ~go;
        for (int k2 = 0; k2 < 4; ++k2) {
            const unsigned two = (go >> (2 * k2)) & 3u;
            if (two == 3u) { CRow R0, R1; crow_load(F, RY, base + 2 * k2, R0); crow_load(F, RY, base + 2 * k2 + 1, R1); crow_finish<FINAL>(F, base + 2 * k2, R0); crow_finish<FINAL>(F, base + 2 * k2 + 1, R1); }
            else if (two) { const int m = base + 2 * k2 + (int)(two >> 1); CRow R0; crow_load(F, RY, m, R0); crow_finish<FINAL>(F, m, R0); }
        }
    }
}
}
namespace mk {
typedef float f32x4v __attribute__((ext_vector_type(4)));
template <bool FUSED = false> __device__ __forceinline__ void phase_router(const Frame& F, int layer) {
    LAS float* red = (LAS float*)F.lds;
    LAS float* ssqr = (LAS float*)(F.lds + 98304);
    LAS float* lg = (LAS float*)(F.lds + 100352);
    LAS float* rsl = (LAS float*)(F.lds + 112640);
    LAS int* sel = (LAS int*)(F.lds + 112896);
    LAS float* gwl = (LAS float*)(F.lds + 113408);
    LAS int* basel = (LAS int*)(F.lds + 113920);
    const bf16_t* RH = (const bf16_t*)(F.ws + WS_ROUTER) + (size_t)(layer * 2) * 49152 + (size_t)F.wave * 6144;
    const bf16_t* RL = RH + 49152;
    unsigned* gcnt = (unsigned*)(F.ws + WS_CTL) + CW_ECNT + layer * 32 * 64;
    const int r = F.lane & 15, q = F.lane >> 4;
    for (int unit = F.vcu; unit < T / 64; unit += F.G) {
        const int tok0 = unit * 64;
        if constexpr (FUSED) {
            const f32x4* PT = (const f32x4*)(F.ws + WS_PART);
            for (int idx = F.tid; idx < 64 * 13; idx += NTHR) { const int t = idx / 13, j = idx - 13 * t;
                f32x4 s = PT[(size_t)(tok0 + t) * 13 + j];
#pragma unroll
                for (int pn = 1; pn < 4; ++pn) s += PT[((size_t)pn * T + tok0 + t) * 13 + j];
                if (j < 12) *(LAS f32x4*)(lg + t * 48 + 4 * j) = s; else rsl[t] = 1.0f / sqrtf(s[0] * (1.f / 1024.f) + EPS); }
        } else {
        const float* X = F.out + (size_t)tok0 * D + 128 * F.wave + 8 * q;
        f32x4 acc[4][3]; float ssq[4];
#pragma unroll
        for (int tt = 0; tt < 4; ++tt) { ssq[tt] = 0.f;
#pragma unroll
            for (int ct = 0; ct < 3; ++ct) acc[tt][ct] = (f32x4){0.f, 0.f, 0.f, 0.f}; }
#pragma unroll 2
        for (int ks = 0; ks < 4; ++ks) {
            bf16x8 bh[3], bl[3];
#pragma unroll
            for (int ct = 0; ct < 3; ++ct) { bh[ct] = *(const GAS bf16x8*)(RH + ((ks * 3 + ct) * 64 + F.lane) * 8); bl[ct] = *(const GAS bf16x8*)(RL + ((ks * 3 + ct) * 64 + F.lane) * 8); }
#pragma unroll
            for (int tt = 0; tt < 4; ++tt) {
                const float* xp = X + (size_t)(16 * tt + r) * D + 32 * ks;
                const f32x4 x0 = *(const GAS f32x4*)xp, x1 = *(const GAS f32x4*)(xp + 4);
                float xv[8] = {x0.x, x0.y, x0.z, x0.w, x1.x, x1.y, x1.z, x1.w};
                unsigned hh[8], ll[8];
#pragma unroll
                for (int j = 0; j < 8; ++j) { ssq[tt] = fmaf(xv[j], xv[j], ssq[tt]); hh[j] = f2bf(xv[j]); ll[j] = f2bf(xv[j] - bf2f(hh[j])); }
                u32x4 ahw, alw;
                ahw.x = hh[0] | (hh[1] << 16); ahw.y = hh[2] | (hh[3] << 16); ahw.z = hh[4] | (hh[5] << 16); ahw.w = hh[6] | (hh[7] << 16);
                alw.x = ll[0] | (ll[1] << 16); alw.y = ll[2] | (ll[3] << 16); alw.z = ll[4] | (ll[5] << 16); alw.w = ll[6] | (ll[7] << 16);
                const bf16x8 ah = __builtin_bit_cast(bf16x8, ahw), al = __builtin_bit_cast(bf16x8, alw);
#pragma unroll
                for (int ct = 0; ct < 3; ++ct) {
                    acc[tt][ct] = __builtin_amdgcn_mfma_f32_16x16x32_bf16(ah, bh[ct], acc[tt][ct], 0, 0, 0);
                    acc[tt][ct] = __builtin_amdgcn_mfma_f32_16x16x32_bf16(al, bh[ct], acc[tt][ct], 0, 0, 0);
                    acc[tt][ct] = __builtin_amdgcn_mfma_f32_16x16x32_bf16(ah, bl[ct], acc[tt][ct], 0, 0, 0);
                }
            }
        }
#pragma unroll
        for (int tt = 0; tt < 4; ++tt) {
#pragma unroll
            for (int ct = 0; ct < 3; ++ct)
#pragma unroll
                for (int i = 0; i < 4; ++i) red[(F.wave * 64 + 16 * tt + 4 * q + i) * 48 + 16 * ct + r] = acc[tt][ct][i];
            float s = ssq[tt]; s += __shfl_xor(s, 16); s += __shfl_xor(s, 32);
            if (q == 0) ssqr[F.wave * 64 + 16 * tt + r] = s;
        }
        __syncthreads();
        for (int idx = F.tid; idx < 3072; idx += NTHR) { float s = 0.f;
#pragma unroll
            for (int w = 0; w < 8; ++w) s += red[w * 3072 + idx];
            lg[idx] = s; }
        if (F.tid < 64) { float s = 0.f;
#pragma unroll
            for (int w = 0; w < 8; ++w) s += ssqr[w * 64 + F.tid];
            rsl[F.tid] = 1.0f / sqrtf(s * (1.f / 1024.f) + EPS); }
        }
        __syncthreads();
        if (F.tid < 64) {
            const int t = tok0 + F.tid; const float rs = rsl[F.tid]; const LAS float* L = lg + F.tid * 48;
            const float* bg = F.in[22] + layer * 4; const float* br = F.in[24] + layer * 32;
            float gl[4];
#pragma unroll
            for (int j = 0; j < 4; ++j) gl[j] = L[j] * rs + bg[j];
            int gi = 0; float gm = gl[0];
#pragma unroll
            for (int j = 1; j < 4; ++j) if (gl[j] > gm) { gm = gl[j]; gi = j; }
            float den = 0.f;
#pragma unroll
            for (int j = 0; j < 4; ++j) den += __expf(gl[j] - gm);
            const float gp = 1.f / den;
            float el[8];
#pragma unroll
            for (int e = 0; e < 8; ++e) el[e] = L[4 + 8 * gi + e] * rs + br[gi * 8 + e];
            int i1 = 0; float v1 = el[0];
#pragma unroll
            for (int e = 1; e < 8; ++e) if (el[e] > v1) { v1 = el[e]; i1 = e; }
            int i2 = 0; float v2 = -3.0e38f;
#pragma unroll
            for (int e = 0; e < 8; ++e) if (e != i1 && el[e] > v2) { v2 = el[e]; i2 = e; }
            const float e2 = __expf(v2 - v1);
            sel[2 * F.tid] = gi * 8 + i1; sel[2 * F.tid + 1] = gi * 8 + i2;
            gwl[2 * F.tid] = gp / (1.f + e2); gwl[2 * F.tid + 1] = gp * e2 / (1.f + e2);
            ((float*)(F.ws + WS_RSM))[t] = rs;
        }
        __syncthreads();
        LAS int* cntw = basel + 32;
        int pos = 0, myexp = 0;
        if (F.tid < 128) { myexp = sel[F.tid]; unsigned long long mymask = 0ull;
#pragma unroll 4
            for (int e = 0; e < 32; ++e) { const unsigned long long m = __ballot(myexp == e); if (myexp == e) mymask = m; if (F.lane == 0) cntw[F.wave * 32 + e] = __popcll(m); }
            pos = __popcll(mymask & ((1ull << F.lane) - 1ull)); }
        __syncthreads();
        if (F.tid >= 128 && F.tid < 160) { const int e = F.tid - 128; const int c = cntw[e] + cntw[32 + e];
            basel[e] = c ? (int)__hip_atomic_fetch_add(gcnt + e * 64, (unsigned)c, __ATOMIC_RELAXED, __HIP_MEMORY_SCOPE_AGENT) : 0; }
        __syncthreads();
        if (F.tid < 128) { const size_t dst = (size_t)myexp * T + basel[myexp] + pos + (F.wave == 1 ? cntw[myexp] : 0);
            ((int*)(F.ws + WS_LSLOT))[dst] = 2 * (tok0 + (F.tid >> 1)) + (F.tid & 1);
            ((float*)(F.ws + WS_LGW))[dst] = gwl[F.tid]; }
        __syncthreads();
    }
}

#ifndef MK_PF1
#define MK_PF1 8
#endif
#ifndef MK_PF2
#define MK_PF2 8
#endif
__device__ __forceinline__ bf16x8 fp8x8_to_bf16(u32x2 w) {
    u32x4 o;
    o.x = __builtin_bit_cast(unsigned, __builtin_amdgcn_cvt_scalef32_pk_bf16_fp8(w.x, 1.0f, false)); o.y = __builtin_bit_cast(unsigned, __builtin_amdgcn_cvt_scalef32_pk_bf16_fp8(w.x, 1.0f, true));
    o.z = __builtin_bit_cast(unsigned, __builtin_amdgcn_cvt_scalef32_pk_bf16_fp8(w.y, 1.0f, false)); o.w = __builtin_bit_cast(unsigned, __builtin_amdgcn_cvt_scalef32_pk_bf16_fp8(w.y, 1.0f, true));
    return __builtin_bit_cast(bf16x8, o);
}
#ifndef MK_YAUX
#define MK_YAUX 16
#endif
#define MOE_LDW(rsrc, soff) __builtin_amdgcn_raw_buffer_load_b128((rsrc), loff, (soff), 0)
template <int NT, int PRB = 0> __device__ __forceinline__ void moe_segment_t(const Frame& F, int layer, int e, int l0, int n, int uoff) {
    constexpr bool P_NOMFMA = PRB == 2 || (PRB >= 16 && (PRB & 1)), P_WHIT = PRB == 3 || (PRB >= 16 && (PRB & 2)), P_NOLDS = PRB == 4 || (PRB >= 16 && (PRB & 4)),
                   P_NOCVT = PRB == 5 || (PRB >= 16 && (PRB & 8)), P_NOSTG = PRB == 6 || (PRB >= 32 && (PRB & 16));
    constexpr int PF = (NT <= 2) ? 8 : MK_PF1, PF2 = (NT <= 2) ? 8 : MK_PF2;
    constexpr int XRB = 34816;
    LAS unsigned char* XR = F.lds;
    LAS unsigned char* HID = F.lds + 2 * XRB;
    LAS int* s_slot = (LAS int*)(F.lds + 2 * XRB + 65536);
    LAS float* s_gw = (LAS float*)(s_slot + 128);
    LAS float* s_rs = s_gw + 128;
    LAS int* u_slots = (LAS int*)(s_rs + 128);
    const int r32 = F.lane & 31, hi = F.lane >> 5, w = F.wave;
    const __amdgpu_buffer_rsrc_t R1 = uniform_rsrc(F.ws + WS_WMOE + (size_t)layer * WMOE_LAYER + (size_t)e * W1_EXP + (size_t)w * 65536, 65536);
    const __amdgpu_buffer_rsrc_t R2 = uniform_rsrc(F.ws + WS_WMOE + (size_t)layer * WMOE_LAYER + WMOE_W2 + (size_t)e * W2_EXP + (size_t)w * 16384, 262144);
    const int loff = F.lane * 16;
    u32x4 wb[PF > PF2 ? PF : PF2];
#pragma unroll
    for (int s = 0; s < PF; ++s) wb[s] = MOE_LDW(R1, s * 1024);
    const int pr = F.tid >> 4, pc = F.tid & 15;
    const __amdgpu_buffer_rsrc_t RXB = uniform_rsrc(F.ws + WS_XB, (unsigned)T * 2048u);
    const int* LS = (const int*)(F.ws + WS_LSLOT) + (size_t)e * T + l0;
    unsigned xo[4];
#pragma unroll
    for (int j = 0; j < 4; ++j) { const int rj = pr + 32 * j; xo[j] = (unsigned)(LS[rj < n ? rj : 0] >> 1) * 2048u + (unsigned)pc * 16u; }
    __builtin_amdgcn_sched_barrier(0);
    const int xw = pr * 272 + pc * 16;
    u32x4 xs[4];
#pragma unroll
    for (int j = 0; j < 4; ++j) xs[j] = __builtin_amdgcn_raw_buffer_load_b128(RXB, xo[j], 0, 0);
    if (F.tid < 128) { const int tl = F.tid < n ? F.tid : 0; const size_t li = (size_t)e * T + l0 + tl;
        const int myslot = LS[tl]; s_slot[F.tid] = F.tid < n ? myslot : -1; if (F.tid < n) u_slots[uoff + F.tid] = myslot; s_gw[F.tid] = F.tid < n ? ((const float*)(F.ws + WS_LGW))[li] * WDESCALE : 0.f;
        s_rs[F.tid] = ((const float*)(F.ws + WS_LRS))[li] * WDESCALE; }
    __builtin_amdgcn_sched_barrier(0);
#pragma unroll
    for (int j = 0; j < 4; ++j) *(LAS u32x4*)(XR + xw + j * 8704) = xs[j];
    __syncthreads();
    f32x16 accg[NT], accu[NT];
#pragma unroll
    for (int i = 0; i < NT; ++i) { accg[i] = f32x16{}; accu[i] = f32x16{}; }
    bf16x8 xf[NT];
    for (int kc = 0; kc < (PRB == 8 ? 0 : 8); ++kc) {
        const LAS unsigned char* buf = XR + (kc & 1) * XRB + r32 * 272 + hi * 16;
        LAS unsigned char* nb = XR + ((kc + 1) & 1) * XRB + xw;
#pragma unroll
        for (int ks = 0; ks < 8; ++ks) {
            __builtin_amdgcn_sched_barrier(0);
#pragma unroll
            for (int i = 0; i < NT; ++i) if (!P_NOLDS || ks == 0) xf[i] = *(const LAS bf16x8*)(buf + 32 * i * 272 + 2 * ks * 16);
            if (kc < 7 && !P_NOSTG) {
                if (ks == 0) { const int so = (kc + 1) * 256;
                    xs[0] = __builtin_amdgcn_raw_buffer_load_b128(RXB, xo[0], so, 0); xs[1] = __builtin_amdgcn_raw_buffer_load_b128(RXB, xo[1], so, 0);
                    xs[2] = __builtin_amdgcn_raw_buffer_load_b128(RXB, xo[2], so, 0); xs[3] = __builtin_amdgcn_raw_buffer_load_b128(RXB, xo[3], so, 0); }
                if (ks == 7) { *(LAS u32x4*)(nb) = xs[0]; *(LAS u32x4*)(nb + 8704) = xs[1]; *(LAS u32x4*)(nb + 17408) = xs[2]; *(LAS u32x4*)(nb + 26112) = xs[3]; }
            }
            const u32x2 g8 = {wb[ks % PF].x, wb[ks % PF].y}, u8 = {wb[ks % PF].z, wb[ks % PF].w};
            if (ks < 8 - PF || kc < 7) { const int o = P_WHIT ? (ks & 3) * 1024 : (kc * 8 + ks + PF) * 1024;
                wb[ks % PF] = MOE_LDW(R1, o); }
            const bf16x8 wg = P_NOCVT ? __builtin_bit_cast(bf16x8, (u32x4){g8.x, g8.y, g8.x, g8.y}) : fp8x8_to_bf16(g8), wu = P_NOCVT ? __builtin_bit_cast(bf16x8, (u32x4){u8.x, u8.y, u8.x, u8.y}) : fp8x8_to_bf16(u8);
#pragma unroll
            for (int i = 0; i < NT; ++i) {
                if (P_NOMFMA) { asm volatile("" :: "v"(wg), "v"(wu), "v"(xf[i])); } else {
                accg[i] = __builtin_amdgcn_mfma_f32_32x32x16_bf16(wg, xf[i], accg[i], 0, 0, 0);
                accu[i] = __builtin_amdgcn_mfma_f32_32x32x16_bf16(wu, xf[i], accu[i], 0, 0, 0); }
            }
        }
        __builtin_amdgcn_sched_barrier(0);
        if (PRB != 7) __syncthreads();
    }
#pragma unroll
    for (int s = 0; s < PF2; ++s) wb[s] = MOE_LDW(R2, s * 1024);
#pragma unroll
    for (int i = 0; i < NT; ++i) {
        const float rs = s_rs[32 * i + r32], gw = s_gw[32 * i + r32];
#pragma unroll
        for (int s = 0; s < 2; ++s) { float hv[8];
#pragma unroll
            for (int j = 0; j < 8; j += 2) { const f32x2 g = {accg[i][8 * s + j], accg[i][8 * s + j + 1]}, u = {accu[i][8 * s + j], accu[i][8 * s + j + 1]};
                const f32x2 v = mul_sigmoid2_f((g * rs) * (u * (rs * gw)), g * (-rs * LOG2E)); hv[j] = v.x; hv[j + 1] = v.y; }
            u32x4 o; o.x = pk2(hv[0], hv[1]); o.y = pk2(hv[2], hv[3]); o.z = pk2(hv[4], hv[5]); o.w = pk2(hv[6], hv[7]);
            *(LAS u32x4*)(HID + (((2 * w + s) * 2 + hi) * 128 + 32 * i + r32) * 16) = o; }
    }
    __syncthreads();
    const __amdgpu_buffer_rsrc_t RY = uniform_rsrc(F.ws + WS_Y, 2u * (unsigned)T * 2048u);
    const LAS unsigned char* hb = HID + (hi * 128 + r32) * 16;
#pragma unroll 1
    for (int p = 0; p < 2; ++p) {
        f32x16 acc2[NT][2];
#pragma unroll
        for (int i = 0; i < NT; ++i) { acc2[i][0] = f32x16{}; acc2[i][1] = f32x16{}; }
#pragma unroll
        for (int kk = 0; kk < (PRB == 8 ? 0 : 16); ++kk) {
            __builtin_amdgcn_sched_barrier(0);
#pragma unroll
            for (int i = 0; i < NT; ++i) if (!P_NOLDS || kk == 0) xf[i] = *(const LAS bf16x8*)(hb + (kk * 2 * 128 + 32 * i) * 16);
            const u32x2 g8 = {wb[kk % PF2].x, wb[kk % PF2].y}, u8 = {wb[kk % PF2].z, wb[kk % PF2].w};
            if (kk < 16 - PF2 || p < 1) { const int o = P_WHIT ? (kk & 3) * 1024 : (kk < 16 - PF2) ? (p * 131072 + (kk + PF2) * 1024) : ((p + 1) * 131072 + (kk + PF2 - 16) * 1024);
                wb[kk % PF2] = MOE_LDW(R2, o); }
            const bf16x8 a0 = P_NOCVT ? __builtin_bit_cast(bf16x8, (u32x4){g8.x, g8.y, g8.x, g8.y}) : fp8x8_to_bf16(g8), a1 = P_NOCVT ? __builtin_bit_cast(bf16x8, (u32x4){u8.x, u8.y, u8.x, u8.y}) : fp8x8_to_bf16(u8);
#pragma unroll
            for (int i = 0; i < NT; ++i) {
                if (P_NOMFMA) { asm volatile("" :: "v"(a0), "v"(a1), "v"(xf[i])); } else {
                acc2[i][0] = __builtin_amdgcn_mfma_f32_32x32x16_bf16(a0, xf[i], acc2[i][0], 0, 0, 0);
                acc2[i][1] = __builtin_amdgcn_mfma_f32_32x32x16_bf16(a1, xf[i], acc2[i][1], 0, 0, 0); }
            }
        }
        __builtin_amdgcn_sched_barrier(0);
#pragma unroll
        for (int i = 0; i < NT; ++i) {
            __builtin_amdgcn_sched_barrier(0);
            if (PRB != 0) { asm volatile("" :: "v"(acc2[i][0]), "v"(acc2[i][1])); } else {
                int ln_ = F.lane; asm volatile("" : "+v"(ln_));
                LAS unsigned char* ysc = F.lds + w * 8192;
                const unsigned yoff = (unsigned)(1024 * p + 128 * w + 16 * (ln_ & 7));
                const int wro = (ln_ & 31) * 144 + 32 * (ln_ >> 5), rdo = (ln_ >> 3) * 144 + (ln_ & 7) * 16;
#pragma unroll
                for (int dt = 0; dt < 2; ++dt)
#pragma unroll
                    for (int q2 = 0; q2 < 2; ++q2) {
                        const unsigned a0 = pk2(acc2[i][dt][4 * q2], acc2[i][dt][4 * q2 + 1]), a1 = pk2(acc2[i][dt][4 * q2 + 2], acc2[i][dt][4 * q2 + 3]);
                        const unsigned b0 = pk2(acc2[i][dt][4 * q2 + 8], acc2[i][dt][4 * q2 + 9]), b1 = pk2(acc2[i][dt][4 * q2 + 10], acc2[i][dt][4 * q2 + 11]);
                        const auto s0 = __builtin_amdgcn_permlane32_swap(a0, b0, false, false), s1 = __builtin_amdgcn_permlane32_swap(a1, b1, false, false);
                        const u32x4 o = {(unsigned)s0[0], (unsigned)s1[0], (unsigned)s0[1], (unsigned)s1[1]};
                        *(LAS u32x4*)(ysc + wro + (32 * dt + 8 * q2) * 2) = o; }
                LDS_WAIT(); asm volatile("" ::: "memory");
#pragma unroll
                for (int k = 0; k < 4; ++k) { const int sl = s_slot[32 * i + 8 * k + (ln_ >> 3)];
                    const u32x4 v = *(const LAS u32x4*)(ysc + rdo + 8 * k * 144);
                    __builtin_amdgcn_raw_buffer_store_b128(v, RY, sl >= 0 ? (unsigned)sl * 2048u + yoff : 0xfffffff0u, 0, MK_YAUX); }
                LDS_WAIT(); asm volatile("" ::: "memory");
            }
        }
    }
    __syncthreads();
}
template <int PRB = 0> __device__ __forceinline__ void moe_segment(const Frame& F, int layer, int e, int l0, int n, int uoff) {
    const int nt = (n + 31) >> 5;
    if (nt == 4) moe_segment_t<4, PRB>(F, layer, e, l0, n, uoff); else if (nt == 3) moe_segment_t<3, PRB>(F, layer, e, l0, n, uoff); else if (nt == 2) moe_segment_t<2, PRB>(F, layer, e, l0, n, uoff); else moe_segment_t<1, PRB>(F, layer, e, l0, n, uoff);
}
template <int PRB = 0> __device__ __forceinline__ int phase_moe(const Frame& F, int layer) {
    int nseg = 0;
    unsigned* gcnt = (unsigned*)(F.ws + WS_CTL) + CW_ECNT + layer * 32 * 64;
    const int mycnt = (int)__hip_atomic_load(gcnt + (F.lane & 31) * 64, __ATOMIC_RELAXED, __HIP_MEMORY_SCOPE_AGENT);
    for (int unit = F.vcu; unit < 256; unit += F.G) {
        const int v0 = 128 * unit, v1 = v0 + 128; int vb = 0;
        for (int e = 0; e < 32; ++e) {
            const int ne = __builtin_amdgcn_readlane(mycnt, e);
            const int lo = v0 > vb ? v0 : vb, hi_ = v1 < vb + ne ? v1 : vb + ne;
            if (lo < hi_) { moe_segment<PRB>(F, layer, e, lo - vb, hi_ - lo, lo - v0); ++nseg; }
            vb += ne;
        }
        if (PRB == 0) {
            asm volatile("s_waitcnt vmcnt(0)" ::: "memory");
            __syncthreads();
            if (F.tid < 128) { const int sl = ((LAS int*)(F.lds + 2 * 34816 + 65536 + 1536))[F.tid];
                __hip_atomic_store((unsigned*)(F.ws + WS_CTL) + CW_READY + layer * 32768 + sl, 1u, __ATOMIC_RELAXED, __HIP_MEMORY_SCOPE_AGENT); }
            __syncthreads();
        }
    }
    return nseg;
}
}
namespace mk {
__device__ __forceinline__ float xmax32(float v) { const unsigned u = __builtin_bit_cast(unsigned, v); const auto rr = __builtin_amdgcn_permlane32_swap(u, u, false, false); return fmaxf(__builtin_bit_cast(float, (unsigned)rr[0]), __builtin_bit_cast(float, (unsigned)rr[1])); }
__device__ __forceinline__ int crow(int r, int hi) { return (r & 3) + 8 * (r >> 2) + 4 * hi; }
__device__ __forceinline__ s16x4 vtr(const LAS unsigned char* p) {
    typedef short v4i16_t __attribute__((ext_vector_type(4)));
    return __builtin_bit_cast(s16x4, __builtin_amdgcn_ds_read_tr16_b64_v4i16((LAS v4i16_t*)p));
}
constexpr float ATT_THR = 8.f;

template <int MODE, int APROBE = 0> __device__ __forceinline__ void attn_unit(const Frame& F, int unit) {
    constexpr int NKC = MODE == 0 ? 12 : 8, ND0 = NKC / 2, KBYTES = NKC * 1024, BUF = KBYTES + 8192;
    const int lane = F.lane, w = F.wave, r32 = lane & 31, hi = lane >> 5;
    LAS unsigned char* lds = F.lds;
    constexpr int NBUF = 3;
    LAS float* wsf = (LAS float*)(lds + NBUF * BUF) + w * 64;
    LAS bf16_t* stg = (LAS bf16_t*)(lds + NBUF * BUF + 2048) + w * 2048;
    const bf16_t* Qb = (const bf16_t*)(F.ws + WS_Q); const bf16_t* KVb = (const bf16_t*)(F.ws + WS_KV); const bf16_t* KPE = (const bf16_t*)(F.ws + WS_KPE);
    const bf16_t* Pb = (const bf16_t*)(F.ws + WS_P); bf16_t* Ob = (bf16_t*)(F.ws + WS_MB);
    int b, h = 0, g = 0, hq = 0, tq0, j_lo, j_hi, kbase0, ocol, qpos0 = 0;
    if (MODE == 0) { b = unit >> 6; h = (unit >> 3) & 7; const int qb = unit & 7; tq0 = b * S + 256 * qb + 32 * w; j_lo = 0; j_hi = 32; kbase0 = b * S; ocol = h * 64; }
    else { b = unit >> 6; const int rem = unit & 63; g = rem >> 5; const int qblk = (rem >> 1) & 15, hp = rem & 1; hq = 4 * g + 2 * hp + (w >> 2);
        qpos0 = 128 * qblk + 32 * (w & 3); tq0 = b * S + qpos0; j_lo = (qblk == 0) ? 2 : 0; j_hi = (qblk == 15) ? 4 : 6; kbase0 = b * S + 128 * qblk - 128; ocol = 512 + hq * 64; }
    bf16x8 qr[ND0];
    if (MODE == 0) { const bf16_t* qrow = Qb + (size_t)(tq0 + r32) * 768;
#pragma unroll
        for (int d0 = 0; d0 < 4; ++d0) qr[d0] = *(const GAS bf16x8*)(qrow + h * 64 + 16 * d0 + 8 * hi);
#pragma unroll
        for (int d0 = 4; d0 < 6; ++d0) qr[d0] = *(const GAS bf16x8*)(qrow + 512 + h * 32 + 16 * (d0 - 4) + 8 * hi);
        {
            const f32x2* rp = (const f32x2*)(F.ws + WS_ROPE) + ((tq0 + r32) & (S - 1)) * 16 + 8 * hi;
            bf16x8 a4 = qr[4], a5 = qr[5];
#pragma unroll
            for (int j = 0; j < 8; ++j) { const f32x2 cs = rp[j]; const float x = bf2f((unsigned short)a4[j]), y = bf2f((unsigned short)a5[j]);
                a4[j] = (short)f2bf(x * cs.x - y * cs.y); a5[j] = (short)f2bf(y * cs.x + x * cs.y); }
            qr[4] = a4; qr[5] = a5; }
    } else { const bf16_t* qrow = Pb + (size_t)(tq0 + r32) * 1280 + 512 + hq * 64;
#pragma unroll
        for (int d0 = 0; d0 < ND0; ++d0) qr[d0] = *(const GAS bf16x8*)(qrow + 16 * d0 + 8 * hi);
    }
    const bf16_t *ksrc0, *ksrc1 = nullptr, *vsrc; size_t kstride, kstride1 = 0, vstride;
    const int vrow = 16 * (w & 3) + (lane >> 2), vcol = (w >> 2) * 32 + (lane & 3) * 8;
    if (MODE == 0) { ksrc0 = KVb + (size_t)(kbase0 + lane) * 1024 + h * 64 + w * 8; kstride = 64 * 1024;
        ksrc1 = KPE + (size_t)(kbase0 + lane) * 32 + (w & 3) * 8; kstride1 = 64 * 32;
        vsrc = KVb + (size_t)(kbase0 + vrow) * 1024 + 512 + h * 64 + vcol; vstride = 64 * 1024; }
    else { ksrc0 = Pb + (size_t)((long)kbase0 + lane) * 1280 + 1024 + g * 64 + w * 8; kstride = 64 * 1280;
        vsrc = Pb + (size_t)((long)kbase0 + vrow) * 1280 + 1152 + g * 64 + vcol; vstride = 64 * 1280; }
    const bool two_k = (MODE == 0) && (w < 4);
    u32x4 ks0s[2], ks1s[2] = {{0u, 0u, 0u, 0u}, {0u, 0u, 0u, 0u}}, vss[2];
#define ATT_LOAD(S, j) do { ks0s[S] = *(const GAS u32x4*)(ksrc0 + (size_t)(j) * kstride); if (MODE == 0) ks1s[S] = *(const GAS u32x4*)(ksrc1 + (size_t)(j) * kstride1); vss[S] = *(const GAS u32x4*)(vsrc + (size_t)(j) * vstride); } while (0)
#define ATT_WRITE(S, bufo) do { *(LAS u32x4*)(lds + (bufo) + w * 1024 + lane * 16) = ks0s[S]; if (MODE == 0) *(LAS u32x4*)(lds + (bufo) + (8 + (w & 3)) * 1024 + lane * 16) = ks1s[S]; \
        *(LAS u32x4*)(lds + (bufo) + KBYTES + w * 1024 + lane * 16) = vss[S]; } while (0)
    float m_run, l_run; f32x16 o[2]; o[0] = f32x16{}; o[1] = f32x16{};
    float slope2 = 0.f;
    if (MODE == 1) { m_run = F.in[19][hq] * LOG2E; l_run = (hi == 0) ? 1.f : 0.f; slope2 = exp2f(-(float)(hq + 1)) * LOG2E; }
    else { m_run = -1e30f; l_run = 0.f; }
#ifndef MK_ATT_STAGGER
#define MK_ATT_STAGGER 0
#endif
    const bool late = MK_ATT_STAGGER && (w >= 4);
    ATT_LOAD(0, j_lo); ATT_WRITE(0, 0); ATT_LOAD(1, j_lo + 1); __syncthreads();
    const int voff = KBYTES + ((lane >> 4) & 1) * 32 + (lane & 3) * 8 + (4 * hi + ((lane & 15) >> 2)) * 64;
    int bo_prev = 0, bo_cur = 0, bo_next = BUF;
    u32x4 pwp[4] = {{0u, 0u, 0u, 0u}, {0u, 0u, 0u, 0u}, {0u, 0u, 0u, 0u}, {0u, 0u, 0u, 0u}};
#define SB() __builtin_amdgcn_sched_barrier(0)
#define ATT_VRD(BO) do { const LAS unsigned char* vp_ = lds + (BO) + voff; \
        _Pragma("unroll") for (int i_ = 0; i_ < 8; ++i_) { vl[i_] = vtr(vp_ + (i_ >> 2) * 4096 + (i_ & 3) * 1024); vh[i_] = vtr(vp_ + (i_ >> 2) * 4096 + (i_ & 3) * 1024 + 512); } } while (0)
#define ATT_PVM(PW) do { _Pragma("unroll") for (int i_ = 0; i_ < 8; ++i_) { \
            const bf16x8 vf = (bf16x8){vl[i_][0], vl[i_][1], vl[i_][2], vl[i_][3], vh[i_][0], vh[i_][1], vh[i_][2], vh[i_][3]}; \
            o[i_ >> 2] = __builtin_amdgcn_mfma_f32_32x32x16_bf16(__builtin_bit_cast(bf16x8, PW[i_ & 3]), vf, o[i_ >> 2], 0, 0, 0); } } while (0)
    s16x4 vl[8], vh[8];
    for (int j2 = j_lo; j2 < j_hi; j2 += 2) {
#pragma unroll
    for (int par = 0; par < 2; ++par) { const int j = j2 + par;
        if (APROBE != 1) { const int jl = (j + 2 < j_hi) ? j + 2 : j_hi - 1; ATT_LOAD(par, jl); }
        if (late && j > j_lo) { ATT_VRD(bo_prev); SB(); ATT_PVM(pwp); SB(); }
        f32x16 p0 = f32x16{}, p1 = f32x16{};
        const LAS unsigned char* kb = lds + bo_cur + hi * 1024 + r32 * 16;
        {
            bf16x8 kf0[ND0], kf1[ND0];
#pragma unroll
            for (int d0 = 0; d0 < ND0; ++d0) { kf0[d0] = *(const LAS bf16x8*)(kb + d0 * 2048); kf1[d0] = *(const LAS bf16x8*)(kb + d0 * 2048 + 512); }
            SB();
#pragma unroll
            for (int d0 = 0; d0 < ND0; ++d0) {
                p0 = __builtin_amdgcn_mfma_f32_32x32x16_bf16(kf0[d0], qr[d0], p0, 0, 0, 0);
                p1 = __builtin_amdgcn_mfma_f32_32x32x16_bf16(kf1[d0], qr[d0], p1, 0, 0, 0);
            }
            SB();
        }
        if (!late) { ATT_VRD(bo_cur); SB(); }
        if (MODE == 1) {
            const int qp = qpos0 + r32, kp = 128 * ((unit >> 1) & 15) - 128 + 64 * j;
#pragma unroll
            for (int r = 0; r < 16; ++r) { const int k0 = kp + crow(r, hi); int d0_ = qp - k0; d0_ = d0_ < 0 ? -d0_ : d0_; int d1_ = qp - (k0 + 32); d1_ = d1_ < 0 ? -d1_ : d1_;
                p0[r] = (d0_ <= 128) ? p0[r] - slope2 * (float)d0_ : -1e30f; p1[r] = (d1_ <= 128) ? p1[r] - slope2 * (float)d1_ : -1e30f; }
        }
        float pmax = p0[0];
#pragma unroll
        for (int r = 1; r < 16; ++r) pmax = fmaxf(pmax, p0[r]);
#pragma unroll
        for (int r = 0; r < 16; ++r) pmax = fmaxf(pmax, p1[r]);
        pmax = fmaxf(pmax, __shfl_xor(pmax, 32));
        if (!__all(pmax - m_run <= ATT_THR)) {
            const float mn = fmaxf(m_run, pmax), alpha = fast_exp2(m_run - mn); m_run = mn; l_run *= alpha;
            if (hi == 0) wsf[r32] = alpha;
            LDS_WAIT(); asm volatile("" ::: "memory");
#pragma unroll
            for (int r = 0; r < 16; ++r) { const float a = wsf[crow(r, hi)]; o[0][r] *= a; o[1][r] *= a; }
        }
        float ps = 0.f;
#pragma unroll
        for (int r = 0; r < 16; ++r) { if (APROBE != 2) { p0[r] = fast_exp2(p0[r] - m_run); p1[r] = fast_exp2(p1[r] - m_run); ps += p0[r] + p1[r]; } }
        l_run += ps;
        u32x4 pw[4];
        pw[0] = (u32x4){pk2(p0[0], p0[1]), pk2(p0[2], p0[3]), pk2(p0[4], p0[5]), pk2(p0[6], p0[7])};
        pw[1] = (u32x4){pk2(p0[8], p0[9]), pk2(p0[10], p0[11]), pk2(p0[12], p0[13]), pk2(p0[14], p0[15])};
        pw[2] = (u32x4){pk2(p1[0], p1[1]), pk2(p1[2], p1[3]), pk2(p1[4], p1[5]), pk2(p1[6], p1[7])};
        pw[3] = (u32x4){pk2(p1[8], p1[9]), pk2(p1[10], p1[11]), pk2(p1[12], p1[13]), pk2(p1[14], p1[15])};
        SB();
        if (!late) ATT_PVM(pw);
        else { pwp[0] = pw[0]; pwp[1] = pw[1]; pwp[2] = pw[2]; pwp[3] = pw[3]; }
        if (APROBE != 1) { ATT_WRITE(par ^ 1, bo_next);
        __syncthreads(); }
        bo_prev = bo_cur; bo_cur = bo_next; bo_next = (bo_next == (NBUF - 1) * BUF) ? 0 : bo_next + BUF;
    } }
    if (late) { ATT_VRD(bo_prev); SB(); ATT_PVM(pwp); }
#undef ATT_VRD
#undef ATT_PVM
#undef SB
#undef ATT_LOAD
#undef ATT_WRITE
    const float lt = xsum32(l_run);
    if (hi == 0) wsf[32 + r32] = lt;
    LDS_WAIT(); asm volatile("" ::: "memory");
#pragma unroll
    for (int r = 0; r < 16; ++r) { const int orow = crow(r, hi); const float rl = fast_rcp(wsf[32 + orow]);
        stg[orow * 64 + r32] = (bf16_t)f2bf(o[0][r] * rl); stg[orow * 64 + 32 + r32] = (bf16_t)f2bf(o[1][r] * rl); }
    LDS_WAIT(); asm volatile("" ::: "memory");
    bf16_t* Ow = Ob + (size_t)tq0 * 1024 + ocol;
#pragma unroll
    for (int i = 0; i < 4; ++i) { const int row = i * 8 + (lane >> 3), ch = lane & 7; const u32x4 v = *(const LAS u32x4*)(stg + row * 64 + ch * 8); if (APROBE == 0) *(GAS u32x4*)(Ow + (size_t)row * 1024 + ch * 8) = v; else asm volatile("" :: "v"(v)); }
    __syncthreads();
}
__device__ __forceinline__ void mla_unit(const Frame& F, int unit) {
    constexpr int ND0 = 6, KBYTES = 12288, BUF = KBYTES + 8192, NBUF = 3, NTILE = 32;
    const int lane = F.lane, w = F.wave, r32 = lane & 31, hi = lane >> 5;
    LAS unsigned char* lds = F.lds;
    LAS float* wsf = (LAS float*)(lds + NBUF * BUF) + w * 64;
    LAS bf16_t* stg = (LAS bf16_t*)(lds + NBUF * BUF + 2048) + w * 2048;
    const bf16_t* Qb = (const bf16_t*)(F.ws + WS_Q); const bf16_t* KVb = (const bf16_t*)(F.ws + WS_KV); const bf16_t* KPE = (const bf16_t*)(F.ws + WS_KPE);
    bf16_t* Ob = (bf16_t*)(F.ws + WS_MB);
    const int b = unit >> 6, h = (unit >> 3) & 7, qb = unit & 7, tq0 = b * S + 256 * qb + 32 * w, kbase0 = b * S;
    const int vrow = 16 * (w & 3) + (lane >> 2), vcol = (w >> 2) * 32 + (lane & 3) * 8;
    const bf16_t* ksrc0 = KVb + (size_t)(kbase0 + lane) * 1024 + h * 64 + w * 8;
    const bf16_t* ksrc1 = KPE + (size_t)(kbase0 + lane) * 32 + (w & 3) * 8;
    const bf16_t* vsrc = KVb + (size_t)(kbase0 + vrow) * 1024 + 512 + h * 64 + vcol;
#define M_DMA(t_, bo_) do { const int tt_ = (t_) < NTILE ? (t_) : NTILE - 1; \
        __builtin_amdgcn_global_load_lds((const unsigned*)(ksrc0 + (size_t)tt_ * 65536), (LAS unsigned*)(lds + (bo_) + w * 1024), 16, 0, 0); \
        __builtin_amdgcn_global_load_lds((const unsigned*)(ksrc1 + (size_t)tt_ * 2048), (LAS unsigned*)(lds + (bo_) + (8 + (w & 3)) * 1024), 16, 0, 0); \
        __builtin_amdgcn_global_load_lds((const unsigned*)(vsrc + (size_t)tt_ * 65536), (LAS unsigned*)(lds + (bo_) + KBYTES + w * 1024), 16, 0, 0); } while (0)
#define M_LANDED() asm volatile("s_waitcnt vmcnt(0)" ::: "memory")
    M_DMA(0, 0); M_DMA(1, BUF);
    bf16x8 qr[ND0];
    { const bf16_t* qrow = Qb + (size_t)(tq0 + r32) * 768;
#pragma unroll
      for (int d0 = 0; d0 < 4; ++d0) qr[d0] = *(const GAS bf16x8*)(qrow + h * 64 + 16 * d0 + 8 * hi);
#pragma unroll
      for (int d0 = 4; d0 < 6; ++d0) qr[d0] = *(const GAS bf16x8*)(qrow + 512 + h * 32 + 16 * (d0 - 4) + 8 * hi);
      const f32x2* rp = (const f32x2*)(F.ws + WS_ROPE) + ((tq0 + r32) & (S - 1)) * 16 + 8 * hi;
      bf16x8 a4 = qr[4], a5 = qr[5];
#pragma unroll
      for (int j = 0; j < 8; ++j) { const f32x2 cs = rp[j]; const float x = bf2f((unsigned short)a4[j]), y = bf2f((unsigned short)a5[j]);
          a4[j] = (short)f2bf(x * cs.x - y * cs.y); a5[j] = (short)f2bf(y * cs.x + x * cs.y); }
      qr[4] = a4; qr[5] = a5; }
    const int voff = KBYTES + ((lane >> 4) & 1) * 32 + (lane & 3) * 8 + (4 * hi + ((lane & 15) >> 2)) * 64;
    float m_run = -1e30f, l_run = 0.f; f32x16 o[2]; o[0] = f32x16{}; o[1] = f32x16{};
    f32x16 pA0, pA1, pB0, pB1; float alA = 1.f, alB = 1.f; u32x4 pw[4];
#define M_QKT(P0, P1, bo_) do { const LAS unsigned char* kb_ = lds + (bo_) + hi * 1024 + r32 * 16; P0 = f32x16{}; P1 = f32x16{}; \
        _Pragma("unroll") for (int d0 = 0; d0 < ND0; ++d0) { const bf16x8 b0_ = *(const LAS bf16x8*)(kb_ + d0 * 2048), b1_ = *(const LAS bf16x8*)(kb_ + d0 * 2048 + 512); \
            P0 = __builtin_amdgcn_mfma_f32_32x32x16_bf16(b0_, qr[d0], P0, 0, 0, 0); P1 = __builtin_amdgcn_mfma_f32_32x32x16_bf16(b1_, qr[d0], P1, 0, 0, 0); } } while (0)
#define M_PART(P0, P1, AL) do { float pm_ = P0[0]; \
        _Pragma("unroll") for (int r = 1; r < 16; ++r) pm_ = fmaxf(pm_, P0[r]); \
        _Pragma("unroll") for (int r = 0; r < 16; ++r) pm_ = fmaxf(pm_, P1[r]); \
        pm_ = xmax32(pm_); \
        { const bool keep_ = __all(pm_ - m_run <= ATT_THR); const float mn_ = keep_ ? m_run : fmaxf(m_run, pm_); AL = fast_exp2(m_run - mn_); m_run = mn_; }     \
        { const f32x2 mm_ = {m_run, m_run}; \
        _Pragma("unroll") for (int r = 0; r < 16; r += 2) { f32x2 a_ = {P0[r], P0[r + 1]}, b_ = {P1[r], P1[r + 1]}; a_ -= mm_; b_ -= mm_;     \
            P0[r] = fast_exp2(a_.x); P0[r + 1] = fast_exp2(a_.y); P1[r] = b_.x; P1[r + 1] = b_.y; } } } while (0)
#define M_FIN(P0, P1, AL) do { f32x2 ps2_ = {0.f, 0.f}; \
        _Pragma("unroll") for (int r = 0; r < 16; r += 2) { P1[r] = fast_exp2(P1[r]); P1[r + 1] = fast_exp2(P1[r + 1]); ps2_ += (f32x2){P0[r], P0[r + 1]} + (f32x2){P1[r], P1[r + 1]}; } \
        const float ps_ = ps2_.x + ps2_.y; \
        l_run = l_run * AL + ps_; \
        pw[0] = (u32x4){pk2(P0[0], P0[1]), pk2(P0[2], P0[3]), pk2(P0[4], P0[5]), pk2(P0[6], P0[7])}; \
        pw[1] = (u32x4){pk2(P0[8], P0[9]), pk2(P0[10], P0[11]), pk2(P0[12], P0[13]), pk2(P0[14], P0[15])}; \
        pw[2] = (u32x4){pk2(P1[0], P1[1]), pk2(P1[2], P1[3]), pk2(P1[4], P1[5]), pk2(P1[6], P1[7])}; \
        pw[3] = (u32x4){pk2(P1[8], P1[9]), pk2(P1[10], P1[11]), pk2(P1[12], P1[13]), pk2(P1[14], P1[15])}; } while (0)
#define M_PV(bo_) do { const LAS unsigned char* vp_ = lds + (bo_) + voff; \
        _Pragma("unroll") for (int i_ = 0; i_ < 8; ++i_) { const s16x4 vl_ = vtr(vp_ + (i_ >> 2) * 4096 + (i_ & 3) * 1024), vh_ = vtr(vp_ + (i_ >> 2) * 4096 + (i_ & 3) * 1024 + 512); \
            const bf16x8 vf_ = (bf16x8){vl_[0], vl_[1], vl_[2], vl_[3], vh_[0], vh_[1], vh_[2], vh_[3]}; \
            o[i_ >> 2] = __builtin_amdgcn_mfma_f32_32x32x16_bf16(__builtin_bit_cast(bf16x8, pw[i_ & 3]), vf_, o[i_ >> 2], 0, 0, 0); } } while (0)
#define M_RESC(AL) do { if (__any(AL < 1.f)) { if (hi == 0) wsf[r32] = AL; LDS_WAIT(); asm volatile("" ::: "memory"); \
        _Pragma("unroll") for (int r = 0; r < 16; ++r) { const float a_ = wsf[crow(r, hi)]; o[0][r] *= a_; o[1][r] *= a_; } } } while (0)
    int bo_prev = 0, bo_cur = 0, bo_next = BUF;
#define M_ROT() do { bo_prev = bo_cur; bo_cur = bo_next; bo_next = (bo_next == (NBUF - 1) * BUF) ? 0 : bo_next + BUF; } while (0)
    M_LANDED(); __syncthreads();
    M_QKT(pA0, pA1, 0); M_PART(pA0, pA1, alA);
    M_ROT();
#define M_STEP(PX0, PX1, ALX, PY0, PY1, ALY, PAR_, jt_) do { \
        __builtin_amdgcn_sched_barrier(0); \
        M_DMA((jt_) + 1, bo_next); \
        __builtin_amdgcn_sched_barrier(0); \
        M_QKT(PX0, PX1, bo_cur); M_FIN(PY0, PY1, ALY); \
        _Pragma("unroll") for (int g_ = 0; g_ < 12; ++g_) { __builtin_amdgcn_sched_group_barrier(0x100, 1, 0); __builtin_amdgcn_sched_group_barrier(0x008, 1, 0); __builtin_amdgcn_sched_group_barrier(0x002, 6, 0); } \
        __builtin_amdgcn_sched_barrier(0); \
        M_PV(bo_prev); M_PART(PX0, PX1, ALX); \
        _Pragma("unroll") for (int g_ = 0; g_ < 8; ++g_) { __builtin_amdgcn_sched_group_barrier(0x100, 2, 1); __builtin_amdgcn_sched_group_barrier(0x008, 1, 1); __builtin_amdgcn_sched_group_barrier(0x002, 10, 1); } \
        __builtin_amdgcn_sched_barrier(0); \
        M_RESC(ALX); \
        M_LANDED(); __syncthreads(); M_ROT(); } while (0)
    for (int j = 1; j < NTILE; j += 2) {
        M_STEP(pB0, pB1, alB, pA0, pA1, alA, 1, j);
        if (j + 1 < NTILE) M_STEP(pA0, pA1, alA, pB0, pB1, alB, 0, j + 1);
    }
    M_FIN(pB0, pB1, alB); M_PV(bo_prev);
    const float lt = xsum32(l_run);
    if (hi == 0) wsf[32 + r32] = lt;
    LDS_WAIT(); asm volatile("" ::: "memory");
#pragma unroll
    for (int r = 0; r < 16; ++r) { const int orow = crow(r, hi); const float rl = fast_rcp(wsf[32 + orow]);
        stg[orow * 64 + r32] = (bf16_t)f2bf(o[0][r] * rl); stg[orow * 64 + 32 + r32] = (bf16_t)f2bf(o[1][r] * rl); }
    LDS_WAIT(); asm volatile("" ::: "memory");
    bf16_t* Ow = Ob + (size_t)tq0 * 1024 + h * 64;
#pragma unroll
    for (int i = 0; i < 4; ++i) { const int row = i * 8 + (lane >> 3), ch = lane & 7; const u32x4 v = *(const LAS u32x4*)(stg + row * 64 + ch * 8); *(GAS u32x4*)(Ow + (size_t)row * 1024 + ch * 8) = v; }
    __syncthreads();
#undef M_DMA
#undef M_LANDED
#undef M_QKT
#undef M_PART
#undef M_FIN
#undef M_PV
#undef M_RESC
#undef M_ROT
#undef M_STEP
}
__device__ __forceinline__ void swa_unit(const Frame& F, int unit) {
    constexpr int TB = 16384;
    const int lane = F.lane, w = F.wave, r32 = lane & 31, hi = lane >> 5;
    LAS unsigned char* lds = F.lds;
    LAS float* wsf = (LAS float*)(lds + 6 * TB) + w * 64;
    LAS bf16_t* stg = (LAS bf16_t*)(lds + 6 * TB + 2048) + w * 2048;
    const bf16_t* Pb = (const bf16_t*)(F.ws + WS_P); bf16_t* Ob = (bf16_t*)(F.ws + WS_MB);
    const int b = unit >> 5, g = (unit >> 4) & 1, qblk = unit & 15;
    const int j_lo = (qblk == 0) ? 2 : 0, j_hi = (qblk == 15) ? 4 : 6, nt = j_hi - j_lo;
    const long kbase = (long)b * S + 128 * qblk - 128 + 64 * j_lo;
    const int qpos0 = 128 * qblk + 32 * (w & 3), tq0 = b * S + qpos0;
    const int vrow = 16 * (w & 3) + (lane >> 2), vcol = (w >> 2) * 32 + (lane & 3) * 8;
    const bf16_t* ksrc = Pb + (size_t)(kbase + lane) * 1280 + 1024 + g * 64 + w * 8;
    const bf16_t* vsrc = Pb + (size_t)(kbase + vrow) * 1280 + 1152 + g * 64 + vcol;
    u32x4 kst[6], vst[6];
#pragma unroll
    for (int t = 0; t < 6; ++t) { const int tt = t < nt ? t : nt - 1;
        kst[t] = *(const GAS u32x4*)(ksrc + (size_t)tt * 64 * 1280); vst[t] = *(const GAS u32x4*)(vsrc + (size_t)tt * 64 * 1280); }
    bf16x8 qr[2][4];
#pragma unroll
    for (int ps = 0; ps < 2; ++ps) { const bf16_t* qrow = Pb + (size_t)(tq0 + r32) * 1280 + 512 + (4 * g + 2 * ps + (w >> 2)) * 64;
#pragma unroll
        for (int d0 = 0; d0 < 4; ++d0) qr[ps][d0] = *(const GAS bf16x8*)(qrow + 16 * d0 + 8 * hi); }
#pragma unroll
    for (int t = 0; t < 6; ++t) { *(LAS u32x4*)(lds + t * TB + w * 1024 + lane * 16) = kst[t]; *(LAS u32x4*)(lds + t * TB + 8192 + w * 1024 + lane * 16) = vst[t]; }
    __syncthreads();
    const int voff = 8192 + ((lane >> 4) & 1) * 32 + (lane & 3) * 8 + (4 * hi + ((lane & 15) >> 2)) * 64;
    const float qf = (float)(qpos0 + r32 - (128 * qblk - 128 + 64 * j_lo) - 4 * hi);
#pragma unroll
    for (int ps = 0; ps < 2; ++ps) {
        const int hq = 4 * g + 2 * ps + (w >> 2);
        float m_run = F.in[19][hq] * LOG2E, l_run = (hi == 0) ? 1.f : 0.f; const float slope2 = exp2f(-(float)(hq + 1)) * LOG2E;
        f32x16 o[2]; o[0] = f32x16{}; o[1] = f32x16{};
        for (int t = 0; t < nt; ++t) {
            const int q0 = qpos0 - (128 * qblk - 128 + 64 * j_lo), k0 = 64 * t;
            if (k0 + 63 < q0 - 128 || k0 > q0 + 31 + 128) continue;
            const bool inside = (k0 >= q0 - 97) && (k0 <= q0 + 65);
            const LAS unsigned char* kb = lds + t * TB + hi * 1024 + r32 * 16;
            f32x16 p0 = f32x16{}, p1 = f32x16{};
            { bf16x8 kf0[4], kf1[4];
#pragma unroll
              for (int d0 = 0; d0 < 4; ++d0) { kf0[d0] = *(const LAS bf16x8*)(kb + d0 * 2048); kf1[d0] = *(const LAS bf16x8*)(kb + d0 * 2048 + 512); }
#pragma unroll
              for (int d0 = 0; d0 < 4; ++d0) { p0 = __builtin_amdgcn_mfma_f32_32x32x16_bf16(kf0[d0], qr[ps][d0], p0, 0, 0, 0); p1 = __builtin_amdgcn_mfma_f32_32x32x16_bf16(kf1[d0], qr[ps][d0], p1, 0, 0, 0); } }
            s16x4 vl[8], vh[8];
            { const LAS unsigned char* vp_ = lds + t * TB + voff;
#pragma unroll
              for (int i_ = 0; i_ < 8; ++i_) { vl[i_] = vtr(vp_ + (i_ >> 2) * 4096 + (i_ & 3) * 1024); vh[i_] = vtr(vp_ + (i_ >> 2) * 4096 + (i_ & 3) * 1024 + 512); } }
            const float tq = qf - (float)k0;
            if (inside) {
#pragma unroll
                for (int r = 0; r < 16; ++r) { const float c = (float)((r & 3) + 8 * (r >> 2)); p0[r] = fmaf(-slope2, fabsf(tq - c), p0[r]); p1[r] = fmaf(-slope2, fabsf(tq - c - 32.f), p1[r]); }
            } else {
#pragma unroll
                for (int r = 0; r < 16; ++r) { const float c = (float)((r & 3) + 8 * (r >> 2)); const float d0_ = fabsf(tq - c), d1_ = fabsf(tq - c - 32.f);
                    p0[r] = (d0_ <= 128.f) ? fmaf(-slope2, d0_, p0[r]) : -1e30f; p1[r] = (d1_ <= 128.f) ? fmaf(-slope2, d1_, p1[r]) : -1e30f; }
            }
            float pmax = p0[0];
#pragma unroll
            for (int r = 1; r < 16; ++r) pmax = fmaxf(pmax, p0[r]);
#pragma unroll
            for (int r = 0; r < 16; ++r) pmax = fmaxf(pmax, p1[r]);
            pmax = xmax32(pmax);
            if (!__all(pmax - m_run <= ATT_THR)) {
                const float mn = fmaxf(m_run, pmax), alpha = fast_exp2(m_run - mn); m_run = mn; l_run *= alpha;
                if (hi == 0) wsf[r32] = alpha;
                LDS_WAIT(); asm volatile("" ::: "memory");
#pragma unroll
                for (int r = 0; r < 16; ++r) { const float a_ = wsf[crow(r, hi)]; o[0][r] *= a_; o[1][r] *= a_; }
            }
            f32x2 ps2 = {0.f, 0.f}; const f32x2 mm = {m_run, m_run};
#pragma unroll
            for (int r = 0; r < 16; r += 2) { const f32x2 a_ = (f32x2){p0[r], p0[r + 1]} - mm, b_ = (f32x2){p1[r], p1[r + 1]} - mm;
                p0[r] = fast_exp2(a_.x); p0[r + 1] = fast_exp2(a_.y); p1[r] = fast_exp2(b_.x); p1[r + 1] = fast_exp2(b_.y);
                ps2 += (f32x2){p0[r], p0[r + 1]} + (f32x2){p1[r], p1[r + 1]}; }
            l_run += ps2.x + ps2.y;
            u32x4 pw[4];
            pw[0] = (u32x4){pk2(p0[0], p0[1]), pk2(p0[2], p0[3]), pk2(p0[4], p0[5]), pk2(p0[6], p0[7])};
            pw[1] = (u32x4){pk2(p0[8], p0[9]), pk2(p0[10], p0[11]), pk2(p0[12], p0[13]), pk2(p0[14], p0[15])};
            pw[2] = (u32x4){pk2(p1[0], p1[1]), pk2(p1[2], p1[3]), pk2(p1[4], p1[5]), pk2(p1[6], p1[7])};
            pw[3] = (u32x4){pk2(p1[8], p1[9]), pk2(p1[10], p1[11]), pk2(p1[12], p1[13]), pk2(p1[14], p1[15])};
#pragma unroll
            for (int i_ = 0; i_ < 8; ++i_) { const bf16x8 vf = (bf16x8){vl[i_][0], vl[i_][1], vl[i_][2], vl[i_][3], vh[i_][0], vh[i_][1], vh[i_][2], vh[i_][3]};
                o[i_ >> 2] = __builtin_amdgcn_mfma_f32_32x32x16_bf16(__builtin_bit_cast(bf16x8, pw[i_ & 3]), vf, o[i_ >> 2], 0, 0, 0); }
        }
        const float lt = xsum32(l_run);
        if (hi == 0) wsf[32 + r32] = lt;
        LDS_WAIT(); asm volatile("" ::: "memory");
#pragma unroll
        for (int r = 0; r < 16; ++r) { const int orow = crow(r, hi); const float rl = fast_rcp(wsf[32 + orow]);
            stg[orow * 64 + r32] = (bf16_t)f2bf(o[0][r] * rl); stg[orow * 64 + 32 + r32] = (bf16_t)f2bf(o[1][r] * rl); }
        LDS_WAIT(); asm volatile("" ::: "memory");
        bf16_t* Ow = Ob + (size_t)tq0 * 1024 + 512 + hq * 64;
#pragma unroll
        for (int i = 0; i < 4; ++i) { const int row = i * 8 + (lane >> 3), ch = lane & 7; const u32x4 v = *(const LAS u32x4*)(stg + row * 64 + ch * 8); *(GAS u32x4*)(Ow + (size_t)row * 1024 + ch * 8) = v; }
        LDS_WAIT(); asm volatile("" ::: "memory");
    }
    __syncthreads();
}
template <int PROBE = 0> __device__ __forceinline__ void phase_attn(const Frame& F) {
#ifdef MK_MLA_OLD
    if (PROBE != 2) for (int u = F.vcu; u < 512; u += F.G) attn_unit<0, (PROBE >= 10 ? PROBE - 10 : 0)>(F, u);
    if (PROBE >= 10) return;
#else
    if (PROBE != 2) for (int u = F.vcu; u < 512; u += F.G) mla_unit(F, u);
#endif
    if (PROBE != 1) for (int u = F.vcu; u < 256; u += F.G) swa_unit(F, u);
}
}
namespace mk {
constexpr int N_PHASES = 14;
__global__ void __launch_bounds__(NTHR, 2) fwd_mega(Args args) {
    extern __shared__ __attribute__((aligned(16))) unsigned char lds_raw[];
    Frame F;
    F.lds = (LAS unsigned char*)lds_raw;
    F.tid = threadIdx.x; F.lane = F.tid & 63; F.wave = __builtin_amdgcn_readfirstlane(F.tid >> 6);
    F.G = gridDim.x; { const int bx = blockIdx.x; F.vcu = (F.G % 8 == 0) ? (bx % 8) * (F.G / 8) + bx / 8 : bx; }
    F.in = args.in; F.out = args.out; F.ws = args.ws;
    volatile LAS unsigned* MISC = (volatile LAS unsigned*)(F.lds + MISC_OFF);
    if (F.tid < 64) MISC[F.tid] = 0u;
    __syncthreads();
    unsigned* ctl = (unsigned*)(F.ws + WS_CTL);
    const int lo = args.ph_lo, hi = args.ph_hi;
    XcdBarrier bar; bar.bar = ctl + CW_BAR + args.li * XCD_BAR_WORDS; bar.x = 0; bar.st = nullptr;
    if (hi - lo > 1) bar = xcd_barrier_post(ctl + CW_BAR + args.li * XCD_BAR_WORDS, MISC + 8);
#ifndef MK_PHASE_MASK
#define MK_PHASE_MASK 0x3fff
#endif
#define IN(k) (((MK_PHASE_MASK >> (k)) & 1) && lo <= (k) && (k) < hi)
#ifndef MK_DUP_MASK
#define MK_DUP_MASK 0
#endif
#define REP(k) for (int rep_ = 0; rep_ <= ((MK_DUP_MASK >> (k)) & 1); ++rep_)
#define FRESH() do { int t_ = threadIdx.x; asm volatile("" : "+v"(t_)); F.tid = t_; F.lane = t_ & 63; F.wave = __builtin_amdgcn_readfirstlane(t_ >> 6); } while (0)
#ifdef MK_STRETCH_K
#define STRETCH_BEGIN(k) unsigned long long st0_ = 0; if ((k) == MK_STRETCH_K) st0_ = __builtin_amdgcn_s_memrealtime();
#define STRETCH_END(k) if ((k) == MK_STRETCH_K) { const unsigned long long d_ = __builtin_amdgcn_s_memrealtime() - st0_; const unsigned long long t1_ = __builtin_amdgcn_s_memrealtime(); while (__builtin_amdgcn_s_memrealtime() - t1_ < 3 * d_) __builtin_amdgcn_s_sleep(4); }
#else
#define STRETCH_BEGIN(k)
#define STRETCH_END(k)
#endif
#if defined(MK_STRETCH_K) && defined(MK_STRETCH_SEG)
#define STRETCH_END5(k) if ((k) == MK_STRETCH_K && ((MK_STRETCH_SEG == 1) ? (nseg_ == 1) : (nseg_ >= 2))) { const unsigned long long d_ = __builtin_amdgcn_s_memrealtime() - st0_; const unsigned long long t1_ = __builtin_amdgcn_s_memrealtime(); while (__builtin_amdgcn_s_memrealtime() - t1_ < 3 * d_) __builtin_amdgcn_s_sleep(4); }
#else
#define STRETCH_END5(k) STRETCH_END(k)
#endif
#define SEAM(k) do { if (IN(k) && IN((k) + 1)) xcd_barrier(bar); } while (0)
#ifdef MK_ROUTER_PHASE
    constexpr bool RSEL = false;
#define SEAM_R(k) SEAM(k)
#else
    constexpr bool RSEL = true;
#define SEAM_R(k) do { if (IN(k) && IN((k) + 2)) xcd_barrier(bar); } while (0)
#endif
    bf16_t* XB = (bf16_t*)(F.ws + WS_XB); bf16_t* MBp = (bf16_t*)(F.ws + WS_MB); bf16_t* Pp = (bf16_t*)(F.ws + WS_P);
    float* RS0 = (float*)(F.ws + WS_RS0);
    const f32x2* rope = (const f32x2*)(F.ws + WS_ROPE);
    const int bid = (int)blockIdx.x;

    if (IN(0)) REP(0) { FRESH(); STRETCH_BEGIN(0)
#ifdef MK_P0_PROBE
        if (rep_ > 0) phase_p0<MK_P0_PROBE>(F); else
#endif
        phase_p0<14>(F); STRETCH_END(0) } SEAM(0);
    if (IN(1)) REP(1) { FRESH(); STRETCH_BEGIN(1) pg8::Gemm g{XB, (const bf16_t*)(F.ws + WS_WINE), T, 2048, 1024, 1024, 1024}; pg8::StaticOrder So; So.init(T, 2048, F.G, bid);
        EpiE1 E{(bf16_t*)F.out, RS0}; pg8::gemm_phase<EpiE1, pg8::StaticOrder, true, true>(F.lds, g, So, E); STRETCH_END(1) } SEAM(1);
#ifdef MK_XBAR
    for (int xb_ = 0; xb_ < MK_XBAR; ++xb_) xcd_barrier(bar);
#endif
    if (IN(2)) REP(2) { FRESH(); STRETCH_BEGIN(2) phase_e2(F); STRETCH_END(2) } SEAM(2);
    if (IN(3)) REP(3) { FRESH(); STRETCH_BEGIN(3) pg8::Gemm g{MBp, (const bf16_t*)(F.ws + WS_WOUTE), T, 1024, 1024, 1024, 1024}; pg8::StaticOrder So; So.init(T, 1024, F.G, bid);
        EpiResR<RSEL> E{XB, (const _Float16*)(F.ws + WS_ROUTER16), (float*)(F.ws + WS_PART), F.ws, F.in[22], F.in[24], ctl + CW_ECNT, ctl + CW_PCNT}; pg8::gemm_phase<EpiResR<RSEL>, pg8::StaticOrder, true, true>(F.lds, g, So, E); STRETCH_END(3) } SEAM_R(3);
#ifdef MK_ROUTER_PHASE
    if (IN(4)) REP(4) { FRESH(); STRETCH_BEGIN(4) phase_router<true>(F, 0); STRETCH_END(4) } SEAM(4);
#endif
    if (IN(5)) REP(5) { FRESH(); STRETCH_BEGIN(5)
#ifdef MK_MOE_PROBE
        if (rep_ > 0) { phase_moe<MK_MOE_PROBE>(F, 0); } else
#endif
        { const int nseg_ = phase_moe<0>(F, 0); (void)nseg_; STRETCH_END5(5) } }
#ifdef MK_HO_BAR
    SEAM(5);
#endif
    if (IN(6)) REP(6) { FRESH(); STRETCH_BEGIN(6) combine_rows<false>(F);
 STRETCH_END(6) } SEAM(6);
#ifndef MK_O12_OFF
    if (IN(7)) REP(7) { FRESH(); STRETCH_BEGIN(7) pg8::Gemm g{XB, (const bf16_t*)(F.ws + WS_WINO), T, 1280, 1024, 1024, 1024}; O1mOrder So; So.init(bid);
        EpiO1 E{Pp, RS0, (float*)(F.ws + WS_SSQQ), (float*)(F.ws + WS_SSQKV), (bf16_t*)(F.ws + WS_KPE), rope};
        pg8::gemm_phase<EpiO1, O1mOrder, true, true>(F.lds, g, So, E);
        if (rep_ == 0 && ((bid >> 3) >= 24 || (bid >> 3) < 16)) { LAS float* scr = (LAS float*)(F.lds + F.wave * 16384); CvtRegs R;
            const int grp = (bid >> 3) >= 24 ? 0 : 1 + ((bid >> 3) >> 3); const int nw = 64 * NWAVES, gw = ((bid & 7) * 8 + ((bid >> 3) & 7)) * NWAVES + F.wave;
            const int it0 = grp == 0 ? 0 : 4096 + 1024 * (grp - 1), it1 = grp == 0 ? 4096 : it0 + 1024;
            int it = it0 + gw; if (it < it1) moe_cvt_load(F, 1, it, R);
            for (; it < it1; it += nw) { moe_cvt_stage(F, 1, it, R, scr); if (it + nw < it1) moe_cvt_load(F, 1, it + nw, R); moe_cvt_emit(F, 1, it, scr); } }
        STRETCH_END(7) }
    if (IN(7) && IN(8)) { asm volatile("s_waitcnt vmcnt(0)" ::: "memory"); __syncthreads(); }
    if (IN(8)) REP(8) { FRESH(); STRETCH_BEGIN(8) const int kK = (((bid >> 3) & 24) == 8) ? 128 : 256;
        pg8::Gemm g{Pp, (const bf16_t*)(F.ws + WS_WUQ), T, 1792, kK, 1280, 256}; O2mOrder So; So.init(bid);
        EpiO2 E{(bf16_t*)(F.ws + WS_Q), (bf16_t*)(F.ws + WS_KV), (const float*)(F.ws + WS_SSQQ), (const float*)(F.ws + WS_SSQKV)};
        pg8::gemm_phase<EpiO2, O2mOrder, true, true>(F.lds, g, So, E);
    STRETCH_END(8) } SEAM(8);
#else
    if (IN(7)) REP(7) { FRESH(); STRETCH_BEGIN(7) pg8::Gemm g{XB, (const bf16_t*)(F.ws + WS_WINO), T, 1280, 1024, 1024, 1024}; pg8::StaticOrder So; So.init(T, 1280, F.G, bid);
        EpiO1 E{Pp, RS0, (float*)(F.ws + WS_SSQQ), (float*)(F.ws + WS_SSQKV), (bf16_t*)(F.ws + WS_KPE), rope};
        pg8::gemm_phase<EpiO1, pg8::StaticOrder, true, true>(F.lds, g, So, E);
        if (rep_ == 0 && (F.G != 256 || bid >= 64)) { LAS float* scr = (LAS float*)(F.lds + F.wave * 16384); CvtRegs R;
            const int nw = (F.G == 256) ? 192 * NWAVES : F.G * NWAVES, gw = ((F.G == 256) ? (bid - 64) : bid) * NWAVES + F.wave;
            int it = gw; if (it < MOE_CVT_ITEMS) moe_cvt_load(F, 1, it, R);
            for (; it < MOE_CVT_ITEMS; it += nw) { moe_cvt_stage(F, 1, it, R, scr); if (it + nw < MOE_CVT_ITEMS) moe_cvt_load(F, 1, it + nw, R); moe_cvt_emit(F, 1, it, scr); } } STRETCH_END(7) } SEAM(7);
    if (IN(8)) REP(8) { FRESH(); STRETCH_BEGIN(8) pg8::Gemm g{Pp, (const bf16_t*)(F.ws + WS_WUQ), T, 1792, 256, 1280, 256}; O2Order So; So.init(T, 1792, F.G, bid);
        EpiO2 E{(bf16_t*)(F.ws + WS_Q), (bf16_t*)(F.ws + WS_KV), (const float*)(F.ws + WS_SSQQ), (const float*)(F.ws + WS_SSQKV)};
        pg8::gemm_phase<EpiO2, O2Order, true, true>(F.lds, g, So, E);
    STRETCH_END(8) } SEAM(8);
#endif
    if (IN(9)) REP(9) { FRESH(); STRETCH_BEGIN(9)
#ifdef MK_ATT_PROBE
        if (rep_ > 0) phase_attn<MK_ATT_PROBE>(F); else
#endif
        phase_attn<0>(F); STRETCH_END(9) } SEAM(9);
    if (IN(10)) REP(10) { FRESH(); STRETCH_BEGIN(10) pg8::Gemm g{MBp, (const bf16_t*)(F.ws + WS_WOUTO), T, 1024, 1024, 1024, 1024}; pg8::StaticOrder So; So.init(T, 1024, F.G, bid);
        EpiResR<RSEL> E{XB, (const _Float16*)(F.ws + WS_ROUTER16) + 49152, (float*)(F.ws + WS_PART), F.ws, F.in[22] + 4, F.in[24] + 32, ctl + CW_ECNT + 32 * 64, ctl + CW_PCNT + 64 * 16}; pg8::gemm_phase<EpiResR<RSEL>, pg8::StaticOrder, true, true>(F.lds, g, So, E); STRETCH_END(10) } SEAM_R(10);
#ifdef MK_ROUTER_PHASE
    if (IN(11)) REP(11) { FRESH(); STRETCH_BEGIN(11) phase_router<true>(F, 1); STRETCH_END(11) } SEAM(11);
#endif
    if (IN(12)) REP(12) { FRESH(); STRETCH_BEGIN(12) phase_moe<0>(F, 1); STRETCH_END(12) }
#ifdef MK_HO_BAR
    SEAM(12);
#endif
#ifdef MK_XCC_CHECK
    if (xb_xcc_id() != ((unsigned)blockIdx.x & 7u) && threadIdx.x == 0) atomicAdd(ctl + CW_TMO + 5, 1u);
#endif
    if (IN(13)) REP(13) { FRESH(); STRETCH_BEGIN(13) combine_rows<true>(F); STRETCH_END(13) }
#ifdef MK_XCC_CHECK
    { xcd_barrier(bar); const unsigned bad = __hip_atomic_load(ctl + CW_TMO + 5, __ATOMIC_RELAXED, __HIP_MEMORY_SCOPE_AGENT);
      if (bad) { for (int i = blockIdx.x * NTHR + threadIdx.x; i < T * D; i += gridDim.x * NTHR) F.out[i] *= (bad >= 128u ? 3.f : 2.f); } }
#endif
#undef IN
#undef SEAM
}

static int g_grid = 0;
static bool setup() {
    if (g_grid) return g_grid > 0;
    int dev = 0, cus = 0;
    if (hipGetDevice(&dev) != hipSuccess || hipDeviceGetAttribute(&cus, hipDeviceAttributeMultiprocessorCount, dev) != hipSuccess) { g_grid = -1; return false; }
    if (hipFuncSetAttribute((const void*)fwd_mega, hipFuncAttributeMaxDynamicSharedMemorySize, LDS_BYTES) != hipSuccess) { fprintf(stderr, "hipFuncSetAttribute failed\n"); g_grid = -1; return false; }
    int per_cu = 0;
    if (hipOccupancyMaxActiveBlocksPerMultiprocessor(&per_cu, (const void*)fwd_mega, NTHR, LDS_BYTES) != hipSuccess || per_cu < 1) { fprintf(stderr, "occupancy query: %d\n", per_cu); }
    (void)hipGetLastError();
    if (cus != 256) { fprintf(stderr, "fwd_mega is laid out for 256 CUs (one E3 / O4 tile per workgroup), found %d\n", cus); g_grid = -1; return false; }
    g_grid = cus;
    return true;
}
static void launch_range(void* const* d_in, float* out, unsigned char* ws, int lo, int hi, hipStream_t st, int li = 0) {
    Args a{};
    for (int i = 0; i < 28; ++i) a.in[i] = (const float*)d_in[i];
    a.out = out; a.ws = ws; a.ph_lo = lo; a.ph_hi = hi; a.li = li;
    hipLaunchKernelGGL(fwd_mega, dim3(g_grid), dim3(NTHR), LDS_BYTES, st, a);
}
}
extern "C" void kernel_launch(void* const* d_in, const int* in_sizes, int n_in, void* d_out, int out_size, void* d_ws, size_t ws_size, hipStream_t stream) {
    if (n_in != 28 || out_size != mk::T * mk::D || ws_size < mk::WS_END) { fprintf(stderr, "kernel_launch: unexpected shapes n_in %d out %d ws %zu\n", n_in, out_size, ws_size); return; }
    if (!mk::setup()) return;
    if (hipMemsetAsync((unsigned char*)d_ws + mk::WS_CTL, 0, mk::CTL_ZERO_BYTES, stream) != hipSuccess) { fprintf(stderr, "kernel_launch: memset failed\n"); return; }
#ifdef MK_SPLIT_K
    mk::launch_range(d_in, (float*)d_out, (unsigned char*)d_ws, 0, MK_SPLIT_K + 1, stream, 0);
#ifndef MK_SPLIT_NOREP
    mk::launch_range(d_in, (float*)d_out, (unsigned char*)d_ws, MK_SPLIT_K, MK_SPLIT_K + 1, stream);
#endif
    mk::launch_range(d_in, (float*)d_out, (unsigned char*)d_ws, MK_SPLIT_K + 1, mk::N_PHASES, stream, 1);
#else
    mk::launch_range(d_in, (float*)d_out, (unsigned char*)d_ws, 0, mk::N_PHASES, stream);
#endif
}
```
